# Optimizing an MI355X kernel written in HIP

```python
import math
import jax
import jax.numpy as jnp
from jax import lax
import numpy as np

D_MODEL = 1024
BATCH = 4
SEQ = 8192
DEPTH = 1

D_MIX = D_MODEL
ML_HEADS = 4
ML_DH = D_MIX // (2 * ML_HEADS)
ML_W = ML_HEADS * ML_DH
ML_CHUNK = 128
CONV_K = 4
DA_HEADS = 4
DA_DH = D_MIX // (4 * DA_HEADS)
DA_W = DA_HEADS * 2 * DA_DH
Q_BLOCK = 128
N_EXPERTS = 256
TOP_K = 8
N_GROUPS = 8
TOPK_GROUPS = 4
D_EXPERT = D_MODEL // 4
D_SHARED = D_EXPERT
ROUTED_SCALE = 2.5
MOE_BLOCK = 128
EPS = 1e-6
COL_SPLITS = (2 * ML_W, 3 * ML_W, 4 * ML_W, 4 * ML_W + ML_HEADS, 4 * ML_W + 2 * ML_HEADS,
              4 * ML_W + 2 * ML_HEADS + DA_W, 4 * ML_W + 2 * ML_HEADS + 2 * DA_W)
D_IN = 4 * ML_W + 2 * ML_HEADS + 3 * DA_W

kernel_name = 'hybrid_mlstm_diffattn_moe_layer'


def rms_norm(x, eps=EPS):
    xf = x.astype(jnp.float32)
    return (xf * lax.rsqrt(jnp.mean(xf * xf, axis=-1, keepdims=True) + eps)).astype(x.dtype)


def lambda_init(layer):
    return 0.8 - 0.6 * math.exp(-0.3 * layer)


def alibi_slopes(n):
    return 2.0 ** (-8.0 * jnp.arange(1, n + 1, dtype=jnp.float32) / n)


def causal_depthwise_conv(u, w, b):
    S = u.shape[1]
    up = jnp.pad(u, ((0, 0), (CONV_K - 1, 0), (0, 0)))
    out = b
    for j in range(CONV_K):
        out = out + w[j] * up[:, j:j + S, :]
    return out


def mlstm_chunkwise(q, k, v, i_pre, f_pre):
    B, S, H, DH = q.shape
    L = ML_CHUNK
    NC = S // L

    def to_chunks(t):
        t = t.astype(jnp.float32).reshape((B, NC, L, H) + t.shape[3:])
        return jnp.moveaxis(t, (1, 3), (0, 2))

    qc = to_chunks(q)
    kc = to_chunks(k) * (DH ** -0.5)
    vc = to_chunks(v)
    ic = to_chunks(i_pre)
    lfc = jax.nn.log_sigmoid(to_chunks(f_pre))
    causal = jnp.tril(jnp.ones((L, L), dtype=bool))

    def step(carry, xs):
        C, n, m = carry
        qb, kb, vb, ib, lfb = xs
        b = jnp.cumsum(lfb, axis=-1)
        d_intra = jnp.where(causal, b[..., :, None] - b[..., None, :] + ib[..., None, :], -jnp.inf)
        d_inter = b + m[..., None]
        m_t = jnp.maximum(d_inter, jnp.max(d_intra, axis=-1))
        w_intra = jnp.exp(d_intra - m_t[..., None])
        w_inter = jnp.exp(d_inter - m_t)
        s = jnp.einsum('bhtd,bhsd->bhts', qb, kb) * w_intra
        num = (w_inter[..., None] * jnp.einsum('bhtd,bhde->bhte', qb, C)
               + jnp.einsum('bhts,bhse->bhte', s, vb))
        den = w_inter * jnp.einsum('bhtd,bhd->bht', qb, n) + jnp.sum(s, axis=-1)
        h = num / jnp.maximum(jnp.abs(den), jnp.exp(-m_t))[..., None]
        b_last = b[..., -1]
        d_state = b_last[..., None] - b + ib
        m_new = jnp.maximum(b_last + m, jnp.max(d_state, axis=-1))
        carry_scale = jnp.exp(b_last + m - m_new)
        wk = jnp.exp(d_state - m_new[..., None])
        C_new = carry_scale[..., None, None] * C + jnp.einsum('bhs,bhsd,bhse->bhde', wk, kb, vb)
        n_new = carry_scale[..., None] * n + jnp.einsum('bhs,bhsd->bhd', wk, kb)
        return (C_new, n_new, m_new), h

    init = (jnp.zeros((B, H, DH, DH), jnp.float32),
            jnp.zeros((B, H, DH), jnp.float32),
            jnp.zeros((B, H), jnp.float32))
    _, h = lax.scan(step, init, (qc, kc, vc, ic, lfc))
    return jnp.moveaxis(h, (0, 2), (1, 3)).reshape(B, S, H, DH)


def diff_attention(q, k, v, lam, slopes):
    B, S, H, _, d = q.shape
    nq = S // Q_BLOCK
    qh = jnp.transpose(q, (0, 2, 3, 1, 4))
    kh = jnp.transpose(k, (0, 2, 3, 1, 4))
    vh = jnp.transpose(v, (0, 2, 1, 3))
    q_blocks = jnp.moveaxis(qh.reshape(B, H, 2, nq, Q_BLOCK, d), 3, 0)
    kpos = jnp.arange(S, dtype=jnp.int32)
    scale = d ** -0.5

    def one_block(args):
        qb, qi = args
        qpos = qi * Q_BLOCK + jnp.arange(Q_BLOCK, dtype=jnp.int32)
        dist = (qpos[:, None] - kpos[None, :]).astype(jnp.float32)
        s = jnp.einsum('bhcqd,bhckd->bhcqk', qb, kh).astype(jnp.float32) * scale
        s = jnp.where(dist >= 0, s - slopes[None, :, None, None, None] * dist, -jnp.inf)
        p = jax.nn.softmax(s, axis=-1)
        a = p[:, :, 0] - lam * p[:, :, 1]
        return jnp.einsum('bhqk,bhke->bhqe', a.astype(vh.dtype), vh)

    o = lax.map(one_block, (q_blocks, jnp.arange(nq, dtype=jnp.int32)))
    return jnp.transpose(o, (1, 0, 3, 2, 4)).reshape(B, S, H, 2 * d)


def swiglu(h, w1, w3, w2):
    return (jax.nn.silu(h @ w1) * (h @ w3)) @ w2


def routed_moe(h, w_router, router_bias, w1, w3, w2, ws1, ws3, ws2):
    T, D = h.shape
    s = jax.nn.sigmoid((h @ w_router).astype(jnp.float32))
    sel = s + router_bias
    g = sel.reshape(T, N_GROUPS, N_EXPERTS // N_GROUPS)
    group_score = jnp.sum(lax.top_k(g, 2)[0], axis=-1)
    _, top_groups = lax.top_k(group_score, TOPK_GROUPS)
    group_mask = jnp.sum(jax.nn.one_hot(top_groups, N_GROUPS, dtype=jnp.float32), axis=1) > 0
    expert_mask = jnp.repeat(group_mask, N_EXPERTS // N_GROUPS, axis=-1)
    _, idx = lax.top_k(jnp.where(expert_mask, sel, -jnp.inf), TOP_K)
    gate = jnp.take_along_axis(s, idx, axis=-1)
    gate = gate / jnp.sum(gate, axis=-1, keepdims=True) * ROUTED_SCALE

    TK = T * TOP_K
    flat_e = idx.reshape(-1)
    flat_tok = jnp.repeat(jnp.arange(T, dtype=jnp.int32), TOP_K)
    flat_w = gate.reshape(-1).astype(h.dtype)
    order = jnp.argsort(flat_e)
    sorted_e = flat_e[order]
    counts = jnp.bincount(flat_e, length=N_EXPERTS)
    padded = (counts + MOE_BLOCK - 1) // MOE_BLOCK * MOE_BLOCK
    pad_end = jnp.cumsum(padded)
    pad_start = pad_end - padded
    start = jnp.cumsum(counts) - counts
    dest = pad_start[sorted_e] + jnp.arange(TK, dtype=jnp.int32) - start[sorted_e]
    n_pad = -(-TK // MOE_BLOCK) * MOE_BLOCK + N_EXPERTS * MOE_BLOCK
    n_blocks = n_pad // MOE_BLOCK
    slot_tok = jnp.full((n_pad,), T, jnp.int32).at[dest].set(flat_tok[order])
    slot_w = jnp.zeros((n_pad,), h.dtype).at[dest].set(flat_w[order])
    block_e = jnp.minimum(
        jnp.searchsorted(pad_end, jnp.arange(n_blocks, dtype=jnp.int32) * MOE_BLOCK, side='right'),
        N_EXPERTS - 1)
    h_pad = jnp.concatenate([h, jnp.zeros((1, D), h.dtype)], axis=0)

    def expert_block(args):
        tok, wt, e = args
        xb = h_pad[tok]
        return swiglu(xb, w1[e], w3[e], w2[e]) * wt[:, None]

    out = lax.map(expert_block, (slot_tok.reshape(n_blocks, MOE_BLOCK),
                                 slot_w.reshape(n_blocks, MOE_BLOCK), block_e))
    routed = jnp.zeros((T + 1, D), h.dtype).at[slot_tok].add(out.reshape(n_pad, D))[:T]
    return routed + swiglu(h, ws1, ws3, ws2)


def setup_inputs(seed: int = 0) -> dict:
    key = jax.random.key(seed)
    ks = jax.random.split(key, 25)
    f32 = jnp.float32
    L = DEPTH

    def nrm(k, shape, scale):
        return jax.random.normal(k, shape, f32) * scale

    f_bias = jnp.linspace(3.0, 6.0, ML_HEADS, dtype=f32)
    gate_b = jnp.concatenate([nrm(ks[7], (L, ML_HEADS), 0.1),
                              f_bias[None, :] + nrm(ks[8], (L, ML_HEADS), 0.1)], axis=-1)
    return {
        'x': nrm(ks[0], (BATCH, SEQ, D_MODEL), 1.0),
        'c': nrm(ks[1], (BATCH, D_MODEL), 1.0),
        'w_ada': nrm(ks[2], (L, D_MODEL, 6 * D_MODEL), 0.5 * D_MODEL ** -0.5),
        'b_ada': nrm(ks[3], (L, 6 * D_MODEL), 0.02),
        'w_in': nrm(ks[4], (L, D_MODEL, D_IN), D_MODEL ** -0.5),
        'conv_w': nrm(ks[5], (L, CONV_K, 2 * ML_W), CONV_K ** -0.5),
        'conv_b': nrm(ks[6], (L, 2 * ML_W), 0.02),
        'gate_b': gate_b,
        'ml_norm_g': 1.0 + nrm(ks[9], (L, ML_DH), 0.02),
        'da_q_norm_g': 1.0 + nrm(ks[10], (L, DA_DH), 0.02),
        'da_k_norm_g': 1.0 + nrm(ks[11], (L, DA_DH), 0.02),
        'lambda_q1': nrm(ks[12], (L, DA_DH), 0.1),
        'lambda_k1': nrm(ks[13], (L, DA_DH), 0.1),
        'lambda_q2': nrm(ks[14], (L, DA_DH), 0.1),
        'lambda_k2': nrm(ks[15], (L, DA_DH), 0.1),
        'da_norm_g': 1.0 + nrm(ks[16], (L, 2 * DA_DH), 0.02),
        'w_out': nrm(ks[17], (L, D_MIX, D_MODEL), D_MIX ** -0.5),
        'w_router': nrm(ks[18], (L, D_MODEL, N_EXPERTS), D_MODEL ** -0.5),
        'router_bias': nrm(ks[19], (L, N_EXPERTS), 0.01),
        'w1': nrm(ks[20], (L, N_EXPERTS, D_MODEL, D_EXPERT), D_MODEL ** -0.5),
        'w3': nrm(ks[21], (L, N_EXPERTS, D_MODEL, D_EXPERT), D_MODEL ** -0.5),
        'w2': nrm(ks[22], (L, N_EXPERTS, D_EXPERT, D_MODEL), D_EXPERT ** -0.5),
        'ws1': nrm(ks[23], (L, D_MODEL, D_SHARED), D_MODEL ** -0.5),
        'ws3': nrm(ks[24], (L, D_MODEL, D_SHARED), D_MODEL ** -0.5),
        'ws2': nrm(jax.random.fold_in(ks[24], 1), (L, D_SHARED, D_MODEL), D_SHARED ** -0.5),
    }


def reference(x, c, w_ada, b_ada, w_in, conv_w, conv_b, gate_b, ml_norm_g, da_q_norm_g, da_k_norm_g,
              lambda_q1, lambda_k1, lambda_q2, lambda_k2, da_norm_g, w_out, w_router, router_bias,
              w1, w3, w2, ws1, ws3, ws2):
    B, S, D = x.shape
    slopes = alibi_slopes(DA_HEADS)
    for l in range(DEPTH):
        lam_init = lambda_init(l)
        mod = (jax.nn.silu(c) @ w_ada[l] + b_ada[l]).reshape(B, 6, 1, D)
        shift_a, scale_a, gate_a = mod[:, 0], mod[:, 1], mod[:, 2]
        shift_f, scale_f, gate_f = mod[:, 3], mod[:, 4], mod[:, 5]

        h = rms_norm(x) * (1.0 + scale_a) + shift_a
        proj = h @ w_in[l]
        qk_raw, mv, mo, mi, mf, dq, dk, dv = jnp.split(proj, COL_SPLITS, axis=-1)

        qk = jax.nn.silu(causal_depthwise_conv(qk_raw, conv_w[l], conv_b[l]))
        mq, mk = jnp.split(qk, 2, axis=-1)
        hm = mlstm_chunkwise(mq.reshape(B, S, ML_HEADS, ML_DH),
                             mk.reshape(B, S, ML_HEADS, ML_DH),
                             mv.reshape(B, S, ML_HEADS, ML_DH),
                             mi + gate_b[l, :ML_HEADS],
                             mf + gate_b[l, ML_HEADS:])
        hm = rms_norm(hm) * ml_norm_g[l] * jax.nn.sigmoid(mo.reshape(B, S, ML_HEADS, ML_DH).astype(jnp.float32))

        dq = rms_norm(dq.reshape(B, S, DA_HEADS, 2, DA_DH)) * da_q_norm_g[l]
        dk = rms_norm(dk.reshape(B, S, DA_HEADS, 2, DA_DH)) * da_k_norm_g[l]
        lam = (jnp.exp(jnp.sum(lambda_q1[l].astype(jnp.float32) * lambda_k1[l].astype(jnp.float32)))
               - jnp.exp(jnp.sum(lambda_q2[l].astype(jnp.float32) * lambda_k2[l].astype(jnp.float32)))
               + lam_init)
        hd = diff_attention(dq, dk, dv.reshape(B, S, DA_HEADS, 2 * DA_DH), lam, slopes)
        hd = rms_norm(hd) * da_norm_g[l] * (1.0 - lam_init)

        mix = jnp.concatenate([hm.reshape(B, S, ML_W).astype(x.dtype),
                               hd.reshape(B, S, DA_W).astype(x.dtype)], axis=-1) @ w_out[l]
        x = x + gate_a * mix

        h2 = rms_norm(x) * (1.0 + scale_f) + shift_f
        y = routed_moe(h2.reshape(B * S, D), w_router[l], router_bias[l], w1[l], w3[l], w2[l],
                       ws1[l], ws3[l], ws2[l]).reshape(B, S, D)
        x = x + gate_f * y
    return x
```

```cpp
#include <hip/hip_runtime.h>
#include <hip/hip_cooperative_groups.h>
#include <cstdio>
#include <cstdint>
namespace cg = cooperative_groups;

typedef unsigned short bf16_t;
typedef short bf16x8 __attribute__((ext_vector_type(8)));
typedef float f32x4 __attribute__((ext_vector_type(4)));
typedef unsigned u32x4 __attribute__((ext_vector_type(4)));
typedef unsigned u32x2 __attribute__((ext_vector_type(2)));

#ifndef ONE_LAUNCH
#define ONE_LAUNCH 1
#endif
#ifndef DBG_LAST_PHASE
#define DBG_LAST_PHASE 14
#endif
#ifndef DBG_DUMP
#define DBG_DUMP 0
#define DBG_M3 0
#define DBG_TWICE 0
#define DBG_REP_LO 5
#define DBG_SKIP_ATTN 0
#endif
#ifndef USE_CG_SYNC
#define USE_CG_SYNC 1
#endif

constexpr int T = 32768, DM = 1024, SEQ = 8192;
constexpr int NPROJ = 3584, DIN = 3592;
constexpr int TOPK = 8, TK = T * TOPK;
constexpr int SHARED_BASE = TK;
constexpr float EPS = 1e-6f;
constexpr float LOG2E = 1.4426950408889634f;
constexpr float C2 = 0.125f * LOG2E;
constexpr float LAM_INIT = 0.2f;
constexpr int NPH = 14;
constexpr int LDS_BYTES = 155648;

constexpr size_t MiB = 1ull << 20;
constexpr size_t WS_MOD = 0;
constexpr size_t WS_TILE = 128 * 1024;
constexpr size_t WS_HIST = 256 * 1024;
constexpr size_t WS_BAR = 512 * 1024;
constexpr size_t BAR_BYTES = 16384;
constexpr size_t WS_IPRE = 1 * MiB, WS_FPRE = 1 * MiB + 512 * 1024;
constexpr size_t WS_IDX = 2 * MiB, WS_GATEV = 3 * MiB, WS_PSLOT = 4 * MiB, WS_SLOTTOK = 5 * MiB, WS_SLOTGATE = 7 * MiB;
constexpr size_t WS_MST = 9 * MiB;
constexpr size_t WS_WIN = 12 * MiB, WS_WOUT = 19 * MiB, WS_WRS = 21 * MiB, WS_W2T = 23 * MiB;
constexpr size_t WS_H = 152 * MiB, WS_ACT = 216 * MiB, WS_MIX = 361 * MiB, WS_PROJ = 425 * MiB, WS_CLOC = 649 * MiB, WS_CIN = 713 * MiB, WS_W13T = 745 * MiB, WS_END = 1001 * MiB;
constexpr size_t WS_YP = WS_MIX;
constexpr size_t WS_LOGITS = WS_CLOC;
constexpr size_t WS_TMP = WS_ACT;

struct Args { const float* in[25]; float* out; unsigned char* ws; int ph_lo, ph_hi; };

__device__ __forceinline__ float bflo(unsigned v) { return __uint_as_float(v << 16); }
__device__ __forceinline__ float bfhi(unsigned v) { return __uint_as_float(v & 0xffff0000u); }
__device__ __forceinline__ unsigned f2bf(float f) { unsigned u = __float_as_uint(f); return (u + 0x7fffu + ((u >> 16) & 1u)) >> 16; }
__device__ __forceinline__ unsigned pk2(float lo, float hi) { return f2bf(lo) | (f2bf(hi) << 16); }
__device__ __forceinline__ float wave_sum(float v) {
#pragma unroll
    for (int o = 1; o < 64; o <<= 1) v += __shfl_xor(v, o);
    return v;
}
__device__ __forceinline__ float siluf(float x) { return x / (1.f + __expf(-x)); }
__device__ __forceinline__ float sigm(float x) { return 1.f / (1.f + __expf(-x)); }
__device__ __forceinline__ void unpack8(const u32x4 v, float (&x)[8]) {
    x[0] = bflo(v.x); x[1] = bfhi(v.x); x[2] = bflo(v.y); x[3] = bfhi(v.y); x[4] = bflo(v.z); x[5] = bfhi(v.z); x[6] = bflo(v.w); x[7] = bfhi(v.w);
}
__device__ __forceinline__ u32x4 pack8(const float (&x)[8]) { u32x4 o; o.x = pk2(x[0], x[1]); o.y = pk2(x[2], x[3]); o.z = pk2(x[4], x[5]); o.w = pk2(x[6], x[7]); return o; }

__device__ __forceinline__ void conv_item(const float* __restrict__ s0, const float* __restrict__ s1, int ldn, int k0, int n0, bool inter,
                                          bf16_t* dst, int ldk, int c0, float* scr, int lane) {
    const float* p = (inter && lane >= 32) ? (s1 + n0 + (lane - 32)) : (s0 + n0 + lane);
    p += (size_t)k0 * ldn;
#pragma unroll 8
    for (int i = 0; i < 64; ++i) scr[i * 65 + lane] = p[(size_t)i * ldn];
    const int c = lane & 7;
#pragma unroll
    for (int j = 0; j < 8; ++j) {
        const int n = (lane >> 3) + 8 * j;
        const float* s = scr + (8 * c) * 65 + n;
        u32x4 o; o.x = pk2(s[0], s[65]); o.y = pk2(s[130], s[195]); o.z = pk2(s[260], s[325]); o.w = pk2(s[390], s[455]);
        const int drow = inter ? (c0 + ((n & 31) >> 2) * 8 + (n >> 5) * 4 + (n & 3)) : (c0 + n);
        *(u32x4*)(dst + (size_t)drow * ldk + k0 + 8 * c) = o;
    }
}

__device__ __forceinline__ void ph0(const Args& a, unsigned char* lds) {
    const int tid = threadIdx.x, lane = tid & 63, wave = tid >> 6;
    const float* c_in = a.in[1]; const float* w_ada = a.in[2]; const float* b_ada = a.in[3];
    float* MOD = (float*)(a.ws + WS_MOD);
    {
        float* sc = (float*)lds; float* red = sc + 4096;
        for (int i = tid; i < 4096; i += 512) sc[i] = siluf(c_in[i]);
        __syncthreads();
        for (int it = blockIdx.x; it < 192; it += gridDim.x) {
            const int cc = tid & 31, ks = tid >> 5, col = it * 32 + cc;
            float a0 = 0.f, a1 = 0.f, a2 = 0.f, a3 = 0.f;
            const float* wp = w_ada + (size_t)(ks * 64) * 6144 + col;
#pragma unroll 8
            for (int k = 0; k < 64; ++k) { const float w = wp[(size_t)k * 6144]; const int kk = ks * 64 + k;
                a0 += sc[kk] * w; a1 += sc[1024 + kk] * w; a2 += sc[2048 + kk] * w; a3 += sc[3072 + kk] * w; }
            float* rp = red + (ks * 32 + cc) * 4; rp[0] = a0; rp[1] = a1; rp[2] = a2; rp[3] = a3;
            __syncthreads();
            if (tid < 128) { const int c2 = tid & 31, b = tid >> 5; float s = 0.f;
                for (int k2 = 0; k2 < 16; ++k2) s += red[(k2 * 32 + c2) * 4 + b];
                MOD[b * 6144 + it * 32 + c2] = s + b_ada[it * 32 + c2]; }
            __syncthreads();
        }
    }
    __syncthreads();
    float* scr = (float*)lds + wave * (64 * 65);
    const int gw = blockIdx.x * 8 + wave, NGW = gridDim.x * 8;
    const float* w_in = a.in[4]; const float* w_out = a.in[16]; const float* w_router = a.in[17];
    const float* w1 = a.in[19]; const float* w3 = a.in[20]; const float* w2 = a.in[21];
    const float* ws1 = a.in[22]; const float* ws3 = a.in[23]; const float* ws2 = a.in[24];
    bf16_t* WIN = (bf16_t*)(a.ws + WS_WIN); bf16_t* WOUT = (bf16_t*)(a.ws + WS_WOUT); bf16_t* WRS = (bf16_t*)(a.ws + WS_WRS);
    bf16_t* W2T = (bf16_t*)(a.ws + WS_W2T); bf16_t* W13T = (bf16_t*)(a.ws + WS_W13T);
    constexpr int IT_WIN = 56 * 16, IT_WOUT = 16 * 16, IT_WR = 4 * 16, IT_WS13 = 8 * 16, IT_WS2 = 4 * 16, IT_E13 = 256 * 128, IT_E2 = 256 * 64;
    constexpr int NITEMS = IT_WIN + IT_WOUT + IT_WR + IT_WS13 + IT_WS2 + IT_E13 + IT_E2;
    for (int it = gw; it < NITEMS; it += NGW) {
        int r = it;
        if (r < IT_WIN) { const int kb = r / 56, cb = r % 56, c0 = 64 * cb, n0 = c0 + (c0 >= 2048 ? 8 : 0);
            conv_item(w_in, w_in, DIN, 64 * kb, n0, false, WIN, 1024, c0, scr, lane); continue; } r -= IT_WIN;
        if (r < IT_WOUT) { const int kb = r / 16, cb = r % 16; conv_item(w_out, w_out, 1024, 64 * kb, 64 * cb, false, WOUT, 1024, 64 * cb, scr, lane); continue; } r -= IT_WOUT;
        if (r < IT_WR) { const int kb = r / 4, cb = r % 4; conv_item(w_router, w_router, 256, 64 * kb, 64 * cb, false, WRS, 1024, 64 * cb, scr, lane); continue; } r -= IT_WR;
        if (r < IT_WS13) { const int kb = r / 8, cb = r % 8; conv_item(ws1, ws3, 256, 64 * kb, 32 * cb, true, WRS + (size_t)256 * 1024, 1024, 64 * cb, scr, lane); continue; } r -= IT_WS13;
        if (r < IT_WS2) { const int kb = r / 16, cb = r % 16; conv_item(ws2, ws2, 1024, 64 * kb, 64 * cb, false, W2T + (size_t)256 * 1024 * 256, 256, 64 * cb, scr, lane); continue; } r -= IT_WS2;
        if (r < IT_E13) { const int e = r >> 7, rr = r & 127, kb = rr >> 3, cb = rr & 7;
            conv_item(w1 + (size_t)e * 1024 * 256, w3 + (size_t)e * 1024 * 256, 256, 64 * kb, 32 * cb, true, W13T + (size_t)e * 512 * 1024, 1024, 64 * cb, scr, lane); continue; } r -= IT_E13;
        { const int e = r >> 6, rr = r & 63, kb = rr >> 4, cb = rr & 15;
            conv_item(w2 + (size_t)e * 256 * 1024, w2, 1024, 64 * kb, 64 * cb, false, W2T + (size_t)e * 1024 * 256, 256, 64 * cb, scr, lane); }
    }
}

template <bool GATES>
__device__ __forceinline__ void ph_norm(const Args& a, unsigned char* lds, const float* X, int mod_shift, int mod_scale) {
    const int tid = threadIdx.x, lane = tid & 63, wave = tid >> 6;
    const float* MOD = (const float*)(a.ws + WS_MOD);
    bf16_t* H = (bf16_t*)(a.ws + WS_H);
    float* wg = (float*)lds;
    if (GATES) {
        const float* w_in = a.in[4];
        for (int i = tid; i < 8192; i += 512) { const int k = i >> 3, g = i & 7; wg[g * 1024 + k] = w_in[(size_t)k * DIN + 2048 + g]; }
        __syncthreads();
    }
    const float* gate_b = a.in[7];
    float* IPRE = (float*)(a.ws + WS_IPRE); float* FPRE = (float*)(a.ws + WS_FPRE);
    const int gw = blockIdx.x * 8 + wave, NGW = gridDim.x * 8;
    for (int row = gw; row < T; row += NGW) {
        const int b = row / SEQ;
        const f32x4* xr = (const f32x4*)(X + (size_t)row * DM) + lane;
        f32x4 v[4]; float ss = 0.f;
#pragma unroll
        for (int j = 0; j < 4; ++j) { v[j] = xr[64 * j]; ss += (v[j].x * v[j].x + v[j].y * v[j].y) + (v[j].z * v[j].z + v[j].w * v[j].w); }
        const float rstd = rsqrtf(wave_sum(ss) * (1.f / DM) + EPS);
        const f32x4* sh = (const f32x4*)(MOD + b * 6144 + mod_shift * 1024) + lane;
        const f32x4* sc = (const f32x4*)(MOD + b * 6144 + mod_scale * 1024) + lane;
        u32x2* o8 = (u32x2*)(H + (size_t)row * DM) + lane;
#pragma unroll
        for (int j = 0; j < 4; ++j) { const f32x4 s4 = sc[64 * j], h4 = sh[64 * j];
            v[j].x = v[j].x * rstd * (1.f + s4.x) + h4.x; v[j].y = v[j].y * rstd * (1.f + s4.y) + h4.y;
            v[j].z = v[j].z * rstd * (1.f + s4.z) + h4.z; v[j].w = v[j].w * rstd * (1.f + s4.w) + h4.w;
            u32x2 p; p.x = pk2(v[j].x, v[j].y); p.y = pk2(v[j].z, v[j].w); o8[64 * j] = p; }
        if (GATES) {
            float g[8];
#pragma unroll
            for (int q = 0; q < 8; ++q) { float s = 0.f;
#pragma unroll
                for (int j = 0; j < 4; ++j) { const f32x4 w4 = *((const f32x4*)(wg + q * 1024) + lane + 64 * j);
                    s += (v[j].x * w4.x + v[j].y * w4.y) + (v[j].z * w4.z + v[j].w * w4.w); }
                g[q] = wave_sum(s); }
            if (lane == 0) {
#pragma unroll
                for (int q = 0; q < 4; ++q) { IPRE[(size_t)row * 4 + q] = g[q] + gate_b[q]; FPRE[(size_t)row * 4 + q] = g[4 + q] + gate_b[4 + q]; }
            }
        }
    }
}

template <class Epi>
__device__ __forceinline__ void ngemm_tile(float* As, float* Bs, const bf16_t* A, size_t lda, const int* gather, int row0, int rend,
                                           const bf16_t* Bt, int K, int n0, const Epi& E, int tid) {
    const int r = tid >> 3, cgp = tid & 7;
    float acc[8];
#pragma unroll
    for (int i = 0; i < 8; ++i) acc[i] = 0.f;
    const int lr = (tid & 127) >> 1, kp = (tid & 1) * 8;
    const bool isA = tid < 128;
    const bf16_t* src = Bt; bool ok = false;
    if (tid < 256) {
        if (isA) { const int ri = row0 + lr; ok = ri < rend; if (ok) { const int sr = gather ? gather[ri] : ri; src = A + (size_t)sr * lda + kp; } }
        else { ok = true; src = Bt + (size_t)(n0 + lr) * K + kp; }
    }
    for (int k0 = 0; k0 < K; k0 += 16) {
        if (tid < 256) {
            u32x4 v = (u32x4){0u, 0u, 0u, 0u};
            if (ok) v = *(const u32x4*)(src + k0);
            float* dp = (isA ? As : Bs) + kp * 68 + lr;
            dp[0] = bflo(v.x); dp[68] = bfhi(v.x); dp[136] = bflo(v.y); dp[204] = bfhi(v.y);
            dp[272] = bflo(v.z); dp[340] = bfhi(v.z); dp[408] = bflo(v.w); dp[476] = bfhi(v.w);
        }
        __syncthreads();
#pragma unroll
        for (int k = 0; k < 16; ++k) {
            const float av = As[k * 68 + r];
            const f32x4 b0 = *(const f32x4*)(Bs + k * 68 + 8 * cgp), b1 = *(const f32x4*)(Bs + k * 68 + 8 * cgp + 4);
            acc[0] += av * b0.x; acc[1] += av * b0.y; acc[2] += av * b0.z; acc[3] += av * b0.w;
            acc[4] += av * b1.x; acc[5] += av * b1.y; acc[6] += av * b1.z; acc[7] += av * b1.w;
        }
        __syncthreads();
    }
    E(row0 + r, (row0 + r) < rend, n0 + 8 * cgp, acc);
}

struct EpiProj { bf16_t* P;
    __device__ __forceinline__ void operator()(int row, bool valid, int col0, const float (&v)[8]) const { if (valid) *(u32x4*)(P + (size_t)row * NPROJ + col0) = pack8(v); } };
struct EpiOut { const float* x; float* x1; const float* MOD;
    __device__ __forceinline__ void operator()(int row, bool valid, int col0, const float (&v)[8]) const {
        if (!valid) return; const int b = row / SEQ; const float* ga = MOD + b * 6144 + 2 * 1024 + col0;
        const f32x4 x0 = *(const f32x4*)(x + (size_t)row * DM + col0), x1v = *(const f32x4*)(x + (size_t)row * DM + col0 + 4);
        f32x4 o0, o1; o0.x = x0.x + ga[0] * v[0]; o0.y = x0.y + ga[1] * v[1]; o0.z = x0.z + ga[2] * v[2]; o0.w = x0.w + ga[3] * v[3];
        o1.x = x1v.x + ga[4] * v[4]; o1.y = x1v.y + ga[5] * v[5]; o1.z = x1v.z + ga[6] * v[6]; o1.w = x1v.w + ga[7] * v[7];
        *(f32x4*)(x1 + (size_t)row * DM + col0) = o0; *(f32x4*)(x1 + (size_t)row * DM + col0 + 4) = o1; } };
struct EpiRS { float* LOG; bf16_t* ACT;
    __device__ __forceinline__ void operator()(int row, bool valid, int col0, const float (&v)[8]) const {
        if (!valid) return;
        if (col0 < 256) { *(f32x4*)(LOG + (size_t)row * 256 + col0) = (f32x4){v[0], v[1], v[2], v[3]}; *(f32x4*)(LOG + (size_t)row * 256 + col0 + 4) = (f32x4){v[4], v[5], v[6], v[7]}; }
        else { const int j0 = (col0 - 256) >> 1; u32x2 p; p.x = pk2(siluf(v[0]) * v[4], siluf(v[1]) * v[5]); p.y = pk2(siluf(v[2]) * v[6], siluf(v[3]) * v[7]);
            *(u32x2*)(ACT + (size_t)(SHARED_BASE + row) * 256 + j0) = p; } } };
struct EpiG1 { const float* SG; bf16_t* ACT;
    __device__ __forceinline__ void operator()(int row, bool valid, int col0, const float (&v)[8]) const {
        if (!valid) return; const float g = SG[row]; const int j0 = col0 >> 1; u32x2 p;
        p.x = pk2(siluf(v[0]) * v[4] * g, siluf(v[1]) * v[5] * g); p.y = pk2(siluf(v[2]) * v[6] * g, siluf(v[3]) * v[7] * g);
        *(u32x2*)(ACT + (size_t)row * 256 + j0) = p; } };
struct EpiG2 { bf16_t* YP;
    __device__ __forceinline__ void operator()(int row, bool valid, int col0, const float (&v)[8]) const { if (valid) *(u32x4*)(YP + (size_t)row * DM + col0) = pack8(v); } };

constexpr int LR = 136;
__device__ __forceinline__ f32x4 mfma16(bf16x8 a, bf16x8 b, f32x4 c) { asm volatile("s_nop 7" : "+v"(a), "+v"(b), "+v"(c)); f32x4 r = __builtin_amdgcn_mfma_f32_16x16x32_bf16(a, b, c, 0, 0, 0); asm volatile("s_nop 15\n\ts_nop 15" : "+v"(r)); return r; }
__device__ __forceinline__ bf16x8 ldfrag(const bf16_t* base, int row, int k0, int lane) { return *(const bf16x8*)(base + (row + (lane & 15)) * LR + k0 + 8 * (lane >> 4)); }

__device__ __forceinline__ void conv8(const bf16_t* PROJ, const float* cw, const float* cb, int b, int sg, int ch, float (&o)[8]) {
    float acc[8];
    { const f32x4 b0 = *(const f32x4*)(cb + ch), b1 = *(const f32x4*)(cb + ch + 4); acc[0] = b0.x; acc[1] = b0.y; acc[2] = b0.z; acc[3] = b0.w; acc[4] = b1.x; acc[5] = b1.y; acc[6] = b1.z; acc[7] = b1.w; }
#pragma unroll
    for (int j = 0; j < 4; ++j) { const int sp = sg - 3 + j;
        if (sp >= 0) { float x[8]; unpack8(*(const u32x4*)(PROJ + (size_t)(b * SEQ + sp) * NPROJ + ch), x);
            const f32x4 w0 = *(const f32x4*)(cw + j * 1024 + ch), w1 = *(const f32x4*)(cw + j * 1024 + ch + 4);
            acc[0] += w0.x * x[0]; acc[1] += w0.y * x[1]; acc[2] += w0.z * x[2]; acc[3] += w0.w * x[3];
            acc[4] += w1.x * x[4]; acc[5] += w1.y * x[5]; acc[6] += w1.z * x[6]; acc[7] += w1.w * x[7]; } }
#pragma unroll
    for (int q = 0; q < 8; ++q) o[q] = siluf(acc[q]);
}

__device__ __forceinline__ void chunk_gates(const Args& a, float* bb, float* ii, float* tmp, int t0, int h, int tid) {
    const float* IPRE = (const float*)(a.ws + WS_IPRE); const float* FPRE = (const float*)(a.ws + WS_FPRE);
    if (tid < 128) { const float f = FPRE[(size_t)(t0 + tid) * 4 + h]; ii[tid] = IPRE[(size_t)(t0 + tid) * 4 + h];
        tmp[tid] = fminf(f, 0.f) - log1pf(expf(-fabsf(f))); }
    __syncthreads();
    if (tid < 128) { float s = 0.f; for (int j = 0; j <= tid; ++j) s += tmp[j]; bb[tid] = s; }
    __syncthreads();
}

__device__ __forceinline__ void mlstm_m1_unit(const Args& a, unsigned char* lds, int unit) {
    const int tid = threadIdx.x, lane = tid & 63, wave = tid >> 6;
    const int bh = unit >> 6, c = unit & 63, b = bh >> 2, h = bh & 3, t0 = b * SEQ + c * 128;
    bf16_t* kT = (bf16_t*)lds; bf16_t* vT = kT + 128 * LR;
    float* sf = (float*)(lds + 2 * 128 * LR * 2); float* bb = sf; float* ii = sf + 128; float* tmp = sf + 256; float* wk = sf + 384;
    const bf16_t* PROJ = (const bf16_t*)(a.ws + WS_PROJ);
    const float* cw = a.in[5]; const float* cbias = a.in[6];
    chunk_gates(a, bb, ii, tmp, t0, h, tid);
    const float blast = bb[127];
    if (tid < 128) tmp[tid] = blast - bb[tid] + ii[tid];
    __syncthreads();
    float mloc = -INFINITY;
    for (int j = 0; j < 128; ++j) mloc = fmaxf(mloc, tmp[j]);
    if (tid < 128) wk[tid] = expf(tmp[tid] - mloc);
    __syncthreads();
    for (int it = tid; it < 2048; it += 512) { const int s = it >> 4, ch = it & 15;
        float kv[8]; conv8(PROJ, cw, cbias, b, c * 128 + s, 512 + h * 128 + 8 * ch, kv);
        const float sc = 0.08838834764831845f * wk[s];
#pragma unroll
        for (int q = 0; q < 8; ++q) kT[(8 * ch + q) * LR + s] = (bf16_t)f2bf(kv[q] * sc);
        float vv[8]; unpack8(*(const u32x4*)(PROJ + (size_t)(t0 + s) * NPROJ + 1024 + h * 128 + 8 * ch), vv);
#pragma unroll
        for (int q = 0; q < 8; ++q) vT[(8 * ch + q) * LR + s] = (bf16_t)f2bf(vv[q]);
    }
    __syncthreads();
    float* CLOC = (float*)(a.ws + WS_CLOC) + (size_t)unit * 16384;
    float* MST = (float*)(a.ws + WS_MST);
    {
        f32x4 acc[8];
#pragma unroll
        for (int i = 0; i < 8; ++i) acc[i] = (f32x4){0.f, 0.f, 0.f, 0.f};
#pragma unroll
        for (int ks = 0; ks < 4; ++ks) { const bf16x8 af = ldfrag(vT, 16 * wave, 32 * ks, lane);
#pragma unroll
            for (int db = 0; db < 8; ++db) acc[db] = mfma16(af, ldfrag(kT, 16 * db, 32 * ks, lane), acc[db]); }
#pragma unroll
        for (int db = 0; db < 8; ++db)
#pragma unroll
            for (int r = 0; r < 4; ++r) CLOC[(16 * wave + 4 * (lane >> 4) + r) * 128 + 16 * db + (lane & 15)] = acc[db][r];
    }
    if (tid < 128) { float s = 0.f; for (int j = 0; j < 128; ++j) s += bflo(kT[tid * LR + j]); MST[16384 + (size_t)unit * 128 + tid] = s; }
    if (tid == 0) { MST[unit] = mloc; MST[1024 + unit] = blast; }
    __syncthreads();
}

__device__ __forceinline__ void mlstm_m2(const Args& a) {
    const float* CLOC = (const float*)(a.ws + WS_CLOC); bf16_t* CIN = (bf16_t*)(a.ws + WS_CIN);
    float* MST = (float*)(a.ws + WS_MST);
    const float* NLOC = MST + 16384; float* NIN = MST + 16384 + 131072;
    const int NEL = 16 * 16512;
    for (int idx = blockIdx.x * 512 + threadIdx.x; idx < NEL; idx += gridDim.x * 512) {
        const int bh = idx / 16512, el = idx % 16512;
        float st = 0.f, m = 0.f;
        for (int c = 0; c < 64; ++c) {
            const int u = bh * 64 + c;
            const float ml = MST[u], bl = MST[1024 + u];
            float loc;
            if (el < 16384) { CIN[(size_t)u * 16384 + el] = (bf16_t)f2bf(st); loc = CLOC[(size_t)u * 16384 + el]; if (el == 0) MST[2048 + u] = m; }
            else { NIN[(size_t)u * 128 + (el - 16384)] = st; loc = NLOC[(size_t)u * 128 + (el - 16384)]; }
            const float mn = fmaxf(bl + m, ml);
            st = expf(bl + m - mn) * st + expf(ml - mn) * loc;
            m = mn;
        }
    }
}

__device__ __forceinline__ void mlstm_m3_unit(const Args& a, unsigned char* lds, int unit) {
    const int tid = threadIdx.x, lane = tid & 63, wave = tid >> 6;
    const int bh = unit >> 6, c = unit & 63, b = bh >> 2, h = bh & 3, t0 = b * SEQ + c * 128;
    bf16_t* qs = (bf16_t*)lds; bf16_t* ks = qs + 128 * LR; bf16_t* vT = ks + 128 * LR; bf16_t* CT = vT + 128 * LR; bf16_t* Ps = ks;
    float* sf = (float*)(lds + 4 * 128 * LR * 2);
    float* bb = sf; float* ii = sf + 128; float* tmp = sf + 256; float* gg = sf + 384; float* wint = sf + 512; float* nn = sf + 640; float* den = sf + 768; float* dint = sf + 896;
    const bf16_t* PROJ = (const bf16_t*)(a.ws + WS_PROJ); const bf16_t* CIN = (const bf16_t*)(a.ws + WS_CIN) + (size_t)unit * 16384;
    const float* MST = (const float*)(a.ws + WS_MST);
    const float* cw = a.in[5]; const float* cbias = a.in[6]; const float* mlg = a.in[8];
    bf16_t* MIX = (bf16_t*)(a.ws + WS_MIX);
    chunk_gates(a, bb, ii, tmp, t0, h, tid);
    const float m_in = MST[2048 + unit];
    if (tid < 128) { float pm = -INFINITY; for (int j = 0; j <= tid; ++j) pm = fmaxf(pm, ii[j] - bb[j]);
        const float g = fmaxf(m_in, pm); gg[tid] = g; wint[tid] = expf(m_in - g); tmp[tid] = ii[tid] - bb[tid];
        nn[tid] = MST[16384 + 131072 + (size_t)unit * 128 + tid]; }
    for (int it = tid; it < 2048; it += 512) { const int s = it >> 4, ch = it & 15;
        float qv[8], kv[8];
        conv8(PROJ, cw, cbias, b, c * 128 + s, h * 128 + 8 * ch, qv);
        conv8(PROJ, cw, cbias, b, c * 128 + s, 512 + h * 128 + 8 * ch, kv);
#pragma unroll
        for (int q = 0; q < 8; ++q) kv[q] *= 0.08838834764831845f;
        *(u32x4*)(qs + s * LR + 8 * ch) = pack8(qv);
        *(u32x4*)(ks + s * LR + 8 * ch) = pack8(kv);
        float vv[8]; unpack8(*(const u32x4*)(PROJ + (size_t)(t0 + s) * NPROJ + 1024 + h * 128 + 8 * ch), vv);
#pragma unroll
        for (int q = 0; q < 8; ++q) vT[(8 * ch + q) * LR + s] = (bf16_t)f2bf(vv[q]);
        *(u32x4*)(CT + s * LR + 8 * ch) = *(const u32x4*)(CIN + s * 128 + 8 * ch);
    }
    __syncthreads();
    if (tid < 128) { float s = 0.f; for (int d = 0; d < 128; ++d) s += bflo(qs[tid * LR + d]) * nn[d]; dint[tid] = s * wint[tid]; }
    f32x4 sacc[8];
#pragma unroll
    for (int i = 0; i < 8; ++i) sacc[i] = (f32x4){0.f, 0.f, 0.f, 0.f};
#pragma unroll
    for (int kk = 0; kk < 4; ++kk) { const bf16x8 bq = ldfrag(qs, 16 * wave, 32 * kk, lane);
#pragma unroll
        for (int sb = 0; sb < 8; ++sb) sacc[sb] = mfma16(ldfrag(ks, 16 * sb, 32 * kk, lane), bq, sacc[sb]); }
    __syncthreads();
    {
        const int t = 16 * wave + (lane & 15); const float g = gg[t]; float rs = 0.f;
#pragma unroll
        for (int sb = 0; sb < 8; ++sb) { float p[4];
#pragma unroll
            for (int r = 0; r < 4; ++r) { const int s = 16 * sb + 4 * (lane >> 4) + r; p[r] = (s <= t) ? sacc[sb][r] * expf(tmp[s] - g) : 0.f; rs += p[r]; }
            u32x2 w; w.x = pk2(p[0], p[1]); w.y = pk2(p[2], p[3]);
#if DBG_M3
            { float* dp = a.out + (size_t)(t0 + t) * DM + h * 256 + 16 * sb + 4 * (lane >> 4); dp[0] = 0.f; dp[1] = 0.f; dp[2] = 0.f; dp[3] = 0.f; }
#endif
            *(u32x2*)(Ps + t * LR + 16 * sb + 4 * (lane >> 4)) = w; }
        rs += __shfl_xor(rs, 16); rs += __shfl_xor(rs, 32);
        if (lane < 16) den[t] = rs + dint[t];
    }
    __syncthreads();
    {
        f32x4 a1[8], a2[8];
#pragma unroll
        for (int i = 0; i < 8; ++i) { a1[i] = (f32x4){0.f, 0.f, 0.f, 0.f}; a2[i] = (f32x4){0.f, 0.f, 0.f, 0.f}; }
#pragma unroll
        for (int kk = 0; kk < 4; ++kk) { const bf16x8 ap = ldfrag(Ps, 16 * wave, 32 * kk, lane), aq = ldfrag(qs, 16 * wave, 32 * kk, lane);
#pragma unroll
            for (int eb = 0; eb < 8; ++eb) { a1[eb] = mfma16(ap, ldfrag(vT, 16 * eb, 32 * kk, lane), a1[eb]); a2[eb] = mfma16(aq, ldfrag(CT, 16 * eb, 32 * kk, lane), a2[eb]); } }
        float hv[8][4]; float ssq[4];
#pragma unroll
        for (int r = 0; r < 4; ++r) { const int t = 16 * wave + 4 * (lane >> 4) + r;
            const float dd = fmaxf(fabsf(den[t]), expf(-(bb[t] + gg[t]))); const float inv = 1.f / dd, wi = wint[t]; float s2 = 0.f;
#pragma unroll
            for (int eb = 0; eb < 8; ++eb) { const float x = (a1[eb][r] + wi * a2[eb][r]) * inv; hv[eb][r] = x; s2 += x * x;
#if DBG_M3
                a.out[(size_t)(t0 + t) * DM + h * 256 + 128 + 16 * eb + (lane & 15)] = (eb == 0) ? bb[t] : (eb == 1) ? gg[t] : 0.f;
#endif
            }
            s2 += __shfl_xor(s2, 1); s2 += __shfl_xor(s2, 2); s2 += __shfl_xor(s2, 4); s2 += __shfl_xor(s2, 8);
            ssq[r] = rsqrtf(s2 * (1.f / 128.f) + EPS); }
#pragma unroll
        for (int eb = 0; eb < 8; ++eb) { const int e = 16 * eb + (lane & 15); const float ge = mlg[e];
#pragma unroll
            for (int r = 0; r < 4; ++r) { const int t = 16 * wave + 4 * (lane >> 4) + r;
                const float mo = bflo(PROJ[(size_t)(t0 + t) * NPROJ + 1536 + h * 128 + e]);
                MIX[(size_t)(t0 + t) * DM + h * 128 + e] = (bf16_t)f2bf(hv[eb][r] * ssq[r] * ge * sigm(mo)); } }
    }
    __syncthreads();
}

__device__ __forceinline__ void qknorm_rows(const Args& a) {
    const int tid = threadIdx.x, lane = tid & 63, wave = tid >> 6;
    bf16_t* PROJ = (bf16_t*)(a.ws + WS_PROJ);
    const float* gq = a.in[9]; const float* gk = a.in[10];
    const float* g = (lane < 32) ? gq : gk; const float scl = (lane < 32) ? C2 : 1.f;
    float gv[16];
#pragma unroll
    for (int i = 0; i < 16; ++i) gv[i] = g[16 * (lane & 3) + i] * scl;
    const int gw = blockIdx.x * 8 + wave, NGW = gridDim.x * 8;
    for (int row = gw; row < T; row += NGW) {
        u32x4* p = (u32x4*)(PROJ + (size_t)row * NPROJ + 2048 + 16 * lane);
        float x[16]; { float t8[8]; unpack8(p[0], t8);
#pragma unroll
            for (int i = 0; i < 8; ++i) x[i] = t8[i]; unpack8(p[1], t8);
#pragma unroll
            for (int i = 0; i < 8; ++i) x[8 + i] = t8[i]; }
        float ss = 0.f;
#pragma unroll
        for (int i = 0; i < 16; ++i) ss += x[i] * x[i];
        ss += __shfl_xor(ss, 1); ss += __shfl_xor(ss, 2);
        const float rstd = rsqrtf(ss * (1.f / 64.f) + EPS);
        float y0[8], y1[8];
#pragma unroll
        for (int i = 0; i < 8; ++i) { y0[i] = x[i] * rstd * gv[i]; y1[i] = x[8 + i] * rstd * gv[8 + i]; }
        p[0] = pack8(y0); p[1] = pack8(y1);
    }
}

__device__ __forceinline__ void attn_naive_unit(const Args& a, unsigned char* lds, int bh, int qb) {
    const int tid = threadIdx.x, wave = tid >> 6;
    const int b = bh >> 2, h = bh & 3;
    float* Ks = (float*)lds; float* Vs = Ks + 64 * 64;
    const bf16_t* PROJ = (const bf16_t*)(a.ws + WS_PROJ); float* TMP = (float*)(a.ws + WS_TMP); bf16_t* MIX = (bf16_t*)(a.ws + WS_MIX);
    const int qi = qb * 512 + tid; const size_t trow = (size_t)b * SEQ + qi;
    const float slope2 = exp2f(-2.f * (float)(h + 1)) * LOG2E;
    float lam;
    { float s1 = 0.f, s2 = 0.f; const float* q1 = a.in[11]; const float* k1 = a.in[12]; const float* q2 = a.in[13]; const float* k2 = a.in[14];
        for (int i = 0; i < 64; ++i) { s1 += q1[i] * k1[i]; s2 += q2[i] * k2[i]; }
        lam = expf(s1) - expf(s2) + LAM_INIT; }
    const int nt = qb * 8 + 8; const int qwmax = qb * 512 + wave * 64 + 63;
    float* tp = TMP + trow * 512 + h * 128;
    for (int pass = 0; pass < 4; ++pass) {
        const int c = pass >> 1, vh = pass & 1;
        float q[64], o[64];
        { const bf16_t* qp = PROJ + trow * NPROJ + 2048 + h * 128 + c * 64;
#pragma unroll
            for (int i = 0; i < 8; ++i) { float t8[8]; unpack8(*(const u32x4*)(qp + 8 * i), t8);
#pragma unroll
                for (int j = 0; j < 8; ++j) q[8 * i + j] = t8[j]; } }
#pragma unroll
        for (int i = 0; i < 64; ++i) o[i] = 0.f;
        float m = -INFINITY, l = 0.f;
        for (int kt = 0; kt < nt; ++kt) {
            __syncthreads();
            { const int key = tid >> 3, ch = tid & 7; const bf16_t* rp = PROJ + ((size_t)b * SEQ + kt * 64 + key) * NPROJ;
                float t8[8]; unpack8(*(const u32x4*)(rp + 2560 + h * 128 + c * 64 + 8 * ch), t8);
                *(f32x4*)(Ks + key * 64 + 8 * ch) = (f32x4){t8[0], t8[1], t8[2], t8[3]}; *(f32x4*)(Ks + key * 64 + 8 * ch + 4) = (f32x4){t8[4], t8[5], t8[6], t8[7]};
                unpack8(*(const u32x4*)(rp + 3072 + h * 128 + vh * 64 + 8 * ch), t8);
                *(f32x4*)(Vs + key * 64 + 8 * ch) = (f32x4){t8[0], t8[1], t8[2], t8[3]}; *(f32x4*)(Vs + key * 64 + 8 * ch + 4) = (f32x4){t8[4], t8[5], t8[6], t8[7]}; }
            __syncthreads();
            if (kt * 64 <= qwmax) {
                for (int j = 0; j < 64; ++j) {
                    const int kpos = kt * 64 + j; const float* kr = Ks + j * 64; const float* vr = Vs + j * 64;
                    float s = 0.f;
#pragma unroll
                    for (int d = 0; d < 64; ++d) s += q[d] * kr[d];
                    s = (kpos <= qi) ? (s - slope2 * (float)(qi - kpos)) : -INFINITY;
                    if (s > m) { const float al = exp2f(m - s); l *= al;
#pragma unroll
                        for (int e = 0; e < 64; ++e) o[e] *= al; m = s; }
                    const float p = exp2f(s - m); l += p;
#pragma unroll
                    for (int e = 0; e < 64; ++e) o[e] += p * vr[e];
                }
            }
        }
        const float inv = 1.f / l;
        if (c == 0) {
#pragma unroll
            for (int e = 0; e < 64; ++e) tp[vh * 64 + e] = o[e] * inv;
        } else {
#pragma unroll
            for (int e = 0; e < 64; ++e) tp[vh * 64 + e] = tp[vh * 64 + e] - lam * o[e] * inv;
        }
    }
    { const float* dg = a.in[15]; float ss = 0.f;
        for (int e = 0; e < 128; ++e) { const float v = tp[e]; ss += v * v; }
        const float rs = rsqrtf(ss * (1.f / 128.f) + EPS) * (1.f - LAM_INIT);
        for (int e = 0; e < 128; e += 2) { const unsigned w = pk2(tp[e] * rs * dg[e], tp[e + 1] * rs * dg[e + 1]);
            *(unsigned*)(MIX + trow * DM + 512 + h * 128 + e) = w; } }
    __syncthreads();
}

__device__ __forceinline__ void ph_route(const Args& a, unsigned char* lds) {
    const int tid = threadIdx.x, lane = tid & 63, wave = tid >> 6;
    int* hist = (int*)lds;
    const float* LOG = (const float*)(a.ws + WS_LOGITS); const float* rb = a.in[18];
    int* IDX = (int*)(a.ws + WS_IDX); float* GATEV = (float*)(a.ws + WS_GATEV); int* HIST = (int*)(a.ws + WS_HIST);
    const f32x4 rb4 = *((const f32x4*)rb + lane);
    for (int tb = blockIdx.x; tb < 256; tb += gridDim.x) {
        if (tid < 256) hist[tid] = 0;
        __syncthreads();
        for (int i = 0; i < 16; ++i) {
            const int t = tb * 128 + wave * 16 + i;
            const f32x4 lg = *((const f32x4*)(LOG + (size_t)t * 256) + lane);
            float s[4], sel[4];
            s[0] = sigm(lg.x); s[1] = sigm(lg.y); s[2] = sigm(lg.z); s[3] = sigm(lg.w);
            sel[0] = s[0] + rb4.x; sel[1] = s[1] + rb4.y; sel[2] = s[2] + rb4.z; sel[3] = s[3] + rb4.w;
            float m1 = fmaxf(sel[0], sel[1]), m2 = fminf(sel[0], sel[1]);
            { const float x = sel[2]; const float n1 = fmaxf(m1, x); m2 = fmaxf(m2, fminf(m1, x)); m1 = n1; }
            { const float x = sel[3]; const float n1 = fmaxf(m1, x); m2 = fmaxf(m2, fminf(m1, x)); m1 = n1; }
#pragma unroll
            for (int off = 1; off < 8; off <<= 1) { const float o1 = __shfl_xor(m1, off), o2 = __shfl_xor(m2, off);
                const float n1 = fmaxf(m1, o1), n2 = fmaxf(fminf(m1, o1), fmaxf(m2, o2)); m1 = n1; m2 = n2; }
            const float gs = m1 + m2; const int grp = lane >> 3; int rank = 0;
#pragma unroll
            for (int g2 = 0; g2 < 8; ++g2) { const float v = __shfl(gs, 8 * g2); rank += ((v > gs) || (v == gs && g2 < grp)) ? 1 : 0; }
            const bool gsel = rank < 4;
            float cand[4];
#pragma unroll
            for (int j = 0; j < 4; ++j) cand[j] = gsel ? sel[j] : -INFINITY;
            float gsum = 0.f; float myg = 0.f; int myidx = 0;
#pragma unroll
            for (int k = 0; k < 8; ++k) {
                float bv = cand[0]; int bi = 4 * lane;
#pragma unroll
                for (int j = 1; j < 4; ++j) if (cand[j] > bv) { bv = cand[j]; bi = 4 * lane + j; }
#pragma unroll
                for (int off = 1; off < 64; off <<= 1) { const float ov = __shfl_xor(bv, off); const int oi = __shfl_xor(bi, off);
                    if (ov > bv || (ov == bv && oi < bi)) { bv = ov; bi = oi; } }
                const int owner = bi >> 2, sub = bi & 3;
                float sv = (sub == 0) ? s[0] : (sub == 1) ? s[1] : (sub == 2) ? s[2] : s[3];
                sv = __shfl(sv, owner);
                if (lane == owner) {
#pragma unroll
                    for (int j = 0; j < 4; ++j) if (j == sub) cand[j] = -INFINITY;
                }
                gsum += sv;
                if (lane == k) { myg = sv; myidx = bi; }
            }
            if (lane < 8) { IDX[(size_t)t * 8 + lane] = myidx; GATEV[(size_t)t * 8 + lane] = myg / gsum * 2.5f; atomicAdd(&hist[myidx], 1); }
        }
        __syncthreads();
        if (tid < 256) HIST[tb * 256 + tid] = hist[tid];
        __syncthreads();
    }
}

__device__ __forceinline__ void ph_scatter(const Args& a, unsigned char* lds) {
    const int tid = threadIdx.x;
    int* tot = (int*)lds; int* cur = tot + 256; int* base = cur + 256;
    const int* HIST = (const int*)(a.ws + WS_HIST); const int* IDX = (const int*)(a.ws + WS_IDX); const float* GATEV = (const float*)(a.ws + WS_GATEV);
    int* PSLOT = (int*)(a.ws + WS_PSLOT); int* SLOTTOK = (int*)(a.ws + WS_SLOTTOK); float* SLOTGATE = (float*)(a.ws + WS_SLOTGATE);
    int* TILE = (int*)(a.ws + WS_TILE);
    for (int tb = blockIdx.x; tb < 256; tb += gridDim.x) {
        __syncthreads();
        int pre = 0;
        if (tid < 256) { int t2 = 0; for (int j = 0; j < 256; ++j) { const int v = HIST[j * 256 + tid]; t2 += v; if (j < tb) pre += v; } tot[tid] = t2; }
        __syncthreads();
        if (tid < 256) { int bs = 0; for (int j = 0; j < tid; ++j) bs += tot[j]; base[tid] = bs; cur[tid] = bs + pre; }
        __syncthreads();
        for (int p = tid; p < 1024; p += 512) { const int t = tb * 128 + (p >> 3), k = p & 7; const int e = IDX[(size_t)t * 8 + k];
            const int slot = atomicAdd(&cur[e], 1); SLOTTOK[slot] = t; SLOTGATE[slot] = GATEV[(size_t)t * 8 + k]; PSLOT[(size_t)t * 8 + k] = slot; }
        if (tb == 0 && tid == 0) {
            int n = 0;
            for (int e = 0; e < 256; ++e) { const int cnt = tot[e], b0 = base[e];
                for (int r0 = 0; r0 < cnt; r0 += 256) { TILE[64 + n] = e; TILE[64 + 2048 + n] = b0 + r0; TILE[64 + 4096 + n] = b0 + cnt; ++n; } }
            TILE[0] = n;
            for (int i = 0; i < 128; ++i) { TILE[64 + n + i] = 256; TILE[64 + 2048 + n + i] = SHARED_BASE + 256 * i; TILE[64 + 4096 + n + i] = SHARED_BASE + T; }
        }
    }
}

__device__ __forceinline__ void ph_final(const Args& a) {
    const int tid = threadIdx.x, lane = tid & 63, wave = tid >> 6;
    const bf16_t* YP = (const bf16_t*)(a.ws + WS_YP); const int* PSLOT = (const int*)(a.ws + WS_PSLOT); const float* MOD = (const float*)(a.ws + WS_MOD);
    float* out = a.out;
    const int gw = blockIdx.x * 8 + wave, NGW = gridDim.x * 8;
    for (int row = gw; row < T; row += NGW) {
        const int b = row / SEQ;
        float acc[16];
#pragma unroll
        for (int i = 0; i < 16; ++i) acc[i] = 0.f;
        int myslot = 0; if (lane < 8) myslot = PSLOT[(size_t)row * 8 + lane]; if (lane == 8) myslot = SHARED_BASE + row;
#pragma unroll
        for (int k = 0; k < 9; ++k) { const int slot = __shfl(myslot, k); const bf16_t* yp = YP + (size_t)slot * DM;
            float t8[8]; unpack8(*(const u32x4*)(yp + 8 * lane), t8);
#pragma unroll
            for (int i = 0; i < 8; ++i) acc[i] += t8[i];
            unpack8(*(const u32x4*)(yp + 512 + 8 * lane), t8);
#pragma unroll
            for (int i = 0; i < 8; ++i) acc[8 + i] += t8[i]; }
        const float* gf = MOD + b * 6144 + 5 * 1024;
#pragma unroll
        for (int hh = 0; hh < 2; ++hh) { float* op = out + (size_t)row * DM + hh * 512 + 8 * lane; const float* gp = gf + hh * 512 + 8 * lane;
            f32x4 x0 = *(const f32x4*)op, x1 = *(const f32x4*)(op + 4); const f32x4 g0 = *(const f32x4*)gp, g1 = *(const f32x4*)(gp + 4);
            x0.x += g0.x * acc[8 * hh + 0]; x0.y += g0.y * acc[8 * hh + 1]; x0.z += g0.z * acc[8 * hh + 2]; x0.w += g0.w * acc[8 * hh + 3];
            x1.x += g1.x * acc[8 * hh + 4]; x1.y += g1.y * acc[8 * hh + 5]; x1.z += g1.z * acc[8 * hh + 6]; x1.w += g1.w * acc[8 * hh + 7];
            *(f32x4*)op = x0; *(f32x4*)(op + 4) = x1; }
    }
}


#define LAS __attribute__((address_space(3)))
#define XB_TMO      128
#define XB_XCNT(j)  (256  + 64 * (j))
#define XB_XSUB(j)  (1280 + 64 * (j))
#define XB_XGEN(j)  (2304 + 64 * (j))
#define XB_TOP      3328
#define XB_TOPGEN   3392
#define XB_SPIN_CAP (1u << 27)
__device__ __forceinline__ unsigned xb_ld(unsigned* p)              { return __hip_atomic_load(p, __ATOMIC_RELAXED, __HIP_MEMORY_SCOPE_AGENT); }
__device__ __forceinline__ unsigned xb_add(unsigned* p, unsigned v) { return __hip_atomic_fetch_add(p, v, __ATOMIC_RELAXED, __HIP_MEMORY_SCOPE_AGENT); }
__device__ __forceinline__ unsigned xb_xcc_id() { return (unsigned)__builtin_amdgcn_s_getreg((3 << 11) | 20) & 0xFu; }
#define XB_SPIN(cond, bar) do { unsigned _sp = 0; while (cond) { __builtin_amdgcn_s_sleep(1); \
    if ((++_sp & 255u) == 0u) { if (xb_ld(&(bar)[XB_TMO])) break; if (_sp > XB_SPIN_CAP) { atomicAdd(&(bar)[XB_TMO], 1u); break; } } } } while (0)
struct XcdBarrier { unsigned* bar; unsigned x; volatile LAS unsigned* st; };
__device__ __forceinline__ XcdBarrier xcd_barrier_post(unsigned* bar, volatile LAS unsigned* st) {
    XcdBarrier b; b.bar = bar; b.x = xb_xcc_id(); b.st = st;
    if (threadIdx.x == 0) (void)xb_add(&bar[XB_XCNT(b.x)], 1u);
    return b;
}
__device__ __forceinline__ void xcd_barrier_complete(unsigned* bar, unsigned x, unsigned& nloc, unsigned& nx) {
    const unsigned G = gridDim.x * gridDim.y * gridDim.z;
    unsigned sum, cnt, mine, sp = 0u;
    for (;;) {
        sum = 0u; cnt = 0u; mine = 0u;
#pragma unroll
        for (unsigned j = 0; j < 16; ++j) { const unsigned c = xb_ld(&bar[XB_XCNT(j)]); sum += c; cnt += (c > 0u) ? 1u : 0u; mine = (j == x) ? c : mine; }
        if (sum == G) break;
        __builtin_amdgcn_s_sleep(1);
        if ((++sp & 255u) == 0u) { if (xb_ld(&bar[XB_TMO])) break; if (sp > XB_SPIN_CAP) { atomicAdd(&bar[XB_TMO], 1u); break; } }
    }
    nloc = mine > 0u ? mine : 1u; nx = cnt > 0u ? cnt : 1u;
}
__device__ __forceinline__ void xcd_barrier(const XcdBarrier& b) {
    asm volatile("s_waitcnt vmcnt(0)" ::: "memory");
    __syncthreads();
    if (threadIdx.x == 0) {
        unsigned* bar = b.bar;
        __builtin_amdgcn_s_waitcnt(0);
        unsigned nloc = b.st[0], nx = b.st[1];
        if (nloc == 0u) { xcd_barrier_complete(bar, b.x, nloc, nx); b.st[0] = nloc; b.st[1] = nx; }
        const unsigned old = xb_add(&bar[XB_XSUB(b.x)], 1u);
        const unsigned gen = old / nloc;
        if (old + 1u == (gen + 1u) * nloc) {
            __builtin_amdgcn_fence(__ATOMIC_RELEASE, "agent");
            asm volatile("s_waitcnt vmcnt(0)" ::: "memory");
            const unsigned og = xb_add(&bar[XB_TOP], 1u);
            const unsigned tg = og / nx;
            if (og + 1u == (tg + 1u) * nx) xb_add(&bar[XB_TOPGEN], 1u);
            else XB_SPIN(xb_ld(&bar[XB_TOPGEN]) == tg, bar);
            __builtin_amdgcn_fence(__ATOMIC_ACQUIRE, "agent");
            xb_add(&bar[XB_XGEN(b.x)], 1u);
            asm volatile("s_waitcnt vmcnt(0)" ::: "memory");
        } else {
            XB_SPIN(xb_ld(&bar[XB_XGEN(b.x)]) == gen, bar);
            __builtin_amdgcn_fence(__ATOMIC_ACQUIRE, "agent");
            asm volatile("s_waitcnt vmcnt(0)" ::: "memory");
        }
    }
    __syncthreads();
}


__device__ __forceinline__ void dbg_dump(const Args& a, const bf16_t* src, int pitch, int coff, float ls, float rs) {
    for (size_t i = blockIdx.x * 512 + threadIdx.x; i < (size_t)T * DM; i += (size_t)gridDim.x * 512) {
        const int c = (int)(i & 1023); const size_t r = i >> 10;
        a.out[i] = bflo(src[r * pitch + coff + c]) * (c >= 512 ? rs : ls);
    }
}

__device__ __forceinline__ void dbg_dump_lin(const Args& a, const void* src, bool isbf, size_t n) {
    for (size_t i = blockIdx.x * 512 + threadIdx.x; i < (size_t)T * DM; i += (size_t)gridDim.x * 512) {
        float v = 0.f; if (i < n) v = isbf ? bflo(((const bf16_t*)src)[i]) : ((const float*)src)[i];
        a.out[i] = v;
    }
}
__global__ void __launch_bounds__(512) mega(Args a) {
    extern __shared__ __attribute__((aligned(16))) unsigned char lds[];
    const int lo = a.ph_lo, hi = a.ph_hi;
    const int tid = threadIdx.x;
    volatile LAS unsigned* bst = (volatile LAS unsigned*)((LAS unsigned char*)lds + (LDS_BYTES - 64));
    if (tid < 16) bst[tid] = 0u;
    __syncthreads();
    XcdBarrier bar = xcd_barrier_post((unsigned*)(a.ws + WS_BAR), bst);
#if USE_CG_SYNC
    cg::this_grid().sync();
#endif
    float* As = (float*)lds; float* Bs = As + 16 * 68;
#define IN(k) (lo <= (k) && (k) < hi)
#define SEAM(k) do { if (IN(k) && IN((k) + 1)) xcd_barrier(bar); } while (0)

    if (IN(0)) { ph0(a, lds); } SEAM(0);
    if (IN(1)) { ph_norm<true>(a, lds, a.in[0], 0, 1); } SEAM(1);
    if (IN(2)) {
        const EpiProj E{(bf16_t*)(a.ws + WS_PROJ)};
        for (int u = blockIdx.x; u < 512 * 56; u += gridDim.x) { const int mt = u / 56, nt = u % 56;
            ngemm_tile(As, Bs, (const bf16_t*)(a.ws + WS_H), DM, nullptr, 64 * mt, T, (const bf16_t*)(a.ws + WS_WIN), DM, 64 * nt, E, tid); }
    } SEAM(2);
    if (IN(3)) { qknorm_rows(a); __syncthreads(); for (int u = blockIdx.x; u < 1024; u += gridDim.x) mlstm_m1_unit(a, lds, u); } SEAM(3);
    if (IN(4)) { mlstm_m2(a); } SEAM(4);
    if (IN(5)) {
#if !DBG_SKIP_ATTN
        for (int u = blockIdx.x; u < 256; u += gridDim.x) { const int v = 255 - u; attn_naive_unit(a, lds, v & 15, v >> 4); }
#endif
        for (int u = blockIdx.x; u < 1024; u += gridDim.x) mlstm_m3_unit(a, lds, u);
    } SEAM(5);
#if !DBG_TWICE
    if (IN(6)) {
        const EpiOut E{a.in[0], a.out, (const float*)(a.ws + WS_MOD)};
        for (int u = blockIdx.x; u < 512 * 16; u += gridDim.x) { const int mt = u / 16, nt = u % 16;
            ngemm_tile(As, Bs, (const bf16_t*)(a.ws + WS_MIX), DM, nullptr, 64 * mt, T, (const bf16_t*)(a.ws + WS_WOUT), DM, 64 * nt, E, tid); }
    } SEAM(6);
    if (IN(7)) { ph_norm<false>(a, lds, a.out, 3, 4); } SEAM(7);
    if (IN(8)) {
        const EpiRS E{(float*)(a.ws + WS_LOGITS), (bf16_t*)(a.ws + WS_ACT)};
        for (int u = blockIdx.x; u < 512 * 12; u += gridDim.x) { const int mt = u / 12, nt = u % 12;
            ngemm_tile(As, Bs, (const bf16_t*)(a.ws + WS_H), DM, nullptr, 64 * mt, T, (const bf16_t*)(a.ws + WS_WRS), DM, 64 * nt, E, tid); }
    } SEAM(8);
    if (IN(9)) { ph_route(a, lds); } SEAM(9);
    if (IN(10)) { ph_scatter(a, lds); } SEAM(10);
    if (IN(11)) {
        const int* TILE = (const int*)(a.ws + WS_TILE); const int ntile = TILE[0];
        const EpiG1 E{(const float*)(a.ws + WS_SLOTGATE), (bf16_t*)(a.ws + WS_ACT)};
        for (int u = blockIdx.x; u < ntile * 32; u += gridDim.x) { const int tl = u >> 5, sub = (u >> 3) & 3, nt = u & 7;
            const int e = TILE[64 + tl], r0 = TILE[64 + 2048 + tl] + 64 * sub, rend = TILE[64 + 4096 + tl];
            if (r0 >= rend) continue;
            ngemm_tile(As, Bs, (const bf16_t*)(a.ws + WS_H), DM, (const int*)(a.ws + WS_SLOTTOK), r0, rend, (const bf16_t*)(a.ws + WS_W13T) + (size_t)e * 512 * 1024, DM, 64 * nt, E, tid); }
    } SEAM(11);
    if (IN(12)) {
        const int* TILE = (const int*)(a.ws + WS_TILE); const int ntile = TILE[0] + 128;
        const EpiG2 E{(bf16_t*)(a.ws + WS_YP)};
        for (int u = blockIdx.x; u < ntile * 64; u += gridDim.x) { const int tl = u >> 6, sub = (u >> 4) & 3, nt = u & 15;
            const int e = TILE[64 + tl], r0 = TILE[64 + 2048 + tl] + 64 * sub, rend = TILE[64 + 4096 + tl];
            if (r0 >= rend) continue;
            ngemm_tile(As, Bs, (const bf16_t*)(a.ws + WS_ACT), 256, nullptr, r0, rend, (const bf16_t*)(a.ws + WS_W2T) + (size_t)e * 1024 * 256, 256, 64 * nt, E, tid); }
    } SEAM(12);
    if (IN(13)) { ph_final(a); }
#endif
#if DBG_TWICE
    if (IN(14)) { bf16_t* SAVE = (bf16_t*)(a.ws + WS_ACT); const bf16_t* MIXp = (const bf16_t*)(a.ws + WS_MIX);
        for (size_t i = blockIdx.x * 512 + tid; i < (size_t)T * 512; i += (size_t)gridDim.x * 512) { const size_t r = i >> 9, c = i & 511; SAVE[i] = MIXp[r * DM + c]; } }
    if (IN(15)) {
        unsigned* CNT = (unsigned*)(a.ws + WS_BAR) + 4000;
        const bf16_t* SAVE = (const bf16_t*)(a.ws + WS_ACT); const bf16_t* MIXp = (const bf16_t*)(a.ws + WS_MIX);
        unsigned bad = 0;
        for (size_t i = blockIdx.x * 512 + tid; i < (size_t)T * 512; i += (size_t)gridDim.x * 512) { const size_t r = i >> 9, c = i & 511; bad += (SAVE[i] != MIXp[r * DM + c]) ? 1u : 0u; }
        if (bad) atomicAdd(CNT, bad);
        xcd_barrier(bar);
        const unsigned tot = __hip_atomic_load(CNT, __ATOMIC_RELAXED, __HIP_MEMORY_SCOPE_AGENT);
        const float cval = (tot == 0u) ? 1.f : (tot < 1000u) ? 3.f : (tot < 100000u) ? 5.f : 7.f;
        for (size_t i = blockIdx.x * 512 + tid; i < (size_t)T * DM; i += (size_t)gridDim.x * 512) a.out[i] = cval;
    }
#endif
#if DBG_DUMP == 5
    xcd_barrier(bar); dbg_dump(a, (const bf16_t*)(a.ws + WS_MIX), DM, 0, 1000.f, 1.f);
#elif DBG_DUMP == 7
    xcd_barrier(bar); dbg_dump_lin(a, a.ws + WS_CIN, true, (size_t)1024 * 16384);
#elif DBG_DUMP == 6
    xcd_barrier(bar); dbg_dump_lin(a, a.ws + WS_CLOC, false, (size_t)1024 * 16384);
#elif DBG_DUMP == 8
    xcd_barrier(bar); dbg_dump_lin(a, a.ws + WS_IPRE, false, (size_t)T * 8);
#elif DBG_DUMP == 9
    xcd_barrier(bar); dbg_dump_lin(a, a.ws + WS_MST, false, (size_t)3072);
#elif DBG_DUMP == 4
    xcd_barrier(bar); dbg_dump(a, (const bf16_t*)(a.ws + WS_PROJ), NPROJ, 2048, 1.f, 1000.f);
#elif DBG_DUMP == 2
    xcd_barrier(bar); dbg_dump(a, (const bf16_t*)(a.ws + WS_PROJ), NPROJ, 0, 1.f, 1.f);
#elif DBG_DUMP == 3
    xcd_barrier(bar); dbg_dump(a, (const bf16_t*)(a.ws + WS_PROJ), NPROJ, 1024, 1.f, 1000.f);
#elif DBG_DUMP == 1
    xcd_barrier(bar); dbg_dump(a, (const bf16_t*)(a.ws + WS_H), DM, 0, 1.f, 1000.f);
#endif
#undef IN
#undef SEAM
}

extern "C" void kernel_launch(void* const* d_in, const int* in_sizes, int n_in, void* d_out, int out_size, void* d_ws, size_t ws_size, hipStream_t stream) {
    static int grid = 0;
    if (grid == 0) {
        if (n_in != 25 || in_sizes[0] != T * DM || out_size != T * DM || ws_size < WS_END) {
            fprintf(stderr, "kernel_launch: unexpected problem (n_in %d, in0 %d, out %d, ws %zu < %zu)\n", n_in, n_in > 0 ? in_sizes[0] : -1, out_size, ws_size, (size_t)WS_END); grid = -1; return; }
        int dev = 0, cus = 0, per_cu = 0;
        (void)hipGetDevice(&dev);
        (void)hipDeviceGetAttribute(&cus, hipDeviceAttributeMultiprocessorCount, dev);
        if (hipFuncSetAttribute((const void*)mega, hipFuncAttributeMaxDynamicSharedMemorySize, LDS_BYTES) != hipSuccess) { fprintf(stderr, "kernel_launch: hipFuncSetAttribute failed\n"); grid = -1; return; }
        if (hipOccupancyMaxActiveBlocksPerMultiprocessor(&per_cu, (const void*)mega, 512, LDS_BYTES) != hipSuccess || per_cu < 1) { fprintf(stderr, "kernel_launch: occupancy query says %d blocks/CU\n", per_cu); grid = -1; return; }
        grid = cus;
    }
    if (grid < 0) return;
    (void)hipMemsetAsync((char*)d_ws + WS_BAR, 0, BAR_BYTES, stream);
    Args a{};
    for (int i = 0; i < 25; ++i) a.in[i] = (const float*)d_in[i];
    a.out = (float*)d_out; a.ws = (unsigned char*)d_ws;
#if DBG_TWICE
    { const int seq[4][2] = {{0, 6}, {14, 15}, {DBG_REP_LO, 6}, {15, 16}};
      for (int i = 0; i < 4; ++i) { (void)hipMemsetAsync((char*)d_ws + WS_BAR, 0, BAR_BYTES, stream); a.ph_lo = seq[i][0]; a.ph_hi = seq[i][1]; void* args[] = {&a};
          hipError_t e = hipLaunchCooperativeKernel((const void*)mega, dim3(grid), dim3(512), args, LDS_BYTES, stream);
          if (e != hipSuccess) { fprintf(stderr, "launch %d failed: %s\n", i, hipGetErrorString(e)); break; } } }
#elif ONE_LAUNCH
    a.ph_lo = 0; a.ph_hi = DBG_LAST_PHASE;
    void* args[] = {&a};
    hipError_t e = hipLaunchCooperativeKernel((const void*)mega, dim3(grid), dim3(512), args, LDS_BYTES, stream);
    if (e != hipSuccess) fprintf(stderr, "cooperative launch failed: %s (grid %d)\n", hipGetErrorString(e), grid);
#else
    for (int ph = 0; ph < NPH; ++ph) { a.ph_lo = ph; a.ph_hi = ph + 1; void* args[] = {&a};
        hipError_t e = hipLaunchCooperativeKernel((const void*)mega, dim3(grid), dim3(512), args, LDS_BYTES, stream);
        if (e != hipSuccess) { fprintf(stderr, "launch %d failed: %s\n", ph, hipGetErrorString(e)); break; } }
#endif
}
```

```cpp
#include <hip/hip_runtime.h>
#include <hip/hip_cooperative_groups.h>
#include <cstdio>
#include <cstdint>
namespace cg = cooperative_groups;

typedef unsigned short bf16_t;
typedef short bf16x8 __attribute__((ext_vector_type(8)));
typedef float f32x4 __attribute__((ext_vector_type(4)));
typedef unsigned u32x4 __attribute__((ext_vector_type(4)));
typedef unsigned u32x2 __attribute__((ext_vector_type(2)));

#ifndef ONE_LAUNCH
#define ONE_LAUNCH 1
#endif
#ifndef DBG_LAST_PHASE
#define DBG_LAST_PHASE 14
#endif
#ifndef DBG_DUMP
#define DBG_DUMP 0
#define DBG_M3 0
#define DBG_TWICE 0
#define DBG_REP_LO 5
#define DBG_SKIP_ATTN 0
#endif
#ifndef USE_MFMA_ATTN
#define USE_MFMA_ATTN 1
#endif
#ifndef USE_PG8
#define USE_PG8 1
#endif
#ifndef USE_CG_SYNC
#define USE_CG_SYNC 1
#endif

constexpr int T = 32768, DM = 1024, SEQ = 8192;
constexpr int NPROJ = 3584, DIN = 3592;
constexpr int TOPK = 8, TK = T * TOPK;
constexpr int SHARED_BASE = TK;
constexpr float EPS = 1e-6f;
constexpr float LOG2E = 1.4426950408889634f;
constexpr float C2 = 0.125f * LOG2E;
constexpr float LAM_INIT = 0.2f;
constexpr int NPH = 14;
constexpr int LDS_BYTES = 155648;

constexpr size_t MiB = 1ull << 20;
constexpr size_t WS_MOD = 0;
constexpr size_t WS_TILE = 128 * 1024;
constexpr size_t WS_HIST = 256 * 1024;
constexpr size_t WS_BAR = 512 * 1024;
constexpr size_t BAR_BYTES = 16384;
constexpr size_t WS_IPRE = 1 * MiB, WS_FPRE = 1 * MiB + 512 * 1024;
constexpr size_t WS_IDX = 2 * MiB, WS_GATEV = 3 * MiB, WS_PSLOT = 4 * MiB, WS_SLOTTOK = 5 * MiB, WS_SLOTGATE = 7 * MiB;
constexpr size_t WS_MST = 9 * MiB;
constexpr size_t WS_WIN = 12 * MiB, WS_WOUT = 19 * MiB, WS_WRS = 21 * MiB, WS_W2T = 23 * MiB;
constexpr size_t WS_H = 152 * MiB, WS_ACT = 216 * MiB, WS_MIX = 361 * MiB, WS_PROJ = 425 * MiB, WS_CLOC = 649 * MiB, WS_CIN = 713 * MiB, WS_W13T = 745 * MiB, WS_END = 1001 * MiB;
constexpr size_t WS_YP = WS_MIX;
constexpr size_t WS_LOGITS = WS_CLOC;
constexpr size_t WS_TMP = WS_ACT;

struct Args { const float* in[25]; float* out; unsigned char* ws; int ph_lo, ph_hi; };

__device__ __forceinline__ float bflo(unsigned v) { return __uint_as_float(v << 16); }
__device__ __forceinline__ float bfhi(unsigned v) { return __uint_as_float(v & 0xffff0000u); }
__device__ __forceinline__ unsigned f2bf(float f) { unsigned u = __float_as_uint(f); return (u + 0x7fffu + ((u >> 16) & 1u)) >> 16; }
__device__ __forceinline__ unsigned pk2(float lo, float hi) { return f2bf(lo) | (f2bf(hi) << 16); }
__device__ __forceinline__ float wave_sum(float v) {
#pragma unroll
    for (int o = 1; o < 64; o <<= 1) v += __shfl_xor(v, o);
    return v;
}
__device__ __forceinline__ float siluf(float x) { return x / (1.f + __expf(-x)); }
__device__ __forceinline__ float sigm(float x) { return 1.f / (1.f + __expf(-x)); }
__device__ __forceinline__ void unpack8(const u32x4 v, float (&x)[8]) {
    x[0] = bflo(v.x); x[1] = bfhi(v.x); x[2] = bflo(v.y); x[3] = bfhi(v.y); x[4] = bflo(v.z); x[5] = bfhi(v.z); x[6] = bflo(v.w); x[7] = bfhi(v.w);
}
__device__ __forceinline__ u32x4 pack8(const float (&x)[8]) { u32x4 o; o.x = pk2(x[0], x[1]); o.y = pk2(x[2], x[3]); o.z = pk2(x[4], x[5]); o.w = pk2(x[6], x[7]); return o; }

__device__ __forceinline__ void conv_item(const float* __restrict__ s0, const float* __restrict__ s1, int ldn, int k0, int n0, bool inter,
                                          bf16_t* dst, int ldk, int c0, float* scr, int lane) {
    const float* p = (inter && lane >= 32) ? (s1 + n0 + (lane - 32)) : (s0 + n0 + lane);
    p += (size_t)k0 * ldn;
#pragma unroll 8
    for (int i = 0; i < 64; ++i) scr[i * 65 + lane] = p[(size_t)i * ldn];
    const int c = lane & 7;
#pragma unroll
    for (int j = 0; j < 8; ++j) {
        const int n = (lane >> 3) + 8 * j;
        const float* s = scr + (8 * c) * 65 + n;
        u32x4 o; o.x = pk2(s[0], s[65]); o.y = pk2(s[130], s[195]); o.z = pk2(s[260], s[325]); o.w = pk2(s[390], s[455]);
        const int drow = inter ? (c0 + ((n & 31) >> 2) * 8 + (n >> 5) * 4 + (n & 3)) : (c0 + n);
        *(u32x4*)(dst + (size_t)drow * ldk + k0 + 8 * c) = o;
    }
}

__device__ __forceinline__ void ph0(const Args& a, unsigned char* lds) {
    const int tid = threadIdx.x, lane = tid & 63, wave = tid >> 6;
    const float* c_in = a.in[1]; const float* w_ada = a.in[2]; const float* b_ada = a.in[3];
    float* MOD = (float*)(a.ws + WS_MOD);
    {
        float* sc = (float*)lds; float* red = sc + 4096;
        for (int i = tid; i < 4096; i += 512) sc[i] = siluf(c_in[i]);
        __syncthreads();
        for (int it = blockIdx.x; it < 192; it += gridDim.x) {
            const int cc = tid & 31, ks = tid >> 5, col = it * 32 + cc;
            float a0 = 0.f, a1 = 0.f, a2 = 0.f, a3 = 0.f;
            const float* wp = w_ada + (size_t)(ks * 64) * 6144 + col;
#pragma unroll 8
            for (int k = 0; k < 64; ++k) { const float w = wp[(size_t)k * 6144]; const int kk = ks * 64 + k;
                a0 += sc[kk] * w; a1 += sc[1024 + kk] * w; a2 += sc[2048 + kk] * w; a3 += sc[3072 + kk] * w; }
            float* rp = red + (ks * 32 + cc) * 4; rp[0] = a0; rp[1] = a1; rp[2] = a2; rp[3] = a3;
            __syncthreads();
            if (tid < 128) { const int c2 = tid & 31, b = tid >> 5; float s = 0.f;
                for (int k2 = 0; k2 < 16; ++k2) s += red[(k2 * 32 + c2) * 4 + b];
                MOD[b * 6144 + it * 32 + c2] = s + b_ada[it * 32 + c2]; }
            __syncthreads();
        }
    }
    __syncthreads();
    float* scr = (float*)lds + wave * (64 * 65);
    const int gw = blockIdx.x * 8 + wave, NGW = gridDim.x * 8;
    const float* w_in = a.in[4]; const float* w_out = a.in[16]; const float* w_router = a.in[17];
    const float* w1 = a.in[19]; const float* w3 = a.in[20]; const float* w2 = a.in[21];
    const float* ws1 = a.in[22]; const float* ws3 = a.in[23]; const float* ws2 = a.in[24];
    bf16_t* WIN = (bf16_t*)(a.ws + WS_WIN); bf16_t* WOUT = (bf16_t*)(a.ws + WS_WOUT); bf16_t* WRS = (bf16_t*)(a.ws + WS_WRS);
    bf16_t* W2T = (bf16_t*)(a.ws + WS_W2T); bf16_t* W13T = (bf16_t*)(a.ws + WS_W13T);
    constexpr int IT_WIN = 56 * 16, IT_WOUT = 16 * 16, IT_WR = 4 * 16, IT_WS13 = 8 * 16, IT_WS2 = 4 * 16, IT_E13 = 256 * 128, IT_E2 = 256 * 64;
    constexpr int NITEMS = IT_WIN + IT_WOUT + IT_WR + IT_WS13 + IT_WS2 + IT_E13 + IT_E2;
    for (int it = gw; it < NITEMS; it += NGW) {
        int r = it;
        if (r < IT_WIN) { const int kb = r / 56, cb = r % 56, c0 = 64 * cb, n0 = c0 + (c0 >= 2048 ? 8 : 0);
            conv_item(w_in, w_in, DIN, 64 * kb, n0, false, WIN, 1024, c0, scr, lane); continue; } r -= IT_WIN;
        if (r < IT_WOUT) { const int kb = r / 16, cb = r % 16; conv_item(w_out, w_out, 1024, 64 * kb, 64 * cb, false, WOUT, 1024, 64 * cb, scr, lane); continue; } r -= IT_WOUT;
        if (r < IT_WR) { const int kb = r / 4, cb = r % 4; conv_item(w_router, w_router, 256, 64 * kb, 64 * cb, false, WRS, 1024, 64 * cb, scr, lane); continue; } r -= IT_WR;
        if (r < IT_WS13) { const int kb = r / 8, cb = r % 8; conv_item(ws1, ws3, 256, 64 * kb, 32 * cb, true, WRS + (size_t)256 * 1024, 1024, 64 * cb, scr, lane); continue; } r -= IT_WS13;
        if (r < IT_WS2) { const int kb = r / 16, cb = r % 16; conv_item(ws2, ws2, 1024, 64 * kb, 64 * cb, false, W2T + (size_t)256 * 1024 * 256, 256, 64 * cb, scr, lane); continue; } r -= IT_WS2;
        if (r < IT_E13) { const int e = r >> 7, rr = r & 127, kb = rr >> 3, cb = rr & 7;
            conv_item(w1 + (size_t)e * 1024 * 256, w3 + (size_t)e * 1024 * 256, 256, 64 * kb, 32 * cb, true, W13T + (size_t)e * 512 * 1024, 1024, 64 * cb, scr, lane); continue; } r -= IT_E13;
        { const int e = r >> 6, rr = r & 63, kb = rr >> 4, cb = rr & 15;
            conv_item(w2 + (size_t)e * 256 * 1024, w2, 1024, 64 * kb, 64 * cb, false, W2T + (size_t)e * 1024 * 256, 256, 64 * cb, scr, lane); }
    }
}

template <bool GATES>
__device__ __forceinline__ void ph_norm(const Args& a, unsigned char* lds, const float* X, int mod_shift, int mod_scale) {
    const int tid = threadIdx.x, lane = tid & 63, wave = tid >> 6;
    const float* MOD = (const float*)(a.ws + WS_MOD);
    bf16_t* H = (bf16_t*)(a.ws + WS_H);
    float* wg = (float*)lds;
    if (GATES) {
        const float* w_in = a.in[4];
        for (int i = tid; i < 8192; i += 512) { const int k = i >> 3, g = i & 7; wg[g * 1024 + k] = w_in[(size_t)k * DIN + 2048 + g]; }
        __syncthreads();
    }
    const float* gate_b = a.in[7];
    float* IPRE = (float*)(a.ws + WS_IPRE); float* FPRE = (float*)(a.ws + WS_FPRE);
    const int gw = blockIdx.x * 8 + wave, NGW = gridDim.x * 8;
    for (int row = gw; row < T; row += NGW) {
        const int b = row / SEQ;
        const f32x4* xr = (const f32x4*)(X + (size_t)row * DM) + lane;
        f32x4 v[4]; float ss = 0.f;
#pragma unroll
        for (int j = 0; j < 4; ++j) { v[j] = xr[64 * j]; ss += (v[j].x * v[j].x + v[j].y * v[j].y) + (v[j].z * v[j].z + v[j].w * v[j].w); }
        const float rstd = rsqrtf(wave_sum(ss) * (1.f / DM) + EPS);
        const f32x4* sh = (const f32x4*)(MOD + b * 6144 + mod_shift * 1024) + lane;
        const f32x4* sc = (const f32x4*)(MOD + b * 6144 + mod_scale * 1024) + lane;
        u32x2* o8 = (u32x2*)(H + (size_t)row * DM) + lane;
#pragma unroll
        for (int j = 0; j < 4; ++j) { const f32x4 s4 = sc[64 * j], h4 = sh[64 * j];
            v[j].x = v[j].x * rstd * (1.f + s4.x) + h4.x; v[j].y = v[j].y * rstd * (1.f + s4.y) + h4.y;
            v[j].z = v[j].z * rstd * (1.f + s4.z) + h4.z; v[j].w = v[j].w * rstd * (1.f + s4.w) + h4.w;
            u32x2 p; p.x = pk2(v[j].x, v[j].y); p.y = pk2(v[j].z, v[j].w); o8[64 * j] = p; }
        if (GATES) {
            float g[8];
#pragma unroll
            for (int q = 0; q < 8; ++q) { float s = 0.f;
#pragma unroll
                for (int j = 0; j < 4; ++j) { const f32x4 w4 = *((const f32x4*)(wg + q * 1024) + lane + 64 * j);
                    s += (v[j].x * w4.x + v[j].y * w4.y) + (v[j].z * w4.z + v[j].w * w4.w); }
                g[q] = wave_sum(s); }
            if (lane == 0) {
#pragma unroll
                for (int q = 0; q < 4; ++q) { IPRE[(size_t)row * 4 + q] = g[q] + gate_b[q]; FPRE[(size_t)row * 4 + q] = g[4 + q] + gate_b[4 + q]; }
            }
        }
    }
}

template <class Epi>
__device__ __forceinline__ void ngemm_tile(float* As, float* Bs, const bf16_t* A, size_t lda, const int* gather, int row0, int rend,
                                           const bf16_t* Bt, int K, int n0, const Epi& E, int tid) {
    const int r = tid >> 3, cgp = tid & 7;
    float acc[8];
#pragma unroll
    for (int i = 0; i < 8; ++i) acc[i] = 0.f;
    const int lr = (tid & 127) >> 1, kp = (tid & 1) * 8;
    const bool isA = tid < 128;
    const bf16_t* src = Bt; bool ok = false;
    if (tid < 256) {
        if (isA) { const int ri = row0 + lr; ok = ri < rend; if (ok) { const int sr = gather ? gather[ri] : ri; src = A + (size_t)sr * lda + kp; } }
        else { ok = true; src = Bt + (size_t)(n0 + lr) * K + kp; }
    }
    for (int k0 = 0; k0 < K; k0 += 16) {
        if (tid < 256) {
            u32x4 v = (u32x4){0u, 0u, 0u, 0u};
            if (ok) v = *(const u32x4*)(src + k0);
            float* dp = (isA ? As : Bs) + kp * 68 + lr;
            dp[0] = bflo(v.x); dp[68] = bfhi(v.x); dp[136] = bflo(v.y); dp[204] = bfhi(v.y);
            dp[272] = bflo(v.z); dp[340] = bfhi(v.z); dp[408] = bflo(v.w); dp[476] = bfhi(v.w);
        }
        __syncthreads();
#pragma unroll
        for (int k = 0; k < 16; ++k) {
            const float av = As[k * 68 + r];
            const f32x4 b0 = *(const f32x4*)(Bs + k * 68 + 8 * cgp), b1 = *(const f32x4*)(Bs + k * 68 + 8 * cgp + 4);
            acc[0] += av * b0.x; acc[1] += av * b0.y; acc[2] += av * b0.z; acc[3] += av * b0.w;
            acc[4] += av * b1.x; acc[5] += av * b1.y; acc[6] += av * b1.z; acc[7] += av * b1.w;
        }
        __syncthreads();
    }
    E(row0 + r, (row0 + r) < rend, n0 + 8 * cgp, acc);
}


namespace pg8 {
#define PG8_LAS __attribute__((address_space(3)))
constexpr int BM = 256, BK = 64, HALF = 128, HTB = HALF * BK * 2;
__device__ __forceinline__ int lds_byte(int r, int c) { const int st = (r >> 4) * 2 + (c >> 5), rr = r & 15, cc = c & 31, ob = rr * 64 + cc * 2; return st * 1024 + (ob ^ (((ob >> 9) & 1) << 5)); }
__device__ __forceinline__ void stage_rc(int b, int& R, int& C) { const int st = b / 1024, sb = b % 1024, swz = sb ^ (((sb >> 9) & 1) << 5); R = (st >> 1) * 16 + swz / 64; C = (st & 1) * 32 + (swz % 64) / 2; }
__device__ __forceinline__ int perm32(int rho) { const int n = rho >> 4, i = rho & 15; return 8 * (i >> 2) + 4 * n + (i & 3); }
struct Unit { const char* A; const char* B; const int* gather; int row0, rend, col0; };

template <class RowEpi>
__device__ __forceinline__ void run_epi(const RowEpi& E, const f32x4 (&acc)[2][2][4][2], const Unit& u, int wr, int wc, int fr, int fq) {
#pragma unroll
    for (int ai = 0; ai < 2; ++ai)
#pragma unroll
        for (int m = 0; m < 4; ++m) { const int row = u.row0 + ai * HALF + wr * 64 + m * 16 + fr; const bool valid = row < u.rend;
#pragma unroll
            for (int bj = 0; bj < 2; ++bj) { const int col0 = u.col0 + bj * HALF + wc * 32 + 8 * fq;
                const float v[8] = {acc[ai][bj][m][0][0], acc[ai][bj][m][0][1], acc[ai][bj][m][0][2], acc[ai][bj][m][0][3], acc[ai][bj][m][1][0], acc[ai][bj][m][1][1], acc[ai][bj][m][1][2], acc[ai][bj][m][1][3]};
                E(row, valid, col0, v); } }
}

template <bool GATHER, class RowEpi, class Sched>
__device__ __forceinline__ void gemm_phase(PG8_LAS unsigned char* lds, const int K, const Sched& S, const RowEpi& E) {
    const int tid = threadIdx.x, wid = __builtin_amdgcn_readfirstlane(tid >> 6), lane = tid & 63, wr = wid >> 2, wc = wid & 3, fr = lane & 15, fq = lane >> 4;
    const int nt = K / BK;
    int Rr[2], Cc[2]; unsigned voffB[2];
#pragma unroll
    for (int i = 0; i < 2; ++i) { stage_rc(tid * 16 + i * 8192, Rr[i], Cc[i]); const int Rb = (Rr[i] & ~31) + perm32(Rr[i] & 31); voffB[i] = (unsigned)(Rb * K + Cc[i]) * 2u; }
    const size_t kstep = (size_t)(BK * 2);
    const size_t hstepB = (size_t)HALF * K * 2;
    const unsigned ldsw = (unsigned)wid * 1024u;
    const int aoff = lds_byte(wr * 64 + fr, fq * 8), boff = lds_byte(wc * 32 + fr, fq * 8);
#define PG8_SA(b, h) (((b) * 2 + (h)) * HTB)
#define PG8_SB(b, h) ((4 + (b) * 2 + (h)) * HTB)
#define PG8_STAGE(bufoff, gbase, voff) do { _Pragma("unroll") for (int _i = 0; _i < 2; ++_i) \
        __builtin_amdgcn_global_load_lds((const unsigned*)((const char*)(gbase) + (voff)[_i]), (PG8_LAS unsigned*)(lds + (bufoff) + ldsw + _i * 8192), 16, 0, 0); } while (0)
#define PG8_LDA(dst, b, h) do { _Pragma("unroll") for (int m = 0; m < 4; ++m) _Pragma("unroll") for (int k = 0; k < 2; ++k) dst[m][k] = *(const PG8_LAS bf16x8*)(lds + PG8_SA(b, h) + aoff + m * 2048 + k * 1024); } while (0)
#define PG8_LDB(dst, b, h) do { _Pragma("unroll") for (int n = 0; n < 2; ++n) _Pragma("unroll") for (int k = 0; k < 2; ++k) dst[n][k] = *(const PG8_LAS bf16x8*)(lds + PG8_SB(b, h) + boff + n * 2048 + k * 1024); } while (0)
#define PG8_MMA(ai, bj, At, Bt) do { __builtin_amdgcn_s_setprio(1); _Pragma("unroll") for (int m = 0; m < 4; ++m) _Pragma("unroll") for (int n = 0; n < 2; ++n) _Pragma("unroll") for (int k = 0; k < 2; ++k) \
        acc[ai][bj][m][n] = __builtin_amdgcn_mfma_f32_16x16x32_bf16(Bt[n][k], At[m][k], acc[ai][bj][m][n], 0, 0, 0); __builtin_amdgcn_s_setprio(0); } while (0)
#define PG8_WAIT_V(n) asm volatile("s_waitcnt vmcnt(" #n ")" ::: "memory")
#define PG8_WAIT_L(n) asm volatile("s_waitcnt lgkmcnt(" #n ")" ::: "memory")
#define PG8_BAR __builtin_amdgcn_s_barrier()
#define PG8_SCHED __builtin_amdgcn_sched_barrier(0)
#define PG8_FILLA(u, v) do { _Pragma("unroll") for (int _h = 0; _h < 2; ++_h) _Pragma("unroll") for (int _i = 0; _i < 2; ++_i) { const int _row = _h * HALF + Rr[_i]; \
        if (GATHER) { const int _ri = (u).row0 + _row; const int _src = (u).gather[_ri < (u).rend ? _ri : (u).row0]; (v)[_h][_i] = (unsigned)(_src * K + Cc[_i]) * 2u; } \
        else (v)[_h][_i] = (unsigned)(_row * K + Cc[_i]) * 2u; } } while (0)
    Unit cur, nxt; int ui = 0;
    if (!S.next(0, cur)) return;
    f32x4 acc[2][2][4][2];
#pragma unroll
    for (int a = 0; a < 2; ++a)
#pragma unroll
        for (int b = 0; b < 2; ++b)
#pragma unroll
            for (int m = 0; m < 4; ++m)
#pragma unroll
                for (int n = 0; n < 2; ++n) acc[a][b][m][n] = (f32x4){0.f, 0.f, 0.f, 0.f};
    bf16x8 At[4][2], B0[2][2], B1[2][2];
    unsigned voffA[2][2], nvoffA[2][2];
    PG8_FILLA(cur, voffA);
    const char* cA = cur.A; const char* cB = cur.B;
    PG8_STAGE(PG8_SB(0, 0), cB, voffB); PG8_STAGE(PG8_SB(0, 1), cB + hstepB, voffB); PG8_STAGE(PG8_SA(0, 0), cA, voffA[0]); PG8_STAGE(PG8_SA(0, 1), cA, voffA[1]);
    if (wr == 1) PG8_BAR;
    PG8_WAIT_V(2); PG8_BAR;
    PG8_STAGE(PG8_SB(1, 0), cB + kstep, voffB); PG8_STAGE(PG8_SA(1, 0), cA + kstep, voffA[0]); PG8_STAGE(PG8_SB(1, 1), cB + hstepB + kstep, voffB);
    PG8_WAIT_V(6); PG8_BAR;
    for (;;) {
        const bool has_next = S.next(ui + 1, nxt);
        const char* nA = has_next ? nxt.A : cA; const char* nB = has_next ? nxt.B : cB;
        if (GATHER && has_next) { PG8_FILLA(nxt, nvoffA); }
        else {
#pragma unroll
            for (int h = 0; h < 2; ++h)
#pragma unroll
                for (int i = 0; i < 2; ++i) nvoffA[h][i] = voffA[h][i]; }
        for (int t = 0; t < nt; t += 2) {
            const bool last = (t == nt - 2);
            const char* a1 = cA + (size_t)(t + 1) * kstep;
            const char* a2 = last ? nA : cA + (size_t)(t + 2) * kstep; const char* b2 = last ? nB : cB + (size_t)(t + 2) * kstep;
            const char* a3 = a2 + kstep; const char* b3 = b2 + kstep;
            unsigned v2[2][2];
#pragma unroll
            for (int h = 0; h < 2; ++h)
#pragma unroll
                for (int i = 0; i < 2; ++i) v2[h][i] = last ? nvoffA[h][i] : voffA[h][i];
            PG8_LDB(B0, 0, 0); PG8_LDB(B1, 0, 1); PG8_SCHED; PG8_LDA(At, 0, 0); PG8_STAGE(PG8_SA(1, 1), a1, voffA[1]);
            PG8_WAIT_V(8); PG8_WAIT_L(0); PG8_BAR; PG8_MMA(0, 0, At, B0); PG8_MMA(0, 1, At, B1); PG8_BAR; PG8_SCHED;
            PG8_LDA(At, 0, 1); PG8_STAGE(PG8_SB(0, 0), b2, voffB); PG8_STAGE(PG8_SB(0, 1), b2 + hstepB, voffB); PG8_STAGE(PG8_SA(0, 0), a2, v2[0]);
            PG8_WAIT_V(8); PG8_WAIT_L(0); PG8_BAR; PG8_MMA(1, 0, At, B0); PG8_MMA(1, 1, At, B1); PG8_BAR; PG8_SCHED;
            PG8_LDB(B0, 1, 0); PG8_LDB(B1, 1, 1); PG8_SCHED; PG8_LDA(At, 1, 0); PG8_STAGE(PG8_SA(0, 1), a2, v2[1]);
            PG8_WAIT_V(8); PG8_WAIT_L(0); PG8_BAR; PG8_MMA(0, 0, At, B0); PG8_MMA(0, 1, At, B1); PG8_BAR; PG8_SCHED;
            PG8_LDA(At, 1, 1); PG8_STAGE(PG8_SB(1, 0), b3, voffB); PG8_STAGE(PG8_SB(1, 1), b3 + hstepB, voffB); PG8_STAGE(PG8_SA(1, 0), a3, v2[0]);
            PG8_WAIT_V(8); PG8_WAIT_L(0); PG8_BAR; PG8_MMA(1, 0, At, B0); PG8_MMA(1, 1, At, B1); PG8_BAR; PG8_SCHED;
        }
        if (wr == 0) PG8_BAR;
        run_epi(E, acc, cur, wr, wc, fr, fq);
        if (!has_next) break;
#pragma unroll
        for (int a = 0; a < 2; ++a)
#pragma unroll
            for (int b = 0; b < 2; ++b)
#pragma unroll
                for (int m = 0; m < 4; ++m)
#pragma unroll
                    for (int n = 0; n < 2; ++n) acc[a][b][m][n] = (f32x4){0.f, 0.f, 0.f, 0.f};
        cur = nxt; cA = nA; cB = nB; ++ui;
#pragma unroll
        for (int h = 0; h < 2; ++h)
#pragma unroll
            for (int i = 0; i < 2; ++i) voffA[h][i] = nvoffA[h][i];
        if (wr == 1) PG8_BAR;
    }
    PG8_WAIT_V(0);
    PG8_BAR;
#undef PG8_SA
#undef PG8_SB
#undef PG8_STAGE
#undef PG8_LDA
#undef PG8_LDB
#undef PG8_MMA
#undef PG8_WAIT_V
#undef PG8_WAIT_L
#undef PG8_BAR
#undef PG8_SCHED
#undef PG8_FILLA
}

struct DenseSched {
    const char* A; const char* Bt; int K, M, nM, nN, nwg, G, c;
    __device__ __forceinline__ void init(const void* A_, const void* Bt_, int M_, int N_, int K_, int G_, int c_) { A = (const char*)A_; Bt = (const char*)Bt_; K = K_; M = M_; nM = M_ / BM; nN = N_ / BM; nwg = nM * nN; G = G_; c = c_; }
    __device__ __forceinline__ bool next(int i, Unit& u) const {
        const long L = (long)i * G + c; if (L >= nwg) return false;
        int wgid = (int)L; { const int q = nwg / 8, r = nwg % 8, xcd = wgid % 8, off = wgid / 8; wgid = (xcd < r ? xcd * (q + 1) : r * (q + 1) + (xcd - r) * q) + off; }
        const int nig = 8 * nN, gid = wgid / nig, fm = gid * 8, gsz = (nM - fm) < 8 ? (nM - fm) : 8;
        const int pm = fm + ((wgid % nig) % gsz), pn = (wgid % nig) / gsz;
        u.A = A + (size_t)pm * BM * K * 2; u.B = Bt + (size_t)pn * BM * K * 2; u.gather = nullptr; u.row0 = pm * BM; u.rend = M; u.col0 = pn * BM; return true;
    }
};
struct ExpertSched {
    const int* TILE; int nunits, NPN; const char* A; const int* gather; const char* Bt; size_t bstride; int K, G, vcu;
    __device__ __forceinline__ bool next(int i, Unit& u) const {
        const int L = i * G + vcu; if (L >= nunits) return false;
        const int tl = L / NPN, pn = L % NPN;
        const int e = __builtin_amdgcn_readfirstlane(TILE[64 + tl]), r0 = __builtin_amdgcn_readfirstlane(TILE[64 + 2048 + tl]), re = __builtin_amdgcn_readfirstlane(TILE[64 + 4096 + tl]);
        u.B = Bt + (size_t)e * bstride + (size_t)pn * BM * K * 2; u.row0 = r0; u.rend = re; u.col0 = pn * BM;
        if (gather) { u.A = A; u.gather = gather; } else { u.A = A + (size_t)r0 * K * 2; u.gather = nullptr; }
        return true;
    }
};
}

struct EpiProj { bf16_t* P;
    __device__ __forceinline__ void operator()(int row, bool valid, int col0, const float (&v)[8]) const { if (valid) *(u32x4*)(P + (size_t)row * NPROJ + col0) = pack8(v); } };
struct EpiOut { const float* x; float* x1; const float* MOD;
    __device__ __forceinline__ void operator()(int row, bool valid, int col0, const float (&v)[8]) const {
        if (!valid) return; const int b = row / SEQ; const float* ga = MOD + b * 6144 + 2 * 1024 + col0;
        const f32x4 x0 = *(const f32x4*)(x + (size_t)row * DM + col0), x1v = *(const f32x4*)(x + (size_t)row * DM + col0 + 4);
        f32x4 o0, o1; o0.x = x0.x + ga[0] * v[0]; o0.y = x0.y + ga[1] * v[1]; o0.z = x0.z + ga[2] * v[2]; o0.w = x0.w + ga[3] * v[3];
        o1.x = x1v.x + ga[4] * v[4]; o1.y = x1v.y + ga[5] * v[5]; o1.z = x1v.z + ga[6] * v[6]; o1.w = x1v.w + ga[7] * v[7];
        *(f32x4*)(x1 + (size_t)row * DM + col0) = o0; *(f32x4*)(x1 + (size_t)row * DM + col0 + 4) = o1; } };
struct EpiRS { float* LOG; bf16_t* ACT;
    __device__ __forceinline__ void operator()(int row, bool valid, int col0, const float (&v)[8]) const {
        if (!valid) return;
        if (col0 < 256) { *(f32x4*)(LOG + (size_t)row * 256 + col0) = (f32x4){v[0], v[1], v[2], v[3]}; *(f32x4*)(LOG + (size_t)row * 256 + col0 + 4) = (f32x4){v[4], v[5], v[6], v[7]}; }
        else { const int j0 = (col0 - 256) >> 1; u32x2 p; p.x = pk2(siluf(v[0]) * v[4], siluf(v[1]) * v[5]); p.y = pk2(siluf(v[2]) * v[6], siluf(v[3]) * v[7]);
            *(u32x2*)(ACT + (size_t)(SHARED_BASE + row) * 256 + j0) = p; } } };
struct EpiG1 { const float* SG; bf16_t* ACT;
    __device__ __forceinline__ void operator()(int row, bool valid, int col0, const float (&v)[8]) const {
        if (!valid) return; const float g = SG[row]; const int j0 = col0 >> 1; u32x2 p;
        p.x = pk2(siluf(v[0]) * v[4] * g, siluf(v[1]) * v[5] * g); p.y = pk2(siluf(v[2]) * v[6] * g, siluf(v[3]) * v[7] * g);
        *(u32x2*)(ACT + (size_t)row * 256 + j0) = p; } };
struct EpiG2 { bf16_t* YP;
    __device__ __forceinline__ void operator()(int row, bool valid, int col0, const float (&v)[8]) const { if (valid) *(u32x4*)(YP + (size_t)row * DM + col0) = pack8(v); } };

constexpr int LR = 136;
__device__ __forceinline__ f32x4 mfma16(bf16x8 a, bf16x8 b, f32x4 c) { asm volatile("s_nop 7" : "+v"(a), "+v"(b), "+v"(c)); f32x4 r = __builtin_amdgcn_mfma_f32_16x16x32_bf16(a, b, c, 0, 0, 0); asm volatile("s_nop 15\n\ts_nop 15" : "+v"(r)); return r; }
__device__ __forceinline__ bf16x8 ldfrag(const bf16_t* base, int row, int k0, int lane) { return *(const bf16x8*)(base + (row + (lane & 15)) * LR + k0 + 8 * (lane >> 4)); }

__device__ __forceinline__ void conv8(const bf16_t* PROJ, const float* cw, const float* cb, int b, int sg, int ch, float (&o)[8]) {
    float acc[8];
    { const f32x4 b0 = *(const f32x4*)(cb + ch), b1 = *(const f32x4*)(cb + ch + 4); acc[0] = b0.x; acc[1] = b0.y; acc[2] = b0.z; acc[3] = b0.w; acc[4] = b1.x; acc[5] = b1.y; acc[6] = b1.z; acc[7] = b1.w; }
#pragma unroll
    for (int j = 0; j < 4; ++j) { const int sp = sg - 3 + j;
        if (sp >= 0) { float x[8]; unpack8(*(const u32x4*)(PROJ + (size_t)(b * SEQ + sp) * NPROJ + ch), x);
            const f32x4 w0 = *(const f32x4*)(cw + j * 1024 + ch), w1 = *(const f32x4*)(cw + j * 1024 + ch + 4);
            acc[0] += w0.x * x[0]; acc[1] += w0.y * x[1]; acc[2] += w0.z * x[2]; acc[3] += w0.w * x[3];
            acc[4] += w1.x * x[4]; acc[5] += w1.y * x[5]; acc[6] += w1.z * x[6]; acc[7] += w1.w * x[7]; } }
#pragma unroll
    for (int q = 0; q < 8; ++q) o[q] = siluf(acc[q]);
}

__device__ __forceinline__ void chunk_gates(const Args& a, float* bb, float* ii, float* tmp, int t0, int h, int tid) {
    const float* IPRE = (const float*)(a.ws + WS_IPRE); const float* FPRE = (const float*)(a.ws + WS_FPRE);
    if (tid < 128) { const float f = FPRE[(size_t)(t0 + tid) * 4 + h]; ii[tid] = IPRE[(size_t)(t0 + tid) * 4 + h];
        tmp[tid] = fminf(f, 0.f) - log1pf(expf(-fabsf(f))); }
    __syncthreads();
    if (tid < 128) { float s = 0.f; for (int j = 0; j <= tid; ++j) s += tmp[j]; bb[tid] = s; }
    __syncthreads();
}

__device__ __forceinline__ void mlstm_m1_unit(const Args& a, unsigned char* lds, int unit) {
    const int tid = threadIdx.x, lane = tid & 63, wave = tid >> 6;
    const int bh = unit >> 6, c = unit & 63, b = bh >> 2, h = bh & 3, t0 = b * SEQ + c * 128;
    bf16_t* kT = (bf16_t*)lds; bf16_t* vT = kT + 128 * LR;
    float* sf = (float*)(lds + 2 * 128 * LR * 2); float* bb = sf; float* ii = sf + 128; float* tmp = sf + 256; float* wk = sf + 384;
    const bf16_t* PROJ = (const bf16_t*)(a.ws + WS_PROJ);
    const float* cw = a.in[5]; const float* cbias = a.in[6];
    chunk_gates(a, bb, ii, tmp, t0, h, tid);
    const float blast = bb[127];
    if (tid < 128) tmp[tid] = blast - bb[tid] + ii[tid];
    __syncthreads();
    float mloc = -INFINITY;
    for (int j = 0; j < 128; ++j) mloc = fmaxf(mloc, tmp[j]);
    if (tid < 128) wk[tid] = expf(tmp[tid] - mloc);
    __syncthreads();
    for (int it = tid; it < 2048; it += 512) { const int s = it >> 4, ch = it & 15;
        float kv[8]; conv8(PROJ, cw, cbias, b, c * 128 + s, 512 + h * 128 + 8 * ch, kv);
        const float sc = 0.08838834764831845f * wk[s];
#pragma unroll
        for (int q = 0; q < 8; ++q) kT[(8 * ch + q) * LR + s] = (bf16_t)f2bf(kv[q] * sc);
        float vv[8]; unpack8(*(const u32x4*)(PROJ + (size_t)(t0 + s) * NPROJ + 1024 + h * 128 + 8 * ch), vv);
#pragma unroll
        for (int q = 0; q < 8; ++q) vT[(8 * ch + q) * LR + s] = (bf16_t)f2bf(vv[q]);
    }
    __syncthreads();
    float* CLOC = (float*)(a.ws + WS_CLOC) + (size_t)unit * 16384;
    float* MST = (float*)(a.ws + WS_MST);
    {
        f32x4 acc[8];
#pragma unroll
        for (int i = 0; i < 8; ++i) acc[i] = (f32x4){0.f, 0.f, 0.f, 0.f};
#pragma unroll
        for (int ks = 0; ks < 4; ++ks) { const bf16x8 af = ldfrag(vT, 16 * wave, 32 * ks, lane);
#pragma unroll
            for (int db = 0; db < 8; ++db) acc[db] = mfma16(af, ldfrag(kT, 16 * db, 32 * ks, lane), acc[db]); }
#pragma unroll
        for (int db = 0; db < 8; ++db)
#pragma unroll
            for (int r = 0; r < 4; ++r) CLOC[(16 * wave + 4 * (lane >> 4) + r) * 128 + 16 * db + (lane & 15)] = acc[db][r];
    }
    if (tid < 128) { float s = 0.f; for (int j = 0; j < 128; ++j) s += bflo(kT[tid * LR + j]); MST[16384 + (size_t)unit * 128 + tid] = s; }
    if (tid == 0) { MST[unit] = mloc; MST[1024 + unit] = blast; }
    __syncthreads();
}

__device__ __forceinline__ void mlstm_m2(const Args& a) {
    const float* CLOC = (const float*)(a.ws + WS_CLOC); bf16_t* CIN = (bf16_t*)(a.ws + WS_CIN);
    float* MST = (float*)(a.ws + WS_MST);
    const float* NLOC = MST + 16384; float* NIN = MST + 16384 + 131072;
    const int NEL = 16 * 16512;
    for (int idx = blockIdx.x * 512 + threadIdx.x; idx < NEL; idx += gridDim.x * 512) {
        const int bh = idx / 16512, el = idx % 16512;
        float st = 0.f, m = 0.f;
        for (int c = 0; c < 64; ++c) {
            const int u = bh * 64 + c;
            const float ml = MST[u], bl = MST[1024 + u];
            float loc;
            if (el < 16384) { CIN[(size_t)u * 16384 + el] = (bf16_t)f2bf(st); loc = CLOC[(size_t)u * 16384 + el]; if (el == 0) MST[2048 + u] = m; }
            else { NIN[(size_t)u * 128 + (el - 16384)] = st; loc = NLOC[(size_t)u * 128 + (el - 16384)]; }
            const float mn = fmaxf(bl + m, ml);
            st = expf(bl + m - mn) * st + expf(ml - mn) * loc;
            m = mn;
        }
    }
}

__device__ __forceinline__ void mlstm_m3_unit(const Args& a, unsigned char* lds, int unit) {
    const int tid = threadIdx.x, lane = tid & 63, wave = tid >> 6;
    const int bh = unit >> 6, c = unit & 63, b = bh >> 2, h = bh & 3, t0 = b * SEQ + c * 128;
    bf16_t* qs = (bf16_t*)lds; bf16_t* ks = qs + 128 * LR; bf16_t* vT = ks + 128 * LR; bf16_t* CT = vT + 128 * LR; bf16_t* Ps = ks;
    float* sf = (float*)(lds + 4 * 128 * LR * 2);
    float* bb = sf; float* ii = sf + 128; float* tmp = sf + 256; float* gg = sf + 384; float* wint = sf + 512; float* nn = sf + 640; float* den = sf + 768; float* dint = sf + 896;
    const bf16_t* PROJ = (const bf16_t*)(a.ws + WS_PROJ); const bf16_t* CIN = (const bf16_t*)(a.ws + WS_CIN) + (size_t)unit * 16384;
    const float* MST = (const float*)(a.ws + WS_MST);
    const float* cw = a.in[5]; const float* cbias = a.in[6]; const float* mlg = a.in[8];
    bf16_t* MIX = (bf16_t*)(a.ws + WS_MIX);
    chunk_gates(a, bb, ii, tmp, t0, h, tid);
    const float m_in = MST[2048 + unit];
    if (tid < 128) { float pm = -INFINITY; for (int j = 0; j <= tid; ++j) pm = fmaxf(pm, ii[j] - bb[j]);
        const float g = fmaxf(m_in, pm); gg[tid] = g; wint[tid] = expf(m_in - g); tmp[tid] = ii[tid] - bb[tid];
        nn[tid] = MST[16384 + 131072 + (size_t)unit * 128 + tid]; }
    for (int it = tid; it < 2048; it += 512) { const int s = it >> 4, ch = it & 15;
        float qv[8], kv[8];
        conv8(PROJ, cw, cbias, b, c * 128 + s, h * 128 + 8 * ch, qv);
        conv8(PROJ, cw, cbias, b, c * 128 + s, 512 + h * 128 + 8 * ch, kv);
#pragma unroll
        for (int q = 0; q < 8; ++q) kv[q] *= 0.08838834764831845f;
        *(u32x4*)(qs + s * LR + 8 * ch) = pack8(qv);
        *(u32x4*)(ks + s * LR + 8 * ch) = pack8(kv);
        float vv[8]; unpack8(*(const u32x4*)(PROJ + (size_t)(t0 + s) * NPROJ + 1024 + h * 128 + 8 * ch), vv);
#pragma unroll
        for (int q = 0; q < 8; ++q) vT[(8 * ch + q) * LR + s] = (bf16_t)f2bf(vv[q]);
        *(u32x4*)(CT + s * LR + 8 * ch) = *(const u32x4*)(CIN + s * 128 + 8 * ch);
    }
    __syncthreads();
    if (tid < 128) { float s = 0.f; for (int d = 0; d < 128; ++d) s += bflo(qs[tid * LR + d]) * nn[d]; dint[tid] = s * wint[tid]; }
    f32x4 sacc[8];
#pragma unroll
    for (int i = 0; i < 8; ++i) sacc[i] = (f32x4){0.f, 0.f, 0.f, 0.f};
#pragma unroll
    for (int kk = 0; kk < 4; ++kk) { const bf16x8 bq = ldfrag(qs, 16 * wave, 32 * kk, lane);
#pragma unroll
        for (int sb = 0; sb < 8; ++sb) sacc[sb] = mfma16(ldfrag(ks, 16 * sb, 32 * kk, lane), bq, sacc[sb]); }
    __syncthreads();
    {
        const int t = 16 * wave + (lane & 15); const float g = gg[t]; float rs = 0.f;
#pragma unroll
        for (int sb = 0; sb < 8; ++sb) { float p[4];
#pragma unroll
            for (int r = 0; r < 4; ++r) { const int s = 16 * sb + 4 * (lane >> 4) + r; p[r] = (s <= t) ? sacc[sb][r] * expf(tmp[s] - g) : 0.f; rs += p[r]; }
            u32x2 w; w.x = pk2(p[0], p[1]); w.y = pk2(p[2], p[3]);
#if DBG_M3
            { float* dp = a.out + (size_t)(t0 + t) * DM + h * 256 + 16 * sb + 4 * (lane >> 4); dp[0] = 0.f; dp[1] = 0.f; dp[2] = 0.f; dp[3] = 0.f; }
#endif
            *(u32x2*)(Ps + t * LR + 16 * sb + 4 * (lane >> 4)) = w; }
        rs += __shfl_xor(rs, 16); rs += __shfl_xor(rs, 32);
        if (lane < 16) den[t] = rs + dint[t];
    }
    __syncthreads();
    {
        f32x4 a1[8], a2[8];
#pragma unroll
        for (int i = 0; i < 8; ++i) { a1[i] = (f32x4){0.f, 0.f, 0.f, 0.f}; a2[i] = (f32x4){0.f, 0.f, 0.f, 0.f}; }
#pragma unroll
        for (int kk = 0; kk < 4; ++kk) { const bf16x8 ap = ldfrag(Ps, 16 * wave, 32 * kk, lane), aq = ldfrag(qs, 16 * wave, 32 * kk, lane);
#pragma unroll
            for (int eb = 0; eb < 8; ++eb) { a1[eb] = mfma16(ap, ldfrag(vT, 16 * eb, 32 * kk, lane), a1[eb]); a2[eb] = mfma16(aq, ldfrag(CT, 16 * eb, 32 * kk, lane), a2[eb]); } }
        float hv[8][4]; float ssq[4];
#pragma unroll
        for (int r = 0; r < 4; ++r) { const int t = 16 * wave + 4 * (lane >> 4) + r;
            const float dd = fmaxf(fabsf(den[t]), expf(-(bb[t] + gg[t]))); const float inv = 1.f / dd, wi = wint[t]; float s2 = 0.f;
#pragma unroll
            for (int eb = 0; eb < 8; ++eb) { const float x = (a1[eb][r] + wi * a2[eb][r]) * inv; hv[eb][r] = x; s2 += x * x;
#if DBG_M3
                a.out[(size_t)(t0 + t) * DM + h * 256 + 128 + 16 * eb + (lane & 15)] = (eb == 0) ? bb[t] : (eb == 1) ? gg[t] : 0.f;
#endif
            }
            s2 += __shfl_xor(s2, 1); s2 += __shfl_xor(s2, 2); s2 += __shfl_xor(s2, 4); s2 += __shfl_xor(s2, 8);
            ssq[r] = rsqrtf(s2 * (1.f / 128.f) + EPS); }
#pragma unroll
        for (int eb = 0; eb < 8; ++eb) { const int e = 16 * eb + (lane & 15); const float ge = mlg[e];
#pragma unroll
            for (int r = 0; r < 4; ++r) { const int t = 16 * wave + 4 * (lane >> 4) + r;
                const float mo = bflo(PROJ[(size_t)(t0 + t) * NPROJ + 1536 + h * 128 + e]);
                MIX[(size_t)(t0 + t) * DM + h * 128 + e] = (bf16_t)f2bf(hv[eb][r] * ssq[r] * ge * sigm(mo)); } }
    }
    __syncthreads();
}

__device__ __forceinline__ void qknorm_rows(const Args& a) {
    const int tid = threadIdx.x, lane = tid & 63, wave = tid >> 6;
    bf16_t* PROJ = (bf16_t*)(a.ws + WS_PROJ);
    const float* gq = a.in[9]; const float* gk = a.in[10];
    const float* g = (lane < 32) ? gq : gk; const float scl = (lane < 32) ? C2 : 1.f;
    float gv[16];
#pragma unroll
    for (int i = 0; i < 16; ++i) gv[i] = g[16 * (lane & 3) + i] * scl;
    const int gw = blockIdx.x * 8 + wave, NGW = gridDim.x * 8;
    for (int row = gw; row < T; row += NGW) {
        u32x4* p = (u32x4*)(PROJ + (size_t)row * NPROJ + 2048 + 16 * lane);
        float x[16]; { float t8[8]; unpack8(p[0], t8);
#pragma unroll
            for (int i = 0; i < 8; ++i) x[i] = t8[i]; unpack8(p[1], t8);
#pragma unroll
            for (int i = 0; i < 8; ++i) x[8 + i] = t8[i]; }
        float ss = 0.f;
#pragma unroll
        for (int i = 0; i < 16; ++i) ss += x[i] * x[i];
        ss += __shfl_xor(ss, 1); ss += __shfl_xor(ss, 2);
        const float rstd = rsqrtf(ss * (1.f / 64.f) + EPS);
        float y0[8], y1[8];
#pragma unroll
        for (int i = 0; i < 8; ++i) { y0[i] = x[i] * rstd * gv[i]; y1[i] = x[8 + i] * rstd * gv[8 + i]; }
        p[0] = pack8(y0); p[1] = pack8(y1);
    }
}

__device__ __forceinline__ void attn_naive_unit(const Args& a, unsigned char* lds, int bh, int qb) {
    const int tid = threadIdx.x, wave = tid >> 6;
    const int b = bh >> 2, h = bh & 3;
    float* Ks = (float*)lds; float* Vs = Ks + 64 * 64;
    const bf16_t* PROJ = (const bf16_t*)(a.ws + WS_PROJ); float* TMP = (float*)(a.ws + WS_TMP); bf16_t* MIX = (bf16_t*)(a.ws + WS_MIX);
    const int qi = qb * 512 + tid; const size_t trow = (size_t)b * SEQ + qi;
    const float slope2 = exp2f(-2.f * (float)(h + 1)) * LOG2E;
    float lam;
    { float s1 = 0.f, s2 = 0.f; const float* q1 = a.in[11]; const float* k1 = a.in[12]; const float* q2 = a.in[13]; const float* k2 = a.in[14];
        for (int i = 0; i < 64; ++i) { s1 += q1[i] * k1[i]; s2 += q2[i] * k2[i]; }
        lam = expf(s1) - expf(s2) + LAM_INIT; }
    const int nt = qb * 8 + 8; const int qwmax = qb * 512 + wave * 64 + 63;
    float* tp = TMP + trow * 512 + h * 128;
    for (int pass = 0; pass < 4; ++pass) {
        const int c = pass >> 1, vh = pass & 1;
        float q[64], o[64];
        { const bf16_t* qp = PROJ + trow * NPROJ + 2048 + h * 128 + c * 64;
#pragma unroll
            for (int i = 0; i < 8; ++i) { float t8[8]; unpack8(*(const u32x4*)(qp + 8 * i), t8);
#pragma unroll
                for (int j = 0; j < 8; ++j) q[8 * i + j] = t8[j]; } }
#pragma unroll
        for (int i = 0; i < 64; ++i) o[i] = 0.f;
        float m = -INFINITY, l = 0.f;
        for (int kt = 0; kt < nt; ++kt) {
            __syncthreads();
            { const int key = tid >> 3, ch = tid & 7; const bf16_t* rp = PROJ + ((size_t)b * SEQ + kt * 64 + key) * NPROJ;
                float t8[8]; unpack8(*(const u32x4*)(rp + 2560 + h * 128 + c * 64 + 8 * ch), t8);
                *(f32x4*)(Ks + key * 64 + 8 * ch) = (f32x4){t8[0], t8[1], t8[2], t8[3]}; *(f32x4*)(Ks + key * 64 + 8 * ch + 4) = (f32x4){t8[4], t8[5], t8[6], t8[7]};
                unpack8(*(const u32x4*)(rp + 3072 + h * 128 + vh * 64 + 8 * ch), t8);
                *(f32x4*)(Vs + key * 64 + 8 * ch) = (f32x4){t8[0], t8[1], t8[2], t8[3]}; *(f32x4*)(Vs + key * 64 + 8 * ch + 4) = (f32x4){t8[4], t8[5], t8[6], t8[7]}; }
            __syncthreads();
            if (kt * 64 <= qwmax) {
                for (int j = 0; j < 64; ++j) {
                    const int kpos = kt * 64 + j; const float* kr = Ks + j * 64; const float* vr = Vs + j * 64;
                    float s = 0.f;
#pragma unroll
                    for (int d = 0; d < 64; ++d) s += q[d] * kr[d];
                    s = (kpos <= qi) ? (s - slope2 * (float)(qi - kpos)) : -INFINITY;
                    if (s > m) { const float al = exp2f(m - s); l *= al;
#pragma unroll
                        for (int e = 0; e < 64; ++e) o[e] *= al; m = s; }
                    const float p = exp2f(s - m); l += p;
#pragma unroll
                    for (int e = 0; e < 64; ++e) o[e] += p * vr[e];
                }
            }
        }
        const float inv = 1.f / l;
        if (c == 0) {
#pragma unroll
            for (int e = 0; e < 64; ++e) tp[vh * 64 + e] = o[e] * inv;
        } else {
#pragma unroll
            for (int e = 0; e < 64; ++e) tp[vh * 64 + e] = tp[vh * 64 + e] - lam * o[e] * inv;
        }
    }
    { const float* dg = a.in[15]; float ss = 0.f;
        for (int e = 0; e < 128; ++e) { const float v = tp[e]; ss += v * v; }
        const float rs = rsqrtf(ss * (1.f / 128.f) + EPS) * (1.f - LAM_INIT);
        for (int e = 0; e < 128; e += 2) { const unsigned w = pk2(tp[e] * rs * dg[e], tp[e + 1] * rs * dg[e + 1]);
            *(unsigned*)(MIX + trow * DM + 512 + h * 128 + e) = w; } }
    __syncthreads();
}

#include <hip/hip_bf16.h>
namespace attn_body {
using bf16=__hip_bfloat16;
using bf16x8=__attribute__((ext_vector_type(8)))short;
using s16x4=__attribute__((ext_vector_type(4)))short;
using f32x16=__attribute__((ext_vector_type(16)))float;
using u32x4=__attribute__((ext_vector_type(4)))unsigned;
constexpr int SEQ=8192,D=64,PQ=3584,PO=512;
constexpr int NW=8,QBLK=32,QB=QBLK*NW,KVBLK=64,NQB=SEQ/QB;
__device__ __forceinline__ int crow(int r,int hi){return (r&3)+8*(r>>2)+4*hi;}
#define SBAR() __builtin_amdgcn_sched_barrier(0)
__device__ __forceinline__ void cmask(f32x16&p0,f32x16&p1,int jb,int qrel,int hi){
  const float NEG=-INFINITY; int kb=64*jb+4*hi;
  #pragma unroll
  for(int r=0;r<16;++r){int kv=kb+(r&3)+8*(r>>2); if(kv>qrel)p0[r]=NEG; if(kv+32>qrel)p1[r]=NEG;}
}

constexpr int NSLOT=3, SLOTB=8192;
constexpr int LDS_K=0, LDS_V=NSLOT*SLOTB, LDS_WS=2*NSLOT*SLOTB, LDS_OST=LDS_WS+NW*64*4, LDS_BYTES=LDS_OST+NW*4096;
constexpr float C2=0.125f*1.4426950408889634f;
__device__ __forceinline__ void glds16(const void*gsrc,unsigned lds_dst){unsigned keep;
  asm volatile("s_mov_b32 %0, m0\n\ts_mov_b32 m0, %2\n\ts_nop 0\n\tglobal_load_lds_dwordx4 %1, off\n\ts_mov_b32 m0, %0":"=&s"(keep):"v"(gsrc),"s"(lds_dst):"memory");}
__device__ __forceinline__ float max3f(float a,float b,float c){float r;asm("v_max3_f32 %0, %1, %2, %3":"=v"(r):"v"(a),"v"(b),"v"(c));return r;}
__device__ __forceinline__ float max2f(float a,float b){float r;asm("v_max_f32_e32 %0, %1, %2":"=v"(r):"v"(a),"v"(b));return r;}
__device__ __forceinline__ float fadd_s(float a,float b){float r;asm("v_add_f32_e32 %0, %1, %2":"=v"(r):"v"(a),"v"(b));return r;}
__device__ __forceinline__ float fsub_s(float a,float b){float r;asm("v_sub_f32_e32 %0, %1, %2":"=v"(r):"v"(a),"v"(b));return r;}
typedef float f32x2_t __attribute__((ext_vector_type(2))); typedef __bf16 bf16x2_t __attribute__((ext_vector_type(2)));
__device__ __forceinline__ unsigned cvtpk_s(float lo,float hi){f32x2_t v={lo,hi};bf16x2_t b=__builtin_convertvector(v,bf16x2_t);return __builtin_bit_cast(unsigned,b);}
#define WAIT_BAR(N) asm volatile("s_waitcnt vmcnt(" #N ") lgkmcnt(0)\n\ts_barrier":::"memory")

__device__ __forceinline__ void qkt(f32x16&p0,f32x16&p1,const char*Kslot,const bf16x8*qr,const f32x16&negm,int r32,int hi){
  const char*kb=Kslot+hi*1024+r32*16;
  #pragma unroll
  for(int d0=0;d0<4;++d0){
    const bf16x8 b0=*reinterpret_cast<const bf16x8*>(kb+d0*2048);
    const bf16x8 b1=*reinterpret_cast<const bf16x8*>(kb+d0*2048+512);
    if(d0==0){p0=__builtin_amdgcn_mfma_f32_32x32x16_bf16(b0,qr[0],negm,0,0,0);p1=__builtin_amdgcn_mfma_f32_32x32x16_bf16(b1,qr[0],negm,0,0,0);}
    else{p0=__builtin_amdgcn_mfma_f32_32x32x16_bf16(b0,qr[d0],p0,0,0,0);p1=__builtin_amdgcn_mfma_f32_32x32x16_bf16(b1,qr[d0],p1,0,0,0);}}
}
typedef __attribute__((address_space(3))) const char* lds_cptr;
typedef short v4i16_t __attribute__((ext_vector_type(4)));
__device__ __forceinline__ void kload8(bf16x8*kf,lds_cptr kp){
  kf[0]=*(const __attribute__((address_space(3))) bf16x8*)(kp);      kf[1]=*(const __attribute__((address_space(3))) bf16x8*)(kp+512);
  kf[2]=*(const __attribute__((address_space(3))) bf16x8*)(kp+2048); kf[3]=*(const __attribute__((address_space(3))) bf16x8*)(kp+2560);
  kf[4]=*(const __attribute__((address_space(3))) bf16x8*)(kp+4096); kf[5]=*(const __attribute__((address_space(3))) bf16x8*)(kp+4608);
  kf[6]=*(const __attribute__((address_space(3))) bf16x8*)(kp+6144); kf[7]=*(const __attribute__((address_space(3))) bf16x8*)(kp+6656);
}
__device__ __forceinline__ void kload2(bf16x8*kf,lds_cptr kp,int j){ kf[2*j]=*(const __attribute__((address_space(3))) bf16x8*)(kp+j*2048); kf[2*j+1]=*(const __attribute__((address_space(3))) bf16x8*)(kp+j*2048+512); }
__device__ __forceinline__ s16x4 vtr(lds_cptr p){ return __builtin_bit_cast(s16x4,__builtin_amdgcn_ds_read_tr16_b64_v4i16((__attribute__((address_space(3))) v4i16_t*)p)); }
__device__ __forceinline__ float rowmax(const f32x16&p0,const f32x16&p1){
  float a=max3f(p0[0],p0[1],p1[0]),b=max3f(p0[2],p0[3],p1[1]);a=max3f(a,p1[2],p1[3]);
  #pragma unroll
  for(int r=4;r<16;r+=4){a=max3f(a,p0[r],p0[r+1]);b=max3f(b,p0[r+2],p0[r+3]);a=max3f(a,p1[r],p1[r+1]);b=max3f(b,p1[r+2],p1[r+3]);}
  const float m=max2f(a,b);
  auto rr=__builtin_amdgcn_permlane32_swap(__float_as_uint(m),__float_as_uint(m),false,false);
  return max2f(__uint_as_float(rr[0]),__uint_as_float(rr[1]));
}
__device__ __forceinline__ void pv(f32x16*o,int vb,bf16x8 pa0,bf16x8 pa1,bf16x8 pa2,bf16x8 pa3){
  #pragma unroll
  for(int d0=0;d0<2;++d0){s16x4 lo[4],hi[4];
    #pragma unroll
    for(int ks=0;ks<4;++ks){
      asm volatile("ds_read_b64_tr_b16 %0,%1 offset:%c2":"=&v"(lo[ks]):"v"(vb),"i"(d0*4096+ks*1024):"memory");
      asm volatile("ds_read_b64_tr_b16 %0,%1 offset:%c2":"=&v"(hi[ks]):"v"(vb),"i"(d0*4096+ks*1024+512):"memory");}
    asm volatile("s_waitcnt lgkmcnt(0)":::"memory");SBAR();
    #define PK(k) (bf16x8){lo[k][0],lo[k][1],lo[k][2],lo[k][3],hi[k][0],hi[k][1],hi[k][2],hi[k][3]}
    o[d0]=__builtin_amdgcn_mfma_f32_32x32x16_bf16(pa0,PK(0),o[d0],0,0,0);
    o[d0]=__builtin_amdgcn_mfma_f32_32x32x16_bf16(pa1,PK(1),o[d0],0,0,0);
    o[d0]=__builtin_amdgcn_mfma_f32_32x32x16_bf16(pa2,PK(2),o[d0],0,0,0);
    o[d0]=__builtin_amdgcn_mfma_f32_32x32x16_bf16(pa3,PK(3),o[d0],0,0,0);
    #undef PK
  }
}


constexpr int A2_K=0, A2_V=32768, A2_WS=65536, A2_STG=67584, A2_SLOT=16384;
__device__ __forceinline__ void attn2_unit(const bf16*PROJ,const float*dg,bf16_t*MIX,char*shm,int bh,int qb,const float lam,const float m0){
  const int tid=threadIdx.x,lane=tid&63,r32=lane&31,hi=lane>>5; const int wid=__builtin_amdgcn_readfirstlane(tid>>6);
  const int c=wid&1,qblk=wid>>1,b=bh>>2,h=bh&3; const long rowbase=(long)b*SEQ; const int q0=qb*128;
  const float sl2=exp2f(-2.f*(float)(h+1))*1.4426950408889634f;
  int tbeg=0; { const float kmin=(float)q0-(2.f*m0+40.f)/sl2; if(kmin>0.f)tbeg=((int)kmin)>>6; }
  const int NT=(q0+128)/KVBLK-tbeg;
  const bf16*Qw=PROJ+(rowbase+q0+qblk*32)*PQ+2048+h*128+c*64;
  const bf16*ksrc=PROJ+(rowbase+(long)tbeg*KVBLK+lane)*PQ+2560+h*128+wid*8;
  const bf16*vsrc=PROJ+(rowbase+(long)tbeg*KVBLK+16*(wid&3)+(lane>>2))*PQ+3072+h*128+(wid>>2)*32+(lane&3)*8;
  const unsigned lds0=(unsigned)(uintptr_t)shm;
  const unsigned kdst=lds0+A2_K+wid*1024, vdst=lds0+A2_V+wid*1024;
  #define A2_DMA(t,s) do{ const bf16*kp_=ksrc+(long)(t)*KVBLK*PQ; const bf16*vp_=vsrc+(long)(t)*KVBLK*PQ; const unsigned so_=(unsigned)(s)*A2_SLOT; \
      glds16(kp_,(unsigned)__builtin_amdgcn_readfirstlane(kdst+so_)); glds16(kp_+64,(unsigned)__builtin_amdgcn_readfirstlane(kdst+so_+8192)); \
      glds16(vp_,(unsigned)__builtin_amdgcn_readfirstlane(vdst+so_)); glds16(vp_+64,(unsigned)__builtin_amdgcn_readfirstlane(vdst+so_+8192)); }while(0)
  A2_DMA(0,0);
  bf16x8 qr[4];
  #pragma unroll
  for(int d0=0;d0<4;++d0)qr[d0]=*reinterpret_cast<const bf16x8*>(&Qw[(long)r32*PQ+d0*16+hi*8]);
  const int qrel=qblk*32+r32;
  const float sl64=sl2*64.f,c32=sl2*32.f;
  float l_reg=0.f; f32x16 o[4]; o[0]=f32x16{};o[1]=f32x16{};o[2]=f32x16{};o[3]=f32x16{}; f32x16 negm;
  { const float nb0=sl2*(float)(4*hi+64*tbeg-q0-qrel)-m0;
    #pragma unroll
    for(int r=0;r<16;++r)negm[r]=__builtin_fmaf(sl2,(float)((r&3)+8*(r>>2)),nb0); }
  const int vb0=(int)(lds0+A2_V)+((lane>>4)&1)*32+(lane&3)*8+(4*hi+((lane&15)>>2))*64;
  asm volatile("s_waitcnt vmcnt(0) lgkmcnt(0)\n\ts_barrier":::"memory");
  for(int t=0;t<NT;++t){
    const int s=t&1;
    if(t+1<NT)A2_DMA(t+1,s^1);
    f32x16 p0,p1;
    qkt(p0,p1,shm+A2_K+s*A2_SLOT+c*8192,qr,negm,r32,hi); asm volatile("s_nop 15\n\ts_nop 7":"+v"(p0),"+v"(p1));
    #pragma unroll
    for(int r=0;r<16;++r){p1[r]+=c32;negm[r]+=sl64;}
    { const int jb=t-(NT-2); if(jb>=0)cmask(p0,p1,jb,qrel,hi); }
    float sacc=0.f;
    #pragma unroll
    for(int r=0;r<16;++r){p0[r]=__builtin_amdgcn_exp2f(p0[r]);p1[r]=__builtin_amdgcn_exp2f(p1[r]);sacc+=p0[r]+p1[r];}
    l_reg+=sacc;
    u32x4 pw0,pw1,pw2,pw3;
    #define PKW(P,B) cvtpk_s(P[B],P[B+1])
    pw0=(u32x4){PKW(p0,0),PKW(p0,2),PKW(p0,4),PKW(p0,6)};pw1=(u32x4){PKW(p0,8),PKW(p0,10),PKW(p0,12),PKW(p0,14)};
    pw2=(u32x4){PKW(p1,0),PKW(p1,2),PKW(p1,4),PKW(p1,6)};pw3=(u32x4){PKW(p1,8),PKW(p1,10),PKW(p1,12),PKW(p1,14)};
    #undef PKW
    SBAR();
    pv(o,vb0+s*A2_SLOT,__builtin_bit_cast(bf16x8,pw0),__builtin_bit_cast(bf16x8,pw1),__builtin_bit_cast(bf16x8,pw2),__builtin_bit_cast(bf16x8,pw3));
    pv(o+2,vb0+s*A2_SLOT+8192,__builtin_bit_cast(bf16x8,pw0),__builtin_bit_cast(bf16x8,pw1),__builtin_bit_cast(bf16x8,pw2),__builtin_bit_cast(bf16x8,pw3));
    asm volatile("s_waitcnt vmcnt(0) lgkmcnt(0)\n\ts_barrier":::"memory");
  }
  #undef A2_DMA
  {auto rr=__builtin_amdgcn_permlane32_swap(__float_as_uint(l_reg),__float_as_uint(l_reg),false,false);l_reg=__uint_as_float(rr[0])+__uint_as_float(rr[1]);}
  float*wsf=(float*)(shm+A2_WS)+wid*64;
  if(hi==0)wsf[r32]=l_reg; asm volatile("s_waitcnt lgkmcnt(0)":::"memory");
  float rli[16];
  #pragma unroll
  for(int r=0;r<16;++r)rli[r]=__builtin_amdgcn_rcpf(wsf[crow(r,hi)]);
  float*X=(float*)shm+qblk*4096;
  if(c==1){
    #pragma unroll
    for(int d0=0;d0<4;++d0)
      #pragma unroll
      for(int r=0;r<16;++r)X[(d0*16+r)*64+lane]=o[d0][r]*rli[r];
  }
  asm volatile("s_waitcnt lgkmcnt(0)\n\ts_barrier":::"memory");
  if(c==0){
    bf16_t*stg=(bf16_t*)(shm+A2_STG)+qblk*4096;
    #pragma unroll
    for(int d0=0;d0<4;++d0)
      #pragma unroll
      for(int r=0;r<16;++r){ const float v=o[d0][r]*rli[r]-lam*X[(d0*16+r)*64+lane]; stg[crow(r,hi)*128+d0*32+r32]=(bf16_t)(__builtin_bit_cast(unsigned short,__float2bfloat16(v))); }
    asm volatile("s_waitcnt lgkmcnt(0)":::"memory");
    const int row=lane>>1,half=lane&1; const bf16_t*sp=stg+row*128+half*64;
    float d[64]; float ss=0.f;
    #pragma unroll
    for(int i=0;i<8;++i){ const u32x4 w=*(const u32x4*)(sp+8*i);
      d[8*i+0]=__uint_as_float(w.x<<16);d[8*i+1]=__uint_as_float(w.x&0xffff0000u);d[8*i+2]=__uint_as_float(w.y<<16);d[8*i+3]=__uint_as_float(w.y&0xffff0000u);
      d[8*i+4]=__uint_as_float(w.z<<16);d[8*i+5]=__uint_as_float(w.z&0xffff0000u);d[8*i+6]=__uint_as_float(w.w<<16);d[8*i+7]=__uint_as_float(w.w&0xffff0000u); }
    #pragma unroll
    for(int i=0;i<64;++i)ss+=d[i]*d[i];
    ss+=__shfl_xor(ss,1);
    const float rs=rsqrtf(ss*(1.f/128.f)+1e-6f)*0.8f;
    bf16_t*mp=MIX+(rowbase+q0+qblk*32+row)*1024+512+h*128+half*64; const float*gp=dg+half*64;
    #pragma unroll
    for(int i=0;i<8;++i){ u32x4 w;
      w.x=cvtpk_s(d[8*i+0]*rs*gp[8*i+0],d[8*i+1]*rs*gp[8*i+1]); w.y=cvtpk_s(d[8*i+2]*rs*gp[8*i+2],d[8*i+3]*rs*gp[8*i+3]);
      w.z=cvtpk_s(d[8*i+4]*rs*gp[8*i+4],d[8*i+5]*rs*gp[8*i+5]); w.w=cvtpk_s(d[8*i+6]*rs*gp[8*i+6],d[8*i+7]*rs*gp[8*i+7]);
      *(u32x4*)(mp+8*i)=w; }
  }
  asm volatile("s_waitcnt lgkmcnt(0)\n\ts_barrier":::"memory");
}
constexpr int ATTN_LDS_BYTES=LDS_BYTES;
#undef SBAR
#undef WAIT_BAR
}

__device__ __forceinline__ void ph_route(const Args& a, unsigned char* lds) {
    const int tid = threadIdx.x, lane = tid & 63, wave = tid >> 6;
    int* hist = (int*)lds;
    const float* LOG = (const float*)(a.ws + WS_LOGITS); const float* rb = a.in[18];
    int* IDX = (int*)(a.ws + WS_IDX); float* GATEV = (float*)(a.ws + WS_GATEV); int* HIST = (int*)(a.ws + WS_HIST);
    const f32x4 rb4 = *((const f32x4*)rb + lane);
    for (int tb = blockIdx.x; tb < 256; tb += gridDim.x) {
        if (tid < 256) hist[tid] = 0;
        __syncthreads();
        for (int i = 0; i < 16; ++i) {
            const int t = tb * 128 + wave * 16 + i;
            const f32x4 lg = *((const f32x4*)(LOG + (size_t)t * 256) + lane);
            float s[4], sel[4];
            s[0] = sigm(lg.x); s[1] = sigm(lg.y); s[2] = sigm(lg.z); s[3] = sigm(lg.w);
            sel[0] = s[0] + rb4.x; sel[1] = s[1] + rb4.y; sel[2] = s[2] + rb4.z; sel[3] = s[3] + rb4.w;
            float m1 = fmaxf(sel[0], sel[1]), m2 = fminf(sel[0], sel[1]);
            { const float x = sel[2]; const float n1 = fmaxf(m1, x); m2 = fmaxf(m2, fminf(m1, x)); m1 = n1; }
            { const float x = sel[3]; const float n1 = fmaxf(m1, x); m2 = fmaxf(m2, fminf(m1, x)); m1 = n1; }
#pragma unroll
            for (int off = 1; off < 8; off <<= 1) { const float o1 = __shfl_xor(m1, off), o2 = __shfl_xor(m2, off);
                const float n1 = fmaxf(m1, o1), n2 = fmaxf(fminf(m1, o1), fmaxf(m2, o2)); m1 = n1; m2 = n2; }
            const float gs = m1 + m2; const int grp = lane >> 3; int rank = 0;
#pragma unroll
            for (int g2 = 0; g2 < 8; ++g2) { const float v = __shfl(gs, 8 * g2); rank += ((v > gs) || (v == gs && g2 < grp)) ? 1 : 0; }
            const bool gsel = rank < 4;
            float cand[4];
#pragma unroll
            for (int j = 0; j < 4; ++j) cand[j] = gsel ? sel[j] : -INFINITY;
            float gsum = 0.f; float myg = 0.f; int myidx = 0;
#pragma unroll
            for (int k = 0; k < 8; ++k) {
                float bv = cand[0]; int bi = 4 * lane;
#pragma unroll
                for (int j = 1; j < 4; ++j) if (cand[j] > bv) { bv = cand[j]; bi = 4 * lane + j; }
#pragma unroll
                for (int off = 1; off < 64; off <<= 1) { const float ov = __shfl_xor(bv, off); const int oi = __shfl_xor(bi, off);
                    if (ov > bv || (ov == bv && oi < bi)) { bv = ov; bi = oi; } }
                const int owner = bi >> 2, sub = bi & 3;
                float sv = (sub == 0) ? s[0] : (sub == 1) ? s[1] : (sub == 2) ? s[2] : s[3];
                sv = __shfl(sv, owner);
                if (lane == owner) {
#pragma unroll
                    for (int j = 0; j < 4; ++j) if (j == sub) cand[j] = -INFINITY;
                }
                gsum += sv;
                if (lane == k) { myg = sv; myidx = bi; }
            }
            if (lane < 8) { IDX[(size_t)t * 8 + lane] = myidx; GATEV[(size_t)t * 8 + lane] = myg / gsum * 2.5f; atomicAdd(&hist[myidx], 1); }
        }
        __syncthreads();
        if (tid < 256) HIST[tb * 256 + tid] = hist[tid];
        __syncthreads();
    }
}

__device__ __forceinline__ void ph_scatter(const Args& a, unsigned char* lds) {
    const int tid = threadIdx.x;
    int* tot = (int*)lds; int* cur = tot + 256; int* base = cur + 256;
    const int* HIST = (const int*)(a.ws + WS_HIST); const int* IDX = (const int*)(a.ws + WS_IDX); const float* GATEV = (const float*)(a.ws + WS_GATEV);
    int* PSLOT = (int*)(a.ws + WS_PSLOT); int* SLOTTOK = (int*)(a.ws + WS_SLOTTOK); float* SLOTGATE = (float*)(a.ws + WS_SLOTGATE);
    int* TILE = (int*)(a.ws + WS_TILE);
    for (int tb = blockIdx.x; tb < 256; tb += gridDim.x) {
        __syncthreads();
        int pre = 0;
        if (tid < 256) { int t2 = 0; for (int j = 0; j < 256; ++j) { const int v = HIST[j * 256 + tid]; t2 += v; if (j < tb) pre += v; } tot[tid] = t2; }
        __syncthreads();
        if (tid < 256) { int bs = 0; for (int j = 0; j < tid; ++j) bs += tot[j]; base[tid] = bs; cur[tid] = bs + pre; }
        __syncthreads();
        for (int p = tid; p < 1024; p += 512) { const int t = tb * 128 + (p >> 3), k = p & 7; const int e = IDX[(size_t)t * 8 + k];
            const int slot = atomicAdd(&cur[e], 1); SLOTTOK[slot] = t; SLOTGATE[slot] = GATEV[(size_t)t * 8 + k]; PSLOT[(size_t)t * 8 + k] = slot; }
        if (tb == 0 && tid == 0) {
            int n = 0;
            for (int e = 0; e < 256; ++e) { const int cnt = tot[e], b0 = base[e];
                for (int r0 = 0; r0 < cnt; r0 += 256) { TILE[64 + n] = e; TILE[64 + 2048 + n] = b0 + r0; TILE[64 + 4096 + n] = b0 + cnt; ++n; } }
            TILE[0] = n;
            for (int i = 0; i < 128; ++i) { TILE[64 + n + i] = 256; TILE[64 + 2048 + n + i] = SHARED_BASE + 256 * i; TILE[64 + 4096 + n + i] = SHARED_BASE + T; }
        }
    }
}

__device__ __forceinline__ void ph_final(const Args& a) {
    const int tid = threadIdx.x, lane = tid & 63, wave = tid >> 6;
    const bf16_t* YP = (const bf16_t*)(a.ws + WS_YP); const int* PSLOT = (const int*)(a.ws + WS_PSLOT); const float* MOD = (const float*)(a.ws + WS_MOD);
    float* out = a.out;
    const int gw = blockIdx.x * 8 + wave, NGW = gridDim.x * 8;
    for (int row = gw; row < T; row += NGW) {
        const int b = row / SEQ;
        float acc[16];
#pragma unroll
        for (int i = 0; i < 16; ++i) acc[i] = 0.f;
        int myslot = 0; if (lane < 8) myslot = PSLOT[(size_t)row * 8 + lane]; if (lane == 8) myslot = SHARED_BASE + row;
#pragma unroll
        for (int k = 0; k < 9; ++k) { const int slot = __shfl(myslot, k); const bf16_t* yp = YP + (size_t)slot * DM;
            float t8[8]; unpack8(*(const u32x4*)(yp + 8 * lane), t8);
#pragma unroll
            for (int i = 0; i < 8; ++i) acc[i] += t8[i];
            unpack8(*(const u32x4*)(yp + 512 + 8 * lane), t8);
#pragma unroll
            for (int i = 0; i < 8; ++i) acc[8 + i] += t8[i]; }
        const float* gf = MOD + b * 6144 + 5 * 1024;
#pragma unroll
        for (int hh = 0; hh < 2; ++hh) { float* op = out + (size_t)row * DM + hh * 512 + 8 * lane; const float* gp = gf + hh * 512 + 8 * lane;
            f32x4 x0 = *(const f32x4*)op, x1 = *(const f32x4*)(op + 4); const f32x4 g0 = *(const f32x4*)gp, g1 = *(const f32x4*)(gp + 4);
            x0.x += g0.x * acc[8 * hh + 0]; x0.y += g0.y * acc[8 * hh + 1]; x0.z += g0.z * acc[8 * hh + 2]; x0.w += g0.w * acc[8 * hh + 3];
            x1.x += g1.x * acc[8 * hh + 4]; x1.y += g1.y * acc[8 * hh + 5]; x1.z += g1.z * acc[8 * hh + 6]; x1.w += g1.w * acc[8 * hh + 7];
            *(f32x4*)op = x0; *(f32x4*)(op + 4) = x1; }
    }
}


#define LAS __attribute__((address_space(3)))
#define XB_TMO      128
#define XB_XCNT(j)  (256  + 64 * (j))
#define XB_XSUB(j)  (1280 + 64 * (j))
#define XB_XGEN(j)  (2304 + 64 * (j))
#define XB_TOP      3328
#define XB_TOPGEN   3392
#define XB_SPIN_CAP (1u << 27)
__device__ __forceinline__ unsigned xb_ld(unsigned* p)              { return __hip_atomic_load(p, __ATOMIC_RELAXED, __HIP_MEMORY_SCOPE_AGENT); }
__device__ __forceinline__ unsigned xb_add(unsigned* p, unsigned v) { return __hip_atomic_fetch_add(p, v, __ATOMIC_RELAXED, __HIP_MEMORY_SCOPE_AGENT); }
__device__ __forceinline__ unsigned xb_xcc_id() { return (unsigned)__builtin_amdgcn_s_getreg((3 << 11) | 20) & 0xFu; }
#define XB_SPIN(cond, bar) do { unsigned _sp = 0; while (cond) { __builtin_amdgcn_s_sleep(1); \
    if ((++_sp & 255u) == 0u) { if (xb_ld(&(bar)[XB_TMO])) break; if (_sp > XB_SPIN_CAP) { atomicAdd(&(bar)[XB_TMO], 1u); break; } } } } while (0)
struct XcdBarrier { unsigned* bar; unsigned x; volatile LAS unsigned* st; };
__device__ __forceinline__ XcdBarrier xcd_barrier_post(unsigned* bar, volatile LAS unsigned* st) {
    XcdBarrier b; b.bar = bar; b.x = xb_xcc_id(); b.st = st;
    if (threadIdx.x == 0) (void)xb_add(&bar[XB_XCNT(b.x)], 1u);
    return b;
}
__device__ __forceinline__ void xcd_barrier_complete(unsigned* bar, unsigned x, unsigned& nloc, unsigned& nx) {
    const unsigned G = gridDim.x * gridDim.y * gridDim.z;
    unsigned sum, cnt, mine, sp = 0u;
    for (;;) {
        sum = 0u; cnt = 0u; mine = 0u;
#pragma unroll
        for (unsigned j = 0; j < 16; ++j) { const unsigned c = xb_ld(&bar[XB_XCNT(j)]); sum += c; cnt += (c > 0u) ? 1u : 0u; mine = (j == x) ? c : mine; }
        if (sum == G) break;
        __builtin_amdgcn_s_sleep(1);
        if ((++sp & 255u) == 0u) { if (xb_ld(&bar[XB_TMO])) break; if (sp > XB_SPIN_CAP) { atomicAdd(&bar[XB_TMO], 1u); break; } }
    }
    nloc = mine > 0u ? mine : 1u; nx = cnt > 0u ? cnt : 1u;
}
__device__ __forceinline__ void xcd_barrier(const XcdBarrier& b) {
    asm volatile("s_waitcnt vmcnt(0)" ::: "memory");
    __syncthreads();
    if (threadIdx.x == 0) {
        unsigned* bar = b.bar;
        __builtin_amdgcn_s_waitcnt(0);
        unsigned nloc = b.st[0], nx = b.st[1];
        if (nloc == 0u) { xcd_barrier_complete(bar, b.x, nloc, nx); b.st[0] = nloc; b.st[1] = nx; }
        const unsigned old = xb_add(&bar[XB_XSUB(b.x)], 1u);
        const unsigned gen = old / nloc;
        if (old + 1u == (gen + 1u) * nloc) {
            __builtin_amdgcn_fence(__ATOMIC_RELEASE, "agent");
            asm volatile("s_waitcnt vmcnt(0)" ::: "memory");
            const unsigned og = xb_add(&bar[XB_TOP], 1u);
            const unsigned tg = og / nx;
            if (og + 1u == (tg + 1u) * nx) xb_add(&bar[XB_TOPGEN], 1u);
            else XB_SPIN(xb_ld(&bar[XB_TOPGEN]) == tg, bar);
            __builtin_amdgcn_fence(__ATOMIC_ACQUIRE, "agent");
            xb_add(&bar[XB_XGEN(b.x)], 1u);
            asm volatile("s_waitcnt vmcnt(0)" ::: "memory");
        } else {
            XB_SPIN(xb_ld(&bar[XB_XGEN(b.x)]) == gen, bar);
            __builtin_amdgcn_fence(__ATOMIC_ACQUIRE, "agent");
            asm volatile("s_waitcnt vmcnt(0)" ::: "memory");
        }
    }
    __syncthreads();
}


__device__ __forceinline__ void dbg_dump(const Args& a, const bf16_t* src, int pitch, int coff, float ls, float rs) {
    for (size_t i = blockIdx.x * 512 + threadIdx.x; i < (size_t)T * DM; i += (size_t)gridDim.x * 512) {
        const int c = (int)(i & 1023); const size_t r = i >> 10;
        a.out[i] = bflo(src[r * pitch + coff + c]) * (c >= 512 ? rs : ls);
    }
}

__device__ __forceinline__ void dbg_dump_lin(const Args& a, const void* src, bool isbf, size_t n) {
    for (size_t i = blockIdx.x * 512 + threadIdx.x; i < (size_t)T * DM; i += (size_t)gridDim.x * 512) {
        float v = 0.f; if (i < n) v = isbf ? bflo(((const bf16_t*)src)[i]) : ((const float*)src)[i];
        a.out[i] = v;
    }
}
__global__ void __launch_bounds__(512) mega(Args a) {
    extern __shared__ __attribute__((aligned(16))) unsigned char lds[];
    const int lo = a.ph_lo, hi = a.ph_hi;
    const int tid = threadIdx.x;
    volatile LAS unsigned* bst = (volatile LAS unsigned*)((LAS unsigned char*)lds + (LDS_BYTES - 64));
    if (tid < 16) bst[tid] = 0u;
    __syncthreads();
    XcdBarrier bar = xcd_barrier_post((unsigned*)(a.ws + WS_BAR), bst);
#if USE_CG_SYNC
    cg::this_grid().sync();
#endif
    float* As = (float*)lds; float* Bs = As + 16 * 68;
#define IN(k) (lo <= (k) && (k) < hi)
#define SEAM(k) do { if (IN(k) && IN((k) + 1)) xcd_barrier(bar); } while (0)

    if (IN(0)) { ph0(a, lds); } SEAM(0);
    if (IN(1)) { ph_norm<true>(a, lds, a.in[0], 0, 1); } SEAM(1);
    if (IN(2)) {
        const EpiProj E{(bf16_t*)(a.ws + WS_PROJ)};
#if USE_PG8
        { pg8::DenseSched S; S.init(a.ws + WS_H, a.ws + WS_WIN, T, NPROJ, DM, (int)gridDim.x, (int)blockIdx.x); __syncthreads();
          pg8::gemm_phase<false>((PG8_LAS unsigned char*)lds, DM, S, E); }
#else
        for (int u = blockIdx.x; u < 512 * 56; u += gridDim.x) { const int mt = u / 56, nt = u % 56;
            ngemm_tile(As, Bs, (const bf16_t*)(a.ws + WS_H), DM, nullptr, 64 * mt, T, (const bf16_t*)(a.ws + WS_WIN), DM, 64 * nt, E, tid); }
#endif
    } SEAM(2);
    if (IN(3)) { qknorm_rows(a); __syncthreads(); for (int u = blockIdx.x; u < 1024; u += gridDim.x) mlstm_m1_unit(a, lds, u); } SEAM(3);
    if (IN(4)) { mlstm_m2(a); } SEAM(4);
    if (IN(5)) {
#if USE_MFMA_ATTN
        { float lam; { float s1 = 0.f, s2 = 0.f; const float* q1 = a.in[11]; const float* k1 = a.in[12]; const float* q2 = a.in[13]; const float* k2 = a.in[14];
              for (int i = 0; i < 64; ++i) { s1 += q1[i] * k1[i]; s2 += q2[i] * k2[i]; } lam = expf(s1) - expf(s2) + LAM_INIT; }
          float m0; { float gq = 0.f, gk = 0.f; for (int i = 0; i < 64; ++i) { gq = fmaxf(gq, fabsf(a.in[9][i])); gk = fmaxf(gk, fabsf(a.in[10][i])); } m0 = 64.f * C2 * gq * gk * 1.01f + 0.01f; }
          const int G = (int)gridDim.x, bx = (int)blockIdx.x, vcu = (G % 8 == 0) ? (bx % 8) * (G / 8) + bx / 8 : bx;
          __syncthreads();
          for (int p = vcu; p < 512; p += G) { const int bh = p >> 5, sidx = p & 31;
              attn_body::attn2_unit((const attn_body::bf16*)(a.ws + WS_PROJ), a.in[15], (bf16_t*)(a.ws + WS_MIX), (char*)lds, bh, 63 - sidx, lam, m0);
              attn_body::attn2_unit((const attn_body::bf16*)(a.ws + WS_PROJ), a.in[15], (bf16_t*)(a.ws + WS_MIX), (char*)lds, bh, sidx, lam, m0); }
          __syncthreads(); }
#elif !DBG_SKIP_ATTN
        for (int u = blockIdx.x; u < 256; u += gridDim.x) { const int v = 255 - u; attn_naive_unit(a, lds, v & 15, v >> 4); }
#endif
        for (int u = blockIdx.x; u < 1024; u += gridDim.x) mlstm_m3_unit(a, lds, u);
    } SEAM(5);
#if !DBG_TWICE
    if (IN(6)) {
        const EpiOut E{a.in[0], a.out, (const float*)(a.ws + WS_MOD)};
#if USE_PG8
        { pg8::DenseSched S; S.init(a.ws + WS_MIX, a.ws + WS_WOUT, T, DM, DM, (int)gridDim.x, (int)blockIdx.x); __syncthreads();
          pg8::gemm_phase<false>((PG8_LAS unsigned char*)lds, DM, S, E); }
#else
        for (int u = blockIdx.x; u < 512 * 16; u += gridDim.x) { const int mt = u / 16, nt = u % 16;
            ngemm_tile(As, Bs, (const bf16_t*)(a.ws + WS_MIX), DM, nullptr, 64 * mt, T, (const bf16_t*)(a.ws + WS_WOUT), DM, 64 * nt, E, tid); }
#endif
    } SEAM(6);
    if (IN(7)) { ph_norm<false>(a, lds, a.out, 3, 4); } SEAM(7);
    if (IN(8)) {
        const EpiRS E{(float*)(a.ws + WS_LOGITS), (bf16_t*)(a.ws + WS_ACT)};
#if USE_PG8
        { pg8::DenseSched S; S.init(a.ws + WS_H, a.ws + WS_WRS, T, 768, DM, (int)gridDim.x, (int)blockIdx.x); __syncthreads();
          pg8::gemm_phase<false>((PG8_LAS unsigned char*)lds, DM, S, E); }
#else
        for (int u = blockIdx.x; u < 512 * 12; u += gridDim.x) { const int mt = u / 12, nt = u % 12;
            ngemm_tile(As, Bs, (const bf16_t*)(a.ws + WS_H), DM, nullptr, 64 * mt, T, (const bf16_t*)(a.ws + WS_WRS), DM, 64 * nt, E, tid); }
#endif
    } SEAM(8);
    if (IN(9)) { ph_route(a, lds); } SEAM(9);
    if (IN(10)) { ph_scatter(a, lds); } SEAM(10);
    if (IN(11)) {
        const int* TILE = (const int*)(a.ws + WS_TILE); const int ntile = TILE[0];
        const EpiG1 E{(const float*)(a.ws + WS_SLOTGATE), (bf16_t*)(a.ws + WS_ACT)};
#if USE_PG8
        { const int G = (int)gridDim.x, bx = (int)blockIdx.x, vcu = (G % 8 == 0) ? (bx % 8) * (G / 8) + bx / 8 : bx;
          const pg8::ExpertSched S{TILE, ntile * 2, 2, (const char*)(a.ws + WS_H), (const int*)(a.ws + WS_SLOTTOK), (const char*)(a.ws + WS_W13T), (size_t)512 * 1024 * 2, DM, G, vcu};
          __syncthreads(); pg8::gemm_phase<true>((PG8_LAS unsigned char*)lds, DM, S, E); }
#else
        for (int u = blockIdx.x; u < ntile * 32; u += gridDim.x) { const int tl = u >> 5, sub = (u >> 3) & 3, nt = u & 7;
            const int e = TILE[64 + tl], r0 = TILE[64 + 2048 + tl] + 64 * sub, rend = TILE[64 + 4096 + tl];
            if (r0 >= rend) continue;
            ngemm_tile(As, Bs, (const bf16_t*)(a.ws + WS_H), DM, (const int*)(a.ws + WS_SLOTTOK), r0, rend, (const bf16_t*)(a.ws + WS_W13T) + (size_t)e * 512 * 1024, DM, 64 * nt, E, tid); }
#endif
    } SEAM(11);
    if (IN(12)) {
        const int* TILE = (const int*)(a.ws + WS_TILE); const int ntile = TILE[0] + 128;
        const EpiG2 E{(bf16_t*)(a.ws + WS_YP)};
#if USE_PG8
        { const int G = (int)gridDim.x, bx = (int)blockIdx.x, vcu = (G % 8 == 0) ? (bx % 8) * (G / 8) + bx / 8 : bx;
          const pg8::ExpertSched S{TILE, ntile * 4, 4, (const char*)(a.ws + WS_ACT), nullptr, (const char*)(a.ws + WS_W2T), (size_t)1024 * 256 * 2, 256, G, vcu};
          __syncthreads(); pg8::gemm_phase<false>((PG8_LAS unsigned char*)lds, 256, S, E); }
#else
        for (int u = blockIdx.x; u < ntile * 64; u += gridDim.x) { const int tl = u >> 6, sub = (u >> 4) & 3, nt = u & 15;
            const int e = TILE[64 + tl], r0 = TILE[64 + 2048 + tl] + 64 * sub, rend = TILE[64 + 4096 + tl];
            if (r0 >= rend) continue;
            ngemm_tile(As, Bs, (const bf16_t*)(a.ws + WS_ACT), 256, nullptr, r0, rend, (const bf16_t*)(a.ws + WS_W2T) + (size_t)e * 1024 * 256, 256, 64 * nt, E, tid); }
#endif
    } SEAM(12);
    if (IN(13)) { ph_final(a); }
#endif
#if DBG_TWICE
    if (IN(14)) { bf16_t* SAVE = (bf16_t*)(a.ws + WS_ACT); const bf16_t* MIXp = (const bf16_t*)(a.ws + WS_MIX);
        for (size_t i = blockIdx.x * 512 + tid; i < (size_t)T * 512; i += (size_t)gridDim.x * 512) { const size_t r = i >> 9, c = i & 511; SAVE[i] = MIXp[r * DM + c]; } }
    if (IN(15)) {
        unsigned* CNT = (unsigned*)(a.ws + WS_BAR) + 4000;
        const bf16_t* SAVE = (const bf16_t*)(a.ws + WS_ACT); const bf16_t* MIXp = (const bf16_t*)(a.ws + WS_MIX);
        unsigned bad = 0;
        for (size_t i = blockIdx.x * 512 + tid; i < (size_t)T * 512; i += (size_t)gridDim.x * 512) { const size_t r = i >> 9, c = i & 511; bad += (SAVE[i] != MIXp[r * DM + c]) ? 1u : 0u; }
        if (bad) atomicAdd(CNT, bad);
        xcd_barrier(bar);
        const unsigned tot = __hip_atomic_load(CNT, __ATOMIC_RELAXED, __HIP_MEMORY_SCOPE_AGENT);
        const float cval = (tot == 0u) ? 1.f : (tot < 1000u) ? 3.f : (tot < 100000u) ? 5.f : 7.f;
        for (size_t i = blockIdx.x * 512 + tid; i < (size_t)T * DM; i += (size_t)gridDim.x * 512) a.out[i] = cval;
    }
#endif
#if DBG_DUMP == 5
    xcd_barrier(bar); dbg_dump(a, (const bf16_t*)(a.ws + WS_MIX), DM, 0, 1000.f, 1.f);
#elif DBG_DUMP == 7
    xcd_barrier(bar); dbg_dump_lin(a, a.ws + WS_CIN, true, (size_t)1024 * 16384);
#elif DBG_DUMP == 6
    xcd_barrier(bar); dbg_dump_lin(a, a.ws + WS_CLOC, false, (size_t)1024 * 16384);
#elif DBG_DUMP == 8
    xcd_barrier(bar); dbg_dump_lin(a, a.ws + WS_IPRE, false, (size_t)T * 8);
#elif DBG_DUMP == 9
    xcd_barrier(bar); dbg_dump_lin(a, a.ws + WS_MST, false, (size_t)3072);
#elif DBG_DUMP == 4
    xcd_barrier(bar); dbg_dump(a, (const bf16_t*)(a.ws + WS_PROJ), NPROJ, 2048, 1.f, 1000.f);
#elif DBG_DUMP == 2
    xcd_barrier(bar); dbg_dump(a, (const bf16_t*)(a.ws + WS_PROJ), NPROJ, 0, 1.f, 1.f);
#elif DBG_DUMP == 3
    xcd_barrier(bar); dbg_dump(a, (const bf16_t*)(a.ws + WS_PROJ), NPROJ, 1024, 1.f, 1000.f);
#elif DBG_DUMP == 1
    xcd_barrier(bar); dbg_dump(a, (const bf16_t*)(a.ws + WS_H), DM, 0, 1.f, 1000.f);
#endif
#undef IN
#undef SEAM
}

extern "C" void kernel_launch(void* const* d_in, const int* in_sizes, int n_in, void* d_out, int out_size, void* d_ws, size_t ws_size, hipStream_t stream) {
    static int grid = 0;
    if (grid == 0) {
        if (n_in != 25 || in_sizes[0] != T * DM || out_size != T * DM || ws_size < WS_END) {
            fprintf(stderr, "kernel_launch: unexpected problem (n_in %d, in0 %d, out %d, ws %zu < %zu)\n", n_in, n_in > 0 ? in_sizes[0] : -1, out_size, ws_size, (size_t)WS_END); grid = -1; return; }
        int dev = 0, cus = 0, per_cu = 0;
        (void)hipGetDevice(&dev);
        (void)hipDeviceGetAttribute(&cus, hipDeviceAttributeMultiprocessorCount, dev);
        if (hipFuncSetAttribute((const void*)mega, hipFuncAttributeMaxDynamicSharedMemorySize, LDS_BYTES) != hipSuccess) { fprintf(stderr, "kernel_launch: hipFuncSetAttribute failed\n"); grid = -1; return; }
        if (hipOccupancyMaxActiveBlocksPerMultiprocessor(&per_cu, (const void*)mega, 512, LDS_BYTES) != hipSuccess || per_cu < 1) { fprintf(stderr, "kernel_launch: occupancy query says %d blocks/CU\n", per_cu); grid = -1; return; }
        grid = cus;
    }
    if (grid < 0) return;
    (void)hipMemsetAsync((char*)d_ws + WS_BAR, 0, BAR_BYTES, stream);
    Args a{};
    for (int i = 0; i < 25; ++i) a.in[i] = (const float*)d_in[i];
    a.out = (float*)d_out; a.ws = (unsigned char*)d_ws;
#if DBG_TWICE
    { const int seq[4][2] = {{0, 6}, {14, 15}, {DBG_REP_LO, 6}, {15, 16}};
      for (int i = 0; i < 4; ++i) { (void)hipMemsetAsync((char*)d_ws + WS_BAR, 0, BAR_BYTES, stream); a.ph_lo = seq[i][0]; a.ph_hi = seq[i][1]; void* args[] = {&a};
          hipError_t e = hipLaunchCooperativeKernel((const void*)mega, dim3(grid), dim3(512), args, LDS_BYTES, stream);
          if (e != hipSuccess) { fprintf(stderr, "launch %d failed: %s\n", i, hipGetErrorString(e)); break; } } }
#elif ONE_LAUNCH
    a.ph_lo = 0; a.ph_hi = DBG_LAST_PHASE;
    void* args[] = {&a};
    hipError_t e = hipLaunchCooperativeKernel((const void*)mega, dim3(grid), dim3(512), args, LDS_BYTES, stream);
    if (e != hipSuccess) fprintf(stderr, "cooperative launch failed: %s (grid %d)\n", hipGetErrorString(e), grid);
#else
    for (int ph = 0; ph < NPH; ++ph) { a.ph_lo = ph; a.ph_hi = ph + 1; void* args[] = {&a};
        hipError_t e = hipLaunchCooperativeKernel((const void*)mega, dim3(grid), dim3(512), args, LDS_BYTES, stream);
        if (e != hipSuccess) { fprintf(stderr, "launch %d failed: %s\n", ph, hipGetErrorString(e)); break; } }
#endif
}
```

```cpp
#include <hip/hip_runtime.h>
#include <hip/hip_cooperative_groups.h>
#include <cstdio>
#include <cstdint>
namespace cg = cooperative_groups;

typedef unsigned short bf16_t;
typedef short bf16x8 __attribute__((ext_vector_type(8)));
typedef float f32x4 __attribute__((ext_vector_type(4)));
typedef unsigned u32x4 __attribute__((ext_vector_type(4)));
typedef unsigned u32x2 __attribute__((ext_vector_type(2)));

#ifndef ONE_LAUNCH
#define ONE_LAUNCH 1
#endif
#ifndef DBG_LAST_PHASE
#define DBG_LAST_PHASE 14
#endif
#ifndef DBG_DUMP
#define DBG_DUMP 0
#define DBG_M3 0
#define DBG_TWICE 0
#define DBG_REP_LO 5
#define DBG_SKIP_ATTN 0
#endif
#ifndef DBG_M3_TWICE
#define DBG_M3_TWICE 0
#endif
#ifndef DBG_SPLIT_AT
#define DBG_SPLIT_AT -1
#endif
#ifndef USE_MFMA_ATTN
#define USE_MFMA_ATTN 1
#endif
#ifndef USE_PG8
#define USE_PG8 1
#endif
#ifndef USE_CG_SYNC
#define USE_CG_SYNC 0
#endif

constexpr int T = 32768, DM = 1024, SEQ = 8192;
constexpr int NPROJ = 3584, DIN = 3592;
constexpr int TOPK = 8, TK = T * TOPK;
constexpr int SHARED_BASE = TK;
constexpr float EPS = 1e-6f;
constexpr float LOG2E = 1.4426950408889634f;
constexpr float C2 = 0.125f * LOG2E;
constexpr float LAM_INIT = 0.2f;
constexpr int NPH = 14;
constexpr int LDS_BYTES = 155648;

constexpr size_t MiB = 1ull << 20;
constexpr size_t WS_MOD = 0;
constexpr size_t WS_TILE = 128 * 1024;
constexpr size_t WS_HIST = 256 * 1024;
constexpr size_t WS_BAR = 512 * 1024;
constexpr size_t BAR_BYTES = 16384;
constexpr size_t WS_IPRE = 1 * MiB, WS_FPRE = 1 * MiB + 512 * 1024;
constexpr size_t WS_IDX = 2 * MiB, WS_GATEV = 3 * MiB, WS_PSLOT = 4 * MiB, WS_SLOTTOK = 5 * MiB, WS_SLOTGATE = 7 * MiB;
constexpr size_t WS_MST = 9 * MiB;
constexpr size_t WS_WIN = 12 * MiB, WS_WOUT = 19 * MiB, WS_WRS = 21 * MiB, WS_W2T = 23 * MiB;
constexpr size_t WS_H = 152 * MiB, WS_ACT = 216 * MiB, WS_MIX = 361 * MiB, WS_PROJ = 425 * MiB, WS_CLOC = 649 * MiB, WS_CIN = 713 * MiB, WS_W13T = 745 * MiB, WS_END = 1001 * MiB;
constexpr size_t WS_H8 = 89 * MiB;
constexpr size_t WS_YP = WS_MIX;
constexpr size_t WS_LOGITS = WS_CLOC;
constexpr size_t WS_TMP = WS_ACT;

struct Args { const float* in[25]; float* out; unsigned char* ws; int ph_lo, ph_hi; };

__device__ __forceinline__ int mk_tid(int wave_s) { int l; asm volatile("v_mbcnt_lo_u32_b32 %0, -1, 0\n\tv_mbcnt_hi_u32_b32 %0, -1, %0" : "=v"(l)); return (wave_s << 6) | l; }

__device__ __forceinline__ float bflo(unsigned v) { return __uint_as_float(v << 16); }
__device__ __forceinline__ float bfhi(unsigned v) { return __uint_as_float(v & 0xffff0000u); }
__device__ __forceinline__ unsigned f2bf(float f) { unsigned u = __float_as_uint(f); return (u + 0x7fffu + ((u >> 16) & 1u)) >> 16; }
__device__ __forceinline__ unsigned pk2(float lo, float hi) { return f2bf(lo) | (f2bf(hi) << 16); }
__device__ __forceinline__ float wave_sum(float v) {
#pragma unroll
    for (int o = 1; o < 64; o <<= 1) v += __shfl_xor(v, o);
    return v;
}
__device__ __forceinline__ float siluf(float x) { return x / (1.f + __expf(-x)); }
__device__ __forceinline__ float sigm(float x) { return 1.f / (1.f + __expf(-x)); }
__device__ __forceinline__ void unpack8(const u32x4 v, float (&x)[8]) {
    x[0] = bflo(v.x); x[1] = bfhi(v.x); x[2] = bflo(v.y); x[3] = bfhi(v.y); x[4] = bflo(v.z); x[5] = bfhi(v.z); x[6] = bflo(v.w); x[7] = bfhi(v.w);
}
__device__ __forceinline__ unsigned pk4_fp8(float a, float b, float c, float d) { int p = __builtin_amdgcn_cvt_pk_fp8_f32(a, b, 0, false); p = __builtin_amdgcn_cvt_pk_fp8_f32(c, d, p, true); return (unsigned)p; }
__device__ __forceinline__ u32x4 pack8(const float (&x)[8]) { u32x4 o; o.x = pk2(x[0], x[1]); o.y = pk2(x[2], x[3]); o.z = pk2(x[4], x[5]); o.w = pk2(x[6], x[7]); return o; }

__device__ __forceinline__ void conv_item(const float* __restrict__ s0, const float* __restrict__ s1, int ldn, int k0, int n0, bool inter,
                                          bf16_t* dst, int ldk, int c0, float* scr, int lane) {
    const float* p = (inter && lane >= 32) ? (s1 + n0 + (lane - 32)) : (s0 + n0 + lane);
    p += (size_t)k0 * ldn;
#pragma unroll 8
    for (int i = 0; i < 64; ++i) scr[i * 65 + lane] = p[(size_t)i * ldn];
    const int c = lane & 7;
#pragma unroll
    for (int j = 0; j < 8; ++j) {
        const int n = (lane >> 3) + 8 * j;
        const float* s = scr + (8 * c) * 65 + n;
        u32x4 o; o.x = pk2(s[0], s[65]); o.y = pk2(s[130], s[195]); o.z = pk2(s[260], s[325]); o.w = pk2(s[390], s[455]);
        const int drow = inter ? (c0 + ((n & 31) >> 2) * 8 + (n >> 5) * 4 + (n & 3)) : (c0 + n);
        *(u32x4*)(dst + (size_t)drow * ldk + k0 + 8 * c) = o;
    }
}


__device__ __forceinline__ void conv_item8(const float* __restrict__ s0, const float* __restrict__ s1, int ldn, int k0, int n0, bool inter,
                                           unsigned char* dst, int ldk, int c0, float* scr, int lane, float scale) {
    const float* p = (inter && lane >= 32) ? (s1 + n0 + (lane - 32)) : (s0 + n0 + lane);
    p += (size_t)k0 * ldn;
#pragma unroll 8
    for (int i = 0; i < 64; ++i) scr[i * 65 + lane] = p[(size_t)i * ldn] * scale;
    const int c = lane & 7;
#pragma unroll
    for (int j = 0; j < 8; ++j) {
        const int n = (lane >> 3) + 8 * j;
        const float* s = scr + (8 * c) * 65 + n;
        u32x2 o; o.x = pk4_fp8(s[0], s[65], s[130], s[195]); o.y = pk4_fp8(s[260], s[325], s[390], s[455]);
        const int drow = inter ? (c0 + ((n & 31) >> 2) * 8 + (n >> 5) * 4 + (n & 3)) : (c0 + n);
        *(u32x2*)(dst + (size_t)drow * ldk + k0 + 8 * c) = o;
    }
}

__device__ __forceinline__ void ph0(const Args& a, unsigned char* lds, const int tid) {
    const int lane = tid & 63, wave = tid >> 6;
    const float* c_in = a.in[1]; const float* w_ada = a.in[2]; const float* b_ada = a.in[3];
    float* MOD = (float*)(a.ws + WS_MOD);
    {
        float* sc = (float*)lds; float* red = sc + 4096;
        for (int i = tid; i < 4096; i += 512) sc[i] = siluf(c_in[i]);
        __syncthreads();
        for (int it = blockIdx.x; it < 192; it += gridDim.x) {
            const int cc = tid & 31, ks = tid >> 5, col = it * 32 + cc;
            float a0 = 0.f, a1 = 0.f, a2 = 0.f, a3 = 0.f;
            const float* wp = w_ada + (size_t)(ks * 64) * 6144 + col;
#pragma unroll 8
            for (int k = 0; k < 64; ++k) { const float w = wp[(size_t)k * 6144]; const int kk = ks * 64 + k;
                a0 += sc[kk] * w; a1 += sc[1024 + kk] * w; a2 += sc[2048 + kk] * w; a3 += sc[3072 + kk] * w; }
            float* rp = red + (ks * 32 + cc) * 4; rp[0] = a0; rp[1] = a1; rp[2] = a2; rp[3] = a3;
            __syncthreads();
            if (tid < 128) { const int c2 = tid & 31, b = tid >> 5; float s = 0.f;
                for (int k2 = 0; k2 < 16; ++k2) s += red[(k2 * 32 + c2) * 4 + b];
                MOD[b * 6144 + it * 32 + c2] = s + b_ada[it * 32 + c2]; }
            __syncthreads();
        }
    }
    __syncthreads();
    float* scr = (float*)lds + wave * (64 * 65);
    const int gw = blockIdx.x * 8 + wave, NGW = gridDim.x * 8;
    const float* w_in = a.in[4]; const float* w_out = a.in[16]; const float* w_router = a.in[17];
    const float* w1 = a.in[19]; const float* w3 = a.in[20]; const float* w2 = a.in[21];
    const float* ws1 = a.in[22]; const float* ws3 = a.in[23]; const float* ws2 = a.in[24];
    bf16_t* WIN = (bf16_t*)(a.ws + WS_WIN); bf16_t* WOUT = (bf16_t*)(a.ws + WS_WOUT); bf16_t* WRS = (bf16_t*)(a.ws + WS_WRS);
    unsigned char* W2T8 = (unsigned char*)(a.ws + WS_W2T); unsigned char* W13T8 = (unsigned char*)(a.ws + WS_W13T);
    constexpr int IT_WIN = 56 * 16, IT_WOUT = 16 * 16, IT_WR = 4 * 16, IT_WS13 = 8 * 16, IT_WS2 = 4 * 16, IT_E13 = 256 * 128, IT_E2 = 256 * 64;
    constexpr int NITEMS = IT_WIN + IT_WOUT + IT_WR + IT_WS13 + IT_WS2 + IT_E13 + IT_E2;
    for (int it = gw; it < NITEMS; it += NGW) {
        int r = it;
        if (r < IT_WIN) { const int kb = r / 56, cb = r % 56, c0 = 64 * cb, n0 = c0 + (c0 >= 2048 ? 8 : 0);
            conv_item(w_in, w_in, DIN, 64 * kb, n0, false, WIN, 1024, c0, scr, lane); continue; } r -= IT_WIN;
        if (r < IT_WOUT) { const int kb = r / 16, cb = r % 16; conv_item(w_out, w_out, 1024, 64 * kb, 64 * cb, false, WOUT, 1024, 64 * cb, scr, lane); continue; } r -= IT_WOUT;
        if (r < IT_WR) { const int kb = r / 4, cb = r % 4; conv_item(w_router, w_router, 256, 64 * kb, 64 * cb, false, WRS, 1024, 64 * cb, scr, lane); continue; } r -= IT_WR;
        if (r < IT_WS13) { const int kb = r / 8, cb = r % 8; conv_item(ws1, ws3, 256, 64 * kb, 32 * cb, true, WRS + (size_t)256 * 1024, 1024, 64 * cb, scr, lane); continue; } r -= IT_WS13;
        if (r < IT_WS2) { const int kb = r / 16, cb = r % 16; conv_item8(ws2, ws2, 1024, 64 * kb, 64 * cb, false, W2T8 + (size_t)256 * 1024 * 256, 256, 64 * cb, scr, lane, 32.f); continue; } r -= IT_WS2;
        if (r < IT_E13) { const int e = r >> 7, rr = r & 127, kb = rr >> 3, cb = rr & 7;
            conv_item8(w1 + (size_t)e * 1024 * 256, w3 + (size_t)e * 1024 * 256, 256, 64 * kb, 32 * cb, true, W13T8 + (size_t)e * 512 * 1024, 1024, 64 * cb, scr, lane, 64.f); continue; } r -= IT_E13;
        { const int e = r >> 6, rr = r & 63, kb = rr >> 4, cb = rr & 15;
            conv_item8(w2 + (size_t)e * 256 * 1024, w2, 1024, 64 * kb, 64 * cb, false, W2T8 + (size_t)e * 1024 * 256, 256, 64 * cb, scr, lane, 32.f); }
    }
}

template <bool GATES>
__device__ __forceinline__ void ph_norm(const Args& a, unsigned char* lds, const float* X, int mod_shift, int mod_scale, const int tid) {
    const int lane = tid & 63, wave = tid >> 6;
    const float* MOD = (const float*)(a.ws + WS_MOD);
    bf16_t* H = (bf16_t*)(a.ws + WS_H);
    float* wg = (float*)lds;
    if (GATES) {
        const float* w_in = a.in[4];
        for (int i = tid; i < 8192; i += 512) { const int k = i >> 3, g = i & 7; wg[g * 1024 + k] = w_in[(size_t)k * DIN + 2048 + g]; }
        __syncthreads();
    }
    const float* gate_b = a.in[7];
    float* IPRE = (float*)(a.ws + WS_IPRE); float* FPRE = (float*)(a.ws + WS_FPRE);
    const int gw = blockIdx.x * 8 + wave, NGW = gridDim.x * 8;
    for (int row = gw; row < T; row += NGW) {
        const int b = row / SEQ;
        const f32x4* xr = (const f32x4*)(X + (size_t)row * DM) + lane;
        f32x4 v[4]; float ss = 0.f;
#pragma unroll
        for (int j = 0; j < 4; ++j) { v[j] = xr[64 * j]; ss += (v[j].x * v[j].x + v[j].y * v[j].y) + (v[j].z * v[j].z + v[j].w * v[j].w); }
        const float rstd = rsqrtf(wave_sum(ss) * (1.f / DM) + EPS);
        const f32x4* sh = (const f32x4*)(MOD + b * 6144 + mod_shift * 1024) + lane;
        const f32x4* sc = (const f32x4*)(MOD + b * 6144 + mod_scale * 1024) + lane;
        u32x2* o8 = (u32x2*)(H + (size_t)row * DM) + lane;
#pragma unroll
        for (int j = 0; j < 4; ++j) { const f32x4 s4 = sc[64 * j], h4 = sh[64 * j];
            v[j].x = v[j].x * rstd * (1.f + s4.x) + h4.x; v[j].y = v[j].y * rstd * (1.f + s4.y) + h4.y;
            v[j].z = v[j].z * rstd * (1.f + s4.z) + h4.z; v[j].w = v[j].w * rstd * (1.f + s4.w) + h4.w;
            u32x2 p; p.x = pk2(v[j].x, v[j].y); p.y = pk2(v[j].z, v[j].w); o8[64 * j] = p;
            if (!GATES) *((unsigned*)(a.ws + WS_H8 + (size_t)row * DM) + lane + 64 * j) = pk4_fp8(v[j].x, v[j].y, v[j].z, v[j].w); }
        if (GATES) {
            float g[8];
#pragma unroll
            for (int q = 0; q < 8; ++q) { float s = 0.f;
#pragma unroll
                for (int j = 0; j < 4; ++j) { const f32x4 w4 = *((const f32x4*)(wg + q * 1024) + lane + 64 * j);
                    s += (v[j].x * w4.x + v[j].y * w4.y) + (v[j].z * w4.z + v[j].w * w4.w); }
                g[q] = wave_sum(s); }
            if (lane == 0) {
#pragma unroll
                for (int q = 0; q < 4; ++q) { IPRE[(size_t)row * 4 + q] = g[q] + gate_b[q]; FPRE[(size_t)row * 4 + q] = g[4 + q] + gate_b[4 + q]; }
            }
        }
    }
}

template <class Epi>
__device__ __forceinline__ void ngemm_tile(float* As, float* Bs, const bf16_t* A, size_t lda, const int* gather, int row0, int rend,
                                           const bf16_t* Bt, int K, int n0, const Epi& E, int tid) {
    const int r = tid >> 3, cgp = tid & 7;
    float acc[8];
#pragma unroll
    for (int i = 0; i < 8; ++i) acc[i] = 0.f;
    const int lr = (tid & 127) >> 1, kp = (tid & 1) * 8;
    const bool isA = tid < 128;
    const bf16_t* src = Bt; bool ok = false;
    if (tid < 256) {
        if (isA) { const int ri = row0 + lr; ok = ri < rend; if (ok) { const int sr = gather ? gather[ri] : ri; src = A + (size_t)sr * lda + kp; } }
        else { ok = true; src = Bt + (size_t)(n0 + lr) * K + kp; }
    }
    for (int k0 = 0; k0 < K; k0 += 16) {
        if (tid < 256) {
            u32x4 v = (u32x4){0u, 0u, 0u, 0u};
            if (ok) v = *(const u32x4*)(src + k0);
            float* dp = (isA ? As : Bs) + kp * 68 + lr;
            dp[0] = bflo(v.x); dp[68] = bfhi(v.x); dp[136] = bflo(v.y); dp[204] = bfhi(v.y);
            dp[272] = bflo(v.z); dp[340] = bfhi(v.z); dp[408] = bflo(v.w); dp[476] = bfhi(v.w);
        }
        __syncthreads();
#pragma unroll
        for (int k = 0; k < 16; ++k) {
            const float av = As[k * 68 + r];
            const f32x4 b0 = *(const f32x4*)(Bs + k * 68 + 8 * cgp), b1 = *(const f32x4*)(Bs + k * 68 + 8 * cgp + 4);
            acc[0] += av * b0.x; acc[1] += av * b0.y; acc[2] += av * b0.z; acc[3] += av * b0.w;
            acc[4] += av * b1.x; acc[5] += av * b1.y; acc[6] += av * b1.z; acc[7] += av * b1.w;
        }
        __syncthreads();
    }
    E(row0 + r, (row0 + r) < rend, n0 + 8 * cgp, acc);
}


namespace pg8 {
#define PG8_LAS __attribute__((address_space(3)))
typedef int i32x4 __attribute__((ext_vector_type(4)));
typedef int i32x8 __attribute__((ext_vector_type(8)));
constexpr int BM = 256, BK = 64, HALF = 128, HTB = HALF * BK * 2;
__device__ __forceinline__ int lds_byte(int r, int c) { const int st = (r >> 4) * 2 + (c >> 5), rr = r & 15, cc = c & 31, ob = rr * 64 + cc * 2; return st * 1024 + (ob ^ (((ob >> 9) & 1) << 5)); }
__device__ __forceinline__ void stage_rc(int b, int& R, int& C) { const int st = b / 1024, sb = b % 1024, swz = sb ^ (((sb >> 9) & 1) << 5); R = (st >> 1) * 16 + swz / 64; C = (st & 1) * 32 + (swz % 64) / 2; }
__device__ __forceinline__ int perm32(int rho) { const int n = rho >> 4, i = rho & 15; return 8 * (i >> 2) + 4 * n + (i & 3); }
struct Unit { const char* A; const char* B; const int* gather; int row0, rend, col0; };

template <class RowEpi>
__device__ __forceinline__ void run_epi(const RowEpi& E, const f32x4 (&acc)[2][2][4][2], const Unit& u, int wr, int wc, int fr, int fq) {
#pragma unroll
    for (int ai = 0; ai < 2; ++ai)
#pragma unroll
        for (int m = 0; m < 4; ++m) { const int row = u.row0 + ai * HALF + wr * 64 + m * 16 + fr; const bool valid = row < u.rend;
#pragma unroll
            for (int bj = 0; bj < 2; ++bj) { const int col0 = u.col0 + bj * HALF + wc * 32 + 8 * fq;
                const float v[8] = {acc[ai][bj][m][0][0], acc[ai][bj][m][0][1], acc[ai][bj][m][0][2], acc[ai][bj][m][0][3], acc[ai][bj][m][1][0], acc[ai][bj][m][1][1], acc[ai][bj][m][1][2], acc[ai][bj][m][1][3]};
                E(row, valid, col0, v); } }
}

template <bool GATHER, bool FP8, int SCW, int SCX, class RowEpi, class Sched>
__device__ __forceinline__ void gemm_phase(PG8_LAS unsigned char* lds, const int KB, const Sched& S, const RowEpi& E) {
    const int tid = threadIdx.x, wid = __builtin_amdgcn_readfirstlane(tid >> 6), lane = tid & 63, wr = wid >> 2, wc = wid & 3, fr = lane & 15, fq = lane >> 4;
    const int nt = KB / 128;
    int scw_ = SCW, scx_ = SCX; asm volatile("" : "+v"(scw_), "+v"(scx_));
    int Rr[2], Cc[2]; unsigned voffB[2];
#pragma unroll
    for (int i = 0; i < 2; ++i) { stage_rc(tid * 16 + i * 8192, Rr[i], Cc[i]); const int Rb = (Rr[i] & ~31) + perm32(Rr[i] & 31); voffB[i] = (unsigned)(Rb * KB + Cc[i] * 2); }
    const size_t kstep = (size_t)(BK * 2);
    const size_t hstepB = (size_t)HALF * KB;
    const unsigned ldsw = (unsigned)wid * 1024u;
    const int aoff = lds_byte(wr * 64 + fr, fq * 8), boff = lds_byte(wc * 32 + fr, fq * 8);
#define PG8_SA(b, h) (((b) * 2 + (h)) * HTB)
#define PG8_SB(b, h) ((4 + (b) * 2 + (h)) * HTB)
#define PG8_STAGE(bufoff, gbase, voff) do { _Pragma("unroll") for (int _i = 0; _i < 2; ++_i) \
        __builtin_amdgcn_global_load_lds((const unsigned*)((const char*)(gbase) + (voff)[_i]), (PG8_LAS unsigned*)(lds + (bufoff) + ldsw + _i * 8192), 16, 0, 0); } while (0)
#define PG8_LD8(dst, addr) do { const i32x4 lo_ = *(const PG8_LAS i32x4*)(addr), hi_ = *(const PG8_LAS i32x4*)((addr) + 1024); dst = __builtin_shufflevector(lo_, hi_, 0, 1, 2, 3, 4, 5, 6, 7); } while (0)
#define PG8_LDA(dst, b, h) do { _Pragma("unroll") for (int m = 0; m < 4; ++m) PG8_LD8(dst[m], lds + PG8_SA(b, h) + aoff + m * 2048); } while (0)
#define PG8_LDB(dst, b, h) do { _Pragma("unroll") for (int n = 0; n < 2; ++n) PG8_LD8(dst[n], lds + PG8_SB(b, h) + boff + n * 2048); } while (0)
#define PG8_HALF(v, k) __builtin_bit_cast(bf16x8, (k) ? __builtin_shufflevector(v, v, 4, 5, 6, 7) : __builtin_shufflevector(v, v, 0, 1, 2, 3))
#define PG8_MMA(ai, bj, At, Bt) do { __builtin_amdgcn_s_setprio(1); _Pragma("unroll") for (int m = 0; m < 4; ++m) _Pragma("unroll") for (int n = 0; n < 2; ++n) { \
        if (FP8) asm volatile("v_mfma_scale_f32_16x16x128_f8f6f4 %0, %1, %2, %0, %3, %4 op_sel_hi:[0,0,0]" : "+v"(acc[ai][bj][m][n]) : "v"(Bt[n]), "v"(At[m]), "v"(scw_), "v"(scx_)); \
        else { _Pragma("unroll") for (int k = 0; k < 2; ++k) acc[ai][bj][m][n] = __builtin_amdgcn_mfma_f32_16x16x32_bf16(PG8_HALF(Bt[n], k), PG8_HALF(At[m], k), acc[ai][bj][m][n], 0, 0, 0); } } \
        __builtin_amdgcn_s_setprio(0); } while (0)
#define PG8_WAIT_V(n) asm volatile("s_waitcnt vmcnt(" #n ")" ::: "memory")
#define PG8_WAIT_L(n) asm volatile("s_waitcnt lgkmcnt(" #n ")" ::: "memory")
#define PG8_BAR __builtin_amdgcn_s_barrier()
#define PG8_SCHED __builtin_amdgcn_sched_barrier(0)
#define PG8_FILLA(u, v) do { _Pragma("unroll") for (int _h = 0; _h < 2; ++_h) _Pragma("unroll") for (int _i = 0; _i < 2; ++_i) { const int _row = _h * HALF + Rr[_i]; \
        if (GATHER) { const int _ri = (u).row0 + _row; const int _src = (u).gather[_ri < (u).rend ? _ri : (u).row0]; (v)[_h][_i] = (unsigned)(_src * KB + Cc[_i] * 2); } \
        else (v)[_h][_i] = (unsigned)(_row * KB + Cc[_i] * 2); } } while (0)
    Unit cur, nxt; int ui = 0;
    if (!S.next(0, cur)) return;
    f32x4 acc[2][2][4][2];
#pragma unroll
    for (int a = 0; a < 2; ++a)
#pragma unroll
        for (int b = 0; b < 2; ++b)
#pragma unroll
            for (int m = 0; m < 4; ++m)
#pragma unroll
                for (int n = 0; n < 2; ++n) acc[a][b][m][n] = (f32x4){0.f, 0.f, 0.f, 0.f};
    i32x8 At[4], B0[2], B1[2];
    unsigned voffA[2][2], nvoffA[2][2];
    PG8_FILLA(cur, voffA);
    const char* cA = cur.A; const char* cB = cur.B;
    PG8_STAGE(PG8_SB(0, 0), cB, voffB); PG8_STAGE(PG8_SB(0, 1), cB + hstepB, voffB); PG8_STAGE(PG8_SA(0, 0), cA, voffA[0]); PG8_STAGE(PG8_SA(0, 1), cA, voffA[1]);
    if (wr == 1) PG8_BAR;
    PG8_WAIT_V(2); PG8_BAR;
    PG8_STAGE(PG8_SB(1, 0), cB + kstep, voffB); PG8_STAGE(PG8_SA(1, 0), cA + kstep, voffA[0]); PG8_STAGE(PG8_SB(1, 1), cB + hstepB + kstep, voffB);
    PG8_WAIT_V(6); PG8_BAR;
    for (;;) {
        const bool has_next = S.next(ui + 1, nxt);
        const char* nA = has_next ? nxt.A : cA; const char* nB = has_next ? nxt.B : cB;
        if (GATHER && has_next) { PG8_FILLA(nxt, nvoffA); }
        else {
#pragma unroll
            for (int h = 0; h < 2; ++h)
#pragma unroll
                for (int i = 0; i < 2; ++i) nvoffA[h][i] = voffA[h][i]; }
        for (int t = 0; t < nt; t += 2) {
            const bool last = (t == nt - 2);
            const char* a1 = cA + (size_t)(t + 1) * kstep;
            const char* a2 = last ? nA : cA + (size_t)(t + 2) * kstep; const char* b2 = last ? nB : cB + (size_t)(t + 2) * kstep;
            const char* a3 = a2 + kstep; const char* b3 = b2 + kstep;
            unsigned v2[2][2];
#pragma unroll
            for (int h = 0; h < 2; ++h)
#pragma unroll
                for (int i = 0; i < 2; ++i) v2[h][i] = last ? nvoffA[h][i] : voffA[h][i];
            PG8_LDB(B0, 0, 0); PG8_LDB(B1, 0, 1); PG8_SCHED; PG8_LDA(At, 0, 0); PG8_STAGE(PG8_SA(1, 1), a1, voffA[1]);
            PG8_WAIT_V(8); PG8_WAIT_L(0); PG8_BAR; PG8_MMA(0, 0, At, B0); PG8_MMA(0, 1, At, B1); PG8_BAR; PG8_SCHED;
            PG8_LDA(At, 0, 1); PG8_STAGE(PG8_SB(0, 0), b2, voffB); PG8_STAGE(PG8_SB(0, 1), b2 + hstepB, voffB); PG8_STAGE(PG8_SA(0, 0), a2, v2[0]);
            PG8_WAIT_V(8); PG8_WAIT_L(0); PG8_BAR; PG8_MMA(1, 0, At, B0); PG8_MMA(1, 1, At, B1); PG8_BAR; PG8_SCHED;
            PG8_LDB(B0, 1, 0); PG8_LDB(B1, 1, 1); PG8_SCHED; PG8_LDA(At, 1, 0); PG8_STAGE(PG8_SA(0, 1), a2, v2[1]);
            PG8_WAIT_V(8); PG8_WAIT_L(0); PG8_BAR; PG8_MMA(0, 0, At, B0); PG8_MMA(0, 1, At, B1); PG8_BAR; PG8_SCHED;
            PG8_LDA(At, 1, 1); PG8_STAGE(PG8_SB(1, 0), b3, voffB); PG8_STAGE(PG8_SB(1, 1), b3 + hstepB, voffB); PG8_STAGE(PG8_SA(1, 0), a3, v2[0]);
            PG8_WAIT_V(8); PG8_WAIT_L(0); PG8_BAR; PG8_MMA(1, 0, At, B0); PG8_MMA(1, 1, At, B1); PG8_BAR; PG8_SCHED;
        }
        if (wr == 0) PG8_BAR;
        if (FP8) { PG8_SCHED; asm volatile("s_nop 15\n\ts_nop 7" ::: "memory"); PG8_SCHED; }
        run_epi(E, acc, cur, wr, wc, fr, fq);
        if (!has_next) break;
#pragma unroll
        for (int a = 0; a < 2; ++a)
#pragma unroll
            for (int b = 0; b < 2; ++b)
#pragma unroll
                for (int m = 0; m < 4; ++m)
#pragma unroll
                    for (int n = 0; n < 2; ++n) acc[a][b][m][n] = (f32x4){0.f, 0.f, 0.f, 0.f};
        cur = nxt; cA = nA; cB = nB; ++ui;
#pragma unroll
        for (int h = 0; h < 2; ++h)
#pragma unroll
            for (int i = 0; i < 2; ++i) voffA[h][i] = nvoffA[h][i];
        if (wr == 1) PG8_BAR;
    }
    PG8_WAIT_V(0);
    PG8_BAR;
#undef PG8_SA
#undef PG8_SB
#undef PG8_STAGE
#undef PG8_LDA
#undef PG8_LD8
#undef PG8_HALF
#undef PG8_LDB
#undef PG8_MMA
#undef PG8_WAIT_V
#undef PG8_WAIT_L
#undef PG8_BAR
#undef PG8_SCHED
#undef PG8_FILLA
}

struct DenseSched {
    const char* A; const char* Bt; int KB, M, nM, nN, nwg, G, c;
    __device__ __forceinline__ void init(const void* A_, const void* Bt_, int M_, int N_, int KB_, int G_, int c_) { A = (const char*)A_; Bt = (const char*)Bt_; KB = KB_; M = M_; nM = M_ / BM; nN = N_ / BM; nwg = nM * nN; G = G_; c = c_; }
    __device__ __forceinline__ bool next(int i, Unit& u) const {
        const long L = (long)i * G + c; if (L >= nwg) return false;
        int wgid = (int)L; { const int q = nwg / 8, r = nwg % 8, xcd = wgid % 8, off = wgid / 8; wgid = (xcd < r ? xcd * (q + 1) : r * (q + 1) + (xcd - r) * q) + off; }
        const int nig = 8 * nN, gid = wgid / nig, fm = gid * 8, gsz = (nM - fm) < 8 ? (nM - fm) : 8;
        const int pm = fm + ((wgid % nig) % gsz), pn = (wgid % nig) / gsz;
        u.A = A + (size_t)pm * BM * KB; u.B = Bt + (size_t)pn * BM * KB; u.gather = nullptr; u.row0 = pm * BM; u.rend = M; u.col0 = pn * BM; return true;
    }
};
struct ExpertSched {
    const int* TILE; int nunits, NPN; const char* A; const int* gather; const char* Bt; size_t bstride; int KB, G, vcu;
    __device__ __forceinline__ bool next(int i, Unit& u) const {
        const int L = i * G + vcu; if (L >= nunits) return false;
        const int tl = L / NPN, pn = L % NPN;
        const int e = __builtin_amdgcn_readfirstlane(TILE[64 + tl]), r0 = __builtin_amdgcn_readfirstlane(TILE[64 + 2048 + tl]), re = __builtin_amdgcn_readfirstlane(TILE[64 + 4096 + tl]);
        u.B = Bt + (size_t)e * bstride + (size_t)pn * BM * KB; u.row0 = r0; u.rend = re; u.col0 = pn * BM;
        if (gather) { u.A = A; u.gather = gather; } else { u.A = A + (size_t)r0 * KB; u.gather = nullptr; }
        return true;
    }
};
}

struct EpiProj { bf16_t* P;
    __device__ __forceinline__ void operator()(int row, bool valid, int col0, const float (&v)[8]) const { if (valid) *(u32x4*)(P + (size_t)row * NPROJ + col0) = pack8(v); } };
struct EpiOut { const float* x; float* x1; const float* MOD;
    __device__ __forceinline__ void operator()(int row, bool valid, int col0, const float (&v)[8]) const {
        if (!valid) return; const int b = row / SEQ; const float* ga = MOD + b * 6144 + 2 * 1024 + col0;
        const f32x4 x0 = *(const f32x4*)(x + (size_t)row * DM + col0), x1v = *(const f32x4*)(x + (size_t)row * DM + col0 + 4);
        f32x4 o0, o1; o0.x = x0.x + ga[0] * v[0]; o0.y = x0.y + ga[1] * v[1]; o0.z = x0.z + ga[2] * v[2]; o0.w = x0.w + ga[3] * v[3];
        o1.x = x1v.x + ga[4] * v[4]; o1.y = x1v.y + ga[5] * v[5]; o1.z = x1v.z + ga[6] * v[6]; o1.w = x1v.w + ga[7] * v[7];
        *(f32x4*)(x1 + (size_t)row * DM + col0) = o0; *(f32x4*)(x1 + (size_t)row * DM + col0 + 4) = o1; } };
struct EpiRS { float* LOG; bf16_t* ACT;
    __device__ __forceinline__ void operator()(int row, bool valid, int col0, const float (&v)[8]) const {
        if (!valid) return;
        if (col0 < 256) { *(f32x4*)(LOG + (size_t)row * 256 + col0) = (f32x4){v[0], v[1], v[2], v[3]}; *(f32x4*)(LOG + (size_t)row * 256 + col0 + 4) = (f32x4){v[4], v[5], v[6], v[7]}; }
        else { const int j0 = (col0 - 256) >> 1;
            *(unsigned*)((unsigned char*)ACT + (size_t)(SHARED_BASE + row) * 256 + j0) = pk4_fp8(8.f * siluf(v[0]) * v[4], 8.f * siluf(v[1]) * v[5], 8.f * siluf(v[2]) * v[6], 8.f * siluf(v[3]) * v[7]); } } };
struct EpiG1 { const float* SG; bf16_t* ACT;
    __device__ __forceinline__ void operator()(int row, bool valid, int col0, const float (&v)[8]) const {
        if (!valid) return; const float g = 8.f * SG[row]; const int j0 = col0 >> 1;
        *(unsigned*)((unsigned char*)ACT + (size_t)row * 256 + j0) = pk4_fp8(siluf(v[0]) * v[4] * g, siluf(v[1]) * v[5] * g, siluf(v[2]) * v[6] * g, siluf(v[3]) * v[7] * g); } };
struct EpiG2 { bf16_t* YP;
    __device__ __forceinline__ void operator()(int row, bool valid, int col0, const float (&v)[8]) const { if (valid) *(u32x4*)(YP + (size_t)row * DM + col0) = pack8(v); } };

constexpr int LR = 136;
__device__ __forceinline__ f32x4 mfma16(bf16x8 a, bf16x8 b, f32x4 c) {
    asm volatile("s_nop 1\n\tv_mfma_f32_16x16x32_bf16 %0, %1, %2, %0" : "+v"(c) : "v"(a), "v"(b)); return c; }
#define MFMA_DRAIN8(x) asm volatile("s_nop 15\n\ts_nop 3" : "+v"(x[0]), "+v"(x[1]), "+v"(x[2]), "+v"(x[3]), "+v"(x[4]), "+v"(x[5]), "+v"(x[6]), "+v"(x[7]))
__device__ __forceinline__ bf16x8 ldfrag(const bf16_t* base, int row, int k0, int lane) { return *(const bf16x8*)(base + (row + (lane & 15)) * LR + k0 + 8 * (lane >> 4)); }

__device__ __forceinline__ void conv8(const bf16_t* PROJ, const float* cw, const float* cb, int b, int sg, int ch, float (&o)[8]) {
    float acc[8];
    { const f32x4 b0 = *(const f32x4*)(cb + ch), b1 = *(const f32x4*)(cb + ch + 4); acc[0] = b0.x; acc[1] = b0.y; acc[2] = b0.z; acc[3] = b0.w; acc[4] = b1.x; acc[5] = b1.y; acc[6] = b1.z; acc[7] = b1.w; }
    u32x4 raw[4];
#pragma unroll
    for (int j = 0; j < 4; ++j) { const int sp = sg - 3 + j, spc = sp < 0 ? 0 : sp; raw[j] = *(const u32x4*)(PROJ + (size_t)(b * SEQ + spc) * NPROJ + ch); }
#pragma unroll
    for (int j = 0; j < 4; ++j) { const float on = (sg - 3 + j >= 0) ? 1.f : 0.f; float x[8]; unpack8(raw[j], x);
        const f32x4 w0 = *(const f32x4*)(cw + j * 1024 + ch) * on, w1 = *(const f32x4*)(cw + j * 1024 + ch + 4) * on;
        acc[0] += w0.x * x[0]; acc[1] += w0.y * x[1]; acc[2] += w0.z * x[2]; acc[3] += w0.w * x[3];
        acc[4] += w1.x * x[4]; acc[5] += w1.y * x[5]; acc[6] += w1.z * x[6]; acc[7] += w1.w * x[7]; }
#pragma unroll
    for (int q = 0; q < 8; ++q) o[q] = siluf(acc[q]);
}


__device__ __forceinline__ void conv8_lds(const bf16_t* R, int pitch, int s, int col, const float* cw, const float* cb, int ch, float (&o)[8]) {
    float acc[8];
    { const f32x4 b0 = *(const f32x4*)(cb + ch), b1 = *(const f32x4*)(cb + ch + 4); acc[0] = b0.x; acc[1] = b0.y; acc[2] = b0.z; acc[3] = b0.w; acc[4] = b1.x; acc[5] = b1.y; acc[6] = b1.z; acc[7] = b1.w; }
#pragma unroll
    for (int j = 0; j < 4; ++j) { float x[8]; unpack8(*(const u32x4*)(R + (s + j) * pitch + col), x);
        const f32x4 w0 = *(const f32x4*)(cw + j * 1024 + ch), w1 = *(const f32x4*)(cw + j * 1024 + ch + 4);
        acc[0] += w0.x * x[0]; acc[1] += w0.y * x[1]; acc[2] += w0.z * x[2]; acc[3] += w0.w * x[3];
        acc[4] += w1.x * x[4]; acc[5] += w1.y * x[5]; acc[6] += w1.z * x[6]; acc[7] += w1.w * x[7]; }
#pragma unroll
    for (int q = 0; q < 8; ++q) o[q] = siluf(acc[q]);
}
__device__ __forceinline__ void chunk_gates(const Args& a, float* bb, float* ii, float* tmp, int t0, int h, int tid) {
    const float* IPRE = (const float*)(a.ws + WS_IPRE); const float* FPRE = (const float*)(a.ws + WS_FPRE);
    if (tid < 128) { const float f = FPRE[(size_t)(t0 + tid) * 4 + h]; ii[tid] = IPRE[(size_t)(t0 + tid) * 4 + h];
        tmp[tid] = fminf(f, 0.f) - log1pf(expf(-fabsf(f))); }
    __syncthreads();
    if (tid < 128) { float s = 0.f;
#pragma unroll 4
        for (int j4 = 0; j4 < 32; ++j4) { const f32x4 v = *(const f32x4*)(tmp + 4 * j4); const int j = 4 * j4;
            s += (j <= tid ? v.x : 0.f); s += (j + 1 <= tid ? v.y : 0.f); s += (j + 2 <= tid ? v.z : 0.f); s += (j + 3 <= tid ? v.w : 0.f); }
        bb[tid] = s; }
    __syncthreads();
}

__device__ __forceinline__ void mlstm_m1_unit(const Args& a, unsigned char* lds, int unit, const int wave_s) {
    const int tid = mk_tid(wave_s);
    const int lane = tid & 63, wave = tid >> 6;
    const int bh = unit >> 6, c = unit & 63, b = bh >> 2, h = bh & 3, t0 = b * SEQ + c * 128;
    bf16_t* kT = (bf16_t*)lds; bf16_t* vT = kT + 128 * LR;
    float* sf = (float*)(lds + 2 * 128 * LR * 2); float* bb = sf; float* ii = sf + 128; float* tmp = sf + 256; float* wk = sf + 384;
    const bf16_t* PROJ = (const bf16_t*)(a.ws + WS_PROJ);
    const float* cw = a.in[5]; const float* cbias = a.in[6];
    bf16_t* R = (bf16_t*)(lds + 2 * 128 * LR * 2 + 2048);
    const int tl = tid;
    u32x4 rawk[5], vreg[4];
#pragma unroll
    for (int k = 0; k < 5; ++k) { const int idx = tl + 512 * k, row = idx >> 4, chunk = idx & 15; const int sp = c * 128 - 3 + row;
        rawk[k] = (u32x4){0u, 0u, 0u, 0u};
        if (idx < 131 * 16 && sp >= 0) rawk[k] = *(const u32x4*)(PROJ + (size_t)(b * SEQ + sp) * NPROJ + 512 + h * 128 + 8 * chunk); }
#pragma unroll
    for (int k = 0; k < 4; ++k) { const int it = tl + 512 * k, sidx = it & 127, ch = it >> 7; vreg[k] = *(const u32x4*)(PROJ + (size_t)(t0 + sidx) * NPROJ + 1024 + h * 128 + 8 * ch); }
    chunk_gates(a, bb, ii, tmp, t0, h, tid);
#pragma unroll
    for (int k = 0; k < 5; ++k) { const int idx = tl + 512 * k; if (idx < 131 * 16) *(u32x4*)(R + (idx >> 4) * 136 + 8 * (idx & 15)) = rawk[k]; }
    const float blast = bb[127];
    if (tid < 128) tmp[tid] = blast - bb[tid] + ii[tid];
    __syncthreads();
    float mloc = -INFINITY;
#pragma unroll 4
    for (int j4 = 0; j4 < 32; ++j4) { const f32x4 v = *(const f32x4*)(tmp + 4 * j4); mloc = fmaxf(fmaxf(mloc, fmaxf(v.x, v.y)), fmaxf(v.z, v.w)); }
    if (tid < 128) wk[tid] = expf(tmp[tid] - mloc);
    __syncthreads();
#pragma unroll
    for (int k = 0; k < 4; ++k) { const int it = tl + 512 * k, sidx = it & 127, ch = it >> 7;
        float kv[8]; conv8_lds(R, 136, sidx, 8 * ch, cw, cbias, 512 + h * 128 + 8 * ch, kv);
        const float sc = 0.08838834764831845f * wk[sidx];
#pragma unroll
        for (int q = 0; q < 8; ++q) kT[(8 * ch + q) * LR + sidx] = (bf16_t)f2bf(kv[q] * sc);
        float vv[8]; unpack8(vreg[k], vv);
#pragma unroll
        for (int q = 0; q < 8; ++q) vT[(8 * ch + q) * LR + sidx] = (bf16_t)f2bf(vv[q]);
    }
    __syncthreads();
    float* CLOC = (float*)(a.ws + WS_CLOC) + (size_t)unit * 16384;
    float* MST = (float*)(a.ws + WS_MST);
    {
        f32x4 acc[8];
#pragma unroll
        for (int i = 0; i < 8; ++i) acc[i] = (f32x4){0.f, 0.f, 0.f, 0.f};
#pragma unroll
        for (int ks = 0; ks < 4; ++ks) { const bf16x8 af = ldfrag(vT, 16 * wave, 32 * ks, lane);
#pragma unroll
            for (int db = 0; db < 8; ++db) acc[db] = mfma16(af, ldfrag(kT, 16 * db, 32 * ks, lane), acc[db]); }
        MFMA_DRAIN8(acc);
#pragma unroll
        for (int db = 0; db < 8; ++db)
#pragma unroll
            for (int r = 0; r < 4; ++r) CLOC[(16 * wave + 4 * (lane >> 4) + r) * 128 + 16 * db + (lane & 15)] = acc[db][r];
    }
    if (tid < 128) { float s = 0.f; for (int j = 0; j < 128; ++j) s += bflo(kT[tid * LR + j]); MST[16384 + (size_t)unit * 128 + tid] = s; }
    if (tid == 0) { MST[unit] = mloc; MST[1024 + unit] = blast; }
    __syncthreads();
}

__device__ __forceinline__ void mlstm_m2(const Args& a, const int tid2) {
    const float* CLOC = (const float*)(a.ws + WS_CLOC); bf16_t* CIN = (bf16_t*)(a.ws + WS_CIN);
    float* MST = (float*)(a.ws + WS_MST);
    const float* NLOC = MST + 16384; float* NIN = MST + 16384 + 131072;
    for (int gid = blockIdx.x * 512 + tid2; gid < 16 * 8192; gid += gridDim.x * 512) {
        const int bh = gid >> 13, e2 = gid & 8191; const bool hasn = e2 < 128;
        const float* cl = CLOC + (size_t)(bh * 64) * 16384 + e2; const float* nl = NLOC + (size_t)(bh * 64) * 128 + e2;
        bf16_t* ci = CIN + (size_t)(bh * 64) * 16384 + e2; float* ni = NIN + (size_t)(bh * 64) * 128 + e2;
        const float* mlp = MST + bh * 64; const float* blp = MST + 1024 + bh * 64;
        float s0 = 0.f, s1 = 0.f, sn = 0.f, m = 0.f;
        float p0[4], p1[4], pn[4], pm[4], pb[4];
#pragma unroll
        for (int k = 0; k < 4; ++k) { p0[k] = cl[(size_t)k * 16384]; p1[k] = cl[(size_t)k * 16384 + 8192]; pn[k] = hasn ? nl[k * 128] : 0.f; pm[k] = mlp[k]; pb[k] = blp[k]; }
        for (int c0 = 0; c0 < 64; c0 += 4) {
            float q0[4], q1[4], qn[4], qm[4], qb[4];
            const bool more = c0 + 4 < 64;
#pragma unroll
            for (int k = 0; k < 4; ++k) { const int c = more ? c0 + 4 + k : c0 + k;
                q0[k] = cl[(size_t)c * 16384]; q1[k] = cl[(size_t)c * 16384 + 8192]; qn[k] = hasn ? nl[c * 128] : 0.f; qm[k] = mlp[c]; qb[k] = blp[c]; }
#pragma unroll
            for (int k = 0; k < 4; ++k) { const int c = c0 + k;
                ci[(size_t)c * 16384] = (bf16_t)f2bf(s0); ci[(size_t)c * 16384 + 8192] = (bf16_t)f2bf(s1);
                if (hasn) ni[c * 128] = sn;
                if (e2 == 0) MST[2048 + bh * 64 + c] = m;
                const float ml = pm[k], bl = pb[k];
                const float mn = fmaxf(bl + m, ml), ca = expf(bl + m - mn), cb = expf(ml - mn);
                s0 = ca * s0 + cb * p0[k]; s1 = ca * s1 + cb * p1[k]; sn = ca * sn + cb * pn[k]; m = mn; }
#pragma unroll
            for (int k = 0; k < 4; ++k) { p0[k] = q0[k]; p1[k] = q1[k]; pn[k] = qn[k]; pm[k] = qm[k]; pb[k] = qb[k]; }
        }
    }
}

template <int MODE>
__device__ __forceinline__ void mlstm_m3_unit(const Args& a, unsigned char* lds, int unit, const int wave_s) {
    const int tid = mk_tid(wave_s);
    const int lane = tid & 63, wave = tid >> 6;
    const int bh = unit >> 6, c = unit & 63, b = bh >> 2, h = bh & 3, t0 = b * SEQ + c * 128;
    bf16_t* qs = (bf16_t*)lds; bf16_t* ks = qs + 128 * LR; bf16_t* vT = ks + 128 * LR; bf16_t* CT = vT + 128 * LR; bf16_t* Ps = ks;
    float* sf = (float*)(lds + 4 * 128 * LR * 2);
    float* bb = sf; float* ii = sf + 128; float* tmp = sf + 256; float* gg = sf + 384; float* wint = sf + 512; float* nn = sf + 640; float* den = sf + 768; float* dint = sf + 896;
    const bf16_t* PROJ = (const bf16_t*)(a.ws + WS_PROJ); const bf16_t* CIN = (const bf16_t*)(a.ws + WS_CIN) + (size_t)unit * 16384;
    const float* MST = (const float*)(a.ws + WS_MST);
    const float* cw = a.in[5]; const float* cbias = a.in[6]; const float* mlg = a.in[8];
    bf16_t* MIX = (bf16_t*)(a.ws + WS_MIX);
    bf16_t* R = vT;
    const float m_in = MST[2048 + unit];
    const int tl = tid;
    u32x4 rawq[9], vreg[4], creg[4];
#pragma unroll
    for (int k = 0; k < 9; ++k) { const int idx = tl + 512 * k, row = idx >> 5, chunk = idx & 31; const int sp = c * 128 - 3 + row;
        rawq[k] = (u32x4){0u, 0u, 0u, 0u};
        if (idx < 131 * 32 && sp >= 0) rawq[k] = *(const u32x4*)(PROJ + (size_t)(b * SEQ + sp) * NPROJ + (chunk < 16 ? h * 128 + 8 * chunk : 512 + h * 128 + 8 * (chunk - 16))); }
#pragma unroll
    for (int k = 0; k < 4; ++k) { const int it = tl + 512 * k, sidx = it & 127, ch = it >> 7, s2 = it >> 4, c2 = it & 15;
        vreg[k] = *(const u32x4*)(PROJ + (size_t)(t0 + sidx) * NPROJ + 1024 + h * 128 + 8 * ch); creg[k] = *(const u32x4*)(CIN + s2 * 128 + 8 * c2); }
    chunk_gates(a, bb, ii, tmp, t0, h, tid);
#pragma unroll
    for (int k = 0; k < 9; ++k) { const int idx = tl + 512 * k; if (idx < 131 * 32) *(u32x4*)(R + (idx >> 5) * 264 + 8 * (idx & 31)) = rawq[k]; }
    if (tid < 128) { float pm = -INFINITY;
#pragma unroll 4
        for (int j4 = 0; j4 < 32; ++j4) { const f32x4 vi = *(const f32x4*)(ii + 4 * j4), vb = *(const f32x4*)(bb + 4 * j4); const int j = 4 * j4;
            pm = fmaxf(pm, j <= tl ? vi.x - vb.x : -INFINITY); pm = fmaxf(pm, j + 1 <= tl ? vi.y - vb.y : -INFINITY);
            pm = fmaxf(pm, j + 2 <= tl ? vi.z - vb.z : -INFINITY); pm = fmaxf(pm, j + 3 <= tl ? vi.w - vb.w : -INFINITY); }
        const float g = fmaxf(m_in, pm); gg[tl] = g; wint[tl] = expf(m_in - g); tmp[tl] = ii[tl] - bb[tl];
        nn[tl] = MST[16384 + 131072 + (size_t)unit * 128 + tl]; }
    __syncthreads();
#pragma unroll 1
    for (int k = 0; k < 4; ++k) { const int it = tl + 512 * k, sidx = it & 127, ch = it >> 7;
        float qv[8], kv[8];
        conv8_lds(R, 264, sidx, 8 * ch, cw, cbias, h * 128 + 8 * ch, qv);
        conv8_lds(R, 264, sidx, 128 + 8 * ch, cw, cbias, 512 + h * 128 + 8 * ch, kv);
#pragma unroll
        for (int q = 0; q < 8; ++q) kv[q] *= 0.08838834764831845f;
        *(u32x4*)(qs + sidx * LR + 8 * ch) = pack8(qv);
        *(u32x4*)(ks + sidx * LR + 8 * ch) = pack8(kv); }
    __syncthreads();
#pragma unroll
    for (int k = 0; k < 4; ++k) { const int it = tl + 512 * k, sidx = it & 127, ch = it >> 7, s2 = it >> 4, c2 = it & 15;
        float vv[8]; unpack8(vreg[k], vv);
#pragma unroll
        for (int q = 0; q < 8; ++q) vT[(8 * ch + q) * LR + sidx] = (bf16_t)f2bf(vv[q]);
        *(u32x4*)(CT + s2 * LR + 8 * c2) = creg[k]; }
    __syncthreads();
    if (MODE == 1) return;
    if (tid < 128) { float s = 0.f; for (int d = 0; d < 128; ++d) s += bflo(qs[tl * LR + d]) * nn[d]; dint[tl] = s * wint[tl]; }
    f32x4 sacc[8];
#pragma unroll
    for (int i = 0; i < 8; ++i) sacc[i] = (f32x4){0.f, 0.f, 0.f, 0.f};
#pragma unroll
    for (int kk = 0; kk < 4; ++kk) { const bf16x8 bq = ldfrag(qs, 16 * wave, 32 * kk, lane);
#pragma unroll
        for (int sb = 0; sb < 8; ++sb) sacc[sb] = mfma16(ldfrag(ks, 16 * sb, 32 * kk, lane), bq, sacc[sb]); }
    MFMA_DRAIN8(sacc);
    __syncthreads();
    {
        const int t = 16 * wave + (lane & 15); const float g = gg[t]; float rs = 0.f;
#pragma unroll
        for (int sb = 0; sb < 8; ++sb) { float p[4];
#pragma unroll
            for (int r = 0; r < 4; ++r) { const int s = 16 * sb + 4 * (lane >> 4) + r; p[r] = (s <= t) ? sacc[sb][r] * expf(tmp[s] - g) : 0.f; rs += p[r]; }
            u32x2 w; w.x = pk2(p[0], p[1]); w.y = pk2(p[2], p[3]);
#if DBG_M3
            { float* dp = a.out + (size_t)(t0 + t) * DM + h * 256 + 16 * sb + 4 * (lane >> 4); dp[0] = 0.f; dp[1] = 0.f; dp[2] = 0.f; dp[3] = 0.f; }
#endif
            *(u32x2*)(Ps + t * LR + 16 * sb + 4 * (lane >> 4)) = w; }
        rs += __shfl_xor(rs, 16); rs += __shfl_xor(rs, 32);
        if (lane < 16) den[t] = rs + dint[t];
    }
    __syncthreads();
    if (MODE == 2) return;
    {
        f32x4 a1[8], a2[8];
#pragma unroll
        for (int i = 0; i < 8; ++i) { a1[i] = (f32x4){0.f, 0.f, 0.f, 0.f}; a2[i] = (f32x4){0.f, 0.f, 0.f, 0.f}; }
#pragma unroll
        for (int kk = 0; kk < 4; ++kk) { const bf16x8 ap = ldfrag(Ps, 16 * wave, 32 * kk, lane), aq = ldfrag(qs, 16 * wave, 32 * kk, lane);
#pragma unroll
            for (int eb = 0; eb < 8; ++eb) { a1[eb] = mfma16(ap, ldfrag(vT, 16 * eb, 32 * kk, lane), a1[eb]); a2[eb] = mfma16(aq, ldfrag(CT, 16 * eb, 32 * kk, lane), a2[eb]); } }
        MFMA_DRAIN8(a1); MFMA_DRAIN8(a2);
        float hv[8][4]; float ssq[4];
#pragma unroll
        for (int r = 0; r < 4; ++r) { const int t = 16 * wave + 4 * (lane >> 4) + r;
            const float dd = fmaxf(fabsf(den[t]), expf(-(bb[t] + gg[t]))); const float inv = 1.f / dd, wi = wint[t]; float s2 = 0.f;
#pragma unroll
            for (int eb = 0; eb < 8; ++eb) { const float x = (a1[eb][r] + wi * a2[eb][r]) * inv; hv[eb][r] = x; s2 += x * x;
#if DBG_M3
                a.out[(size_t)(t0 + t) * DM + h * 256 + 128 + 16 * eb + (lane & 15)] = (eb == 0) ? bb[t] : (eb == 1) ? gg[t] : 0.f;
#endif
            }
            s2 += __shfl_xor(s2, 1); s2 += __shfl_xor(s2, 2); s2 += __shfl_xor(s2, 4); s2 += __shfl_xor(s2, 8);
            ssq[r] = rsqrtf(s2 * (1.f / 128.f) + EPS); }
        float mov[8][4];
#pragma unroll
        for (int eb = 0; eb < 8; ++eb)
#pragma unroll
            for (int r = 0; r < 4; ++r) mov[eb][r] = bflo(PROJ[(size_t)(t0 + 16 * wave + 4 * (lane >> 4) + r) * NPROJ + 1536 + h * 128 + 16 * eb + (lane & 15)]);
#pragma unroll
        for (int eb = 0; eb < 8; ++eb) { const int e = 16 * eb + (lane & 15); const float ge = mlg[e];
#pragma unroll
            for (int r = 0; r < 4; ++r) { const int t = 16 * wave + 4 * (lane >> 4) + r;
                const float outv = hv[eb][r] * ssq[r] * ge * sigm(mov[eb][r]);
                if (MODE == 0) MIX[(size_t)(t0 + t) * DM + h * 128 + e] = (bf16_t)f2bf(outv); else asm volatile("" :: "v"(outv)); } }
    }
    __syncthreads();
}

__device__ __forceinline__ void qknorm_rows(const Args& a, const int tid) {
    const int lane = tid & 63, wave = tid >> 6;
    bf16_t* PROJ = (bf16_t*)(a.ws + WS_PROJ);
    const float* gq = a.in[9]; const float* gk = a.in[10];
    const float* g = (lane < 32) ? gq : gk; const float scl = (lane < 32) ? C2 : 1.f;
    float gv[16];
#pragma unroll
    for (int i = 0; i < 16; ++i) gv[i] = g[16 * (lane & 3) + i] * scl;
    const int gw = blockIdx.x * 8 + wave, NGW = gridDim.x * 8;
    for (int row = gw; row < T; row += NGW) {
        u32x4* p = (u32x4*)(PROJ + (size_t)row * NPROJ + 2048 + 16 * lane);
        float x[16]; { float t8[8]; unpack8(p[0], t8);
#pragma unroll
            for (int i = 0; i < 8; ++i) x[i] = t8[i]; unpack8(p[1], t8);
#pragma unroll
            for (int i = 0; i < 8; ++i) x[8 + i] = t8[i]; }
        float ss = 0.f;
#pragma unroll
        for (int i = 0; i < 16; ++i) ss += x[i] * x[i];
        ss += __shfl_xor(ss, 1); ss += __shfl_xor(ss, 2);
        const float rstd = rsqrtf(ss * (1.f / 64.f) + EPS);
        float y0[8], y1[8];
#pragma unroll
        for (int i = 0; i < 8; ++i) { y0[i] = x[i] * rstd * gv[i]; y1[i] = x[8 + i] * rstd * gv[8 + i]; }
        p[0] = pack8(y0); p[1] = pack8(y1);
    }
}

__device__ __forceinline__ void attn_naive_unit(const Args& a, unsigned char* lds, int bh, int qb) {
    const int tid = threadIdx.x, wave = tid >> 6;
    const int b = bh >> 2, h = bh & 3;
    float* Ks = (float*)lds; float* Vs = Ks + 64 * 64;
    const bf16_t* PROJ = (const bf16_t*)(a.ws + WS_PROJ); float* TMP = (float*)(a.ws + WS_TMP); bf16_t* MIX = (bf16_t*)(a.ws + WS_MIX);
    const int qi = qb * 512 + tid; const size_t trow = (size_t)b * SEQ + qi;
    const float slope2 = exp2f(-2.f * (float)(h + 1)) * LOG2E;
    float lam;
    { float s1 = 0.f, s2 = 0.f; const float* q1 = a.in[11]; const float* k1 = a.in[12]; const float* q2 = a.in[13]; const float* k2 = a.in[14];
        for (int i = 0; i < 64; ++i) { s1 += q1[i] * k1[i]; s2 += q2[i] * k2[i]; }
        lam = expf(s1) - expf(s2) + LAM_INIT; }
    const int nt = qb * 8 + 8; const int qwmax = qb * 512 + wave * 64 + 63;
    float* tp = TMP + trow * 512 + h * 128;
    for (int pass = 0; pass < 4; ++pass) {
        const int c = pass >> 1, vh = pass & 1;
        float q[64], o[64];
        { const bf16_t* qp = PROJ + trow * NPROJ + 2048 + h * 128 + c * 64;
#pragma unroll
            for (int i = 0; i < 8; ++i) { float t8[8]; unpack8(*(const u32x4*)(qp + 8 * i), t8);
#pragma unroll
                for (int j = 0; j < 8; ++j) q[8 * i + j] = t8[j]; } }
#pragma unroll
        for (int i = 0; i < 64; ++i) o[i] = 0.f;
        float m = -INFINITY, l = 0.f;
        for (int kt = 0; kt < nt; ++kt) {
            __syncthreads();
            { const int key = tid >> 3, ch = tid & 7; const bf16_t* rp = PROJ + ((size_t)b * SEQ + kt * 64 + key) * NPROJ;
                float t8[8]; unpack8(*(const u32x4*)(rp + 2560 + h * 128 + c * 64 + 8 * ch), t8);
                *(f32x4*)(Ks + key * 64 + 8 * ch) = (f32x4){t8[0], t8[1], t8[2], t8[3]}; *(f32x4*)(Ks + key * 64 + 8 * ch + 4) = (f32x4){t8[4], t8[5], t8[6], t8[7]};
                unpack8(*(const u32x4*)(rp + 3072 + h * 128 + vh * 64 + 8 * ch), t8);
                *(f32x4*)(Vs + key * 64 + 8 * ch) = (f32x4){t8[0], t8[1], t8[2], t8[3]}; *(f32x4*)(Vs + key * 64 + 8 * ch + 4) = (f32x4){t8[4], t8[5], t8[6], t8[7]}; }
            __syncthreads();
            if (kt * 64 <= qwmax) {
                for (int j = 0; j < 64; ++j) {
                    const int kpos = kt * 64 + j; const float* kr = Ks + j * 64; const float* vr = Vs + j * 64;
                    float s = 0.f;
#pragma unroll
                    for (int d = 0; d < 64; ++d) s += q[d] * kr[d];
                    s = (kpos <= qi) ? (s - slope2 * (float)(qi - kpos)) : -INFINITY;
                    if (s > m) { const float al = exp2f(m - s); l *= al;
#pragma unroll
                        for (int e = 0; e < 64; ++e) o[e] *= al; m = s; }
                    const float p = exp2f(s - m); l += p;
#pragma unroll
                    for (int e = 0; e < 64; ++e) o[e] += p * vr[e];
                }
            }
        }
        const float inv = 1.f / l;
        if (c == 0) {
#pragma unroll
            for (int e = 0; e < 64; ++e) tp[vh * 64 + e] = o[e] * inv;
        } else {
#pragma unroll
            for (int e = 0; e < 64; ++e) tp[vh * 64 + e] = tp[vh * 64 + e] - lam * o[e] * inv;
        }
    }
    { const float* dg = a.in[15]; float ss = 0.f;
        for (int e = 0; e < 128; ++e) { const float v = tp[e]; ss += v * v; }
        const float rs = rsqrtf(ss * (1.f / 128.f) + EPS) * (1.f - LAM_INIT);
        for (int e = 0; e < 128; e += 2) { const unsigned w = pk2(tp[e] * rs * dg[e], tp[e + 1] * rs * dg[e + 1]);
            *(unsigned*)(MIX + trow * DM + 512 + h * 128 + e) = w; } }
    __syncthreads();
}

#include <hip/hip_bf16.h>
namespace attn_body {
using bf16=__hip_bfloat16;
using bf16x8=__attribute__((ext_vector_type(8)))short;
using s16x4=__attribute__((ext_vector_type(4)))short;
using f32x16=__attribute__((ext_vector_type(16)))float;
using u32x4=__attribute__((ext_vector_type(4)))unsigned;
constexpr int SEQ=8192,D=64,PQ=3584,PO=512;
constexpr int NW=8,QBLK=32,QB=QBLK*NW,KVBLK=64,NQB=SEQ/QB;
__device__ __forceinline__ int crow(int r,int hi){return (r&3)+8*(r>>2)+4*hi;}
#define SBAR() __builtin_amdgcn_sched_barrier(0)
__device__ __forceinline__ void cmask(f32x16&p0,f32x16&p1,int jb,int qrel,int hi){
  const float NEG=-INFINITY; int kb=64*jb+4*hi;
  #pragma unroll
  for(int r=0;r<16;++r){int kv=kb+(r&3)+8*(r>>2); if(kv>qrel)p0[r]=NEG; if(kv+32>qrel)p1[r]=NEG;}
}

constexpr int NSLOT=3, SLOTB=8192;
constexpr int LDS_K=0, LDS_V=NSLOT*SLOTB, LDS_WS=2*NSLOT*SLOTB, LDS_OST=LDS_WS+NW*64*4, LDS_BYTES=LDS_OST+NW*4096;
constexpr float C2=0.125f*1.4426950408889634f;
__device__ __forceinline__ void glds16(const void*gsrc,unsigned lds_dst){unsigned keep;
  asm volatile("s_mov_b32 %0, m0\n\ts_mov_b32 m0, %2\n\ts_nop 0\n\tglobal_load_lds_dwordx4 %1, off\n\ts_mov_b32 m0, %0":"=&s"(keep):"v"(gsrc),"s"(lds_dst):"memory");}
__device__ __forceinline__ float max3f(float a,float b,float c){float r;asm("v_max3_f32 %0, %1, %2, %3":"=v"(r):"v"(a),"v"(b),"v"(c));return r;}
__device__ __forceinline__ float max2f(float a,float b){float r;asm("v_max_f32_e32 %0, %1, %2":"=v"(r):"v"(a),"v"(b));return r;}
__device__ __forceinline__ float fadd_s(float a,float b){float r;asm("v_add_f32_e32 %0, %1, %2":"=v"(r):"v"(a),"v"(b));return r;}
__device__ __forceinline__ float fsub_s(float a,float b){float r;asm("v_sub_f32_e32 %0, %1, %2":"=v"(r):"v"(a),"v"(b));return r;}
typedef float f32x2_t __attribute__((ext_vector_type(2))); typedef __bf16 bf16x2_t __attribute__((ext_vector_type(2)));
__device__ __forceinline__ unsigned cvtpk_s(float lo,float hi){f32x2_t v={lo,hi};bf16x2_t b=__builtin_convertvector(v,bf16x2_t);return __builtin_bit_cast(unsigned,b);}
#define WAIT_BAR(N) asm volatile("s_waitcnt vmcnt(" #N ") lgkmcnt(0)\n\ts_barrier":::"memory")

__device__ __forceinline__ void qkt(f32x16&p0,f32x16&p1,const char*Kslot,const bf16x8*qr,const f32x16&negm,int r32,int hi){
  const char*kb=Kslot+hi*1024+r32*16;
  #pragma unroll
  for(int d0=0;d0<4;++d0){
    const bf16x8 b0=*reinterpret_cast<const bf16x8*>(kb+d0*2048);
    const bf16x8 b1=*reinterpret_cast<const bf16x8*>(kb+d0*2048+512);
    if(d0==0){p0=__builtin_amdgcn_mfma_f32_32x32x16_bf16(b0,qr[0],negm,0,0,0);p1=__builtin_amdgcn_mfma_f32_32x32x16_bf16(b1,qr[0],negm,0,0,0);}
    else{p0=__builtin_amdgcn_mfma_f32_32x32x16_bf16(b0,qr[d0],p0,0,0,0);p1=__builtin_amdgcn_mfma_f32_32x32x16_bf16(b1,qr[d0],p1,0,0,0);}}
}
typedef __attribute__((address_space(3))) const char* lds_cptr;
typedef short v4i16_t __attribute__((ext_vector_type(4)));
__device__ __forceinline__ void kload8(bf16x8*kf,lds_cptr kp){
  kf[0]=*(const __attribute__((address_space(3))) bf16x8*)(kp);      kf[1]=*(const __attribute__((address_space(3))) bf16x8*)(kp+512);
  kf[2]=*(const __attribute__((address_space(3))) bf16x8*)(kp+2048); kf[3]=*(const __attribute__((address_space(3))) bf16x8*)(kp+2560);
  kf[4]=*(const __attribute__((address_space(3))) bf16x8*)(kp+4096); kf[5]=*(const __attribute__((address_space(3))) bf16x8*)(kp+4608);
  kf[6]=*(const __attribute__((address_space(3))) bf16x8*)(kp+6144); kf[7]=*(const __attribute__((address_space(3))) bf16x8*)(kp+6656);
}
__device__ __forceinline__ void kload2(bf16x8*kf,lds_cptr kp,int j){ kf[2*j]=*(const __attribute__((address_space(3))) bf16x8*)(kp+j*2048); kf[2*j+1]=*(const __attribute__((address_space(3))) bf16x8*)(kp+j*2048+512); }
__device__ __forceinline__ s16x4 vtr(lds_cptr p){ return __builtin_bit_cast(s16x4,__builtin_amdgcn_ds_read_tr16_b64_v4i16((__attribute__((address_space(3))) v4i16_t*)p)); }
__device__ __forceinline__ float rowmax(const f32x16&p0,const f32x16&p1){
  float a=max3f(p0[0],p0[1],p1[0]),b=max3f(p0[2],p0[3],p1[1]);a=max3f(a,p1[2],p1[3]);
  #pragma unroll
  for(int r=4;r<16;r+=4){a=max3f(a,p0[r],p0[r+1]);b=max3f(b,p0[r+2],p0[r+3]);a=max3f(a,p1[r],p1[r+1]);b=max3f(b,p1[r+2],p1[r+3]);}
  const float m=max2f(a,b);
  auto rr=__builtin_amdgcn_permlane32_swap(__float_as_uint(m),__float_as_uint(m),false,false);
  return max2f(__uint_as_float(rr[0]),__uint_as_float(rr[1]));
}
__device__ __forceinline__ void pv(f32x16*o,int vb,bf16x8 pa0,bf16x8 pa1,bf16x8 pa2,bf16x8 pa3){
  #pragma unroll
  for(int d0=0;d0<2;++d0){s16x4 lo[4],hi[4];
    #pragma unroll
    for(int ks=0;ks<4;++ks){
      asm volatile("ds_read_b64_tr_b16 %0,%1 offset:%c2":"=&v"(lo[ks]):"v"(vb),"i"(d0*4096+ks*1024):"memory");
      asm volatile("ds_read_b64_tr_b16 %0,%1 offset:%c2":"=&v"(hi[ks]):"v"(vb),"i"(d0*4096+ks*1024+512):"memory");}
    asm volatile("s_waitcnt lgkmcnt(0)":::"memory");SBAR();
    #define PK(k) (bf16x8){lo[k][0],lo[k][1],lo[k][2],lo[k][3],hi[k][0],hi[k][1],hi[k][2],hi[k][3]}
    o[d0]=__builtin_amdgcn_mfma_f32_32x32x16_bf16(pa0,PK(0),o[d0],0,0,0);
    o[d0]=__builtin_amdgcn_mfma_f32_32x32x16_bf16(pa1,PK(1),o[d0],0,0,0);
    o[d0]=__builtin_amdgcn_mfma_f32_32x32x16_bf16(pa2,PK(2),o[d0],0,0,0);
    o[d0]=__builtin_amdgcn_mfma_f32_32x32x16_bf16(pa3,PK(3),o[d0],0,0,0);
    #undef PK
  }
}


constexpr int A2_SLOT=32768, A2_NS=4, A2_K=0, A2_V=16384, A2_WS=131072, A2_STG=65536;
__device__ __forceinline__ void attn2_unit(const bf16*PROJ,const float*dg,bf16_t*MIX,char*shm,int bh,int qb,const float lam,const float m0){
  const int tid=threadIdx.x,lane=tid&63,r32=lane&31,hi=lane>>5; const int wid=__builtin_amdgcn_readfirstlane(tid>>6);
  const int c=wid&1,qblk=wid>>1,b=bh>>2,h=bh&3; const long rowbase=(long)b*SEQ; const int q0=qb*128;
  const float sl2=exp2f(-2.f*(float)(h+1))*1.4426950408889634f;
  int tbeg=0; { const float kmin=(float)q0-(2.f*m0+40.f)/sl2; if(kmin>0.f)tbeg=((int)kmin)>>6; }
  const int NT=(q0+128)/KVBLK-tbeg;
  const bf16*Qw=PROJ+(rowbase+q0+qblk*32)*PQ+2048+h*128+c*64;
  const bf16*ksrc=PROJ+(rowbase+(long)tbeg*KVBLK+lane)*PQ+2560+h*128+wid*8;
  const bf16*vsrc=PROJ+(rowbase+(long)tbeg*KVBLK+16*(wid&3)+(lane>>2))*PQ+3072+h*128+(wid>>2)*32+(lane&3)*8;
  const unsigned lds0=(unsigned)(uintptr_t)shm;
  const unsigned kdst=lds0+A2_K+wid*1024, vdst=lds0+A2_V+wid*1024;
  #define A2_DMA(t,s) do{ const bf16*kp_=ksrc+(long)(t)*KVBLK*PQ; const bf16*vp_=vsrc+(long)(t)*KVBLK*PQ; const unsigned so_=(unsigned)(s)*A2_SLOT; \
      glds16(kp_,(unsigned)__builtin_amdgcn_readfirstlane(kdst+so_)); glds16(kp_+64,(unsigned)__builtin_amdgcn_readfirstlane(kdst+so_+8192)); \
      glds16(vp_,(unsigned)__builtin_amdgcn_readfirstlane(vdst+so_)); glds16(vp_+64,(unsigned)__builtin_amdgcn_readfirstlane(vdst+so_+8192)); }while(0)
  A2_DMA(0,0); if(NT>1)A2_DMA(1,1); if(NT>2)A2_DMA(2,2);
  bf16x8 qr[4];
  #pragma unroll
  for(int d0=0;d0<4;++d0)qr[d0]=*reinterpret_cast<const bf16x8*>(&Qw[(long)r32*PQ+d0*16+hi*8]);
  const int qrel=qblk*32+r32;
  const float sl64=sl2*64.f,c32=sl2*32.f;
  float l_reg=0.f; f32x16 o[4]; o[0]=f32x16{};o[1]=f32x16{};o[2]=f32x16{};o[3]=f32x16{}; f32x16 negm;
  { const float nb0=sl2*(float)(4*hi+64*tbeg-q0-qrel)-m0;
    #pragma unroll
    for(int r=0;r<16;++r)negm[r]=__builtin_fmaf(sl2,(float)((r&3)+8*(r>>2)),nb0); }
  const int vb0=(int)(lds0+A2_V)+((lane>>4)&1)*32+(lane&3)*8+(4*hi+((lane&15)>>2))*64;
  { asm volatile("s_waitcnt vmcnt(0)":::"memory"); asm volatile("s_barrier":::"memory"); }
  const int grp=wid>>2;
  if(grp==1)asm volatile("s_barrier":::"memory");
  for(int t=0;t<NT;++t){
    const int s=t&3;
    f32x16 p0,p1;
    qkt(p0,p1,shm+A2_K+s*A2_SLOT+c*8192,qr,negm,r32,hi); asm volatile("s_nop 15\n\ts_nop 7":"+v"(p0),"+v"(p1));
    #pragma unroll
    for(int r=0;r<16;++r){p1[r]+=c32;negm[r]+=sl64;}
    { const int jb=t-(NT-2); if(jb>=0)cmask(p0,p1,jb,qrel,hi); }
    float sacc=0.f;
    #pragma unroll
    for(int r=0;r<16;++r){p0[r]=__builtin_amdgcn_exp2f(p0[r]);p1[r]=__builtin_amdgcn_exp2f(p1[r]);sacc+=p0[r]+p1[r];}
    l_reg+=sacc;
    u32x4 pw0,pw1,pw2,pw3;
    #define PKW(P,B) cvtpk_s(P[B],P[B+1])
    pw0=(u32x4){PKW(p0,0),PKW(p0,2),PKW(p0,4),PKW(p0,6)};pw1=(u32x4){PKW(p0,8),PKW(p0,10),PKW(p0,12),PKW(p0,14)};
    pw2=(u32x4){PKW(p1,0),PKW(p1,2),PKW(p1,4),PKW(p1,6)};pw3=(u32x4){PKW(p1,8),PKW(p1,10),PKW(p1,12),PKW(p1,14)};
    #undef PKW
    if(t+2<NT)asm volatile("s_waitcnt vmcnt(4) lgkmcnt(0)\n\ts_barrier":::"memory"); else asm volatile("s_waitcnt vmcnt(0) lgkmcnt(0)\n\ts_barrier":::"memory");
    if(t+3<NT)A2_DMA(t+3,(t+3)&3);
    SBAR();
    pv(o,vb0+s*A2_SLOT,__builtin_bit_cast(bf16x8,pw0),__builtin_bit_cast(bf16x8,pw1),__builtin_bit_cast(bf16x8,pw2),__builtin_bit_cast(bf16x8,pw3));
    pv(o+2,vb0+s*A2_SLOT+8192,__builtin_bit_cast(bf16x8,pw0),__builtin_bit_cast(bf16x8,pw1),__builtin_bit_cast(bf16x8,pw2),__builtin_bit_cast(bf16x8,pw3));
    asm volatile("s_waitcnt lgkmcnt(0)\n\ts_barrier":::"memory");
  }
  if(grp==0)asm volatile("s_barrier":::"memory");
  asm volatile("s_waitcnt vmcnt(0)":::"memory");
  #undef A2_DMA
  {auto rr=__builtin_amdgcn_permlane32_swap(__float_as_uint(l_reg),__float_as_uint(l_reg),false,false);l_reg=__uint_as_float(rr[0])+__uint_as_float(rr[1]);}
  float*wsf=(float*)(shm+A2_WS)+wid*64;
  if(hi==0)wsf[r32]=l_reg; asm volatile("s_waitcnt lgkmcnt(0)":::"memory");
  float rli[16];
  #pragma unroll
  for(int r=0;r<16;++r)rli[r]=__builtin_amdgcn_rcpf(wsf[crow(r,hi)]);
  float*X=(float*)shm+qblk*4096;
  if(c==1){
    #pragma unroll
    for(int d0=0;d0<4;++d0)
      #pragma unroll
      for(int r=0;r<16;++r)X[(d0*16+r)*64+lane]=o[d0][r]*rli[r];
  }
  asm volatile("s_waitcnt lgkmcnt(0)\n\ts_barrier":::"memory");
  if(c==0){
    bf16_t*stg=(bf16_t*)(shm+A2_STG)+qblk*4096;
    #pragma unroll
    for(int d0=0;d0<4;++d0)
      #pragma unroll
      for(int r=0;r<16;++r){ const float v=o[d0][r]*rli[r]-lam*X[(d0*16+r)*64+lane]; stg[crow(r,hi)*128+d0*32+r32]=(bf16_t)(__builtin_bit_cast(unsigned short,__float2bfloat16(v))); }
    asm volatile("s_waitcnt lgkmcnt(0)":::"memory");
    const int row=lane>>1,half=lane&1; const bf16_t*sp=stg+row*128+half*64;
    float d[64]; float ss=0.f;
    #pragma unroll
    for(int i=0;i<8;++i){ const u32x4 w=*(const u32x4*)(sp+8*i);
      d[8*i+0]=__uint_as_float(w.x<<16);d[8*i+1]=__uint_as_float(w.x&0xffff0000u);d[8*i+2]=__uint_as_float(w.y<<16);d[8*i+3]=__uint_as_float(w.y&0xffff0000u);
      d[8*i+4]=__uint_as_float(w.z<<16);d[8*i+5]=__uint_as_float(w.z&0xffff0000u);d[8*i+6]=__uint_as_float(w.w<<16);d[8*i+7]=__uint_as_float(w.w&0xffff0000u); }
    #pragma unroll
    for(int i=0;i<64;++i)ss+=d[i]*d[i];
    ss+=__shfl_xor(ss,1);
    const float rs=rsqrtf(ss*(1.f/128.f)+1e-6f)*0.8f;
    bf16_t*mp=MIX+(rowbase+q0+qblk*32+row)*1024+512+h*128+half*64; const float*gp=dg+half*64;
    #pragma unroll
    for(int i=0;i<8;++i){ u32x4 w;
      w.x=cvtpk_s(d[8*i+0]*rs*gp[8*i+0],d[8*i+1]*rs*gp[8*i+1]); w.y=cvtpk_s(d[8*i+2]*rs*gp[8*i+2],d[8*i+3]*rs*gp[8*i+3]);
      w.z=cvtpk_s(d[8*i+4]*rs*gp[8*i+4],d[8*i+5]*rs*gp[8*i+5]); w.w=cvtpk_s(d[8*i+6]*rs*gp[8*i+6],d[8*i+7]*rs*gp[8*i+7]);
      *(u32x4*)(mp+8*i)=w; }
  }
  asm volatile("s_waitcnt lgkmcnt(0)\n\ts_barrier":::"memory");
}
constexpr int ATTN_LDS_BYTES=LDS_BYTES;
#undef SBAR
#undef WAIT_BAR
}

__device__ __forceinline__ unsigned wave_umax(unsigned x) {
    x = max(x, (unsigned)__builtin_amdgcn_update_dpp(0, (int)x, 0x111, 0xf, 0xf, false));
    x = max(x, (unsigned)__builtin_amdgcn_update_dpp(0, (int)x, 0x112, 0xf, 0xf, false));
    x = max(x, (unsigned)__builtin_amdgcn_update_dpp(0, (int)x, 0x114, 0xf, 0xf, false));
    x = max(x, (unsigned)__builtin_amdgcn_update_dpp(0, (int)x, 0x118, 0xf, 0xf, false));
    x = max(x, (unsigned)__builtin_amdgcn_update_dpp(0, (int)x, 0x142, 0xa, 0xf, false));
    x = max(x, (unsigned)__builtin_amdgcn_update_dpp(0, (int)x, 0x143, 0xc, 0xf, false));
    return (unsigned)__builtin_amdgcn_readlane((int)x, 63);
}
__device__ __forceinline__ unsigned sel_key(float v, int idx) { unsigned u = __float_as_uint(v); u = (u & 0x80000000u) ? ~u : (u | 0x80000000u); return (u & 0xffffff00u) | (unsigned)(255 - idx); }

__device__ __forceinline__ void ph_route(const Args& a, unsigned char* lds, const int tid) {
    const int lane = tid & 63, wave = tid >> 6;
    int* hist = (int*)lds;
    const float* LOG = (const float*)(a.ws + WS_LOGITS); const float* rb = a.in[18];
    int* IDX = (int*)(a.ws + WS_IDX); float* GATEV = (float*)(a.ws + WS_GATEV); int* HIST = (int*)(a.ws + WS_HIST);
    unsigned* TOT = (unsigned*)(a.ws + WS_BAR) + 3456;
    const f32x4 rb4 = *((const f32x4*)rb + lane);
    for (int tb = blockIdx.x; tb < 256; tb += gridDim.x) {
        if (tid < 256) hist[tid] = 0;
        __syncthreads();
        f32x4 lgn = *((const f32x4*)(LOG + (size_t)(tb * 128 + wave * 16) * 256) + lane);
        for (int i = 0; i < 16; ++i) {
            const int t = tb * 128 + wave * 16 + i;
            const f32x4 lg = lgn;
            if (i < 15) lgn = *((const f32x4*)(LOG + (size_t)(t + 1) * 256) + lane);
            float s[4], sel[4];
            s[0] = sigm(lg.x); s[1] = sigm(lg.y); s[2] = sigm(lg.z); s[3] = sigm(lg.w);
            sel[0] = s[0] + rb4.x; sel[1] = s[1] + rb4.y; sel[2] = s[2] + rb4.z; sel[3] = s[3] + rb4.w;
            float m1 = fmaxf(sel[0], sel[1]), m2 = fminf(sel[0], sel[1]);
            { const float x = sel[2]; const float n1 = fmaxf(m1, x); m2 = fmaxf(m2, fminf(m1, x)); m1 = n1; }
            { const float x = sel[3]; const float n1 = fmaxf(m1, x); m2 = fmaxf(m2, fminf(m1, x)); m1 = n1; }
#pragma unroll
            for (int off = 1; off < 8; off <<= 1) { const float o1 = __shfl_xor(m1, off), o2 = __shfl_xor(m2, off);
                const float n1 = fmaxf(m1, o1), n2 = fmaxf(fminf(m1, o1), fmaxf(m2, o2)); m1 = n1; m2 = n2; }
            const float gs = m1 + m2; const int grp = lane >> 3; int rank = 0;
#pragma unroll
            for (int g2 = 0; g2 < 8; ++g2) { const float v = __builtin_bit_cast(float, __builtin_amdgcn_readlane(__builtin_bit_cast(int, gs), 8 * g2)); rank += ((v > gs) || (v == gs && g2 < grp)) ? 1 : 0; }
            const bool gsel = rank < 4;
            unsigned key[4];
#pragma unroll
            for (int j = 0; j < 4; ++j) key[j] = gsel ? sel_key(sel[j], 4 * lane + j) : 0u;
            float gsum = 0.f; float myg = 0.f; int myidx = 0;
#pragma unroll
            for (int k = 0; k < 8; ++k) {
                const unsigned best = wave_umax(max(max(key[0], key[1]), max(key[2], key[3])));
                const int bi = 255 - (int)(best & 255u);
                const int owner = bi >> 2, sub = bi & 3;
                float sv = (sub == 0) ? s[0] : (sub == 1) ? s[1] : (sub == 2) ? s[2] : s[3];
                sv = __builtin_bit_cast(float, __builtin_amdgcn_readlane(__builtin_bit_cast(int, sv), owner));
                if (lane == owner) {
#pragma unroll
                    for (int j = 0; j < 4; ++j) if (j == sub) key[j] = 0u;
                }
                gsum += sv;
                if (lane == k) { myg = sv; myidx = bi; }
            }
            if (lane < 8) { IDX[(size_t)t * 8 + lane] = myidx; GATEV[(size_t)t * 8 + lane] = myg / gsum * 2.5f; atomicAdd(&hist[myidx], 1); }
        }
        __syncthreads();
        if (tid < 256) { const int hv = hist[tid]; HIST[tb * 256 + tid] = hv; if (hv) atomicAdd(TOT + tid, (unsigned)hv); }
        __syncthreads();
    }
}

__device__ __forceinline__ void ph_scatter(const Args& a, unsigned char* lds, const int tid) {
    int* tot = (int*)lds; int* cur = tot + 256; int* base = cur + 256; int* tstart = base + 256;
    const int* HIST = (const int*)(a.ws + WS_HIST); const int* IDX = (const int*)(a.ws + WS_IDX); const float* GATEV = (const float*)(a.ws + WS_GATEV);
    int* PSLOT = (int*)(a.ws + WS_PSLOT); int* SLOTTOK = (int*)(a.ws + WS_SLOTTOK); float* SLOTGATE = (float*)(a.ws + WS_SLOTGATE);
    int* TILE = (int*)(a.ws + WS_TILE);
    unsigned* TOT = (unsigned*)(a.ws + WS_BAR) + 3456; unsigned* CUR = TOT + 256;
    for (int tb = blockIdx.x; tb < 256; tb += gridDim.x) {
        __syncthreads();
        if (tid < 256) tot[tid] = (int)__hip_atomic_load(TOT + tid, __ATOMIC_RELAXED, __HIP_MEMORY_SCOPE_AGENT);
        __syncthreads();
        if (tid < 256) { int bs = 0, ts = 0; for (int j = 0; j < tid; ++j) { const int c = tot[j]; bs += c; ts += (c + 255) >> 8; } base[tid] = bs; tstart[tid] = ts;
            const int mine = HIST[tb * 256 + tid]; cur[tid] = bs + (mine ? (int)atomicAdd(CUR + tid, (unsigned)mine) : 0); }
        __syncthreads();
        for (int p = tid; p < 1024; p += 512) { const int t = tb * 128 + (p >> 3), k = p & 7; const int e = IDX[(size_t)t * 8 + k];
            const int slot = atomicAdd(&cur[e], 1); SLOTTOK[slot] = t; SLOTGATE[slot] = GATEV[(size_t)t * 8 + k]; PSLOT[(size_t)t * 8 + k] = slot; }
        if (tb == 0) {
            if (tid < 256) { const int cnt = tot[tid], b0 = base[tid]; int n = tstart[tid];
                for (int r0 = 0; r0 < cnt; r0 += 256) { TILE[64 + n] = tid; TILE[64 + 2048 + n] = b0 + r0; TILE[64 + 4096 + n] = b0 + cnt; ++n; }
                if (tid == 255) TILE[0] = n; }
            __syncthreads();
            if (tid < 128) { const int n = tstart[255] + ((tot[255] + 255) >> 8);
                TILE[64 + n + tid] = 256; TILE[64 + 2048 + n + tid] = SHARED_BASE + 256 * tid; TILE[64 + 4096 + n + tid] = SHARED_BASE + T; }
        }
    }
}

__device__ __forceinline__ void ph_final(const Args& a, const int tid) {
    const int lane = tid & 63, wave = tid >> 6;
    const bf16_t* YP = (const bf16_t*)(a.ws + WS_YP); const int* PSLOT = (const int*)(a.ws + WS_PSLOT); const float* MOD = (const float*)(a.ws + WS_MOD);
    float* out = a.out;
    const int gw = blockIdx.x * 8 + wave, NGW = gridDim.x * 8;
    for (int row = gw; row < T; row += NGW) {
        const int b = row / SEQ;
        float acc[16];
#pragma unroll
        for (int i = 0; i < 16; ++i) acc[i] = 0.f;
        int myslot = 0; if (lane < 8) myslot = PSLOT[(size_t)row * 8 + lane]; if (lane == 8) myslot = SHARED_BASE + row;
#pragma unroll
        for (int k = 0; k < 9; ++k) { const int slot = __shfl(myslot, k); const bf16_t* yp = YP + (size_t)slot * DM;
            float t8[8]; unpack8(*(const u32x4*)(yp + 8 * lane), t8);
#pragma unroll
            for (int i = 0; i < 8; ++i) acc[i] += t8[i];
            unpack8(*(const u32x4*)(yp + 512 + 8 * lane), t8);
#pragma unroll
            for (int i = 0; i < 8; ++i) acc[8 + i] += t8[i]; }
        const float* gf = MOD + b * 6144 + 5 * 1024;
#pragma unroll
        for (int hh = 0; hh < 2; ++hh) { float* op = out + (size_t)row * DM + hh * 512 + 8 * lane; const float* gp = gf + hh * 512 + 8 * lane;
            f32x4 x0 = *(const f32x4*)op, x1 = *(const f32x4*)(op + 4); const f32x4 g0 = *(const f32x4*)gp, g1 = *(const f32x4*)(gp + 4);
            x0.x += g0.x * acc[8 * hh + 0]; x0.y += g0.y * acc[8 * hh + 1]; x0.z += g0.z * acc[8 * hh + 2]; x0.w += g0.w * acc[8 * hh + 3];
            x1.x += g1.x * acc[8 * hh + 4]; x1.y += g1.y * acc[8 * hh + 5]; x1.z += g1.z * acc[8 * hh + 6]; x1.w += g1.w * acc[8 * hh + 7];
            *(f32x4*)op = x0; *(f32x4*)(op + 4) = x1; }
    }
}


#define LAS __attribute__((address_space(3)))
#define XB_TMO      128
#define XB_XCNT(j)  (256  + 64 * (j))
#define XB_XSUB(j)  (1280 + 64 * (j))
#define XB_XGEN(j)  (2304 + 64 * (j))
#define XB_TOP      3328
#define XB_TOPGEN   3392
#define XB_SPIN_CAP (1u << 27)
__device__ __forceinline__ unsigned xb_ld(unsigned* p)              { return __hip_atomic_load(p, __ATOMIC_RELAXED, __HIP_MEMORY_SCOPE_AGENT); }
__device__ __forceinline__ unsigned xb_add(unsigned* p, unsigned v) { return __hip_atomic_fetch_add(p, v, __ATOMIC_RELAXED, __HIP_MEMORY_SCOPE_AGENT); }
__device__ __forceinline__ unsigned xb_xcc_id() { return (unsigned)__builtin_amdgcn_s_getreg((3 << 11) | 20) & 0xFu; }
#define XB_SPIN(cond, bar) do { unsigned _sp = 0; while (cond) { __builtin_amdgcn_s_sleep(1); \
    if ((++_sp & 255u) == 0u) { if (xb_ld(&(bar)[XB_TMO])) break; if (_sp > XB_SPIN_CAP) { atomicAdd(&(bar)[XB_TMO], 1u); break; } } } } while (0)
struct XcdBarrier { unsigned* bar; unsigned x; volatile LAS unsigned* st; };
__device__ __forceinline__ XcdBarrier xcd_barrier_post(unsigned* bar, volatile LAS unsigned* st, const bool t0) {
    XcdBarrier b; b.bar = bar; b.x = xb_xcc_id(); b.st = st;
    if (t0) (void)xb_add(&bar[XB_XCNT(b.x)], 1u);
    return b;
}
__device__ __forceinline__ void xcd_barrier_complete(unsigned* bar, unsigned x, unsigned& nloc, unsigned& nx) {
    const unsigned G = gridDim.x * gridDim.y * gridDim.z;
    unsigned sum, cnt, mine, sp = 0u;
    for (;;) {
        sum = 0u; cnt = 0u; mine = 0u;
#pragma unroll
        for (unsigned j = 0; j < 16; ++j) { const unsigned c = xb_ld(&bar[XB_XCNT(j)]); sum += c; cnt += (c > 0u) ? 1u : 0u; mine = (j == x) ? c : mine; }
        if (sum == G) break;
        __builtin_amdgcn_s_sleep(1);
        if ((++sp & 255u) == 0u) { if (xb_ld(&bar[XB_TMO])) break; if (sp > XB_SPIN_CAP) { atomicAdd(&bar[XB_TMO], 1u); break; } }
    }
    nloc = mine > 0u ? mine : 1u; nx = cnt > 0u ? cnt : 1u;
}
__device__ __forceinline__ void xcd_barrier(const XcdBarrier& b, const bool t0) {
    asm volatile("s_waitcnt vmcnt(0)" ::: "memory");
    __syncthreads();
    if (t0) {
        unsigned* bar = b.bar;
        __builtin_amdgcn_s_waitcnt(0);
        unsigned nloc = b.st[0], nx = b.st[1];
        if (nloc == 0u) { xcd_barrier_complete(bar, b.x, nloc, nx); b.st[0] = nloc; b.st[1] = nx; }
        const unsigned old = xb_add(&bar[XB_XSUB(b.x)], 1u);
        const unsigned gen = old / nloc;
        if (old + 1u == (gen + 1u) * nloc) {
            __builtin_amdgcn_fence(__ATOMIC_RELEASE, "agent");
            asm volatile("s_waitcnt vmcnt(0)" ::: "memory");
            const unsigned og = xb_add(&bar[XB_TOP], 1u);
            const unsigned tg = og / nx;
            if (og + 1u == (tg + 1u) * nx) xb_add(&bar[XB_TOPGEN], 1u);
            else XB_SPIN(xb_ld(&bar[XB_TOPGEN]) == tg, bar);
            __builtin_amdgcn_fence(__ATOMIC_ACQUIRE, "agent");
            xb_add(&bar[XB_XGEN(b.x)], 1u);
            asm volatile("s_waitcnt vmcnt(0)" ::: "memory");
        } else {
            XB_SPIN(xb_ld(&bar[XB_XGEN(b.x)]) == gen, bar);
            __builtin_amdgcn_fence(__ATOMIC_ACQUIRE, "agent");
            asm volatile("s_waitcnt vmcnt(0)" ::: "memory");
        }
    }
    __syncthreads();
}


__device__ __forceinline__ void dbg_dump(const Args& a, const bf16_t* src, int pitch, int coff, float ls, float rs) {
    for (size_t i = blockIdx.x * 512 + threadIdx.x; i < (size_t)T * DM; i += (size_t)gridDim.x * 512) {
        const int c = (int)(i & 1023); const size_t r = i >> 10;
        a.out[i] = bflo(src[r * pitch + coff + c]) * (c >= 512 ? rs : ls);
    }
}

__device__ __forceinline__ void dbg_dump_lin(const Args& a, const void* src, bool isbf, size_t n) {
    for (size_t i = blockIdx.x * 512 + threadIdx.x; i < (size_t)T * DM; i += (size_t)gridDim.x * 512) {
        float v = 0.f; if (i < n) v = isbf ? bflo(((const bf16_t*)src)[i]) : ((const float*)src)[i];
        a.out[i] = v;
    }
}
__global__ void __launch_bounds__(512) mega(Args a) {
    extern __shared__ __attribute__((aligned(16))) unsigned char lds[];
    const int lo = a.ph_lo, hi = a.ph_hi;
    const int wave_s = __builtin_amdgcn_readfirstlane((int)threadIdx.x >> 6);
#define tid mk_tid(wave_s)
    volatile LAS unsigned* bst = (volatile LAS unsigned*)((LAS unsigned char*)lds + (LDS_BYTES - 64));
    if (tid < 16) bst[tid] = 0u;
    __syncthreads();
    XcdBarrier bar = xcd_barrier_post((unsigned*)(a.ws + WS_BAR), bst, tid == 0);
#if USE_CG_SYNC
    cg::this_grid().sync();
#endif
    float* As = (float*)lds; float* Bs = As + 16 * 68;
#define IN(k) (lo <= (k) && (k) < hi)
#define SEAM(k) do { if (IN(k) && IN((k) + 1)) xcd_barrier(bar, tid == 0); } while (0)

    if (IN(0)) { ph0(a, lds, tid); } SEAM(0);
    if (IN(1)) { ph_norm<true>(a, lds, a.in[0], 0, 1, tid); } SEAM(1);
    if (IN(2)) {
        const EpiProj E{(bf16_t*)(a.ws + WS_PROJ)};
#if USE_PG8
        { pg8::DenseSched S; S.init(a.ws + WS_H, a.ws + WS_WIN, T, NPROJ, 2 * DM, (int)gridDim.x, (int)blockIdx.x); __syncthreads();
          pg8::gemm_phase<false, false, 0, 0>((PG8_LAS unsigned char*)lds, 2 * DM, S, E); }
#else
        for (int u = blockIdx.x; u < 512 * 56; u += gridDim.x) { const int mt = u / 56, nt = u % 56;
            ngemm_tile(As, Bs, (const bf16_t*)(a.ws + WS_H), DM, nullptr, 64 * mt, T, (const bf16_t*)(a.ws + WS_WIN), DM, 64 * nt, E, tid); }
#endif
    } SEAM(2);
    if (IN(3)) { qknorm_rows(a, tid); __syncthreads(); for (int u = blockIdx.x; u < 1024; u += gridDim.x) mlstm_m1_unit(a, lds, u, wave_s); } SEAM(3);
    if (IN(4)) { mlstm_m2(a, tid); } SEAM(4);
    if (IN(5)) {
#if USE_MFMA_ATTN
        { float lam; { float s1 = 0.f, s2 = 0.f; const float* q1 = a.in[11]; const float* k1 = a.in[12]; const float* q2 = a.in[13]; const float* k2 = a.in[14];
              for (int i = 0; i < 64; ++i) { s1 += q1[i] * k1[i]; s2 += q2[i] * k2[i]; } lam = expf(s1) - expf(s2) + LAM_INIT; }
          float m0; { float gq = 0.f, gk = 0.f; for (int i = 0; i < 64; ++i) { gq = fmaxf(gq, fabsf(a.in[9][i])); gk = fmaxf(gk, fabsf(a.in[10][i])); } m0 = 64.f * C2 * gq * gk * 1.01f + 0.01f; }
          unsigned* qhead = (unsigned*)(a.ws + WS_BAR) + 4001;
          for (;;) {
              __syncthreads();
              if (tid == 0) bst[8] = atomicAdd(qhead, 1u);
              __syncthreads();
              const int idx = (int)bst[8];
              if (idx >= 1024) break;
              const int qb = 63 - (idx >> 4), j = idx & 15, bh = (j & 3) * 4 + (3 - (j >> 2));
              attn_body::attn2_unit((const attn_body::bf16*)(a.ws + WS_PROJ), a.in[15], (bf16_t*)(a.ws + WS_MIX), (char*)lds, bh, qb, lam, m0);
          }
          for (;;) {
              __syncthreads();
              if (tid == 0) bst[8] = atomicAdd(qhead + 1, 1u);
              __syncthreads();
              const int idx = (int)bst[8];
              if (idx >= 1024) break;
              mlstm_m3_unit<0>(a, lds, idx, wave_s);
          }
#if DBG_M3_TWICE
          for (;;) {
              __syncthreads();
              if (tid == 0) bst[8] = atomicAdd(qhead + 2, 1u);
              __syncthreads();
              const int idx = (int)bst[8];
              if (idx >= 1024) break;
              mlstm_m3_unit<DBG_M3_TWICE>(a, lds, idx, wave_s);
          }
#endif
          __syncthreads(); }
#elif !DBG_SKIP_ATTN
        for (int u = blockIdx.x; u < 256; u += gridDim.x) { const int v = 255 - u; attn_naive_unit(a, lds, v & 15, v >> 4); }
#endif
#if !USE_MFMA_ATTN
        for (int u = blockIdx.x; u < 1024; u += gridDim.x) mlstm_m3_unit<0>(a, lds, u, wave_s);
#endif
    } SEAM(5);
#if !DBG_TWICE
    if (IN(6)) {
        const EpiOut E{a.in[0], a.out, (const float*)(a.ws + WS_MOD)};
#if USE_PG8
        { pg8::DenseSched S; S.init(a.ws + WS_MIX, a.ws + WS_WOUT, T, DM, 2 * DM, (int)gridDim.x, (int)blockIdx.x); __syncthreads();
          pg8::gemm_phase<false, false, 0, 0>((PG8_LAS unsigned char*)lds, 2 * DM, S, E); }
#else
        for (int u = blockIdx.x; u < 512 * 16; u += gridDim.x) { const int mt = u / 16, nt = u % 16;
            ngemm_tile(As, Bs, (const bf16_t*)(a.ws + WS_MIX), DM, nullptr, 64 * mt, T, (const bf16_t*)(a.ws + WS_WOUT), DM, 64 * nt, E, tid); }
#endif
    } SEAM(6);
    if (IN(7)) { ph_norm<false>(a, lds, a.out, 3, 4, tid); } SEAM(7);
    if (IN(8)) {
        const EpiRS E{(float*)(a.ws + WS_LOGITS), (bf16_t*)(a.ws + WS_ACT)};
#if USE_PG8
        { pg8::DenseSched S; S.init(a.ws + WS_H, a.ws + WS_WRS, T, 768, 2 * DM, (int)gridDim.x, (int)blockIdx.x); __syncthreads();
          pg8::gemm_phase<false, false, 0, 0>((PG8_LAS unsigned char*)lds, 2 * DM, S, E); }
#else
        for (int u = blockIdx.x; u < 512 * 12; u += gridDim.x) { const int mt = u / 12, nt = u % 12;
            ngemm_tile(As, Bs, (const bf16_t*)(a.ws + WS_H), DM, nullptr, 64 * mt, T, (const bf16_t*)(a.ws + WS_WRS), DM, 64 * nt, E, tid); }
#endif
    } SEAM(8);
    if (IN(9)) { ph_route(a, lds, tid); } SEAM(9);
    if (IN(10)) { ph_scatter(a, lds, tid); } SEAM(10);
    if (IN(11)) {
        const int* TILE = (const int*)(a.ws + WS_TILE); const int ntile = TILE[0];
        const EpiG1 E{(const float*)(a.ws + WS_SLOTGATE), (bf16_t*)(a.ws + WS_ACT)};
#if USE_PG8
        { const int G = (int)gridDim.x, bx = (int)blockIdx.x, vcu = (G % 8 == 0) ? (bx % 8) * (G / 8) + bx / 8 : bx;
          const pg8::ExpertSched S{TILE, ntile * 2, 2, (const char*)(a.ws + WS_H8), (const int*)(a.ws + WS_SLOTTOK), (const char*)(a.ws + WS_W13T), (size_t)512 * 1024, DM, G, vcu};
          __syncthreads(); pg8::gemm_phase<true, true, 0x79797979, 0x7f7f7f7f>((PG8_LAS unsigned char*)lds, DM, S, E); }
#else
        for (int u = blockIdx.x; u < ntile * 32; u += gridDim.x) { const int tl = u >> 5, sub = (u >> 3) & 3, nt = u & 7;
            const int e = TILE[64 + tl], r0 = TILE[64 + 2048 + tl] + 64 * sub, rend = TILE[64 + 4096 + tl];
            if (r0 >= rend) continue;
            ngemm_tile(As, Bs, (const bf16_t*)(a.ws + WS_H), DM, (const int*)(a.ws + WS_SLOTTOK), r0, rend, (const bf16_t*)(a.ws + WS_W13T) + (size_t)e * 512 * 1024, DM, 64 * nt, E, tid); }
#endif
    } SEAM(11);
    if (IN(12)) {
        const int* TILE = (const int*)(a.ws + WS_TILE); const int ntile = TILE[0] + 128;
        const EpiG2 E{(bf16_t*)(a.ws + WS_YP)};
#if USE_PG8
        { const int G = (int)gridDim.x, bx = (int)blockIdx.x, vcu = (G % 8 == 0) ? (bx % 8) * (G / 8) + bx / 8 : bx;
          const pg8::ExpertSched S{TILE, ntile * 4, 4, (const char*)(a.ws + WS_ACT), nullptr, (const char*)(a.ws + WS_W2T), (size_t)1024 * 256, 256, G, vcu};
          __syncthreads(); pg8::gemm_phase<false, true, 0x7a7a7a7a, 0x7c7c7c7c>((PG8_LAS unsigned char*)lds, 256, S, E); }
#else
        for (int u = blockIdx.x; u < ntile * 64; u += gridDim.x) { const int tl = u >> 6, sub = (u >> 4) & 3, nt = u & 15;
            const int e = TILE[64 + tl], r0 = TILE[64 + 2048 + tl] + 64 * sub, rend = TILE[64 + 4096 + tl];
            if (r0 >= rend) continue;
            ngemm_tile(As, Bs, (const bf16_t*)(a.ws + WS_ACT), 256, nullptr, r0, rend, (const bf16_t*)(a.ws + WS_W2T) + (size_t)e * 1024 * 256, 256, 64 * nt, E, tid); }
#endif
    } SEAM(12);
    if (IN(13)) { ph_final(a, tid); }
#endif
#if DBG_TWICE
    if (IN(14)) { bf16_t* SAVE = (bf16_t*)(a.ws + WS_ACT); const bf16_t* MIXp = (const bf16_t*)(a.ws + WS_MIX);
        for (size_t i = blockIdx.x * 512 + tid; i < (size_t)T * 512; i += (size_t)gridDim.x * 512) { const size_t r = i >> 9, c = i & 511; SAVE[i] = MIXp[r * DM + c]; } }
    if (IN(15)) {
        unsigned* CNT = (unsigned*)(a.ws + WS_BAR) + 4000;
        const bf16_t* SAVE = (const bf16_t*)(a.ws + WS_ACT); const bf16_t* MIXp = (const bf16_t*)(a.ws + WS_MIX);
        unsigned bad = 0;
        for (size_t i = blockIdx.x * 512 + tid; i < (size_t)T * 512; i += (size_t)gridDim.x * 512) { const size_t r = i >> 9, c = i & 511; bad += (SAVE[i] != MIXp[r * DM + c]) ? 1u : 0u; }
        if (bad) atomicAdd(CNT, bad);
        xcd_barrier(bar, tid == 0);
        const unsigned tot = __hip_atomic_load(CNT, __ATOMIC_RELAXED, __HIP_MEMORY_SCOPE_AGENT);
        const float cval = (tot == 0u) ? 1.f : (tot < 1000u) ? 3.f : (tot < 100000u) ? 5.f : 7.f;
        for (size_t i = blockIdx.x * 512 + tid; i < (size_t)T * DM; i += (size_t)gridDim.x * 512) a.out[i] = cval;
    }
#endif
#if DBG_DUMP == 5
    xcd_barrier(bar, tid == 0); dbg_dump(a, (const bf16_t*)(a.ws + WS_MIX), DM, 0, 1000.f, 1.f);
#elif DBG_DUMP == 7
    xcd_barrier(bar, tid == 0); dbg_dump_lin(a, a.ws + WS_CIN, true, (size_t)1024 * 16384);
#elif DBG_DUMP == 6
    xcd_barrier(bar, tid == 0); dbg_dump_lin(a, a.ws + WS_CLOC, false, (size_t)1024 * 16384);
#elif DBG_DUMP == 8
    xcd_barrier(bar, tid == 0); dbg_dump_lin(a, a.ws + WS_IPRE, false, (size_t)T * 8);
#elif DBG_DUMP == 9
    xcd_barrier(bar, tid == 0); dbg_dump_lin(a, a.ws + WS_MST, false, (size_t)3072);
#elif DBG_DUMP == 4
    xcd_barrier(bar, tid == 0); dbg_dump(a, (const bf16_t*)(a.ws + WS_PROJ), NPROJ, 2048, 1.f, 1000.f);
#elif DBG_DUMP == 2
    xcd_barrier(bar, tid == 0); dbg_dump(a, (const bf16_t*)(a.ws + WS_PROJ), NPROJ, 0, 1.f, 1.f);
#elif DBG_DUMP == 3
    xcd_barrier(bar, tid == 0); dbg_dump(a, (const bf16_t*)(a.ws + WS_PROJ), NPROJ, 1024, 1.f, 1000.f);
#elif DBG_DUMP == 1
    xcd_barrier(bar, tid == 0); dbg_dump(a, (const bf16_t*)(a.ws + WS_H), DM, 0, 1.f, 1000.f);
#endif
#undef IN
#undef SEAM
#undef tid
}

extern "C" void kernel_launch(void* const* d_in, const int* in_sizes, int n_in, void* d_out, int out_size, void* d_ws, size_t ws_size, hipStream_t stream) {
    static int grid = 0;
    if (grid == 0) {
        if (n_in != 25 || in_sizes[0] != T * DM || out_size != T * DM || ws_size < WS_END) {
            fprintf(stderr, "kernel_launch: unexpected problem (n_in %d, in0 %d, out %d, ws %zu < %zu)\n", n_in, n_in > 0 ? in_sizes[0] : -1, out_size, ws_size, (size_t)WS_END); grid = -1; return; }
        int dev = 0, cus = 0, per_cu = 0;
        (void)hipGetDevice(&dev);
        (void)hipDeviceGetAttribute(&cus, hipDeviceAttributeMultiprocessorCount, dev);
        if (hipFuncSetAttribute((const void*)mega, hipFuncAttributeMaxDynamicSharedMemorySize, LDS_BYTES) != hipSuccess) { fprintf(stderr, "kernel_launch: hipFuncSetAttribute failed\n"); grid = -1; return; }
        if (hipOccupancyMaxActiveBlocksPerMultiprocessor(&per_cu, (const void*)mega, 512, LDS_BYTES) != hipSuccess || per_cu < 1) { fprintf(stderr, "kernel_launch: occupancy query says %d blocks/CU\n", per_cu); grid = -1; return; }
        grid = cus;
    }
    if (grid < 0) return;
    (void)hipMemsetAsync((char*)d_ws + WS_BAR, 0, BAR_BYTES, stream);
    Args a{};
    for (int i = 0; i < 25; ++i) a.in[i] = (const float*)d_in[i];
    a.out = (float*)d_out; a.ws = (unsigned char*)d_ws;
#if DBG_SPLIT_AT >= 0
    { const int seq[2][2] = {{0, DBG_SPLIT_AT + 1}, {DBG_SPLIT_AT, NPH}};
      for (int i = 0; i < 2; ++i) { (void)hipMemsetAsync((char*)d_ws + WS_BAR, 0, BAR_BYTES, stream); a.ph_lo = seq[i][0]; a.ph_hi = seq[i][1]; void* args[] = {&a};
          hipError_t e = hipLaunchCooperativeKernel((const void*)mega, dim3(grid), dim3(512), args, LDS_BYTES, stream);
          if (e != hipSuccess) { fprintf(stderr, "launch %d failed: %s\n", i, hipGetErrorString(e)); break; } } }
#elif DBG_TWICE
    { const int seq[4][2] = {{0, 6}, {14, 15}, {DBG_REP_LO, 6}, {15, 16}};
      for (int i = 0; i < 4; ++i) { (void)hipMemsetAsync((char*)d_ws + WS_BAR, 0, BAR_BYTES, stream); a.ph_lo = seq[i][0]; a.ph_hi = seq[i][1]; void* args[] = {&a};
          hipError_t e = hipLaunchCooperativeKernel((const void*)mega, dim3(grid), dim3(512), args, LDS_BYTES, stream);
          if (e != hipSuccess) { fprintf(stderr, "launch %d failed: %s\n", i, hipGetErrorString(e)); break; } } }
#elif ONE_LAUNCH
    a.ph_lo = 0; a.ph_hi = DBG_LAST_PHASE;
    void* args[] = {&a};
    hipError_t e = hipLaunchCooperativeKernel((const void*)mega, dim3(grid), dim3(512), args, LDS_BYTES, stream);
    if (e != hipSuccess) fprintf(stderr, "cooperative launch failed: %s (grid %d)\n", hipGetErrorString(e), grid);
#else
    for (int ph = 0; ph < NPH; ++ph) { a.ph_lo = ph; a.ph_hi = ph + 1; void* args[] = {&a};
        hipError_t e = hipLaunchCooperativeKernel((const void*)mega, dim3(grid), dim3(512), args, LDS_BYTES, stream);
        if (e != hipSuccess) { fprintf(stderr, "launch %d failed: %s\n", ph, hipGetErrorString(e)); break; } }
#endif
}
```

```cpp
#include <hip/hip_runtime.h>
#include <cstdio>
#include <cstdint>

typedef unsigned short bf16_t;
typedef short bf16x8 __attribute__((ext_vector_type(8)));
typedef float f32x4 __attribute__((ext_vector_type(4)));
typedef unsigned u32x4 __attribute__((ext_vector_type(4)));
typedef unsigned u32x2 __attribute__((ext_vector_type(2)));


constexpr int T = 32768, DM = 1024, SEQ = 8192;
constexpr int NPROJ = 3584, DIN = 3592;
constexpr int TOPK = 8, TK = T * TOPK;
constexpr int SHARED_BASE = TK;
constexpr float EPS = 1e-6f;
constexpr float LOG2E = 1.4426950408889634f;
constexpr float C2 = 0.125f * LOG2E;
constexpr float LAM_INIT = 0.2f;
constexpr int NPH = 14;
constexpr int LDS_BYTES = 155648;

constexpr size_t MiB = 1ull << 20;
constexpr size_t WS_MOD = 0;
constexpr size_t WS_TILE = 128 * 1024;
constexpr size_t WS_HIST = 256 * 1024;
constexpr size_t WS_BAR = 512 * 1024;
constexpr size_t BAR_BYTES = 16384;
constexpr size_t WS_IPRE = 1 * MiB, WS_FPRE = 1 * MiB + 512 * 1024;
constexpr size_t WS_IDX = 2 * MiB, WS_GATEV = 3 * MiB, WS_PSLOT = 4 * MiB, WS_SLOTTOK = 5 * MiB, WS_SLOTGATE = 7 * MiB;
constexpr size_t WS_MST = 9 * MiB;
constexpr size_t WS_WIN = 12 * MiB, WS_WOUT = 19 * MiB, WS_WRS = 21 * MiB, WS_W2T = 23 * MiB;
constexpr size_t WS_H = 152 * MiB, WS_ACT = 216 * MiB, WS_MIX = 361 * MiB, WS_PROJ = 425 * MiB, WS_CLOC = 649 * MiB, WS_CIN = 713 * MiB, WS_W13T = 745 * MiB, WS_END = 1001 * MiB;
constexpr size_t WS_H8 = 89 * MiB;
constexpr size_t WS_YP = WS_MIX;
constexpr size_t WS_LOGITS = WS_CLOC;
constexpr size_t WS_TMP = WS_ACT;

struct Args { const float* in[25]; float* out; unsigned char* ws; int ph_lo, ph_hi; };

__device__ __forceinline__ int mk_tid(int wave_s) { int l; asm volatile("v_mbcnt_lo_u32_b32 %0, -1, 0\n\tv_mbcnt_hi_u32_b32 %0, -1, %0" : "=v"(l)); return (wave_s << 6) | l; }

__device__ __forceinline__ float bflo(unsigned v) { return __uint_as_float(v << 16); }
__device__ __forceinline__ float bfhi(unsigned v) { return __uint_as_float(v & 0xffff0000u); }
__device__ __forceinline__ unsigned f2bf(float f) { unsigned u = __float_as_uint(f); return (u + 0x7fffu + ((u >> 16) & 1u)) >> 16; }
__device__ __forceinline__ unsigned pk2(float lo, float hi) { return f2bf(lo) | (f2bf(hi) << 16); }
__device__ __forceinline__ float wave_sum(float v) {
    v += __builtin_bit_cast(float, __builtin_amdgcn_update_dpp(0, __builtin_bit_cast(int, v), 0x111, 0xf, 0xf, false));
    v += __builtin_bit_cast(float, __builtin_amdgcn_update_dpp(0, __builtin_bit_cast(int, v), 0x112, 0xf, 0xf, false));
    v += __builtin_bit_cast(float, __builtin_amdgcn_update_dpp(0, __builtin_bit_cast(int, v), 0x114, 0xf, 0xf, false));
    v += __builtin_bit_cast(float, __builtin_amdgcn_update_dpp(0, __builtin_bit_cast(int, v), 0x118, 0xf, 0xf, false));
    v += __builtin_bit_cast(float, __builtin_amdgcn_update_dpp(0, __builtin_bit_cast(int, v), 0x142, 0xa, 0xf, false));
    v += __builtin_bit_cast(float, __builtin_amdgcn_update_dpp(0, __builtin_bit_cast(int, v), 0x143, 0xc, 0xf, false));
    return __builtin_bit_cast(float, __builtin_amdgcn_readlane(__builtin_bit_cast(int, v), 63));
}
__device__ __forceinline__ float siluf(float x) { return x / (1.f + __expf(-x)); }
__device__ __forceinline__ float sigm(float x) { return 1.f / (1.f + __expf(-x)); }
__device__ __forceinline__ void unpack8(const u32x4 v, float (&x)[8]) {
    x[0] = bflo(v.x); x[1] = bfhi(v.x); x[2] = bflo(v.y); x[3] = bfhi(v.y); x[4] = bflo(v.z); x[5] = bfhi(v.z); x[6] = bflo(v.w); x[7] = bfhi(v.w);
}
__device__ __forceinline__ unsigned pk4_fp8(float a, float b, float c, float d) { int p = __builtin_amdgcn_cvt_pk_fp8_f32(a, b, 0, false); p = __builtin_amdgcn_cvt_pk_fp8_f32(c, d, p, true); return (unsigned)p; }
__device__ __forceinline__ u32x4 pack8(const float (&x)[8]) { u32x4 o; o.x = pk2(x[0], x[1]); o.y = pk2(x[2], x[3]); o.z = pk2(x[4], x[5]); o.w = pk2(x[6], x[7]); return o; }

__device__ __forceinline__ void conv_item(const float* __restrict__ s0, const float* __restrict__ s1, int ldn, int k0, int n0, bool inter,
                                          bf16_t* dst, int ldk, int c0, float* scr, int lane) {
    const float* p = (inter && lane >= 32) ? (s1 + n0 + (lane - 32)) : (s0 + n0 + lane);
    p += (size_t)k0 * ldn;
#pragma unroll 8
    for (int i = 0; i < 64; ++i) scr[i * 65 + lane] = p[(size_t)i * ldn];
    const int c = lane & 7;
#pragma unroll
    for (int j = 0; j < 8; ++j) {
        const int n = (lane >> 3) + 8 * j;
        const float* s = scr + (8 * c) * 65 + n;
        u32x4 o; o.x = pk2(s[0], s[65]); o.y = pk2(s[130], s[195]); o.z = pk2(s[260], s[325]); o.w = pk2(s[390], s[455]);
        const int drow = inter ? (c0 + ((n & 31) >> 2) * 8 + (n >> 5) * 4 + (n & 3)) : (c0 + n);
        *(u32x4*)(dst + (size_t)drow * ldk + k0 + 8 * c) = o;
    }
}


__device__ __forceinline__ void conv_item8(const float* __restrict__ s0, const float* __restrict__ s1, int ldn, int k0, int n0, bool inter,
                                           unsigned char* dst, int ldk, int c0, float* scr, int lane, float scale) {
    const float* p = (inter && lane >= 32) ? (s1 + n0 + (lane - 32)) : (s0 + n0 + lane);
    p += (size_t)k0 * ldn;
#pragma unroll 8
    for (int i = 0; i < 64; ++i) scr[i * 65 + lane] = p[(size_t)i * ldn] * scale;
    const int c = lane & 7;
#pragma unroll
    for (int j = 0; j < 8; ++j) {
        const int n = (lane >> 3) + 8 * j;
        const float* s = scr + (8 * c) * 65 + n;
        u32x2 o; o.x = pk4_fp8(s[0], s[65], s[130], s[195]); o.y = pk4_fp8(s[260], s[325], s[390], s[455]);
        const int drow = inter ? (c0 + ((n & 31) >> 2) * 8 + (n >> 5) * 4 + (n & 3)) : (c0 + n);
        *(u32x2*)(dst + (size_t)drow * ldk + k0 + 8 * c) = o;
    }
}

__device__ __forceinline__ void ph0(const Args& a, unsigned char* lds, const int tid) {
    const int lane = tid & 63, wave = tid >> 6;
    const float* c_in = a.in[1]; const float* w_ada = a.in[2]; const float* b_ada = a.in[3];
    float* MOD = (float*)(a.ws + WS_MOD);
    {
        float* sc = (float*)lds; float* red = sc + 4096;
        for (int i = tid; i < 4096; i += 512) sc[i] = siluf(c_in[i]);
        __syncthreads();
        for (int it = blockIdx.x; it < 192; it += gridDim.x) {
            const int cc = tid & 31, ks = tid >> 5, col = it * 32 + cc;
            float a0 = 0.f, a1 = 0.f, a2 = 0.f, a3 = 0.f;
            const float* wp = w_ada + (size_t)(ks * 64) * 6144 + col;
            float wv[64];
#pragma unroll
            for (int k = 0; k < 64; ++k) wv[k] = wp[(size_t)k * 6144];
#pragma unroll
            for (int k = 0; k < 64; ++k) { const float w = wv[k]; const int kk = ks * 64 + k;
                a0 += sc[kk] * w; a1 += sc[1024 + kk] * w; a2 += sc[2048 + kk] * w; a3 += sc[3072 + kk] * w; }
            float* rp = red + (ks * 32 + cc) * 4; rp[0] = a0; rp[1] = a1; rp[2] = a2; rp[3] = a3;
            __syncthreads();
            if (tid < 128) { const int c2 = tid & 31, b = tid >> 5; float s = 0.f;
                for (int k2 = 0; k2 < 16; ++k2) s += red[(k2 * 32 + c2) * 4 + b];
                MOD[b * 6144 + it * 32 + c2] = s + b_ada[it * 32 + c2]; }
            __syncthreads();
        }
    }
    __syncthreads();
    float* scr = (float*)lds + wave * (64 * 65);
    const int gw = blockIdx.x * 8 + wave, NGW = gridDim.x * 8;
    const float* w_in = a.in[4]; const float* w_out = a.in[16]; const float* w_router = a.in[17];
    const float* w1 = a.in[19]; const float* w3 = a.in[20]; const float* w2 = a.in[21];
    const float* ws1 = a.in[22]; const float* ws3 = a.in[23]; const float* ws2 = a.in[24];
    bf16_t* WIN = (bf16_t*)(a.ws + WS_WIN); bf16_t* WOUT = (bf16_t*)(a.ws + WS_WOUT); bf16_t* WRS = (bf16_t*)(a.ws + WS_WRS);
    unsigned char* W2T8 = (unsigned char*)(a.ws + WS_W2T); unsigned char* W13T8 = (unsigned char*)(a.ws + WS_W13T);
    constexpr int IT_WIN = 56 * 16, IT_WOUT = 16 * 16, IT_WR = 4 * 16, IT_WS13 = 8 * 16, IT_WS2 = 4 * 16, IT_E13 = 256 * 128, IT_E2 = 256 * 64;
    constexpr int NITEMS = IT_WIN + IT_WOUT + IT_WR + IT_WS13 + IT_WS2 + IT_E13 + IT_E2;
    for (int it = gw; it < NITEMS; it += NGW) {
        int r = it;
        if (r < IT_WIN) { const int kb = r / 56, cb = r % 56, c0 = 64 * cb, n0 = c0 + (c0 >= 2048 ? 8 : 0);
            conv_item8(w_in, w_in, DIN, 64 * kb, n0, false, (unsigned char*)WIN, 1024, c0, scr, lane, 64.f); continue; } r -= IT_WIN;
        if (r < IT_WOUT) { const int kb = r / 16, cb = r % 16; conv_item(w_out, w_out, 1024, 64 * kb, 64 * cb, false, WOUT, 1024, 64 * cb, scr, lane); continue; } r -= IT_WOUT;
        if (r < IT_WR) { const int kb = r / 4, cb = r % 4; conv_item(w_router, w_router, 256, 64 * kb, 64 * cb, false, WRS, 1024, 64 * cb, scr, lane); continue; } r -= IT_WR;
        if (r < IT_WS13) { const int kb = r / 8, cb = r % 8; conv_item(ws1, ws3, 256, 64 * kb, 32 * cb, true, WRS + (size_t)256 * 1024, 1024, 64 * cb, scr, lane); continue; } r -= IT_WS13;
        if (r < IT_WS2) { const int kb = r / 16, cb = r % 16; conv_item8(ws2, ws2, 1024, 64 * kb, 64 * cb, false, W2T8 + (size_t)256 * 1024 * 256, 256, 64 * cb, scr, lane, 32.f); continue; } r -= IT_WS2;
        if (r < IT_E13) { const int e = r >> 7, rr = r & 127, kb = rr >> 3, cb = rr & 7;
            conv_item8(w1 + (size_t)e * 1024 * 256, w3 + (size_t)e * 1024 * 256, 256, 64 * kb, 32 * cb, true, W13T8 + (size_t)e * 512 * 1024, 1024, 64 * cb, scr, lane, 64.f); continue; } r -= IT_E13;
        { const int e = r >> 6, rr = r & 63, kb = rr >> 4, cb = rr & 15;
            conv_item8(w2 + (size_t)e * 256 * 1024, w2, 1024, 64 * kb, 64 * cb, false, W2T8 + (size_t)e * 1024 * 256, 256, 64 * cb, scr, lane, 32.f); }
    }
}

template <bool GATES>
__device__ __forceinline__ void ph_norm(const Args& a, unsigned char* lds, const float* X, int mod_shift, int mod_scale, const int tid) {
    const int lane = tid & 63, wave = tid >> 6;
    const float* MOD = (const float*)(a.ws + WS_MOD);
    bf16_t* H = (bf16_t*)(a.ws + WS_H);
    float* wg = (float*)lds;
    if (GATES) {
        const float* w_in = a.in[4];
        for (int i = tid; i < 8192; i += 512) { const int k = i >> 3, g = i & 7; wg[g * 1024 + k] = w_in[(size_t)k * DIN + 2048 + g]; }
        __syncthreads();
    }
    const float* gate_b = a.in[7];
    float* IPRE = (float*)(a.ws + WS_IPRE); float* FPRE = (float*)(a.ws + WS_FPRE);
    const int gw = blockIdx.x * 8 + wave, NGW = gridDim.x * 8;
    for (int row = gw; row < T; row += NGW) {
        const int b = row / SEQ;
        const f32x4* xr = (const f32x4*)(X + (size_t)row * DM) + lane;
        f32x4 v[4]; float ss = 0.f;
#pragma unroll
        for (int j = 0; j < 4; ++j) { v[j] = xr[64 * j]; ss += (v[j].x * v[j].x + v[j].y * v[j].y) + (v[j].z * v[j].z + v[j].w * v[j].w); }
        const float rstd = rsqrtf(wave_sum(ss) * (1.f / DM) + EPS);
        const f32x4* sh = (const f32x4*)(MOD + b * 6144 + mod_shift * 1024) + lane;
        const f32x4* sc = (const f32x4*)(MOD + b * 6144 + mod_scale * 1024) + lane;
        u32x2* o8 = (u32x2*)(H + (size_t)row * DM) + lane;
#pragma unroll
        for (int j = 0; j < 4; ++j) { const f32x4 s4 = sc[64 * j], h4 = sh[64 * j];
            v[j].x = v[j].x * rstd * (1.f + s4.x) + h4.x; v[j].y = v[j].y * rstd * (1.f + s4.y) + h4.y;
            v[j].z = v[j].z * rstd * (1.f + s4.z) + h4.z; v[j].w = v[j].w * rstd * (1.f + s4.w) + h4.w;
            if (!GATES) { u32x2 p; p.x = pk2(v[j].x, v[j].y); p.y = pk2(v[j].z, v[j].w); o8[64 * j] = p; }
            *((unsigned*)(a.ws + WS_H8 + (size_t)row * DM) + lane + 64 * j) = pk4_fp8(v[j].x, v[j].y, v[j].z, v[j].w); }
        if (GATES) {
            float g[8];
#pragma unroll
            for (int q = 0; q < 8; ++q) { float s = 0.f;
#pragma unroll
                for (int j = 0; j < 4; ++j) { const f32x4 w4 = *((const f32x4*)(wg + q * 1024) + lane + 64 * j);
                    s += (v[j].x * w4.x + v[j].y * w4.y) + (v[j].z * w4.z + v[j].w * w4.w); }
                g[q] = wave_sum(s); }
            if (lane == 0) {
#pragma unroll
                for (int q = 0; q < 4; ++q) { IPRE[(size_t)row * 4 + q] = g[q] + gate_b[q]; FPRE[(size_t)row * 4 + q] = g[4 + q] + gate_b[4 + q]; }
            }
        }
    }
}


namespace pg8 {
#define PG8_LAS __attribute__((address_space(3)))
typedef int i32x4 __attribute__((ext_vector_type(4)));
typedef int i32x8 __attribute__((ext_vector_type(8)));
constexpr int BM = 256, BK = 64, HALF = 128, HTB = HALF * BK * 2;
__device__ __forceinline__ int lds_byte(int r, int c) { const int st = (r >> 4) * 2 + (c >> 5), rr = r & 15, cc = c & 31, ob = rr * 64 + cc * 2; return st * 1024 + (ob ^ (((ob >> 9) & 1) << 5)); }
__device__ __forceinline__ void stage_rc(int b, int& R, int& C) { const int st = b / 1024, sb = b % 1024, swz = sb ^ (((sb >> 9) & 1) << 5); R = (st >> 1) * 16 + swz / 64; C = (st & 1) * 32 + (swz % 64) / 2; }
__device__ __forceinline__ int perm32(int rho) { const int n = rho >> 4, i = rho & 15; return 8 * (i >> 2) + 4 * n + (i & 3); }
struct Unit { const char* A; const char* B; const int* gather; int row0, rend, col0; };

template <bool P16, class RowEpi>
__device__ __forceinline__ void run_epi(const RowEpi& E, const f32x4 (&acc)[2][2][4][2], const Unit& u, int wr, int wc, int fr, int fq) {
#pragma unroll
    for (int ai = 0; ai < 2; ++ai)
#pragma unroll
        for (int m = 0; m < 4; ++m) { const int row = u.row0 + ai * HALF + wr * 64 + m * 16 + fr; const bool valid = row < u.rend;
            if constexpr (P16) { const float v16[16] = {acc[ai][0][m][0][0], acc[ai][0][m][0][1], acc[ai][0][m][0][2], acc[ai][0][m][0][3], acc[ai][0][m][1][0], acc[ai][0][m][1][1], acc[ai][0][m][1][2], acc[ai][0][m][1][3],
                                                 acc[ai][1][m][0][0], acc[ai][1][m][0][1], acc[ai][1][m][0][2], acc[ai][1][m][0][3], acc[ai][1][m][1][0], acc[ai][1][m][1][1], acc[ai][1][m][1][2], acc[ai][1][m][1][3]};
                E.row16(row, valid, u.col0 + 64 * wc + 16 * fq, v16); } else
#pragma unroll
            for (int bj = 0; bj < 2; ++bj) { const int col0 = u.col0 + bj * HALF + wc * 32 + 8 * fq;
                const float v[8] = {acc[ai][bj][m][0][0], acc[ai][bj][m][0][1], acc[ai][bj][m][0][2], acc[ai][bj][m][0][3], acc[ai][bj][m][1][0], acc[ai][bj][m][1][1], acc[ai][bj][m][1][2], acc[ai][bj][m][1][3]};
                E(row, valid, col0, v); } }
}

template <bool GATHER, bool FP8, int SCW, int SCX, bool P16, class RowEpi, class Sched>
__device__ __forceinline__ void gemm_phase(PG8_LAS unsigned char* lds, const int KB, const Sched& S, const RowEpi& E) {
    const int tid = threadIdx.x, wid = __builtin_amdgcn_readfirstlane(tid >> 6), lane = tid & 63, wr = wid >> 2, wc = wid & 3, fr = lane & 15, fq = lane >> 4;
    const int nt = KB / 128;
    int scw_ = SCW, scx_ = SCX; asm volatile("" : "+v"(scw_), "+v"(scx_));
    int Rr[2], Cc[2]; unsigned voffB[2][2];
#pragma unroll
    for (int i = 0; i < 2; ++i) { stage_rc(tid * 16 + i * 8192, Rr[i], Cc[i]);
#pragma unroll
        for (int h = 0; h < 2; ++h) { const int R = Rr[i];
            const int cperm = P16 ? 64 * (R >> 5) + 16 * ((R >> 2) & 3) + 8 * h + 4 * ((R >> 4) & 1) + (R & 3) : h * HALF + (R & ~31) + perm32(R & 31);
            voffB[h][i] = (unsigned)(cperm * KB + Cc[i] * 2); } }
    const size_t kstep = (size_t)(BK * 2);
    const unsigned ldsw = (unsigned)wid * 1024u;
    const int aoff = lds_byte(wr * 64 + fr, fq * 8), boff = lds_byte(wc * 32 + fr, fq * 8);
#define PG8_SA(b, h) (((b) * 2 + (h)) * HTB)
#define PG8_SB(b, h) ((4 + (b) * 2 + (h)) * HTB)
#define PG8_STAGE(bufoff, gbase, voff) do { _Pragma("unroll") for (int _i = 0; _i < 2; ++_i) \
        __builtin_amdgcn_global_load_lds((const unsigned*)((const char*)(gbase) + (voff)[_i]), (PG8_LAS unsigned*)(lds + (bufoff) + ldsw + _i * 8192), 16, 0, 0); } while (0)
#define PG8_LD8(dst, addr) do { const i32x4 lo_ = *(const PG8_LAS i32x4*)(addr), hi_ = *(const PG8_LAS i32x4*)((addr) + 1024); dst = __builtin_shufflevector(lo_, hi_, 0, 1, 2, 3, 4, 5, 6, 7); } while (0)
#define PG8_LDA(dst, b, h) do { _Pragma("unroll") for (int m = 0; m < 4; ++m) PG8_LD8(dst[m], lds + PG8_SA(b, h) + aoff + m * 2048); } while (0)
#define PG8_LDB(dst, b, h) do { _Pragma("unroll") for (int n = 0; n < 2; ++n) PG8_LD8(dst[n], lds + PG8_SB(b, h) + boff + n * 2048); } while (0)
#define PG8_HALF(v, k) __builtin_bit_cast(bf16x8, (k) ? __builtin_shufflevector(v, v, 4, 5, 6, 7) : __builtin_shufflevector(v, v, 0, 1, 2, 3))
#define PG8_MMA(ai, bj, At, Bt) do { __builtin_amdgcn_s_setprio(1); _Pragma("unroll") for (int m = 0; m < 4; ++m) _Pragma("unroll") for (int n = 0; n < 2; ++n) { \
        if (FP8) asm volatile("v_mfma_scale_f32_16x16x128_f8f6f4 %0, %1, %2, %0, %3, %4 op_sel_hi:[0,0,0]" : "+v"(acc[ai][bj][m][n]) : "v"(Bt[n]), "v"(At[m]), "v"(scw_), "v"(scx_)); \
        else { _Pragma("unroll") for (int k = 0; k < 2; ++k) acc[ai][bj][m][n] = __builtin_amdgcn_mfma_f32_16x16x32_bf16(PG8_HALF(Bt[n], k), PG8_HALF(At[m], k), acc[ai][bj][m][n], 0, 0, 0); } } \
        __builtin_amdgcn_s_setprio(0); } while (0)
#define PG8_WAIT_V(n) asm volatile("s_waitcnt vmcnt(" #n ")" ::: "memory")
#define PG8_WAIT_L(n) asm volatile("s_waitcnt lgkmcnt(" #n ")" ::: "memory")
#define PG8_BAR __builtin_amdgcn_s_barrier()
#define PG8_SCHED __builtin_amdgcn_sched_barrier(0)
#define PG8_FILLA(u, v) do { _Pragma("unroll") for (int _h = 0; _h < 2; ++_h) _Pragma("unroll") for (int _i = 0; _i < 2; ++_i) { const int _row = _h * HALF + Rr[_i]; \
        if (GATHER) { const int _ri = (u).row0 + _row; const int _src = (u).gather[_ri < (u).rend ? _ri : (u).row0]; (v)[_h][_i] = (unsigned)(_src * KB + Cc[_i] * 2); } \
        else (v)[_h][_i] = (unsigned)(_row * KB + Cc[_i] * 2); } } while (0)
    Unit cur, nxt; int ui = 0;
    if (!S.next(0, cur)) return;
    f32x4 acc[2][2][4][2];
#pragma unroll
    for (int a = 0; a < 2; ++a)
#pragma unroll
        for (int b = 0; b < 2; ++b)
#pragma unroll
            for (int m = 0; m < 4; ++m)
#pragma unroll
                for (int n = 0; n < 2; ++n) acc[a][b][m][n] = (f32x4){0.f, 0.f, 0.f, 0.f};
    i32x8 At[4], B0[2], B1[2];
    unsigned voffA[2][2], nvoffA[2][2];
    PG8_FILLA(cur, voffA);
    const char* cA = cur.A; const char* cB = cur.B;
    PG8_STAGE(PG8_SB(0, 0), cB, voffB[0]); PG8_STAGE(PG8_SB(0, 1), cB, voffB[1]); PG8_STAGE(PG8_SA(0, 0), cA, voffA[0]); PG8_STAGE(PG8_SA(0, 1), cA, voffA[1]);
    if (wr == 1) PG8_BAR;
    PG8_WAIT_V(2); PG8_BAR;
    PG8_STAGE(PG8_SB(1, 0), cB + kstep, voffB[0]); PG8_STAGE(PG8_SA(1, 0), cA + kstep, voffA[0]); PG8_STAGE(PG8_SB(1, 1), cB + kstep, voffB[1]);
    PG8_WAIT_V(6); PG8_BAR;
    for (;;) {
        const bool has_next = S.next(ui + 1, nxt);
        const char* nA = has_next ? nxt.A : cA; const char* nB = has_next ? nxt.B : cB;
        if (GATHER && has_next) { PG8_FILLA(nxt, nvoffA); }
        else {
#pragma unroll
            for (int h = 0; h < 2; ++h)
#pragma unroll
                for (int i = 0; i < 2; ++i) nvoffA[h][i] = voffA[h][i]; }
        for (int t = 0; t < nt; t += 2) {
            const bool last = (t == nt - 2);
            const char* a1 = cA + (size_t)(t + 1) * kstep;
            const char* a2 = last ? nA : cA + (size_t)(t + 2) * kstep; const char* b2 = last ? nB : cB + (size_t)(t + 2) * kstep;
            const char* a3 = a2 + kstep; const char* b3 = b2 + kstep;
            unsigned v2[2][2];
#pragma unroll
            for (int h = 0; h < 2; ++h)
#pragma unroll
                for (int i = 0; i < 2; ++i) v2[h][i] = last ? nvoffA[h][i] : voffA[h][i];
            PG8_LDB(B0, 0, 0); PG8_LDB(B1, 0, 1); PG8_SCHED; PG8_LDA(At, 0, 0); PG8_STAGE(PG8_SA(1, 1), a1, voffA[1]);
            PG8_WAIT_V(8); PG8_WAIT_L(0); PG8_BAR; PG8_MMA(0, 0, At, B0); PG8_MMA(0, 1, At, B1); PG8_BAR; PG8_SCHED;
            PG8_LDA(At, 0, 1); PG8_STAGE(PG8_SB(0, 0), b2, voffB[0]); PG8_STAGE(PG8_SB(0, 1), b2, voffB[1]); PG8_STAGE(PG8_SA(0, 0), a2, v2[0]);
            PG8_WAIT_V(8); PG8_WAIT_L(0); PG8_BAR; PG8_MMA(1, 0, At, B0); PG8_MMA(1, 1, At, B1); PG8_BAR; PG8_SCHED;
            PG8_LDB(B0, 1, 0); PG8_LDB(B1, 1, 1); PG8_SCHED; PG8_LDA(At, 1, 0); PG8_STAGE(PG8_SA(0, 1), a2, v2[1]);
            PG8_WAIT_V(8); PG8_WAIT_L(0); PG8_BAR; PG8_MMA(0, 0, At, B0); PG8_MMA(0, 1, At, B1); PG8_BAR; PG8_SCHED;
            PG8_LDA(At, 1, 1); PG8_STAGE(PG8_SB(1, 0), b3, voffB[0]); PG8_STAGE(PG8_SB(1, 1), b3, voffB[1]); PG8_STAGE(PG8_SA(1, 0), a3, v2[0]);
            PG8_WAIT_V(8); PG8_WAIT_L(0); PG8_BAR; PG8_MMA(1, 0, At, B0); PG8_MMA(1, 1, At, B1); PG8_BAR; PG8_SCHED;
        }
        if (wr == 0) PG8_BAR;
        if (FP8) { PG8_SCHED; asm volatile("s_nop 15\n\ts_nop 7" ::: "memory"); PG8_SCHED; }
        run_epi<P16>(E, acc, cur, wr, wc, fr, fq);
        if (!has_next) break;
#pragma unroll
        for (int a = 0; a < 2; ++a)
#pragma unroll
            for (int b = 0; b < 2; ++b)
#pragma unroll
                for (int m = 0; m < 4; ++m)
#pragma unroll
                    for (int n = 0; n < 2; ++n) acc[a][b][m][n] = (f32x4){0.f, 0.f, 0.f, 0.f};
        cur = nxt; cA = nA; cB = nB; ++ui;
#pragma unroll
        for (int h = 0; h < 2; ++h)
#pragma unroll
            for (int i = 0; i < 2; ++i) voffA[h][i] = nvoffA[h][i];
        if (wr == 1) PG8_BAR;
    }
    PG8_WAIT_V(0);
    PG8_BAR;
#undef PG8_SA
#undef PG8_SB
#undef PG8_STAGE
#undef PG8_LDA
#undef PG8_LD8
#undef PG8_HALF
#undef PG8_LDB
#undef PG8_MMA
#undef PG8_WAIT_V
#undef PG8_WAIT_L
#undef PG8_BAR
#undef PG8_SCHED
#undef PG8_FILLA
}

struct DenseSched {
    const char* A; const char* Bt; int KB, M, nM, nN, nwg, G, c;
    __device__ __forceinline__ void init(const void* A_, const void* Bt_, int M_, int N_, int KB_, int G_, int c_) { A = (const char*)A_; Bt = (const char*)Bt_; KB = KB_; M = M_; nM = M_ / BM; nN = N_ / BM; nwg = nM * nN; G = G_; c = c_; }
    __device__ __forceinline__ bool next(int i, Unit& u) const {
        const long L = (long)i * G + c; if (L >= nwg) return false;
        int wgid = (int)L; { const int q = nwg / 8, r = nwg % 8, xcd = wgid % 8, off = wgid / 8; wgid = (xcd < r ? xcd * (q + 1) : r * (q + 1) + (xcd - r) * q) + off; }
        const int nig = 8 * nN, gid = wgid / nig, fm = gid * 8, gsz = (nM - fm) < 8 ? (nM - fm) : 8;
        const int pm = fm + ((wgid % nig) % gsz), pn = (wgid % nig) / gsz;
        u.A = A + (size_t)pm * BM * KB; u.B = Bt + (size_t)pn * BM * KB; u.gather = nullptr; u.row0 = pm * BM; u.rend = M; u.col0 = pn * BM; return true;
    }
};
struct ExpertSched {
    const int* TILE; int nunits, NPN; const char* A; const int* gather; const char* Bt; size_t bstride; int KB, G, vcu;
    __device__ __forceinline__ bool next(int i, Unit& u) const {
        const int L = i * G + vcu; if (L >= nunits) return false;
        const int tl = L / NPN, pn = L % NPN;
        const int e = __builtin_amdgcn_readfirstlane(TILE[64 + tl]), r0 = __builtin_amdgcn_readfirstlane(TILE[64 + 2048 + tl]), re = __builtin_amdgcn_readfirstlane(TILE[64 + 4096 + tl]);
        u.B = Bt + (size_t)e * bstride + (size_t)pn * BM * KB; u.row0 = r0; u.rend = re; u.col0 = pn * BM;
        if (gather) { u.A = A; u.gather = gather; } else { u.A = A + (size_t)r0 * KB; u.gather = nullptr; }
        return true;
    }
};
}

struct EpiProj { bf16_t* P;
    __device__ __forceinline__ void operator()(int row, bool valid, int col0, const float (&v)[8]) const { if (valid) *(u32x4*)(P + (size_t)row * NPROJ + col0) = pack8(v); } };
struct EpiOut { const float* x; float* x1; const float* MOD;
    __device__ __forceinline__ void operator()(int row, bool valid, int col0, const float (&v)[8]) const {
        if (!valid) return; const int b = row / SEQ; const float* ga = MOD + b * 6144 + 2 * 1024 + col0;
        const f32x4 x0 = *(const f32x4*)(x + (size_t)row * DM + col0), x1v = *(const f32x4*)(x + (size_t)row * DM + col0 + 4);
        f32x4 o0, o1; o0.x = x0.x + ga[0] * v[0]; o0.y = x0.y + ga[1] * v[1]; o0.z = x0.z + ga[2] * v[2]; o0.w = x0.w + ga[3] * v[3];
        o1.x = x1v.x + ga[4] * v[4]; o1.y = x1v.y + ga[5] * v[5]; o1.z = x1v.z + ga[6] * v[6]; o1.w = x1v.w + ga[7] * v[7];
        *(f32x4*)(x1 + (size_t)row * DM + col0) = o0; *(f32x4*)(x1 + (size_t)row * DM + col0 + 4) = o1; } };
struct EpiRS { float* LOG; bf16_t* ACT;
    __device__ __forceinline__ void operator()(int row, bool valid, int col0, const float (&v)[8]) const {
        if (!valid) return;
        if (col0 < 256) { *(f32x4*)(LOG + (size_t)row * 256 + col0) = (f32x4){v[0], v[1], v[2], v[3]}; *(f32x4*)(LOG + (size_t)row * 256 + col0 + 4) = (f32x4){v[4], v[5], v[6], v[7]}; }
        else { const int j0 = (col0 - 256) >> 1;
            *(unsigned*)((unsigned char*)ACT + (size_t)(SHARED_BASE + row) * 256 + j0) = pk4_fp8(8.f * siluf(v[0]) * v[4], 8.f * siluf(v[1]) * v[5], 8.f * siluf(v[2]) * v[6], 8.f * siluf(v[3]) * v[7]); } } };
struct EpiG1 { const float* SG; bf16_t* ACT;
    __device__ __forceinline__ void operator()(int row, bool valid, int col0, const float (&v)[8]) const {
        if (!valid) return; const float g = 8.f * SG[row]; const int j0 = col0 >> 1;
        *(unsigned*)((unsigned char*)ACT + (size_t)row * 256 + j0) = pk4_fp8(siluf(v[0]) * v[4] * g, siluf(v[1]) * v[5] * g, siluf(v[2]) * v[6] * g, siluf(v[3]) * v[7] * g); } };
struct EpiG2 { bf16_t* YP;
    __device__ __forceinline__ void operator()(int row, bool valid, int col0, const float (&v)[8]) const { if (valid) { u32x2 p; p.x = pk4_fp8(16.f * v[0], 16.f * v[1], 16.f * v[2], 16.f * v[3]); p.y = pk4_fp8(16.f * v[4], 16.f * v[5], 16.f * v[6], 16.f * v[7]);
            *(u32x2*)((unsigned char*)YP + (size_t)row * DM + col0) = p; } }
    __device__ __forceinline__ void row16(int row, bool valid, int col0, const float (&v)[16]) const { if (valid) { u32x4 p;
            p.x = pk4_fp8(16.f * v[0], 16.f * v[1], 16.f * v[2], 16.f * v[3]); p.y = pk4_fp8(16.f * v[4], 16.f * v[5], 16.f * v[6], 16.f * v[7]);
            p.z = pk4_fp8(16.f * v[8], 16.f * v[9], 16.f * v[10], 16.f * v[11]); p.w = pk4_fp8(16.f * v[12], 16.f * v[13], 16.f * v[14], 16.f * v[15]);
            *(u32x4*)((unsigned char*)YP + (size_t)row * DM + col0) = p; } } };

constexpr int LR = 136;
__device__ __forceinline__ f32x4 mfma16(bf16x8 a, bf16x8 b, f32x4 c) {
    asm volatile("s_nop 1\n\tv_mfma_f32_16x16x32_bf16 %0, %1, %2, %0" : "+v"(c) : "v"(a), "v"(b)); return c; }
#define MFMA_DRAIN8(x) asm volatile("s_nop 15\n\ts_nop 3" : "+v"(x[0]), "+v"(x[1]), "+v"(x[2]), "+v"(x[3]), "+v"(x[4]), "+v"(x[5]), "+v"(x[6]), "+v"(x[7]))
__device__ __forceinline__ bf16x8 ldfrag(const bf16_t* base, int row, int k0, int lane) { return *(const bf16x8*)(base + (row + (lane & 15)) * LR + k0 + 8 * (lane >> 4)); }


__device__ __forceinline__ void conv8_lds(const bf16_t* R, int pitch, int s, int col, const float* cw, int wpitch, const float* cb, int ch, float (&o)[8]) {
    float acc[8];
    { const f32x4 b0 = *(const f32x4*)(cb + ch), b1 = *(const f32x4*)(cb + ch + 4); acc[0] = b0.x; acc[1] = b0.y; acc[2] = b0.z; acc[3] = b0.w; acc[4] = b1.x; acc[5] = b1.y; acc[6] = b1.z; acc[7] = b1.w; }
#pragma unroll
    for (int j = 0; j < 4; ++j) { float x[8]; unpack8(*(const u32x4*)(R + (s + j) * pitch + col), x);
        const f32x4 w0 = *(const f32x4*)(cw + j * wpitch + ch), w1 = *(const f32x4*)(cw + j * wpitch + ch + 4);
        acc[0] += w0.x * x[0]; acc[1] += w0.y * x[1]; acc[2] += w0.z * x[2]; acc[3] += w0.w * x[3];
        acc[4] += w1.x * x[4]; acc[5] += w1.y * x[5]; acc[6] += w1.z * x[6]; acc[7] += w1.w * x[7]; }
#pragma unroll
    for (int q = 0; q < 8; ++q) o[q] = siluf(acc[q]);
}
__device__ __forceinline__ void chunk_gates(const Args& a, float* bb, float* ii, float* tmp, int t0, int h, int tid) {
    const float* IPRE = (const float*)(a.ws + WS_IPRE); const float* FPRE = (const float*)(a.ws + WS_FPRE);
    if (tid < 128) { const float f = FPRE[(size_t)(t0 + tid) * 4 + h]; ii[tid] = IPRE[(size_t)(t0 + tid) * 4 + h];
        tmp[tid] = fminf(f, 0.f) - log1pf(expf(-fabsf(f))); }
    __syncthreads();
    if (tid < 128) { float s = 0.f;
#pragma unroll 4
        for (int j4 = 0; j4 < 32; ++j4) { const f32x4 v = *(const f32x4*)(tmp + 4 * j4); const int j = 4 * j4;
            s += (j <= tid ? v.x : 0.f); s += (j + 1 <= tid ? v.y : 0.f); s += (j + 2 <= tid ? v.z : 0.f); s += (j + 3 <= tid ? v.w : 0.f); }
        bb[tid] = s; }
    __syncthreads();
}

__device__ __forceinline__ void mlstm_m1_unit(const Args& a, unsigned char* lds, int unit, const int wave_s) {
    const int tid = mk_tid(wave_s);
    const int lane = tid & 63, wave = tid >> 6;
    const int bh = unit >> 6, c = unit & 63, b = bh >> 2, h = bh & 3, t0 = b * SEQ + c * 128;
    bf16_t* kT = (bf16_t*)lds; bf16_t* vT = kT + 128 * LR;
    float* sf = (float*)(lds + 2 * 128 * LR * 2); float* bb = sf; float* ii = sf + 128; float* tmp = sf + 256; float* wk = sf + 384;
    const bf16_t* PROJ = (const bf16_t*)(a.ws + WS_PROJ);
    const float* cw = a.in[5]; const float* cbias = a.in[6];
    bf16_t* R = (bf16_t*)(lds + 2 * 128 * LR * 2 + 2048);
    const int tl = tid;
    u32x4 rawk[5], vreg[4];
#pragma unroll
    for (int k = 0; k < 5; ++k) { const int idx = tl + 512 * k, row = idx >> 4, chunk = idx & 15; const int sp = c * 128 - 3 + row;
        rawk[k] = (u32x4){0u, 0u, 0u, 0u};
        if (idx < 131 * 16 && sp >= 0) rawk[k] = *(const u32x4*)(PROJ + (size_t)(b * SEQ + sp) * NPROJ + 512 + h * 128 + 8 * chunk); }
#pragma unroll
    for (int k = 0; k < 4; ++k) { const int it = tl + 512 * k, sidx = it & 127, ch = it >> 7; vreg[k] = *(const u32x4*)(PROJ + (size_t)(t0 + sidx) * NPROJ + 1024 + h * 128 + 8 * ch); }
    float* WL = (float*)(lds + 147456);
    float wl0 = 0.f, wl1 = 0.f; if (tl < 512) wl0 = cw[(tl >> 7) * 1024 + 512 + h * 128 + (tl & 127)]; if (tl < 128) wl1 = cbias[512 + h * 128 + tl];
    chunk_gates(a, bb, ii, tmp, t0, h, tid);
    if (tl < 512) WL[tl] = wl0; if (tl < 128) WL[512 + tl] = wl1;
#pragma unroll
    for (int k = 0; k < 5; ++k) { const int idx = tl + 512 * k; if (idx < 131 * 16) *(u32x4*)(R + (idx >> 4) * 136 + 8 * (idx & 15)) = rawk[k]; }
    const float blast = bb[127];
    if (tid < 128) tmp[tid] = blast - bb[tid] + ii[tid];
    __syncthreads();
    float mloc = -INFINITY;
#pragma unroll 4
    for (int j4 = 0; j4 < 32; ++j4) { const f32x4 v = *(const f32x4*)(tmp + 4 * j4); mloc = fmaxf(fmaxf(mloc, fmaxf(v.x, v.y)), fmaxf(v.z, v.w)); }
    if (tid < 128) wk[tid] = expf(tmp[tid] - mloc);
    __syncthreads();
#pragma unroll
    for (int k = 0; k < 4; ++k) { const int it = tl + 512 * k, sidx = it & 127, ch = it >> 7;
        float kv[8]; conv8_lds(R, 136, sidx, 8 * ch, WL, 128, WL + 512, 8 * ch, kv);
        const float sc = 0.08838834764831845f * wk[sidx];
#pragma unroll
        for (int q = 0; q < 8; ++q) kT[(8 * ch + q) * LR + sidx] = (bf16_t)f2bf(kv[q] * sc);
        float vv[8]; unpack8(vreg[k], vv);
#pragma unroll
        for (int q = 0; q < 8; ++q) vT[(8 * ch + q) * LR + sidx] = (bf16_t)f2bf(vv[q]);
    }
    __syncthreads();
    float* CLOC = (float*)(a.ws + WS_CLOC) + (size_t)unit * 16384;
    float* MST = (float*)(a.ws + WS_MST);
    {
        f32x4 acc[8];
#pragma unroll
        for (int i = 0; i < 8; ++i) acc[i] = (f32x4){0.f, 0.f, 0.f, 0.f};
#pragma unroll
        for (int ks = 0; ks < 4; ++ks) { const bf16x8 af = ldfrag(vT, 16 * wave, 32 * ks, lane);
#pragma unroll
            for (int db = 0; db < 8; ++db) acc[db] = mfma16(af, ldfrag(kT, 16 * db, 32 * ks, lane), acc[db]); }
        MFMA_DRAIN8(acc);
#pragma unroll
        for (int db = 0; db < 8; ++db)
#pragma unroll
            for (int r = 0; r < 4; ++r) CLOC[(16 * wave + 4 * (lane >> 4) + r) * 128 + 16 * db + (lane & 15)] = acc[db][r];
    }
    if (tid < 128) { float s = 0.f;
#pragma unroll 4
        for (int j8 = 0; j8 < 16; ++j8) { float x[8]; unpack8(*(const u32x4*)(kT + tid * LR + 8 * j8), x); s += ((x[0] + x[1]) + (x[2] + x[3])) + ((x[4] + x[5]) + (x[6] + x[7])); }
        MST[16384 + (size_t)unit * 128 + tid] = s; }
    if (tid == 0) { MST[unit] = mloc; MST[1024 + unit] = blast; }
    __syncthreads();
}

__device__ __forceinline__ void mlstm_m2(const Args& a, const int tid2) {
    const float* CLOC = (const float*)(a.ws + WS_CLOC); bf16_t* CIN = (bf16_t*)(a.ws + WS_CIN);
    float* MST = (float*)(a.ws + WS_MST);
    const float* NLOC = MST + 16384; float* NIN = MST + 16384 + 131072;
    for (int gid = blockIdx.x * 512 + tid2; gid < 16 * 8192; gid += gridDim.x * 512) {
        const int bh = gid >> 13, e2 = gid & 8191; const bool hasn = e2 < 128;
        const float* cl = CLOC + (size_t)(bh * 64) * 16384 + e2; const float* nl = NLOC + (size_t)(bh * 64) * 128 + e2;
        bf16_t* ci = CIN + (size_t)(bh * 64) * 16384 + e2; float* ni = NIN + (size_t)(bh * 64) * 128 + e2;
        const float* mlp = MST + bh * 64; const float* blp = MST + 1024 + bh * 64;
        float s0 = 0.f, s1 = 0.f, sn = 0.f, m = 0.f;
        float p0[4], p1[4], pn[4], pm[4], pb[4];
#pragma unroll
        for (int k = 0; k < 4; ++k) { p0[k] = cl[(size_t)k * 16384]; p1[k] = cl[(size_t)k * 16384 + 8192]; pn[k] = hasn ? nl[k * 128] : 0.f; pm[k] = mlp[k]; pb[k] = blp[k]; }
        for (int c0 = 0; c0 < 64; c0 += 4) {
            float q0[4], q1[4], qn[4], qm[4], qb[4];
            const bool more = c0 + 4 < 64;
#pragma unroll
            for (int k = 0; k < 4; ++k) { const int c = more ? c0 + 4 + k : c0 + k;
                q0[k] = cl[(size_t)c * 16384]; q1[k] = cl[(size_t)c * 16384 + 8192]; qn[k] = hasn ? nl[c * 128] : 0.f; qm[k] = mlp[c]; qb[k] = blp[c]; }
#pragma unroll
            for (int k = 0; k < 4; ++k) { const int c = c0 + k;
                ci[(size_t)c * 16384] = (bf16_t)f2bf(s0); ci[(size_t)c * 16384 + 8192] = (bf16_t)f2bf(s1);
                if (hasn) ni[c * 128] = sn;
                if (e2 == 0) MST[2048 + bh * 64 + c] = m;
                const float ml = pm[k], bl = pb[k];
                const float mn = fmaxf(bl + m, ml), ca = expf(bl + m - mn), cb = expf(ml - mn);
                s0 = ca * s0 + cb * p0[k]; s1 = ca * s1 + cb * p1[k]; sn = ca * sn + cb * pn[k]; m = mn; }
#pragma unroll
            for (int k = 0; k < 4; ++k) { p0[k] = q0[k]; p1[k] = q1[k]; pn[k] = qn[k]; pm[k] = qm[k]; pb[k] = qb[k]; }
        }
    }
}

template <int MODE>
__device__ __forceinline__ void mlstm_m3_unit(const Args& a, unsigned char* lds, int unit, const int wave_s) {
    const int tid = mk_tid(wave_s);
    const int lane = tid & 63, wave = tid >> 6;
    const int bh = unit >> 6, c = unit & 63, b = bh >> 2, h = bh & 3, t0 = b * SEQ + c * 128;
    bf16_t* qs = (bf16_t*)lds; bf16_t* ks = qs + 128 * LR; bf16_t* vT = ks + 128 * LR; bf16_t* CT = vT + 128 * LR; bf16_t* Ps = ks;
    float* sf = (float*)(lds + 4 * 128 * LR * 2);
    float* bb = sf; float* ii = sf + 128; float* tmp = sf + 256; float* gg = sf + 384; float* wint = sf + 512; float* nn = sf + 640; float* den = sf + 768; float* dint = sf + 896;
    const bf16_t* PROJ = (const bf16_t*)(a.ws + WS_PROJ); const bf16_t* CIN = (const bf16_t*)(a.ws + WS_CIN) + (size_t)unit * 16384;
    const float* MST = (const float*)(a.ws + WS_MST);
    const float* cw = a.in[5]; const float* cbias = a.in[6]; const float* mlg = a.in[8];
    bf16_t* MIX = (bf16_t*)(a.ws + WS_MIX);
    bf16_t* R = vT;
    const float m_in = MST[2048 + unit];
    const int tl = tid;
    u32x4 rawq[9], vreg[4], creg[4];
#pragma unroll
    for (int k = 0; k < 9; ++k) { const int idx = tl + 512 * k, row = idx >> 5, chunk = idx & 31; const int sp = c * 128 - 3 + row;
        rawq[k] = (u32x4){0u, 0u, 0u, 0u};
        if (idx < 131 * 32 && sp >= 0) rawq[k] = *(const u32x4*)(PROJ + (size_t)(b * SEQ + sp) * NPROJ + (chunk < 16 ? h * 128 + 8 * chunk : 512 + h * 128 + 8 * (chunk - 16))); }
#pragma unroll
    for (int k = 0; k < 4; ++k) { const int it = tl + 512 * k, sidx = it & 127, ch = it >> 7, s2 = it >> 4, c2 = it & 15;
        vreg[k] = *(const u32x4*)(PROJ + (size_t)(t0 + sidx) * NPROJ + 1024 + h * 128 + 8 * ch); creg[k] = *(const u32x4*)(CIN + s2 * 128 + 8 * c2); }
    float* WL = (float*)(lds + 147456);
    const float wl0 = cw[(tl >> 7) * 1024 + h * 128 + (tl & 127)], wl1 = cw[(tl >> 7) * 1024 + 512 + h * 128 + (tl & 127)]; float wl2 = 0.f; if (tl < 256) wl2 = cbias[(tl >> 7) * 512 + h * 128 + (tl & 127)];
    chunk_gates(a, bb, ii, tmp, t0, h, tid);
    WL[tl] = wl0; WL[512 + tl] = wl1; if (tl < 256) WL[1024 + tl] = wl2;
#pragma unroll
    for (int k = 0; k < 9; ++k) { const int idx = tl + 512 * k; if (idx < 131 * 32) *(u32x4*)(R + (idx >> 5) * 264 + 8 * (idx & 31)) = rawq[k]; }
    if (tid < 128) { float pm = -INFINITY;
#pragma unroll 4
        for (int j4 = 0; j4 < 32; ++j4) { const f32x4 vi = *(const f32x4*)(ii + 4 * j4), vb = *(const f32x4*)(bb + 4 * j4); const int j = 4 * j4;
            pm = fmaxf(pm, j <= tl ? vi.x - vb.x : -INFINITY); pm = fmaxf(pm, j + 1 <= tl ? vi.y - vb.y : -INFINITY);
            pm = fmaxf(pm, j + 2 <= tl ? vi.z - vb.z : -INFINITY); pm = fmaxf(pm, j + 3 <= tl ? vi.w - vb.w : -INFINITY); }
        const float g = fmaxf(m_in, pm); gg[tl] = g; wint[tl] = expf(m_in - g); tmp[tl] = ii[tl] - bb[tl];
        nn[tl] = MST[16384 + 131072 + (size_t)unit * 128 + tl]; }
    __syncthreads();
#pragma unroll 1
    for (int k = 0; k < 4; ++k) { const int it = tl + 512 * k, sidx = it & 127, ch = it >> 7;
        float qv[8], kv[8];
        conv8_lds(R, 264, sidx, 8 * ch, WL, 128, WL + 1024, 8 * ch, qv);
        conv8_lds(R, 264, sidx, 128 + 8 * ch, WL + 512, 128, WL + 1152, 8 * ch, kv);
#pragma unroll
        for (int q = 0; q < 8; ++q) kv[q] *= 0.08838834764831845f;
        *(u32x4*)(qs + sidx * LR + 8 * ch) = pack8(qv);
        *(u32x4*)(ks + sidx * LR + 8 * ch) = pack8(kv); }
    __syncthreads();
#pragma unroll
    for (int k = 0; k < 4; ++k) { const int it = tl + 512 * k, sidx = it & 127, ch = it >> 7, s2 = it >> 4, c2 = it & 15;
        float vv[8]; unpack8(vreg[k], vv);
#pragma unroll
        for (int q = 0; q < 8; ++q) vT[(8 * ch + q) * LR + sidx] = (bf16_t)f2bf(vv[q]);
        *(u32x4*)(CT + s2 * LR + 8 * c2) = creg[k]; }
    __syncthreads();
    if (MODE == 1) return;
    if (tid < 128) { float s = 0.f;
#pragma unroll 4
        for (int d8 = 0; d8 < 16; ++d8) { float x[8]; unpack8(*(const u32x4*)(qs + tl * LR + 8 * d8), x); const f32x4 n0 = *(const f32x4*)(nn + 8 * d8), n1 = *(const f32x4*)(nn + 8 * d8 + 4);
            s += (x[0] * n0.x + x[1] * n0.y) + (x[2] * n0.z + x[3] * n0.w) + (x[4] * n1.x + x[5] * n1.y) + (x[6] * n1.z + x[7] * n1.w); }
        dint[tl] = s * wint[tl]; }
    f32x4 sacc[8];
#pragma unroll
    for (int i = 0; i < 8; ++i) sacc[i] = (f32x4){0.f, 0.f, 0.f, 0.f};
#pragma unroll
    for (int kk = 0; kk < 4; ++kk) { const bf16x8 bq = ldfrag(qs, 16 * wave, 32 * kk, lane);
#pragma unroll
        for (int sb = 0; sb < 8; ++sb) sacc[sb] = mfma16(ldfrag(ks, 16 * sb, 32 * kk, lane), bq, sacc[sb]); }
    MFMA_DRAIN8(sacc);
    __syncthreads();
    {
        const int t = 16 * wave + (lane & 15); const float g = gg[t]; float rs = 0.f;
#pragma unroll
        for (int sb = 0; sb < 8; ++sb) { float p[4];
            const f32x4 u4 = *(const f32x4*)(tmp + 16 * sb + 4 * (lane >> 4));
#pragma unroll
            for (int r = 0; r < 4; ++r) { const int s = 16 * sb + 4 * (lane >> 4) + r;
                const float w = __builtin_amdgcn_exp2f(fminf(u4[r] - g, 0.f) * LOG2E);
                p[r] = (s <= t) ? sacc[sb][r] * w : 0.f; rs += p[r]; }
            u32x2 w; w.x = pk2(p[0], p[1]); w.y = pk2(p[2], p[3]);
            *(u32x2*)(Ps + t * LR + 16 * sb + 4 * (lane >> 4)) = w; }
        rs += __shfl_xor(rs, 16); rs += __shfl_xor(rs, 32);
        if (lane < 16) den[t] = rs + dint[t];
    }
    __syncthreads();
    if (MODE == 2) return;
    {
        f32x4 a1[8], a2[8];
#pragma unroll
        for (int i = 0; i < 8; ++i) { a1[i] = (f32x4){0.f, 0.f, 0.f, 0.f}; a2[i] = (f32x4){0.f, 0.f, 0.f, 0.f}; }
#pragma unroll
        for (int kk = 0; kk < 4; ++kk) { const bf16x8 ap = ldfrag(Ps, 16 * wave, 32 * kk, lane), aq = ldfrag(qs, 16 * wave, 32 * kk, lane);
#pragma unroll
            for (int eb = 0; eb < 8; ++eb) { a1[eb] = mfma16(ap, ldfrag(vT, 16 * eb, 32 * kk, lane), a1[eb]); a2[eb] = mfma16(aq, ldfrag(CT, 16 * eb, 32 * kk, lane), a2[eb]); } }
        MFMA_DRAIN8(a1); MFMA_DRAIN8(a2);
        float hv[8][4]; float ssq[4];
#pragma unroll
        for (int r = 0; r < 4; ++r) { const int t = 16 * wave + 4 * (lane >> 4) + r;
            const float dd = fmaxf(fabsf(den[t]), expf(-(bb[t] + gg[t]))); const float inv = 1.f / dd, wi = wint[t]; float s2 = 0.f;
#pragma unroll
            for (int eb = 0; eb < 8; ++eb) { const float x = (a1[eb][r] + wi * a2[eb][r]) * inv; hv[eb][r] = x; s2 += x * x;
            }
            s2 += __shfl_xor(s2, 1); s2 += __shfl_xor(s2, 2); s2 += __shfl_xor(s2, 4); s2 += __shfl_xor(s2, 8);
            ssq[r] = rsqrtf(s2 * (1.f / 128.f) + EPS); }
        float mov[8][4];
#pragma unroll
        for (int eb = 0; eb < 8; ++eb)
#pragma unroll
            for (int r = 0; r < 4; ++r) mov[eb][r] = bflo(PROJ[(size_t)(t0 + 16 * wave + 4 * (lane >> 4) + r) * NPROJ + 1536 + h * 128 + 16 * eb + (lane & 15)]);
#pragma unroll
        for (int eb = 0; eb < 8; ++eb) { const int e = 16 * eb + (lane & 15); const float ge = mlg[e];
#pragma unroll
            for (int r = 0; r < 4; ++r) { const int t = 16 * wave + 4 * (lane >> 4) + r;
                const float outv = hv[eb][r] * ssq[r] * ge * sigm(mov[eb][r]);
                if (MODE == 0) MIX[(size_t)(t0 + t) * DM + h * 128 + e] = (bf16_t)f2bf(outv); else asm volatile("" :: "v"(outv)); } }
    }
    __syncthreads();
}

__device__ __forceinline__ void qknorm_rows(const Args& a, const int tid) {
    const int lane = tid & 63, wave = tid >> 6;
    bf16_t* PROJ = (bf16_t*)(a.ws + WS_PROJ);
    const float* gq = a.in[9]; const float* gk = a.in[10];
    const float* g = (lane < 32) ? gq : gk; const float scl = (lane < 32) ? C2 : 1.f;
    float gv[16];
#pragma unroll
    for (int i = 0; i < 16; ++i) gv[i] = g[16 * (lane & 3) + i] * scl;
    const int gw = blockIdx.x * 8 + wave, NGW = gridDim.x * 8;
    for (int row = gw; row < T; row += NGW) {
        u32x4* p = (u32x4*)(PROJ + (size_t)row * NPROJ + 2048 + 16 * lane);
        float x[16]; { float t8[8]; unpack8(p[0], t8);
#pragma unroll
            for (int i = 0; i < 8; ++i) x[i] = t8[i]; unpack8(p[1], t8);
#pragma unroll
            for (int i = 0; i < 8; ++i) x[8 + i] = t8[i]; }
        float ss = 0.f;
#pragma unroll
        for (int i = 0; i < 16; ++i) ss += x[i] * x[i];
        ss += __shfl_xor(ss, 1); ss += __shfl_xor(ss, 2);
        const float rstd = rsqrtf(ss * (1.f / 64.f) + EPS);
        float y0[8], y1[8];
#pragma unroll
        for (int i = 0; i < 8; ++i) { y0[i] = x[i] * rstd * gv[i]; y1[i] = x[8 + i] * rstd * gv[8 + i]; }
        p[0] = pack8(y0); p[1] = pack8(y1);
    }
}

#include <hip/hip_bf16.h>
namespace attn_body {
using bf16=__hip_bfloat16;
using bf16x8=__attribute__((ext_vector_type(8)))short;
using s16x4=__attribute__((ext_vector_type(4)))short;
using f32x16=__attribute__((ext_vector_type(16)))float;
using u32x4=__attribute__((ext_vector_type(4)))unsigned;
constexpr int SEQ=8192,PQ=3584,KVBLK=64;
__device__ __forceinline__ int crow(int r,int hi){return (r&3)+8*(r>>2)+4*hi;}
#define SBAR() __builtin_amdgcn_sched_barrier(0)
__device__ __forceinline__ void cmask(f32x16&p0,f32x16&p1,int jb,int qrel,int hi){
  const float NEG=-INFINITY; int kb=64*jb+4*hi;
  #pragma unroll
  for(int r=0;r<16;++r){int kv=kb+(r&3)+8*(r>>2); if(kv>qrel)p0[r]=NEG; if(kv+32>qrel)p1[r]=NEG;}
}

__device__ __forceinline__ void glds16(const void*gsrc,unsigned lds_dst){unsigned keep;
  asm volatile("s_mov_b32 %0, m0\n\ts_mov_b32 m0, %2\n\ts_nop 0\n\tglobal_load_lds_dwordx4 %1, off\n\ts_mov_b32 m0, %0":"=&s"(keep):"v"(gsrc),"s"(lds_dst):"memory");}
typedef float f32x2_t __attribute__((ext_vector_type(2))); typedef __bf16 bf16x2_t __attribute__((ext_vector_type(2)));
__device__ __forceinline__ unsigned cvtpk_s(float lo,float hi){f32x2_t v={lo,hi};bf16x2_t b=__builtin_convertvector(v,bf16x2_t);return __builtin_bit_cast(unsigned,b);}

__device__ __forceinline__ void qkt(f32x16&p0,f32x16&p1,const char*Kslot,const bf16x8*qr,const f32x16&negm,int r32,int hi){
  const char*kb=Kslot+hi*1024+r32*16;
  #pragma unroll
  for(int d0=0;d0<4;++d0){
    const bf16x8 b0=*reinterpret_cast<const bf16x8*>(kb+d0*2048);
    const bf16x8 b1=*reinterpret_cast<const bf16x8*>(kb+d0*2048+512);
    if(d0==0){p0=__builtin_amdgcn_mfma_f32_32x32x16_bf16(b0,qr[0],negm,0,0,0);p1=__builtin_amdgcn_mfma_f32_32x32x16_bf16(b1,qr[0],negm,0,0,0);}
    else{p0=__builtin_amdgcn_mfma_f32_32x32x16_bf16(b0,qr[d0],p0,0,0,0);p1=__builtin_amdgcn_mfma_f32_32x32x16_bf16(b1,qr[d0],p1,0,0,0);}}
}

__device__ __forceinline__ void pv4(f32x16*o,int vb,bf16x8 pa0,bf16x8 pa1,bf16x8 pa2,bf16x8 pa3){
  s16x4 la[4],ha[4],lb[4],hb[4];
  #define PV_READ(L,H,OFF) do{ _Pragma("unroll") for(int ks=0;ks<4;++ks){ \
      asm volatile("ds_read_b64_tr_b16 %0,%1 offset:%c2":"=&v"(L[ks]):"v"(vb),"i"((OFF)+ks*1024):"memory"); \
      asm volatile("ds_read_b64_tr_b16 %0,%1 offset:%c2":"=&v"(H[ks]):"v"(vb),"i"((OFF)+ks*1024+512):"memory"); } }while(0)
  #define PV_PK(L,H,k) (bf16x8){L[k][0],L[k][1],L[k][2],L[k][3],H[k][0],H[k][1],H[k][2],H[k][3]}
  #define PV_MMA(dst,L,H) do{ dst=__builtin_amdgcn_mfma_f32_32x32x16_bf16(pa0,PV_PK(L,H,0),dst,0,0,0); dst=__builtin_amdgcn_mfma_f32_32x32x16_bf16(pa1,PV_PK(L,H,1),dst,0,0,0); \
      dst=__builtin_amdgcn_mfma_f32_32x32x16_bf16(pa2,PV_PK(L,H,2),dst,0,0,0); dst=__builtin_amdgcn_mfma_f32_32x32x16_bf16(pa3,PV_PK(L,H,3),dst,0,0,0); }while(0)
  PV_READ(la,ha,0); PV_READ(lb,hb,4096);
  asm volatile("s_waitcnt lgkmcnt(8)":::"memory");SBAR(); PV_MMA(o[0],la,ha); SBAR();
  PV_READ(la,ha,8192);
  asm volatile("s_waitcnt lgkmcnt(8)":::"memory");SBAR(); PV_MMA(o[1],lb,hb); SBAR();
  PV_READ(lb,hb,12288);
  asm volatile("s_waitcnt lgkmcnt(8)":::"memory");SBAR(); PV_MMA(o[2],la,ha); SBAR();
  asm volatile("s_waitcnt lgkmcnt(0)":::"memory");SBAR(); PV_MMA(o[3],lb,hb); SBAR();
  #undef PV_READ
  #undef PV_PK
  #undef PV_MMA
}

constexpr int A2_SLOT=32768, A2_NS=4, A2_K=0, A2_V=16384, A2_WS=131072, A2_STG=65536;
__device__ __forceinline__ void attn2_unit(const bf16*PROJ,const float*dg,bf16_t*MIX,char*shm,int bh,int qb,const float lam,const float m0){
  const int tid=threadIdx.x,lane=tid&63,r32=lane&31,hi=lane>>5; const int wid=__builtin_amdgcn_readfirstlane(tid>>6);
  const int c=wid&1,qblk=wid>>1,b=bh>>2,h=bh&3; const long rowbase=(long)b*SEQ; const int q0=qb*128;
  const float sl2=exp2f(-2.f*(float)(h+1))*1.4426950408889634f;
  int tbeg=0; { const float kmin=(float)q0-(2.f*m0+40.f)/sl2; if(kmin>0.f)tbeg=((int)kmin)>>6; }
  const int NT=(q0+128)/KVBLK-tbeg;
  const bf16*Qw=PROJ+(rowbase+q0+qblk*32)*PQ+2048+h*128+c*64;
  const bf16*ksrc=PROJ+(rowbase+(long)tbeg*KVBLK+lane)*PQ+2560+h*128+wid*8;
  const bf16*vsrc=PROJ+(rowbase+(long)tbeg*KVBLK+16*(wid&3)+(lane>>2))*PQ+3072+h*128+(wid>>2)*32+(lane&3)*8;
  const unsigned lds0=(unsigned)(uintptr_t)shm;
  const unsigned kdst=lds0+A2_K+wid*1024, vdst=lds0+A2_V+wid*1024;
  #define A2_DMA(t,s) do{ const bf16*kp_=ksrc+(long)(t)*KVBLK*PQ; const bf16*vp_=vsrc+(long)(t)*KVBLK*PQ; const unsigned so_=(unsigned)(s)*A2_SLOT; \
      glds16(kp_,(unsigned)__builtin_amdgcn_readfirstlane(kdst+so_)); glds16(kp_+64,(unsigned)__builtin_amdgcn_readfirstlane(kdst+so_+8192)); \
      glds16(vp_,(unsigned)__builtin_amdgcn_readfirstlane(vdst+so_)); glds16(vp_+64,(unsigned)__builtin_amdgcn_readfirstlane(vdst+so_+8192)); }while(0)
  A2_DMA(0,0); if(NT>1)A2_DMA(1,1); if(NT>2)A2_DMA(2,2);
  bf16x8 qr[4];
  #pragma unroll
  for(int d0=0;d0<4;++d0)qr[d0]=*reinterpret_cast<const bf16x8*>(&Qw[(long)r32*PQ+d0*16+hi*8]);
  const int qrel=qblk*32+r32;
  const float sl64=sl2*64.f,c32=sl2*32.f;
  float l_reg=0.f; f32x16 o[4]; o[0]=f32x16{};o[1]=f32x16{};o[2]=f32x16{};o[3]=f32x16{}; f32x16 negm;
  { const float nb0=sl2*(float)(4*hi+64*tbeg-q0-qrel)-m0;
    #pragma unroll
    for(int r=0;r<16;++r)negm[r]=__builtin_fmaf(sl2,(float)((r&3)+8*(r>>2)),nb0); }
  const int vb0=(int)(lds0+A2_V)+((lane>>4)&1)*32+(lane&3)*8+(4*hi+((lane&15)>>2))*64;
  { asm volatile("s_waitcnt vmcnt(0)":::"memory"); asm volatile("s_barrier":::"memory"); }
  const int grp=wid>>2;
  if(grp==1)asm volatile("s_barrier":::"memory");
  for(int t=0;t<NT;++t){
    const int s=t&3;
    f32x16 p0,p1;
    qkt(p0,p1,shm+A2_K+s*A2_SLOT+c*8192,qr,negm,r32,hi); asm volatile("s_nop 15\n\ts_nop 7":"+v"(p0),"+v"(p1));
    #pragma unroll
    for(int r=0;r<16;++r){p1[r]+=c32;negm[r]+=sl64;}
    { const int jb=t-(NT-2); if(jb>=0)cmask(p0,p1,jb,qrel,hi); }
    float sacc=0.f;
    #pragma unroll
    for(int r=0;r<16;++r){p0[r]=__builtin_amdgcn_exp2f(p0[r]);p1[r]=__builtin_amdgcn_exp2f(p1[r]);sacc+=p0[r]+p1[r];}
    l_reg+=sacc;
    u32x4 pw0,pw1,pw2,pw3;
    #define PKW(P,B) cvtpk_s(P[B],P[B+1])
    pw0=(u32x4){PKW(p0,0),PKW(p0,2),PKW(p0,4),PKW(p0,6)};pw1=(u32x4){PKW(p0,8),PKW(p0,10),PKW(p0,12),PKW(p0,14)};
    pw2=(u32x4){PKW(p1,0),PKW(p1,2),PKW(p1,4),PKW(p1,6)};pw3=(u32x4){PKW(p1,8),PKW(p1,10),PKW(p1,12),PKW(p1,14)};
    #undef PKW
    if(t+2<NT)asm volatile("s_waitcnt vmcnt(4) lgkmcnt(0)\n\ts_barrier":::"memory"); else asm volatile("s_waitcnt vmcnt(0) lgkmcnt(0)\n\ts_barrier":::"memory");
    if(t+3<NT)A2_DMA(t+3,(t+3)&3);
    SBAR();
    pv4(o,vb0+s*A2_SLOT,__builtin_bit_cast(bf16x8,pw0),__builtin_bit_cast(bf16x8,pw1),__builtin_bit_cast(bf16x8,pw2),__builtin_bit_cast(bf16x8,pw3));
    asm volatile("s_waitcnt lgkmcnt(0)\n\ts_barrier":::"memory");
  }
  if(grp==0)asm volatile("s_barrier":::"memory");
  asm volatile("s_waitcnt vmcnt(0)":::"memory");
  #undef A2_DMA
  {auto rr=__builtin_amdgcn_permlane32_swap(__float_as_uint(l_reg),__float_as_uint(l_reg),false,false);l_reg=__uint_as_float(rr[0])+__uint_as_float(rr[1]);}
  float*wsf=(float*)(shm+A2_WS)+wid*64;
  if(hi==0)wsf[r32]=l_reg; asm volatile("s_waitcnt lgkmcnt(0)":::"memory");
  float rli[16];
  #pragma unroll
  for(int r=0;r<16;++r)rli[r]=__builtin_amdgcn_rcpf(wsf[crow(r,hi)]);
  float*X=(float*)shm+qblk*4096;
  if(c==1){
    #pragma unroll
    for(int d0=0;d0<4;++d0)
      #pragma unroll
      for(int r=0;r<16;++r)X[(d0*16+r)*64+lane]=o[d0][r]*rli[r];
  }
  asm volatile("s_waitcnt lgkmcnt(0)\n\ts_barrier":::"memory");
  if(c==0){
    bf16_t*stg=(bf16_t*)(shm+A2_STG)+qblk*4096;
    #pragma unroll
    for(int d0=0;d0<4;++d0)
      #pragma unroll
      for(int r=0;r<16;++r){ const float v=o[d0][r]*rli[r]-lam*X[(d0*16+r)*64+lane]; stg[crow(r,hi)*128+d0*32+r32]=(bf16_t)(__builtin_bit_cast(unsigned short,__float2bfloat16(v))); }
    asm volatile("s_waitcnt lgkmcnt(0)":::"memory");
    const int row=lane>>1,half=lane&1; const bf16_t*sp=stg+row*128+half*64;
    float d[64]; float ss=0.f;
    #pragma unroll
    for(int i=0;i<8;++i){ const u32x4 w=*(const u32x4*)(sp+8*i);
      d[8*i+0]=__uint_as_float(w.x<<16);d[8*i+1]=__uint_as_float(w.x&0xffff0000u);d[8*i+2]=__uint_as_float(w.y<<16);d[8*i+3]=__uint_as_float(w.y&0xffff0000u);
      d[8*i+4]=__uint_as_float(w.z<<16);d[8*i+5]=__uint_as_float(w.z&0xffff0000u);d[8*i+6]=__uint_as_float(w.w<<16);d[8*i+7]=__uint_as_float(w.w&0xffff0000u); }
    #pragma unroll
    for(int i=0;i<64;++i)ss+=d[i]*d[i];
    ss+=__shfl_xor(ss,1);
    const float rs=rsqrtf(ss*(1.f/128.f)+1e-6f)*0.8f;
    bf16_t*mp=MIX+(rowbase+q0+qblk*32+row)*1024+512+h*128+half*64; const float*gp=dg+half*64;
    #pragma unroll
    for(int i=0;i<8;++i){ u32x4 w;
      w.x=cvtpk_s(d[8*i+0]*rs*gp[8*i+0],d[8*i+1]*rs*gp[8*i+1]); w.y=cvtpk_s(d[8*i+2]*rs*gp[8*i+2],d[8*i+3]*rs*gp[8*i+3]);
      w.z=cvtpk_s(d[8*i+4]*rs*gp[8*i+4],d[8*i+5]*rs*gp[8*i+5]); w.w=cvtpk_s(d[8*i+6]*rs*gp[8*i+6],d[8*i+7]*rs*gp[8*i+7]);
      *(u32x4*)(mp+8*i)=w; }
  }
  asm volatile("s_waitcnt lgkmcnt(0)\n\ts_barrier":::"memory");
}
constexpr int ATTN_LDS_BYTES=LDS_BYTES;
#undef SBAR
#undef WAIT_BAR
}

__device__ __forceinline__ unsigned wave_umax(unsigned x) {
    x = max(x, (unsigned)__builtin_amdgcn_update_dpp(0, (int)x, 0x111, 0xf, 0xf, false));
    x = max(x, (unsigned)__builtin_amdgcn_update_dpp(0, (int)x, 0x112, 0xf, 0xf, false));
    x = max(x, (unsigned)__builtin_amdgcn_update_dpp(0, (int)x, 0x114, 0xf, 0xf, false));
    x = max(x, (unsigned)__builtin_amdgcn_update_dpp(0, (int)x, 0x118, 0xf, 0xf, false));
    x = max(x, (unsigned)__builtin_amdgcn_update_dpp(0, (int)x, 0x142, 0xa, 0xf, false));
    x = max(x, (unsigned)__builtin_amdgcn_update_dpp(0, (int)x, 0x143, 0xc, 0xf, false));
    return (unsigned)__builtin_amdgcn_readlane((int)x, 63);
}
__device__ __forceinline__ unsigned sel_key(float v, int idx) { unsigned u = __float_as_uint(v); u = (u & 0x80000000u) ? ~u : (u | 0x80000000u); return (u & 0xffffff00u) | (unsigned)(255 - idx); }

__device__ __forceinline__ void ph_route(const Args& a, unsigned char* lds, const int tid) {
    const int lane = tid & 63, wave = tid >> 6;
    int* hist = (int*)lds;
    const float* LOG = (const float*)(a.ws + WS_LOGITS); const float* rb = a.in[18];
    int* IDX = (int*)(a.ws + WS_IDX); float* GATEV = (float*)(a.ws + WS_GATEV); int* HIST = (int*)(a.ws + WS_HIST);
    unsigned* TOT = (unsigned*)(a.ws + WS_BAR) + 3456;
    const f32x4 rb4 = *((const f32x4*)rb + lane);
    for (int tb = blockIdx.x; tb < 256; tb += gridDim.x) {
        if (tid < 256) hist[tid] = 0;
        __syncthreads();
        f32x4 lgn = *((const f32x4*)(LOG + (size_t)(tb * 128 + wave * 16) * 256) + lane);
        for (int i = 0; i < 16; ++i) {
            const int t = tb * 128 + wave * 16 + i;
            const f32x4 lg = lgn;
            if (i < 15) lgn = *((const f32x4*)(LOG + (size_t)(t + 1) * 256) + lane);
            float s[4], sel[4];
            s[0] = sigm(lg.x); s[1] = sigm(lg.y); s[2] = sigm(lg.z); s[3] = sigm(lg.w);
            sel[0] = s[0] + rb4.x; sel[1] = s[1] + rb4.y; sel[2] = s[2] + rb4.z; sel[3] = s[3] + rb4.w;
            float m1 = fmaxf(sel[0], sel[1]), m2 = fminf(sel[0], sel[1]);
            { const float x = sel[2]; const float n1 = fmaxf(m1, x); m2 = fmaxf(m2, fminf(m1, x)); m1 = n1; }
            { const float x = sel[3]; const float n1 = fmaxf(m1, x); m2 = fmaxf(m2, fminf(m1, x)); m1 = n1; }
#pragma unroll
            for (int off = 1; off < 8; off <<= 1) { const float o1 = __shfl_xor(m1, off), o2 = __shfl_xor(m2, off);
                const float n1 = fmaxf(m1, o1), n2 = fmaxf(fminf(m1, o1), fmaxf(m2, o2)); m1 = n1; m2 = n2; }
            const float gs = m1 + m2; const int grp = lane >> 3; int rank = 0;
#pragma unroll
            for (int g2 = 0; g2 < 8; ++g2) { const float v = __builtin_bit_cast(float, __builtin_amdgcn_readlane(__builtin_bit_cast(int, gs), 8 * g2)); rank += ((v > gs) || (v == gs && g2 < grp)) ? 1 : 0; }
            const bool gsel = rank < 4;
            unsigned key[4];
#pragma unroll
            for (int j = 0; j < 4; ++j) key[j] = gsel ? sel_key(sel[j], 4 * lane + j) : 0u;
            float gsum = 0.f; float myg = 0.f; int myidx = 0;
#pragma unroll
            for (int k = 0; k < 8; ++k) {
                const unsigned best = wave_umax(max(max(key[0], key[1]), max(key[2], key[3])));
                const int bi = 255 - (int)(best & 255u);
                const int owner = bi >> 2, sub = bi & 3;
                float sv = (sub == 0) ? s[0] : (sub == 1) ? s[1] : (sub == 2) ? s[2] : s[3];
                sv = __builtin_bit_cast(float, __builtin_amdgcn_readlane(__builtin_bit_cast(int, sv), owner));
                if (lane == owner) {
#pragma unroll
                    for (int j = 0; j < 4; ++j) if (j == sub) key[j] = 0u;
                }
                gsum += sv;
                if (lane == k) { myg = sv; myidx = bi; }
            }
            if (lane < 8) { IDX[(size_t)t * 8 + lane] = myidx; GATEV[(size_t)t * 8 + lane] = myg / gsum * 2.5f; atomicAdd(&hist[myidx], 1); }
        }
        __syncthreads();
        if (tid < 256) { const int hv = hist[tid]; HIST[tb * 256 + tid] = hv; if (hv) atomicAdd(TOT + tid, (unsigned)hv); }
        __syncthreads();
    }
}

__device__ __forceinline__ void ph_scatter(const Args& a, unsigned char* lds, const int tid) {
    int* tot = (int*)lds; int* cur = tot + 256; int* base = cur + 256; int* tstart = base + 256;
    const int* HIST = (const int*)(a.ws + WS_HIST); const int* IDX = (const int*)(a.ws + WS_IDX); const float* GATEV = (const float*)(a.ws + WS_GATEV);
    int* PSLOT = (int*)(a.ws + WS_PSLOT); int* SLOTTOK = (int*)(a.ws + WS_SLOTTOK); float* SLOTGATE = (float*)(a.ws + WS_SLOTGATE);
    int* TILE = (int*)(a.ws + WS_TILE);
    unsigned* TOT = (unsigned*)(a.ws + WS_BAR) + 3456; unsigned* CUR = TOT + 256;
    for (int tb = blockIdx.x; tb < 256; tb += gridDim.x) {
        __syncthreads();
        if (tid < 256) tot[tid] = (int)__hip_atomic_load(TOT + tid, __ATOMIC_RELAXED, __HIP_MEMORY_SCOPE_AGENT);
        __syncthreads();
        if (tid < 256) { int bs = 0, ts = 0; for (int j = 0; j < tid; ++j) { const int c = tot[j]; bs += c; ts += (c + 255) >> 8; } base[tid] = bs; tstart[tid] = ts;
            const int mine = HIST[tb * 256 + tid]; cur[tid] = bs + (mine ? (int)atomicAdd(CUR + tid, (unsigned)mine) : 0); }
        __syncthreads();
        for (int p = tid; p < 1024; p += 512) { const int t = tb * 128 + (p >> 3), k = p & 7; const int e = IDX[(size_t)t * 8 + k];
            const int slot = atomicAdd(&cur[e], 1); SLOTTOK[slot] = t; SLOTGATE[slot] = GATEV[(size_t)t * 8 + k]; PSLOT[(size_t)t * 8 + k] = slot; }
        if (tb == 0) {
            if (tid < 256) { const int cnt = tot[tid], b0 = base[tid]; int n = tstart[tid];
                for (int r0 = 0; r0 < cnt; r0 += 256) { TILE[64 + n] = tid; TILE[64 + 2048 + n] = b0 + r0; TILE[64 + 4096 + n] = b0 + cnt; ++n; }
                if (tid == 255) TILE[0] = n; }
            __syncthreads();
            if (tid < 128) { const int n = tstart[255] + ((tot[255] + 255) >> 8);
                TILE[64 + n + tid] = 256; TILE[64 + 2048 + n + tid] = SHARED_BASE + 256 * tid; TILE[64 + 4096 + n + tid] = SHARED_BASE + T; }
        }
    }
}

template <int MODE>
__device__ __forceinline__ void ph_final(const Args& a, const int tid) {
    const int lane = tid & 63, wave = tid >> 6;
    const unsigned char* YP = (const unsigned char*)(a.ws + WS_YP); const int* PSLOT = (const int*)(a.ws + WS_PSLOT); const float* MOD = (const float*)(a.ws + WS_MOD);
    float* out = a.out;
    const int gw = blockIdx.x * 8 + wave, NGW = gridDim.x * 8;
    const int sub = lane & 15, rsel = lane >> 4;
    int nslot = 0;
    { const int r0 = gw + (rsel == 1 ? NGW : 0); if (rsel < 2 && sub < 9 && r0 < T) nslot = sub < 8 ? PSLOT[(size_t)r0 * 8 + sub] : SHARED_BASE + r0; }
    for (int row = gw; row < T; row += 2 * NGW) {
        const int myslot = nslot;
        { const int r1 = row + 2 * NGW + (rsel == 1 ? NGW : 0); if (rsel < 2 && sub < 9 && r1 < T) nslot = sub < 8 ? PSLOT[(size_t)r1 * 8 + sub] : SHARED_BASE + r1; }
#pragma unroll
        for (int half = 0; half < 2; ++half) {
            const int rw = row + half * NGW;
            if (rw < T) {
                const int b = rw / SEQ;
                float* o0 = out + (size_t)rw * DM + 8 * lane; float* o1 = o0 + 512;
                const f32x4 xa = *(const f32x4*)o0, xb = *(const f32x4*)(o0 + 4), xc = *(const f32x4*)o1, xd = *(const f32x4*)(o1 + 4);
                float acc[16];
#pragma unroll
                for (int i = 0; i < 16; ++i) acc[i] = 0.f;
                u32x2 w0[9], w1[9];
#pragma unroll
                for (int k = 0; k < 9; ++k) { const int slot = __shfl(myslot, 16 * half + k); const unsigned char* yp = YP + (size_t)slot * DM; w0[k] = *(const u32x2*)(yp + 8 * lane); w1[k] = *(const u32x2*)(yp + 512 + 8 * lane); }
#pragma unroll
                for (int k = 0; k < 9; ++k) {
                    { const auto a0 = __builtin_amdgcn_cvt_pk_f32_fp8((int)w0[k].x, false), a1 = __builtin_amdgcn_cvt_pk_f32_fp8((int)w0[k].x, true), a2 = __builtin_amdgcn_cvt_pk_f32_fp8((int)w0[k].y, false), a3 = __builtin_amdgcn_cvt_pk_f32_fp8((int)w0[k].y, true);
                      acc[0] += a0[0]; acc[1] += a0[1]; acc[2] += a1[0]; acc[3] += a1[1]; acc[4] += a2[0]; acc[5] += a2[1]; acc[6] += a3[0]; acc[7] += a3[1]; }
                    { const auto a0 = __builtin_amdgcn_cvt_pk_f32_fp8((int)w1[k].x, false), a1 = __builtin_amdgcn_cvt_pk_f32_fp8((int)w1[k].x, true), a2 = __builtin_amdgcn_cvt_pk_f32_fp8((int)w1[k].y, false), a3 = __builtin_amdgcn_cvt_pk_f32_fp8((int)w1[k].y, true);
                      acc[8] += a0[0]; acc[9] += a0[1]; acc[10] += a1[0]; acc[11] += a1[1]; acc[12] += a2[0]; acc[13] += a2[1]; acc[14] += a3[0]; acc[15] += a3[1]; } }
                const float* gf = MOD + b * 6144 + 5 * 1024 + 8 * lane;
                const f32x4 g0 = *(const f32x4*)gf * (1.f / 16.f), g1 = *(const f32x4*)(gf + 4) * (1.f / 16.f), g2 = *(const f32x4*)(gf + 512) * (1.f / 16.f), g3 = *(const f32x4*)(gf + 516) * (1.f / 16.f);
                f32x4 ya = xa, yb = xb, yc = xc, yd = xd;
                ya.x += g0.x * acc[0]; ya.y += g0.y * acc[1]; ya.z += g0.z * acc[2]; ya.w += g0.w * acc[3];
                yb.x += g1.x * acc[4]; yb.y += g1.y * acc[5]; yb.z += g1.z * acc[6]; yb.w += g1.w * acc[7];
                yc.x += g2.x * acc[8]; yc.y += g2.y * acc[9]; yc.z += g2.z * acc[10]; yc.w += g2.w * acc[11];
                yd.x += g3.x * acc[12]; yd.y += g3.y * acc[13]; yd.z += g3.z * acc[14]; yd.w += g3.w * acc[15];
                if (MODE == 0) { *(f32x4*)o0 = ya; *(f32x4*)(o0 + 4) = yb; *(f32x4*)o1 = yc; *(f32x4*)(o1 + 4) = yd; }
                else asm volatile("" :: "v"(ya), "v"(yb), "v"(yc), "v"(yd));
            }
        }
    }
}

#define LAS __attribute__((address_space(3)))
#define XB_TMO      128
#define XB_XCNT(j)  (256  + 64 * (j))
#define XB_XSUB(j)  (1280 + 64 * (j))
#define XB_XGEN(j)  (2304 + 64 * (j))
#define XB_TOP      3328
#define XB_TOPGEN   3392
#define XB_SPIN_CAP (1u << 27)
__device__ __forceinline__ unsigned xb_ld(unsigned* p)              { return __hip_atomic_load(p, __ATOMIC_RELAXED, __HIP_MEMORY_SCOPE_AGENT); }
__device__ __forceinline__ unsigned xb_add(unsigned* p, unsigned v) { return __hip_atomic_fetch_add(p, v, __ATOMIC_RELAXED, __HIP_MEMORY_SCOPE_AGENT); }
__device__ __forceinline__ unsigned xb_xcc_id() { return (unsigned)__builtin_amdgcn_s_getreg((3 << 11) | 20) & 0xFu; }
#define XB_SPIN(cond, bar) do { unsigned _sp = 0; while (cond) { __builtin_amdgcn_s_sleep(1); \
    if ((++_sp & 255u) == 0u) { if (xb_ld(&(bar)[XB_TMO])) break; if (_sp > XB_SPIN_CAP) { atomicAdd(&(bar)[XB_TMO], 1u); break; } } } } while (0)
struct XcdBarrier { unsigned* bar; unsigned x; volatile LAS unsigned* st; };
__device__ __forceinline__ XcdBarrier xcd_barrier_post(unsigned* bar, volatile LAS unsigned* st, const bool t0) {
    XcdBarrier b; b.bar = bar; b.x = xb_xcc_id(); b.st = st;
    if (t0) (void)xb_add(&bar[XB_XCNT(b.x)], 1u);
    return b;
}
__device__ __forceinline__ void xcd_barrier_complete(unsigned* bar, unsigned x, unsigned& nloc, unsigned& nx) {
    const unsigned G = gridDim.x * gridDim.y * gridDim.z;
    unsigned sum, cnt, mine, sp = 0u;
    for (;;) {
        sum = 0u; cnt = 0u; mine = 0u;
#pragma unroll
        for (unsigned j = 0; j < 16; ++j) { const unsigned c = xb_ld(&bar[XB_XCNT(j)]); sum += c; cnt += (c > 0u) ? 1u : 0u; mine = (j == x) ? c : mine; }
        if (sum == G) break;
        __builtin_amdgcn_s_sleep(1);
        if ((++sp & 255u) == 0u) { if (xb_ld(&bar[XB_TMO])) break; if (sp > XB_SPIN_CAP) { atomicAdd(&bar[XB_TMO], 1u); break; } }
    }
    nloc = mine > 0u ? mine : 1u; nx = cnt > 0u ? cnt : 1u;
}
__device__ __forceinline__ void xcd_barrier(const XcdBarrier& b, const bool t0) {
    asm volatile("s_waitcnt vmcnt(0)" ::: "memory");
    __syncthreads();
    if (t0) {
        unsigned* bar = b.bar;
        __builtin_amdgcn_s_waitcnt(0);
        unsigned nloc = b.st[0], nx = b.st[1];
        if (nloc == 0u) { xcd_barrier_complete(bar, b.x, nloc, nx); b.st[0] = nloc; b.st[1] = nx; }
        const unsigned old = xb_add(&bar[XB_XSUB(b.x)], 1u);
        const unsigned gen = old / nloc;
        if (old + 1u == (gen + 1u) * nloc) {
            __builtin_amdgcn_fence(__ATOMIC_RELEASE, "agent");
            asm volatile("s_waitcnt vmcnt(0)" ::: "memory");
            const unsigned og = xb_add(&bar[XB_TOP], 1u);
            const unsigned tg = og / nx;
            if (og + 1u == (tg + 1u) * nx) xb_add(&bar[XB_TOPGEN], 1u);
            else XB_SPIN(xb_ld(&bar[XB_TOPGEN]) == tg, bar);
            __builtin_amdgcn_fence(__ATOMIC_ACQUIRE, "agent");
            xb_add(&bar[XB_XGEN(b.x)], 1u);
            asm volatile("s_waitcnt vmcnt(0)" ::: "memory");
        } else {
            XB_SPIN(xb_ld(&bar[XB_XGEN(b.x)]) == gen, bar);
            __builtin_amdgcn_fence(__ATOMIC_ACQUIRE, "agent");
            asm volatile("s_waitcnt vmcnt(0)" ::: "memory");
        }
    }
    __syncthreads();
}


__global__ void __launch_bounds__(512) mega(Args a) {
    extern __shared__ __attribute__((aligned(16))) unsigned char lds[];
    const int lo = a.ph_lo, hi = a.ph_hi;
    const int wave_s = __builtin_amdgcn_readfirstlane((int)threadIdx.x >> 6);
#define tid mk_tid(wave_s)
    volatile LAS unsigned* bst = (volatile LAS unsigned*)((LAS unsigned char*)lds + (LDS_BYTES - 64));
    if (tid < 16) bst[tid] = 0u;
    __syncthreads();
    XcdBarrier bar = xcd_barrier_post((unsigned*)(a.ws + WS_BAR), bst, tid == 0);
#define IN(k) (lo <= (k) && (k) < hi)
#define SEAM(k) do { if (IN(k) && IN((k) + 1)) xcd_barrier(bar, tid == 0); } while (0)

    if (IN(0)) { ph0(a, lds, tid); } SEAM(0);
    if (IN(1)) { ph_norm<true>(a, lds, a.in[0], 0, 1, tid); } SEAM(1);
    if (IN(2)) {
        const EpiProj E{(bf16_t*)(a.ws + WS_PROJ)};
        { pg8::DenseSched S; S.init(a.ws + WS_H8, a.ws + WS_WIN, T, NPROJ, DM, (int)gridDim.x, (int)blockIdx.x); __syncthreads();
          pg8::gemm_phase<false, true, 0x79797979, 0x7f7f7f7f, false>((PG8_LAS unsigned char*)lds, DM, S, E); }
    } SEAM(2);
    if (IN(3)) { qknorm_rows(a, tid); __syncthreads(); for (int u = blockIdx.x; u < 1024; u += gridDim.x) mlstm_m1_unit(a, lds, u, wave_s);
 } SEAM(3);
    if (IN(4)) { mlstm_m2(a, tid); } SEAM(4);
    if (IN(5)) {
        { float lam; { float s1 = 0.f, s2 = 0.f; const float* q1 = a.in[11]; const float* k1 = a.in[12]; const float* q2 = a.in[13]; const float* k2 = a.in[14];
              for (int i = 0; i < 64; ++i) { s1 += q1[i] * k1[i]; s2 += q2[i] * k2[i]; } lam = expf(s1) - expf(s2) + LAM_INIT; }
          float m0; { float gq = 0.f, gk = 0.f; for (int i = 0; i < 64; ++i) { gq = fmaxf(gq, fabsf(a.in[9][i])); gk = fmaxf(gk, fabsf(a.in[10][i])); } m0 = 64.f * C2 * gq * gk * 1.01f + 0.01f; }
          unsigned* qhead = (unsigned*)(a.ws + WS_BAR) + 4001;
          for (;;) {
              __syncthreads();
              if (tid == 0) bst[8] = atomicAdd(qhead, 1u);
              __syncthreads();
              const int idx = (int)bst[8];
              if (idx >= 1024) break;
              const int qb = 63 - (idx >> 4), j = idx & 15, bh = (j & 3) * 4 + (3 - (j >> 2));
              attn_body::attn2_unit((const attn_body::bf16*)(a.ws + WS_PROJ), a.in[15], (bf16_t*)(a.ws + WS_MIX), (char*)lds, bh, qb, lam, m0);
          }
          __syncthreads();
          for (int u = (int)blockIdx.x; u < 1024; u += (int)gridDim.x) mlstm_m3_unit<0>(a, lds, u, wave_s);
          __syncthreads(); }
    } SEAM(5);
    if (IN(6)) {
        const EpiOut E{a.in[0], a.out, (const float*)(a.ws + WS_MOD)};
        { pg8::DenseSched S; S.init(a.ws + WS_MIX, a.ws + WS_WOUT, T, DM, 2 * DM, (int)gridDim.x, (int)blockIdx.x); __syncthreads();
          pg8::gemm_phase<false, false, 0, 0, false>((PG8_LAS unsigned char*)lds, 2 * DM, S, E); }
    } SEAM(6);
    if (IN(7)) { ph_norm<false>(a, lds, a.out, 3, 4, tid); } SEAM(7);
    if (IN(8)) {
        const EpiRS E{(float*)(a.ws + WS_LOGITS), (bf16_t*)(a.ws + WS_ACT)};
        { pg8::DenseSched S; S.init(a.ws + WS_H, a.ws + WS_WRS, T, 768, 2 * DM, (int)gridDim.x, (int)blockIdx.x); __syncthreads();
          pg8::gemm_phase<false, false, 0, 0, false>((PG8_LAS unsigned char*)lds, 2 * DM, S, E); }
    } SEAM(8);
    if (IN(9)) { ph_route(a, lds, tid); } SEAM(9);
    if (IN(10)) { ph_scatter(a, lds, tid); } SEAM(10);
    if (IN(11)) {
        const int* TILE = (const int*)(a.ws + WS_TILE); const int ntile = TILE[0];
        const EpiG1 E{(const float*)(a.ws + WS_SLOTGATE), (bf16_t*)(a.ws + WS_ACT)};
        { const int G = (int)gridDim.x, bx = (int)blockIdx.x, vcu = (G % 8 == 0) ? (bx % 8) * (G / 8) + bx / 8 : bx;
          const pg8::ExpertSched S{TILE, ntile * 2, 2, (const char*)(a.ws + WS_H8), (const int*)(a.ws + WS_SLOTTOK), (const char*)(a.ws + WS_W13T), (size_t)512 * 1024, DM, G, vcu};
          __syncthreads(); pg8::gemm_phase<true, true, 0x79797979, 0x7f7f7f7f, false>((PG8_LAS unsigned char*)lds, DM, S, E); }
    } SEAM(11);
    if (IN(12)) {
        const int* TILE = (const int*)(a.ws + WS_TILE); const int ntile = TILE[0] + 128;
        const EpiG2 E{(bf16_t*)(a.ws + WS_YP)};
        { const int G = (int)gridDim.x, bx = (int)blockIdx.x, vcu = (G % 8 == 0) ? (bx % 8) * (G / 8) + bx / 8 : bx;
          const pg8::ExpertSched S{TILE, ntile * 4, 4, (const char*)(a.ws + WS_ACT), nullptr, (const char*)(a.ws + WS_W2T), (size_t)1024 * 256, 256, G, vcu};
          __syncthreads(); pg8::gemm_phase<false, true, 0x7a7a7a7a, 0x7c7c7c7c, true>((PG8_LAS unsigned char*)lds, 256, S, E); }
    } SEAM(12);
    if (IN(13)) {
        ph_final<0>(a, tid); }
#undef IN
#undef SEAM
#undef tid
}

extern "C" void kernel_launch(void* const* d_in, const int* in_sizes, int n_in, void* d_out, int out_size, void* d_ws, size_t ws_size, hipStream_t stream) {
    static int grid = 0;
    if (grid == 0) {
        if (n_in != 25 || in_sizes[0] != T * DM || out_size != T * DM || ws_size < WS_END) {
            fprintf(stderr, "kernel_launch: unexpected problem (n_in %d, in0 %d, out %d, ws %zu < %zu)\n", n_in, n_in > 0 ? in_sizes[0] : -1, out_size, ws_size, (size_t)WS_END); grid = -1; return; }
        int dev = 0, cus = 0, per_cu = 0;
        (void)hipGetDevice(&dev);
        (void)hipDeviceGetAttribute(&cus, hipDeviceAttributeMultiprocessorCount, dev);
        if (hipFuncSetAttribute((const void*)mega, hipFuncAttributeMaxDynamicSharedMemorySize, LDS_BYTES) != hipSuccess) { fprintf(stderr, "kernel_launch: hipFuncSetAttribute failed\n"); grid = -1; return; }
        if (hipOccupancyMaxActiveBlocksPerMultiprocessor(&per_cu, (const void*)mega, 512, LDS_BYTES) != hipSuccess || per_cu < 1) { fprintf(stderr, "kernel_launch: occupancy query says %d blocks/CU\n", per_cu); grid = -1; return; }
        grid = cus;
    }
    if (grid < 0) return;
    (void)hipMemsetAsync((char*)d_ws + WS_BAR, 0, BAR_BYTES, stream);
    Args a{};
    for (int i = 0; i < 25; ++i) a.in[i] = (const float*)d_in[i];
    a.out = (float*)d_out; a.ws = (unsigned char*)d_ws;
    a.ph_lo = 0; a.ph_hi = NPH;
    void* args[] = {&a};
    hipError_t e = hipLaunchCooperativeKernel((const void*)mega, dim3(grid), dim3(512), args, LDS_BYTES, stream);
    if (e != hipSuccess) fprintf(stderr, "cooperative launch failed: %s (grid %d)\n", hipGetErrorString(e), grid);
}
```

```cpp
#include <hip/hip_runtime.h>
#include <cstdio>
#include <cstdint>

typedef unsigned short bf16_t;
typedef short bf16x8 __attribute__((ext_vector_type(8)));
typedef float f32x4 __attribute__((ext_vector_type(4)));
typedef unsigned u32x4 __attribute__((ext_vector_type(4)));
typedef unsigned u32x2 __attribute__((ext_vector_type(2)));


constexpr int T = 32768, DM = 1024, SEQ = 8192;
constexpr int NPROJ = 3584, DIN = 3592;
constexpr int TOPK = 8, TK = T * TOPK;
constexpr int SHARED_BASE = TK;
constexpr float EPS = 1e-6f;
constexpr float LOG2E = 1.4426950408889634f;
constexpr float C2 = 0.125f * LOG2E;
constexpr float LAM_INIT = 0.2f;
constexpr int NPH = 14;
constexpr int LDS_BYTES = 155648;

constexpr size_t MiB = 1ull << 20;
constexpr size_t WS_MOD = 0;
constexpr size_t WS_TILE = 128 * 1024;
constexpr size_t WS_HIST = 256 * 1024;
constexpr size_t WS_BAR = 512 * 1024;
constexpr size_t BAR_BYTES = 16384;
constexpr size_t WS_IPRE = 1 * MiB, WS_FPRE = 1 * MiB + 512 * 1024;
constexpr size_t WS_IDX = 2 * MiB, WS_GATEV = 3 * MiB, WS_PSLOT = 4 * MiB, WS_SLOTTOK = 5 * MiB, WS_SLOTGATE = 7 * MiB;
constexpr size_t WS_MST = 9 * MiB;
constexpr size_t WS_WIN = 12 * MiB, WS_WOUT = 19 * MiB, WS_WRS = 21 * MiB, WS_W2T = 23 * MiB;
constexpr size_t WS_H = 152 * MiB, WS_ACT = 216 * MiB, WS_MIX = 361 * MiB, WS_PROJ = 425 * MiB, WS_CLOC = 649 * MiB, WS_CIN = 713 * MiB, WS_W13T = 745 * MiB, WS_END = 1001 * MiB;
constexpr size_t WS_H8 = 89 * MiB;
constexpr size_t WS_YP = WS_MIX;
constexpr size_t WS_LOGITS = WS_CLOC;
constexpr size_t WS_TMP = WS_ACT;

struct Args { const float* in[25]; float* out; unsigned char* ws; int ph_lo, ph_hi; };

__device__ __forceinline__ int mk_tid(int wave_s) { int l; asm volatile("v_mbcnt_lo_u32_b32 %0, -1, 0\n\tv_mbcnt_hi_u32_b32 %0, -1, %0" : "=v"(l)); return (wave_s << 6) | l; }

__device__ __forceinline__ float bflo(unsigned v) { return __uint_as_float(v << 16); }
__device__ __forceinline__ float bfhi(unsigned v) { return __uint_as_float(v & 0xffff0000u); }
__device__ __forceinline__ unsigned f2bf(float f) { unsigned u = __float_as_uint(f); return (u + 0x7fffu + ((u >> 16) & 1u)) >> 16; }
__device__ __forceinline__ unsigned pk2(float lo, float hi) { return f2bf(lo) | (f2bf(hi) << 16); }
__device__ __forceinline__ float wave_sum(float v) {
    v += __builtin_bit_cast(float, __builtin_amdgcn_update_dpp(0, __builtin_bit_cast(int, v), 0x111, 0xf, 0xf, false));
    v += __builtin_bit_cast(float, __builtin_amdgcn_update_dpp(0, __builtin_bit_cast(int, v), 0x112, 0xf, 0xf, false));
    v += __builtin_bit_cast(float, __builtin_amdgcn_update_dpp(0, __builtin_bit_cast(int, v), 0x114, 0xf, 0xf, false));
    v += __builtin_bit_cast(float, __builtin_amdgcn_update_dpp(0, __builtin_bit_cast(int, v), 0x118, 0xf, 0xf, false));
    v += __builtin_bit_cast(float, __builtin_amdgcn_update_dpp(0, __builtin_bit_cast(int, v), 0x142, 0xa, 0xf, false));
    v += __builtin_bit_cast(float, __builtin_amdgcn_update_dpp(0, __builtin_bit_cast(int, v), 0x143, 0xc, 0xf, false));
    return __builtin_bit_cast(float, __builtin_amdgcn_readlane(__builtin_bit_cast(int, v), 63));
}
__device__ __forceinline__ float siluf(float x) { return x / (1.f + __expf(-x)); }
__device__ __forceinline__ float sigm(float x) { return 1.f / (1.f + __expf(-x)); }
__device__ __forceinline__ void unpack8(const u32x4 v, float (&x)[8]) {
    x[0] = bflo(v.x); x[1] = bfhi(v.x); x[2] = bflo(v.y); x[3] = bfhi(v.y); x[4] = bflo(v.z); x[5] = bfhi(v.z); x[6] = bflo(v.w); x[7] = bfhi(v.w);
}
__device__ __forceinline__ unsigned pk4_fp8(float a, float b, float c, float d) { int p = __builtin_amdgcn_cvt_pk_fp8_f32(a, b, 0, false); p = __builtin_amdgcn_cvt_pk_fp8_f32(c, d, p, true); return (unsigned)p; }
__device__ __forceinline__ u32x4 pack8(const float (&x)[8]) { u32x4 o; o.x = pk2(x[0], x[1]); o.y = pk2(x[2], x[3]); o.z = pk2(x[4], x[5]); o.w = pk2(x[6], x[7]); return o; }

__device__ __forceinline__ void conv_item(const float* __restrict__ s0, const float* __restrict__ s1, int ldn, int k0, int n0, bool inter,
                                          bf16_t* dst, int ldk, int c0, float* scr, int lane) {
    const float* p = (inter && lane >= 32) ? (s1 + n0 + (lane - 32)) : (s0 + n0 + lane);
    p += (size_t)k0 * ldn;
#pragma unroll 8
    for (int i = 0; i < 64; ++i) scr[i * 65 + lane] = __builtin_nontemporal_load(p + (size_t)i * ldn);
    const int c = lane & 7;
#pragma unroll
    for (int j = 0; j < 8; ++j) {
        const int n = (lane >> 3) + 8 * j;
        const float* s = scr + (8 * c) * 65 + n;
        u32x4 o; o.x = pk2(s[0], s[65]); o.y = pk2(s[130], s[195]); o.z = pk2(s[260], s[325]); o.w = pk2(s[390], s[455]);
        const int drow = inter ? (c0 + ((n & 31) >> 2) * 8 + (n >> 5) * 4 + (n & 3)) : (c0 + n);
        __builtin_nontemporal_store(o, (u32x4*)(dst + (size_t)drow * ldk + k0 + 8 * c));
    }
}


__device__ __forceinline__ void conv_item8(const float* __restrict__ s0, const float* __restrict__ s1, int ldn, int k0, int n0, bool inter,
                                           unsigned char* dst, int ldk, int c0, float* scr, int lane, float scale) {
    const float* p = (inter && lane >= 32) ? (s1 + n0 + (lane - 32)) : (s0 + n0 + lane);
    p += (size_t)k0 * ldn;
#pragma unroll 8
    for (int i = 0; i < 64; ++i) scr[i * 65 + lane] = __builtin_nontemporal_load(p + (size_t)i * ldn) * scale;
    const int c = lane & 7;
#pragma unroll
    for (int j = 0; j < 8; ++j) {
        const int n = (lane >> 3) + 8 * j;
        const float* s = scr + (8 * c) * 65 + n;
        u32x2 o; o.x = pk4_fp8(s[0], s[65], s[130], s[195]); o.y = pk4_fp8(s[260], s[325], s[390], s[455]);
        const int drow = inter ? (c0 + ((n & 31) >> 2) * 8 + (n >> 5) * 4 + (n & 3)) : (c0 + n);
        __builtin_nontemporal_store(o, (u32x2*)(dst + (size_t)drow * ldk + k0 + 8 * c));
    }
}

__device__ __forceinline__ void ph0(const Args& a, unsigned char* lds, const int tid) {
    const int lane = tid & 63, wave = tid >> 6;
    const float* c_in = a.in[1]; const float* w_ada = a.in[2]; const float* b_ada = a.in[3];
    float* MOD = (float*)(a.ws + WS_MOD);
    {
        float* sc = (float*)lds; float* red = sc + 4096;
        for (int i = tid; i < 4096; i += 512) sc[i] = siluf(c_in[i]);
        __syncthreads();
        for (int it = blockIdx.x; it < 192; it += gridDim.x) {
            const int cc = tid & 31, ks = tid >> 5, col = it * 32 + cc;
            float a0 = 0.f, a1 = 0.f, a2 = 0.f, a3 = 0.f;
            const float* wp = w_ada + (size_t)(ks * 64) * 6144 + col;
            float wv[64];
#pragma unroll
            for (int k = 0; k < 64; ++k) wv[k] = __builtin_nontemporal_load(wp + (size_t)k * 6144);
#pragma unroll
            for (int k = 0; k < 64; ++k) { const float w = wv[k]; const int kk = ks * 64 + k;
                a0 += sc[kk] * w; a1 += sc[1024 + kk] * w; a2 += sc[2048 + kk] * w; a3 += sc[3072 + kk] * w; }
            float* rp = red + (ks * 32 + cc) * 4; rp[0] = a0; rp[1] = a1; rp[2] = a2; rp[3] = a3;
            __syncthreads();
            if (tid < 128) { const int c2 = tid & 31, b = tid >> 5; float s = 0.f;
                for (int k2 = 0; k2 < 16; ++k2) s += red[(k2 * 32 + c2) * 4 + b];
                MOD[b * 6144 + it * 32 + c2] = s + b_ada[it * 32 + c2]; }
            __syncthreads();
        }
    }
    __syncthreads();
    float* scr = (float*)lds + wave * (64 * 65);
    const int gw = blockIdx.x * 8 + wave, NGW = gridDim.x * 8;
    const float* w_in = a.in[4]; const float* w_out = a.in[16]; const float* w_router = a.in[17];
    const float* w1 = a.in[19]; const float* w3 = a.in[20]; const float* w2 = a.in[21];
    const float* ws1 = a.in[22]; const float* ws3 = a.in[23]; const float* ws2 = a.in[24];
    bf16_t* WIN = (bf16_t*)(a.ws + WS_WIN); bf16_t* WOUT = (bf16_t*)(a.ws + WS_WOUT); bf16_t* WRS = (bf16_t*)(a.ws + WS_WRS);
    unsigned char* W2T8 = (unsigned char*)(a.ws + WS_W2T); unsigned char* W13T8 = (unsigned char*)(a.ws + WS_W13T);
    constexpr int IT_WIN = 56 * 16, IT_WOUT = 16 * 16, IT_WR = 4 * 16, IT_WS13 = 8 * 16, IT_WS2 = 4 * 16, IT_E13 = 256 * 128, IT_E2 = 256 * 64;
    constexpr int NITEMS = IT_WIN + IT_WOUT + IT_WR + IT_WS13 + IT_WS2 + IT_E13 + IT_E2;
    for (int it = gw; it < NITEMS; it += NGW) {
        int r = it;
        if (r < IT_WIN) { const int kb = r / 56, cb = r % 56, c0 = 64 * cb, n0 = c0 + (c0 >= 2048 ? 8 : 0);
            conv_item8(w_in, w_in, DIN, 64 * kb, n0, false, (unsigned char*)WIN, 1024, c0, scr, lane, 64.f); continue; } r -= IT_WIN;
        if (r < IT_WOUT) { const int kb = r / 16, cb = r % 16; conv_item(w_out, w_out, 1024, 64 * kb, 64 * cb, false, WOUT, 1024, 64 * cb, scr, lane); continue; } r -= IT_WOUT;
        if (r < IT_WR) { const int kb = r / 4, cb = r % 4; conv_item(w_router, w_router, 256, 64 * kb, 64 * cb, false, WRS, 1024, 64 * cb, scr, lane); continue; } r -= IT_WR;
        if (r < IT_WS13) { const int kb = r / 8, cb = r % 8; conv_item(ws1, ws3, 256, 64 * kb, 32 * cb, true, WRS + (size_t)256 * 1024, 1024, 64 * cb, scr, lane); continue; } r -= IT_WS13;
        if (r < IT_WS2) { const int kb = r / 16, cb = r % 16; conv_item8(ws2, ws2, 1024, 64 * kb, 64 * cb, false, W2T8 + (size_t)256 * 1024 * 256, 256, 64 * cb, scr, lane, 32.f); continue; } r -= IT_WS2;
        if (r < IT_E13) { const int e = r >> 7, rr = r & 127, kb = rr >> 3, cb = rr & 7;
            conv_item8(w1 + (size_t)e * 1024 * 256, w3 + (size_t)e * 1024 * 256, 256, 64 * kb, 32 * cb, true, W13T8 + (size_t)e * 512 * 1024, 1024, 64 * cb, scr, lane, 64.f); continue; } r -= IT_E13;
        { const int e = r >> 6, rr = r & 63, kb = rr >> 4, cb = rr & 15;
            conv_item8(w2 + (size_t)e * 256 * 1024, w2, 1024, 64 * kb, 64 * cb, false, W2T8 + (size_t)e * 1024 * 256, 256, 64 * cb, scr, lane, 32.f); }
    }
}

template <bool GATES>
__device__ __forceinline__ void ph_norm(const Args& a, unsigned char* lds, const float* X, int mod_shift, int mod_scale, const int tid) {
    const int lane = tid & 63, wave = tid >> 6;
    const float* MOD = (const float*)(a.ws + WS_MOD);
    bf16_t* H = (bf16_t*)(a.ws + WS_H);
    float* wg = (float*)lds;
    if (GATES) {
        const float* w_in = a.in[4];
        for (int i = tid; i < 8192; i += 512) { const int k = i >> 3, g = i & 7; wg[g * 1024 + k] = w_in[(size_t)k * DIN + 2048 + g]; }
        __syncthreads();
    }
    const float* gate_b = a.in[7];
    float* IPRE = (float*)(a.ws + WS_IPRE); float* FPRE = (float*)(a.ws + WS_FPRE);
    const int gw = blockIdx.x * 8 + wave, NGW = gridDim.x * 8;
    for (int row = gw; row < T; row += NGW) {
        const int b = row / SEQ;
        const f32x4* xr = (const f32x4*)(X + (size_t)row * DM) + lane;
        f32x4 v[4]; float ss = 0.f;
#pragma unroll
        for (int j = 0; j < 4; ++j) { v[j] = __builtin_nontemporal_load(xr + 64 * j); ss += (v[j].x * v[j].x + v[j].y * v[j].y) + (v[j].z * v[j].z + v[j].w * v[j].w); }
        const float rstd = rsqrtf(wave_sum(ss) * (1.f / DM) + EPS);
        const f32x4* sh = (const f32x4*)(MOD + b * 6144 + mod_shift * 1024) + lane;
        const f32x4* sc = (const f32x4*)(MOD + b * 6144 + mod_scale * 1024) + lane;
        u32x2* o8 = (u32x2*)(H + (size_t)row * DM) + lane;
#pragma unroll
        for (int j = 0; j < 4; ++j) { const f32x4 s4 = sc[64 * j], h4 = sh[64 * j];
            v[j].x = v[j].x * rstd * (1.f + s4.x) + h4.x; v[j].y = v[j].y * rstd * (1.f + s4.y) + h4.y;
            v[j].z = v[j].z * rstd * (1.f + s4.z) + h4.z; v[j].w = v[j].w * rstd * (1.f + s4.w) + h4.w;
            if (!GATES) { u32x2 p; p.x = pk2(v[j].x, v[j].y); p.y = pk2(v[j].z, v[j].w); o8[64 * j] = p; }
            *((unsigned*)(a.ws + WS_H8 + (size_t)row * DM) + lane + 64 * j) = pk4_fp8(v[j].x, v[j].y, v[j].z, v[j].w); }
        if (GATES) {
            float g[8];
#pragma unroll
            for (int q = 0; q < 8; ++q) { float s = 0.f;
#pragma unroll
                for (int j = 0; j < 4; ++j) { const f32x4 w4 = *((const f32x4*)(wg + q * 1024) + lane + 64 * j);
                    s += (v[j].x * w4.x + v[j].y * w4.y) + (v[j].z * w4.z + v[j].w * w4.w); }
                g[q] = wave_sum(s); }
            if (lane == 0) {
#pragma unroll
                for (int q = 0; q < 4; ++q) { IPRE[(size_t)row * 4 + q] = g[q] + gate_b[q]; FPRE[(size_t)row * 4 + q] = g[4 + q] + gate_b[4 + q]; }
            }
        }
    }
}


namespace pg8 {
#define PG8_LAS __attribute__((address_space(3)))
typedef int i32x4 __attribute__((ext_vector_type(4)));
typedef int i32x8 __attribute__((ext_vector_type(8)));
constexpr int BM = 256, BK = 64, HALF = 128, HTB = HALF * BK * 2;
__device__ __forceinline__ int lds_byte(int r, int c) { const int st = (r >> 4) * 2 + (c >> 5), rr = r & 15, cc = c & 31, ob = rr * 64 + cc * 2; return st * 1024 + (ob ^ (((ob >> 9) & 1) << 5)); }
__device__ __forceinline__ void stage_rc(int b, int& R, int& C) { const int st = b / 1024, sb = b % 1024, swz = sb ^ (((sb >> 9) & 1) << 5); R = (st >> 1) * 16 + swz / 64; C = (st & 1) * 32 + (swz % 64) / 2; }
__device__ __forceinline__ int perm32(int rho) { const int n = rho >> 4, i = rho & 15; return 8 * (i >> 2) + 4 * n + (i & 3); }
struct Unit { const char* A; const char* B; const int* gather; int row0, rend, col0; };

template <bool P16, class RowEpi>
__device__ __forceinline__ void run_epi(const RowEpi& E, const f32x4 (&acc)[2][2][4][2], const Unit& u, int wr, int wc, int fr, int fq) {
#pragma unroll
    for (int ai = 0; ai < 2; ++ai)
#pragma unroll
        for (int m = 0; m < 4; ++m) { const int row = u.row0 + ai * HALF + wr * 64 + m * 16 + fr; const bool valid = row < u.rend;
            if constexpr (P16) { const float v16[16] = {acc[ai][0][m][0][0], acc[ai][0][m][0][1], acc[ai][0][m][0][2], acc[ai][0][m][0][3], acc[ai][0][m][1][0], acc[ai][0][m][1][1], acc[ai][0][m][1][2], acc[ai][0][m][1][3],
                                                 acc[ai][1][m][0][0], acc[ai][1][m][0][1], acc[ai][1][m][0][2], acc[ai][1][m][0][3], acc[ai][1][m][1][0], acc[ai][1][m][1][1], acc[ai][1][m][1][2], acc[ai][1][m][1][3]};
                E.row16(row, valid, u.col0 + 64 * wc + 16 * fq, v16); } else
#pragma unroll
            for (int bj = 0; bj < 2; ++bj) { const int col0 = u.col0 + bj * HALF + wc * 32 + 8 * fq;
                const float v[8] = {acc[ai][bj][m][0][0], acc[ai][bj][m][0][1], acc[ai][bj][m][0][2], acc[ai][bj][m][0][3], acc[ai][bj][m][1][0], acc[ai][bj][m][1][1], acc[ai][bj][m][1][2], acc[ai][bj][m][1][3]};
                E(row, valid, col0, v); } }
}

template <bool GATHER, bool FP8, int SCW, int SCX, bool P16, class RowEpi, class Sched>
__device__ __forceinline__ void gemm_phase(PG8_LAS unsigned char* lds, const int KB, const Sched& S, const RowEpi& E) {
    const int tid = threadIdx.x, wid = __builtin_amdgcn_readfirstlane(tid >> 6), lane = tid & 63, wr = wid >> 2, wc = wid & 3, fr = lane & 15, fq = lane >> 4;
    const int nt = KB / 128;
    int scw_ = SCW, scx_ = SCX; asm volatile("" : "+v"(scw_), "+v"(scx_));
    int Rr[2], Cc[2]; unsigned voffB[2][2];
#pragma unroll
    for (int i = 0; i < 2; ++i) { stage_rc(tid * 16 + i * 8192, Rr[i], Cc[i]);
#pragma unroll
        for (int h = 0; h < 2; ++h) { const int R = Rr[i];
            const int cperm = P16 ? 64 * (R >> 5) + 16 * ((R >> 2) & 3) + 8 * h + 4 * ((R >> 4) & 1) + (R & 3) : h * HALF + (R & ~31) + perm32(R & 31);
            voffB[h][i] = (unsigned)(cperm * KB + Cc[i] * 2); } }
    const size_t kstep = (size_t)(BK * 2);
    const unsigned ldsw = (unsigned)wid * 1024u;
    const int aoff = lds_byte(wr * 64 + fr, fq * 8), boff = lds_byte(wc * 32 + fr, fq * 8);
#define PG8_SA(b, h) (((b) * 2 + (h)) * HTB)
#define PG8_SB(b, h) ((4 + (b) * 2 + (h)) * HTB)
#define PG8_STAGE(bufoff, gbase, voff) do { _Pragma("unroll") for (int _i = 0; _i < 2; ++_i) \
        __builtin_amdgcn_global_load_lds((const unsigned*)((const char*)(gbase) + (voff)[_i]), (PG8_LAS unsigned*)(lds + (bufoff) + ldsw + _i * 8192), 16, 0, 0); } while (0)
#define PG8_LD8(dst, addr) do { const i32x4 lo_ = *(const PG8_LAS i32x4*)(addr), hi_ = *(const PG8_LAS i32x4*)((addr) + 1024); dst = __builtin_shufflevector(lo_, hi_, 0, 1, 2, 3, 4, 5, 6, 7); } while (0)
#define PG8_LDA(dst, b, h) do { _Pragma("unroll") for (int m = 0; m < 4; ++m) PG8_LD8(dst[m], lds + PG8_SA(b, h) + aoff + m * 2048); } while (0)
#define PG8_LDB(dst, b, h) do { _Pragma("unroll") for (int n = 0; n < 2; ++n) PG8_LD8(dst[n], lds + PG8_SB(b, h) + boff + n * 2048); } while (0)
#define PG8_HALF(v, k) __builtin_bit_cast(bf16x8, (k) ? __builtin_shufflevector(v, v, 4, 5, 6, 7) : __builtin_shufflevector(v, v, 0, 1, 2, 3))
#define PG8_MMA(ai, bj, At, Bt) do { __builtin_amdgcn_s_setprio(1); _Pragma("unroll") for (int m = 0; m < 4; ++m) _Pragma("unroll") for (int n = 0; n < 2; ++n) { \
        if (FP8) asm volatile("v_mfma_scale_f32_16x16x128_f8f6f4 %0, %1, %2, %0, %3, %4 op_sel_hi:[0,0,0]" : "+v"(acc[ai][bj][m][n]) : "v"(Bt[n]), "v"(At[m]), "v"(scw_), "v"(scx_)); \
        else { _Pragma("unroll") for (int k = 0; k < 2; ++k) acc[ai][bj][m][n] = __builtin_amdgcn_mfma_f32_16x16x32_bf16(PG8_HALF(Bt[n], k), PG8_HALF(At[m], k), acc[ai][bj][m][n], 0, 0, 0); } } \
        __builtin_amdgcn_s_setprio(0); } while (0)
#define PG8_WAIT_V(n) asm volatile("s_waitcnt vmcnt(" #n ")" ::: "memory")
#define PG8_WAIT_L(n) asm volatile("s_waitcnt lgkmcnt(" #n ")" ::: "memory")
#define PG8_BAR __builtin_amdgcn_s_barrier()
#define PG8_SCHED __builtin_amdgcn_sched_barrier(0)
#define PG8_FILLA(u, v) do { _Pragma("unroll") for (int _h = 0; _h < 2; ++_h) _Pragma("unroll") for (int _i = 0; _i < 2; ++_i) { const int _row = _h * HALF + Rr[_i]; \
        if (GATHER) { const int _ri = (u).row0 + _row; const int _src = (u).gather[_ri < (u).rend ? _ri : (u).row0]; (v)[_h][_i] = (unsigned)(_src * KB + Cc[_i] * 2); } \
        else (v)[_h][_i] = (unsigned)(_row * KB + Cc[_i] * 2); } } while (0)
    Unit cur, nxt; int ui = 0;
    if (!S.next(0, cur)) return;
    f32x4 acc[2][2][4][2];
#pragma unroll
    for (int a = 0; a < 2; ++a)
#pragma unroll
        for (int b = 0; b < 2; ++b)
#pragma unroll
            for (int m = 0; m < 4; ++m)
#pragma unroll
                for (int n = 0; n < 2; ++n) acc[a][b][m][n] = (f32x4){0.f, 0.f, 0.f, 0.f};
    i32x8 At[4], B0[2], B1[2];
    unsigned voffA[2][2], nvoffA[2][2];
    PG8_FILLA(cur, voffA);
    const char* cA = cur.A; const char* cB = cur.B;
    PG8_STAGE(PG8_SB(0, 0), cB, voffB[0]); PG8_STAGE(PG8_SB(0, 1), cB, voffB[1]); PG8_STAGE(PG8_SA(0, 0), cA, voffA[0]); PG8_STAGE(PG8_SA(0, 1), cA, voffA[1]);
    if (wr == 1) PG8_BAR;
    PG8_WAIT_V(2); PG8_BAR;
    PG8_STAGE(PG8_SB(1, 0), cB + kstep, voffB[0]); PG8_STAGE(PG8_SA(1, 0), cA + kstep, voffA[0]); PG8_STAGE(PG8_SB(1, 1), cB + kstep, voffB[1]);
    PG8_WAIT_V(6); PG8_BAR;
    for (;;) {
        const bool has_next = S.next(ui + 1, nxt);
        const char* nA = has_next ? nxt.A : cA; const char* nB = has_next ? nxt.B : cB;
        if (GATHER && has_next) { PG8_FILLA(nxt, nvoffA); }
        else {
#pragma unroll
            for (int h = 0; h < 2; ++h)
#pragma unroll
                for (int i = 0; i < 2; ++i) nvoffA[h][i] = voffA[h][i]; }
        for (int t = 0; t < nt; t += 2) {
            const bool last = (t == nt - 2);
            const char* a1 = cA + (size_t)(t + 1) * kstep;
            const char* a2 = last ? nA : cA + (size_t)(t + 2) * kstep; const char* b2 = last ? nB : cB + (size_t)(t + 2) * kstep;
            const char* a3 = a2 + kstep; const char* b3 = b2 + kstep;
            unsigned v2[2][2];
#pragma unroll
            for (int h = 0; h < 2; ++h)
#pragma unroll
                for (int i = 0; i < 2; ++i) v2[h][i] = last ? nvoffA[h][i] : voffA[h][i];
            PG8_LDB(B0, 0, 0); PG8_LDB(B1, 0, 1); PG8_SCHED; PG8_LDA(At, 0, 0); PG8_STAGE(PG8_SA(1, 1), a1, voffA[1]);
            PG8_WAIT_V(8); PG8_WAIT_L(0); PG8_BAR; PG8_MMA(0, 0, At, B0); PG8_MMA(0, 1, At, B1); PG8_BAR; PG8_SCHED;
            PG8_LDA(At, 0, 1); PG8_STAGE(PG8_SB(0, 0), b2, voffB[0]); PG8_STAGE(PG8_SB(0, 1), b2, voffB[1]); PG8_STAGE(PG8_SA(0, 0), a2, v2[0]);
            PG8_WAIT_V(8); PG8_WAIT_L(0); PG8_BAR; PG8_MMA(1, 0, At, B0); PG8_MMA(1, 1, At, B1); PG8_BAR; PG8_SCHED;
            PG8_LDB(B0, 1, 0); PG8_LDB(B1, 1, 1); PG8_SCHED; PG8_LDA(At, 1, 0); PG8_STAGE(PG8_SA(0, 1), a2, v2[1]);
            PG8_WAIT_V(8); PG8_WAIT_L(0); PG8_BAR; PG8_MMA(0, 0, At, B0); PG8_MMA(0, 1, At, B1); PG8_BAR; PG8_SCHED;
            PG8_LDA(At, 1, 1); PG8_STAGE(PG8_SB(1, 0), b3, voffB[0]); PG8_STAGE(PG8_SB(1, 1), b3, voffB[1]); PG8_STAGE(PG8_SA(1, 0), a3, v2[0]);
            PG8_WAIT_V(8); PG8_WAIT_L(0); PG8_BAR; PG8_MMA(1, 0, At, B0); PG8_MMA(1, 1, At, B1); PG8_BAR; PG8_SCHED;
        }
        if (wr == 0) PG8_BAR;
        if (FP8) { PG8_SCHED; asm volatile("s_nop 15\n\ts_nop 7" ::: "memory"); PG8_SCHED; }
        run_epi<P16>(E, acc, cur, wr, wc, fr, fq);
        if (!has_next) break;
#pragma unroll
        for (int a = 0; a < 2; ++a)
#pragma unroll
            for (int b = 0; b < 2; ++b)
#pragma unroll
                for (int m = 0; m < 4; ++m)
#pragma unroll
                    for (int n = 0; n < 2; ++n) acc[a][b][m][n] = (f32x4){0.f, 0.f, 0.f, 0.f};
        cur = nxt; cA = nA; cB = nB; ++ui;
#pragma unroll
        for (int h = 0; h < 2; ++h)
#pragma unroll
            for (int i = 0; i < 2; ++i) voffA[h][i] = nvoffA[h][i];
        if (wr == 1) PG8_BAR;
    }
    PG8_WAIT_V(0);
    PG8_BAR;
#undef PG8_SA
#undef PG8_SB
#undef PG8_STAGE
#undef PG8_LDA
#undef PG8_LD8
#undef PG8_HALF
#undef PG8_LDB
#undef PG8_MMA
#undef PG8_WAIT_V
#undef PG8_WAIT_L
#undef PG8_BAR
#undef PG8_SCHED
#undef PG8_FILLA
}

struct DenseSched {
    const char* A; const char* Bt; int KB, M, nM, nN, nwg, G, c;
    __device__ __forceinline__ void init(const void* A_, const void* Bt_, int M_, int N_, int KB_, int G_, int c_) { A = (const char*)A_; Bt = (const char*)Bt_; KB = KB_; M = M_; nM = M_ / BM; nN = N_ / BM; nwg = nM * nN; G = G_; c = c_; }
    __device__ __forceinline__ bool next(int i, Unit& u) const {
        const long L = (long)i * G + c; if (L >= nwg) return false;
        int wgid = (int)L; { const int q = nwg / 8, r = nwg % 8, xcd = wgid % 8, off = wgid / 8; wgid = (xcd < r ? xcd * (q + 1) : r * (q + 1) + (xcd - r) * q) + off; }
        const int nig = 8 * nN, gid = wgid / nig, fm = gid * 8, gsz = (nM - fm) < 8 ? (nM - fm) : 8;
        const int pm = fm + ((wgid % nig) % gsz), pn = (wgid % nig) / gsz;
        u.A = A + (size_t)pm * BM * KB; u.B = Bt + (size_t)pn * BM * KB; u.gather = nullptr; u.row0 = pm * BM; u.rend = M; u.col0 = pn * BM; return true;
    }
};
struct ExpertSched {
    const int* TILE; int nunits, NPN; const char* A; const int* gather; const char* Bt; size_t bstride; int KB, G, vcu;
    __device__ __forceinline__ bool next(int i, Unit& u) const {
        const int L = i * G + vcu; if (L >= nunits) return false;
        const int tl = L / NPN, pn = L % NPN;
        const int e = __builtin_amdgcn_readfirstlane(TILE[64 + tl]), r0 = __builtin_amdgcn_readfirstlane(TILE[64 + 2048 + tl]), re = __builtin_amdgcn_readfirstlane(TILE[64 + 4096 + tl]);
        u.B = Bt + (size_t)e * bstride + (size_t)pn * BM * KB; u.row0 = r0; u.rend = re; u.col0 = pn * BM;
        if (gather) { u.A = A; u.gather = gather; } else { u.A = A + (size_t)r0 * KB; u.gather = nullptr; }
        return true;
    }
};
}

struct EpiProj { bf16_t* P;
    __device__ __forceinline__ void operator()(int row, bool valid, int col0, const float (&v)[8]) const { if (valid) *(u32x4*)(P + (size_t)row * NPROJ + col0) = pack8(v); } };
struct EpiOut { const float* x; float* x1; const float* MOD;
    __device__ __forceinline__ void operator()(int row, bool valid, int col0, const float (&v)[8]) const {
        if (!valid) return; const int b = row / SEQ; const float* ga = MOD + b * 6144 + 2 * 1024 + col0;
        const f32x4 x0 = __builtin_nontemporal_load((const f32x4*)(x + (size_t)row * DM + col0)), x1v = __builtin_nontemporal_load((const f32x4*)(x + (size_t)row * DM + col0 + 4));
        f32x4 o0, o1; o0.x = x0.x + ga[0] * v[0]; o0.y = x0.y + ga[1] * v[1]; o0.z = x0.z + ga[2] * v[2]; o0.w = x0.w + ga[3] * v[3];
        o1.x = x1v.x + ga[4] * v[4]; o1.y = x1v.y + ga[5] * v[5]; o1.z = x1v.z + ga[6] * v[6]; o1.w = x1v.w + ga[7] * v[7];
        *(f32x4*)(x1 + (size_t)row * DM + col0) = o0; *(f32x4*)(x1 + (size_t)row * DM + col0 + 4) = o1; } };
struct EpiRS { float* LOG; bf16_t* ACT;
    __device__ __forceinline__ void operator()(int row, bool valid, int col0, const float (&v)[8]) const {
        if (!valid) return;
        if (col0 < 256) { *(f32x4*)(LOG + (size_t)row * 256 + col0) = (f32x4){v[0], v[1], v[2], v[3]}; *(f32x4*)(LOG + (size_t)row * 256 + col0 + 4) = (f32x4){v[4], v[5], v[6], v[7]}; }
        else { const int j0 = (col0 - 256) >> 1;
            *(unsigned*)((unsigned char*)ACT + (size_t)(SHARED_BASE + row) * 256 + j0) = pk4_fp8(8.f * siluf(v[0]) * v[4], 8.f * siluf(v[1]) * v[5], 8.f * siluf(v[2]) * v[6], 8.f * siluf(v[3]) * v[7]); } } };
struct EpiG1 { const float* SG; bf16_t* ACT;
    __device__ __forceinline__ void operator()(int row, bool valid, int col0, const float (&v)[8]) const {
        if (!valid) return; const float g = 8.f * SG[row]; const int j0 = col0 >> 1;
        *(unsigned*)((unsigned char*)ACT + (size_t)row * 256 + j0) = pk4_fp8(siluf(v[0]) * v[4] * g, siluf(v[1]) * v[5] * g, siluf(v[2]) * v[6] * g, siluf(v[3]) * v[7] * g); } };
struct EpiG2 { bf16_t* YP;
    __device__ __forceinline__ void operator()(int row, bool valid, int col0, const float (&v)[8]) const { if (valid) { u32x2 p; p.x = pk4_fp8(16.f * v[0], 16.f * v[1], 16.f * v[2], 16.f * v[3]); p.y = pk4_fp8(16.f * v[4], 16.f * v[5], 16.f * v[6], 16.f * v[7]);
            *(u32x2*)((unsigned char*)YP + (size_t)row * DM + col0) = p; } }
    __device__ __forceinline__ void row16(int row, bool valid, int col0, const float (&v)[16]) const { if (valid) { u32x4 p;
            p.x = pk4_fp8(16.f * v[0], 16.f * v[1], 16.f * v[2], 16.f * v[3]); p.y = pk4_fp8(16.f * v[4], 16.f * v[5], 16.f * v[6], 16.f * v[7]);
            p.z = pk4_fp8(16.f * v[8], 16.f * v[9], 16.f * v[10], 16.f * v[11]); p.w = pk4_fp8(16.f * v[12], 16.f * v[13], 16.f * v[14], 16.f * v[15]);
            __builtin_nontemporal_store(p, (u32x4*)((unsigned char*)YP + (size_t)row * DM + col0)); } } };

constexpr int LR = 136;
__device__ __forceinline__ f32x4 mfma16(bf16x8 a, bf16x8 b, f32x4 c) {
    asm volatile("s_nop 1\n\tv_mfma_f32_16x16x32_bf16 %0, %1, %2, %0" : "+v"(c) : "v"(a), "v"(b)); return c; }
#define MFMA_DRAIN8(x) asm volatile("s_nop 15\n\ts_nop 3" : "+v"(x[0]), "+v"(x[1]), "+v"(x[2]), "+v"(x[3]), "+v"(x[4]), "+v"(x[5]), "+v"(x[6]), "+v"(x[7]))
__device__ __forceinline__ bf16x8 ldfrag(const bf16_t* base, int row, int k0, int lane) { return *(const bf16x8*)(base + (row + (lane & 15)) * LR + k0 + 8 * (lane >> 4)); }


__device__ __forceinline__ void conv8_lds(const bf16_t* R, int pitch, int s, int col, const float* cw, int wpitch, const float* cb, int ch, float (&o)[8]) {
    float acc[8];
    { const f32x4 b0 = *(const f32x4*)(cb + ch), b1 = *(const f32x4*)(cb + ch + 4); acc[0] = b0.x; acc[1] = b0.y; acc[2] = b0.z; acc[3] = b0.w; acc[4] = b1.x; acc[5] = b1.y; acc[6] = b1.z; acc[7] = b1.w; }
#pragma unroll
    for (int j = 0; j < 4; ++j) { float x[8]; unpack8(*(const u32x4*)(R + (s + j) * pitch + col), x);
        const f32x4 w0 = *(const f32x4*)(cw + j * wpitch + ch), w1 = *(const f32x4*)(cw + j * wpitch + ch + 4);
        acc[0] += w0.x * x[0]; acc[1] += w0.y * x[1]; acc[2] += w0.z * x[2]; acc[3] += w0.w * x[3];
        acc[4] += w1.x * x[4]; acc[5] += w1.y * x[5]; acc[6] += w1.z * x[6]; acc[7] += w1.w * x[7]; }
#pragma unroll
    for (int q = 0; q < 8; ++q) o[q] = siluf(acc[q]);
}
__device__ __forceinline__ void chunk_gates(const Args& a, float* bb, float* ii, float* tmp, int t0, int h, int tid) {
    const float* IPRE = (const float*)(a.ws + WS_IPRE); const float* FPRE = (const float*)(a.ws + WS_FPRE);
    if (tid < 128) { const float f = FPRE[(size_t)(t0 + tid) * 4 + h]; ii[tid] = IPRE[(size_t)(t0 + tid) * 4 + h];
        tmp[tid] = fminf(f, 0.f) - log1pf(expf(-fabsf(f))); }
    __syncthreads();
    if (tid < 128) { float s = 0.f;
#pragma unroll 4
        for (int j4 = 0; j4 < 32; ++j4) { const f32x4 v = *(const f32x4*)(tmp + 4 * j4); const int j = 4 * j4;
            s += (j <= tid ? v.x : 0.f); s += (j + 1 <= tid ? v.y : 0.f); s += (j + 2 <= tid ? v.z : 0.f); s += (j + 3 <= tid ? v.w : 0.f); }
        bb[tid] = s; }
    __syncthreads();
}

__device__ __forceinline__ void mlstm_m1_unit(const Args& a, unsigned char* lds, int unit, const int wave_s) {
    const int tid = mk_tid(wave_s);
    const int lane = tid & 63, wave = tid >> 6;
    const int bh = unit >> 6, c = unit & 63, b = bh >> 2, h = bh & 3, t0 = b * SEQ + c * 128;
    bf16_t* kT = (bf16_t*)lds; bf16_t* vT = kT + 128 * LR;
    float* sf = (float*)(lds + 2 * 128 * LR * 2); float* bb = sf; float* ii = sf + 128; float* tmp = sf + 256; float* wk = sf + 384;
    const bf16_t* PROJ = (const bf16_t*)(a.ws + WS_PROJ);
    const float* cw = a.in[5]; const float* cbias = a.in[6];
    bf16_t* R = (bf16_t*)(lds + 2 * 128 * LR * 2 + 2048);
    const int tl = tid;
    u32x4 rawk[5], vreg[4];
#pragma unroll
    for (int k = 0; k < 5; ++k) { const int idx = tl + 512 * k, row = idx >> 4, chunk = idx & 15; const int sp = c * 128 - 3 + row;
        rawk[k] = (u32x4){0u, 0u, 0u, 0u};
        if (idx < 131 * 16 && sp >= 0) rawk[k] = *(const u32x4*)(PROJ + (size_t)(b * SEQ + sp) * NPROJ + 512 + h * 128 + 8 * chunk); }
#pragma unroll
    for (int k = 0; k < 4; ++k) { const int it = tl + 512 * k, sidx = it & 127, ch = it >> 7; vreg[k] = *(const u32x4*)(PROJ + (size_t)(t0 + sidx) * NPROJ + 1024 + h * 128 + 8 * ch); }
    float* WL = (float*)(lds + 147456);
    float wl0 = 0.f, wl1 = 0.f; if (tl < 512) wl0 = cw[(tl >> 7) * 1024 + 512 + h * 128 + (tl & 127)]; if (tl < 128) wl1 = cbias[512 + h * 128 + tl];
    chunk_gates(a, bb, ii, tmp, t0, h, tid);
    if (tl < 512) WL[tl] = wl0; if (tl < 128) WL[512 + tl] = wl1;
#pragma unroll
    for (int k = 0; k < 5; ++k) { const int idx = tl + 512 * k; if (idx < 131 * 16) *(u32x4*)(R + (idx >> 4) * 136 + 8 * (idx & 15)) = rawk[k]; }
    const float blast = bb[127];
    if (tid < 128) tmp[tid] = blast - bb[tid] + ii[tid];
    __syncthreads();
    float mloc = -INFINITY;
#pragma unroll 4
    for (int j4 = 0; j4 < 32; ++j4) { const f32x4 v = *(const f32x4*)(tmp + 4 * j4); mloc = fmaxf(fmaxf(mloc, fmaxf(v.x, v.y)), fmaxf(v.z, v.w)); }
    if (tid < 128) wk[tid] = expf(tmp[tid] - mloc);
    __syncthreads();
#pragma unroll
    for (int k = 0; k < 4; ++k) { const int it = tl + 512 * k, sidx = it & 127, ch = it >> 7;
        float kv[8]; conv8_lds(R, 136, sidx, 8 * ch, WL, 128, WL + 512, 8 * ch, kv);
        const float sc = 0.08838834764831845f * wk[sidx];
#pragma unroll
        for (int q = 0; q < 8; ++q) kT[(8 * ch + q) * LR + sidx] = (bf16_t)f2bf(kv[q] * sc);
        float vv[8]; unpack8(vreg[k], vv);
#pragma unroll
        for (int q = 0; q < 8; ++q) vT[(8 * ch + q) * LR + sidx] = (bf16_t)f2bf(vv[q]);
    }
    __syncthreads();
    float* CLOC = (float*)(a.ws + WS_CLOC) + (size_t)unit * 16384;
    float* MST = (float*)(a.ws + WS_MST);
    {
        f32x4 acc[8];
#pragma unroll
        for (int i = 0; i < 8; ++i) acc[i] = (f32x4){0.f, 0.f, 0.f, 0.f};
#pragma unroll
        for (int ks = 0; ks < 4; ++ks) { const bf16x8 af = ldfrag(vT, 16 * wave, 32 * ks, lane);
#pragma unroll
            for (int db = 0; db < 8; ++db) acc[db] = mfma16(af, ldfrag(kT, 16 * db, 32 * ks, lane), acc[db]); }
        MFMA_DRAIN8(acc);
#pragma unroll
        for (int db = 0; db < 8; ++db)
#pragma unroll
            for (int r = 0; r < 4; ++r) CLOC[(16 * wave + 4 * (lane >> 4) + r) * 128 + 16 * db + (lane & 15)] = acc[db][r];
    }
    if (tid < 128) { float s = 0.f;
#pragma unroll 4
        for (int j8 = 0; j8 < 16; ++j8) { float x[8]; unpack8(*(const u32x4*)(kT + tid * LR + 8 * j8), x); s += ((x[0] + x[1]) + (x[2] + x[3])) + ((x[4] + x[5]) + (x[6] + x[7])); }
        MST[16384 + (size_t)unit * 128 + tid] = s; }
    if (tid == 0) { MST[unit] = mloc; MST[1024 + unit] = blast; }
    __syncthreads();
}

__device__ __forceinline__ void mlstm_m2(const Args& a, const int tid2) {
    const float* CLOC = (const float*)(a.ws + WS_CLOC); bf16_t* CIN = (bf16_t*)(a.ws + WS_CIN);
    float* MST = (float*)(a.ws + WS_MST);
    const float* NLOC = MST + 16384; float* NIN = MST + 16384 + 131072;
    for (int gid = blockIdx.x * 512 + tid2; gid < 16 * 8192; gid += gridDim.x * 512) {
        const int bh = gid >> 13, e2 = gid & 8191; const bool hasn = e2 < 128;
        const float* cl = CLOC + (size_t)(bh * 64) * 16384 + e2; const float* nl = NLOC + (size_t)(bh * 64) * 128 + e2;
        bf16_t* ci = CIN + (size_t)(bh * 64) * 16384 + e2; float* ni = NIN + (size_t)(bh * 64) * 128 + e2;
        const float* mlp = MST + bh * 64; const float* blp = MST + 1024 + bh * 64;
        float s0 = 0.f, s1 = 0.f, sn = 0.f, m = 0.f;
        float p0[4], p1[4], pn[4], pm[4], pb[4];
#pragma unroll
        for (int k = 0; k < 4; ++k) { p0[k] = __builtin_nontemporal_load(cl + (size_t)k * 16384); p1[k] = __builtin_nontemporal_load(cl + (size_t)k * 16384 + 8192); pn[k] = hasn ? nl[k * 128] : 0.f; pm[k] = mlp[k]; pb[k] = blp[k]; }
        for (int c0 = 0; c0 < 64; c0 += 4) {
            float q0[4], q1[4], qn[4], qm[4], qb[4];
            const bool more = c0 + 4 < 64;
#pragma unroll
            for (int k = 0; k < 4; ++k) { const int c = more ? c0 + 4 + k : c0 + k;
                q0[k] = __builtin_nontemporal_load(cl + (size_t)c * 16384); q1[k] = __builtin_nontemporal_load(cl + (size_t)c * 16384 + 8192); qn[k] = hasn ? nl[c * 128] : 0.f; qm[k] = mlp[c]; qb[k] = blp[c]; }
#pragma unroll
            for (int k = 0; k < 4; ++k) { const int c = c0 + k;
                ci[(size_t)c * 16384] = (bf16_t)f2bf(s0); ci[(size_t)c * 16384 + 8192] = (bf16_t)f2bf(s1);
                if (hasn) ni[c * 128] = sn;
                if (e2 == 0) MST[2048 + bh * 64 + c] = m;
                const float ml = pm[k], bl = pb[k];
                const float mn = fmaxf(bl + m, ml), ca = expf(bl + m - mn), cb = expf(ml - mn);
                s0 = ca * s0 + cb * p0[k]; s1 = ca * s1 + cb * p1[k]; sn = ca * sn + cb * pn[k]; m = mn; }
#pragma unroll
            for (int k = 0; k < 4; ++k) { p0[k] = q0[k]; p1[k] = q1[k]; pn[k] = qn[k]; pm[k] = qm[k]; pb[k] = qb[k]; }
        }
    }
}

template <int MODE>
__device__ __forceinline__ void mlstm_m3_unit(const Args& a, unsigned char* lds, int unit, const int wave_s) {
    const int tid = mk_tid(wave_s);
    const int lane = tid & 63, wave = tid >> 6;
    const int bh = unit >> 6, c = unit & 63, b = bh >> 2, h = bh & 3, t0 = b * SEQ + c * 128;
    bf16_t* qs = (bf16_t*)lds; bf16_t* ks = qs + 128 * LR; bf16_t* vT = ks + 128 * LR; bf16_t* CT = vT + 128 * LR; bf16_t* Ps = ks;
    float* sf = (float*)(lds + 4 * 128 * LR * 2);
    float* bb = sf; float* ii = sf + 128; float* tmp = sf + 256; float* gg = sf + 384; float* wint = sf + 512; float* nn = sf + 640; float* den = sf + 768; float* dint = sf + 896;
    const bf16_t* PROJ = (const bf16_t*)(a.ws + WS_PROJ); const bf16_t* CIN = (const bf16_t*)(a.ws + WS_CIN) + (size_t)unit * 16384;
    const float* MST = (const float*)(a.ws + WS_MST);
    const float* cw = a.in[5]; const float* cbias = a.in[6]; const float* mlg = a.in[8];
    bf16_t* MIX = (bf16_t*)(a.ws + WS_MIX);
    bf16_t* R = vT;
    const float m_in = MST[2048 + unit];
    const int tl = tid;
    u32x4 rawq[9], vreg[4], creg[4];
#pragma unroll
    for (int k = 0; k < 9; ++k) { const int idx = tl + 512 * k, row = idx >> 5, chunk = idx & 31; const int sp = c * 128 - 3 + row;
        rawq[k] = (u32x4){0u, 0u, 0u, 0u};
        if (idx < 131 * 32 && sp >= 0) rawq[k] = *(const u32x4*)(PROJ + (size_t)(b * SEQ + sp) * NPROJ + (chunk < 16 ? h * 128 + 8 * chunk : 512 + h * 128 + 8 * (chunk - 16))); }
#pragma unroll
    for (int k = 0; k < 4; ++k) { const int it = tl + 512 * k, sidx = it & 127, ch = it >> 7, s2 = it >> 4, c2 = it & 15;
        vreg[k] = *(const u32x4*)(PROJ + (size_t)(t0 + sidx) * NPROJ + 1024 + h * 128 + 8 * ch); creg[k] = *(const u32x4*)(CIN + s2 * 128 + 8 * c2); }
    float* WL = (float*)(lds + 147456);
    const float wl0 = cw[(tl >> 7) * 1024 + h * 128 + (tl & 127)], wl1 = cw[(tl >> 7) * 1024 + 512 + h * 128 + (tl & 127)]; float wl2 = 0.f; if (tl < 256) wl2 = cbias[(tl >> 7) * 512 + h * 128 + (tl & 127)];
    chunk_gates(a, bb, ii, tmp, t0, h, tid);
    WL[tl] = wl0; WL[512 + tl] = wl1; if (tl < 256) WL[1024 + tl] = wl2;
#pragma unroll
    for (int k = 0; k < 9; ++k) { const int idx = tl + 512 * k; if (idx < 131 * 32) *(u32x4*)(R + (idx >> 5) * 264 + 8 * (idx & 31)) = rawq[k]; }
    if (tid < 128) { float pm = -INFINITY;
#pragma unroll 4
        for (int j4 = 0; j4 < 32; ++j4) { const f32x4 vi = *(const f32x4*)(ii + 4 * j4), vb = *(const f32x4*)(bb + 4 * j4); const int j = 4 * j4;
            pm = fmaxf(pm, j <= tl ? vi.x - vb.x : -INFINITY); pm = fmaxf(pm, j + 1 <= tl ? vi.y - vb.y : -INFINITY);
            pm = fmaxf(pm, j + 2 <= tl ? vi.z - vb.z : -INFINITY); pm = fmaxf(pm, j + 3 <= tl ? vi.w - vb.w : -INFINITY); }
        const float g = fmaxf(m_in, pm); gg[tl] = g; wint[tl] = expf(m_in - g); tmp[tl] = ii[tl] - bb[tl];
        nn[tl] = MST[16384 + 131072 + (size_t)unit * 128 + tl]; }
    __syncthreads();
#pragma unroll 1
    for (int k = 0; k < 4; ++k) { const int it = tl + 512 * k, sidx = it & 127, ch = it >> 7;
        float qv[8], kv[8];
        conv8_lds(R, 264, sidx, 8 * ch, WL, 128, WL + 1024, 8 * ch, qv);
        conv8_lds(R, 264, sidx, 128 + 8 * ch, WL + 512, 128, WL + 1152, 8 * ch, kv);
#pragma unroll
        for (int q = 0; q < 8; ++q) kv[q] *= 0.08838834764831845f;
        *(u32x4*)(qs + sidx * LR + 8 * ch) = pack8(qv);
        *(u32x4*)(ks + sidx * LR + 8 * ch) = pack8(kv); }
    __syncthreads();
#pragma unroll
    for (int k = 0; k < 4; ++k) { const int it = tl + 512 * k, sidx = it & 127, ch = it >> 7, s2 = it >> 4, c2 = it & 15;
        float vv[8]; unpack8(vreg[k], vv);
#pragma unroll
        for (int q = 0; q < 8; ++q) vT[(8 * ch + q) * LR + sidx] = (bf16_t)f2bf(vv[q]);
        *(u32x4*)(CT + s2 * LR + 8 * c2) = creg[k]; }
    __syncthreads();
    if (MODE == 1) return;
    if (tid < 128) { float s = 0.f;
#pragma unroll 4
        for (int d8 = 0; d8 < 16; ++d8) { float x[8]; unpack8(*(const u32x4*)(qs + tl * LR + 8 * d8), x); const f32x4 n0 = *(const f32x4*)(nn + 8 * d8), n1 = *(const f32x4*)(nn + 8 * d8 + 4);
            s += (x[0] * n0.x + x[1] * n0.y) + (x[2] * n0.z + x[3] * n0.w) + (x[4] * n1.x + x[5] * n1.y) + (x[6] * n1.z + x[7] * n1.w); }
        dint[tl] = s * wint[tl]; }
    f32x4 sacc[8];
#pragma unroll
    for (int i = 0; i < 8; ++i) sacc[i] = (f32x4){0.f, 0.f, 0.f, 0.f};
#pragma unroll
    for (int kk = 0; kk < 4; ++kk) { const bf16x8 bq = ldfrag(qs, 16 * wave, 32 * kk, lane);
#pragma unroll
        for (int sb = 0; sb < 8; ++sb) sacc[sb] = mfma16(ldfrag(ks, 16 * sb, 32 * kk, lane), bq, sacc[sb]); }
    MFMA_DRAIN8(sacc);
    __syncthreads();
    {
        const int t = 16 * wave + (lane & 15); const float g = gg[t]; float rs = 0.f;
#pragma unroll
        for (int sb = 0; sb < 8; ++sb) { float p[4];
            const f32x4 u4 = *(const f32x4*)(tmp + 16 * sb + 4 * (lane >> 4));
#pragma unroll
            for (int r = 0; r < 4; ++r) { const int s = 16 * sb + 4 * (lane >> 4) + r;
                const float w = __builtin_amdgcn_exp2f(fminf(u4[r] - g, 0.f) * LOG2E);
                p[r] = (s <= t) ? sacc[sb][r] * w : 0.f; rs += p[r]; }
            u32x2 w; w.x = pk2(p[0], p[1]); w.y = pk2(p[2], p[3]);
            *(u32x2*)(Ps + t * LR + 16 * sb + 4 * (lane >> 4)) = w; }
        rs += __shfl_xor(rs, 16); rs += __shfl_xor(rs, 32);
        if (lane < 16) den[t] = rs + dint[t];
    }
    __syncthreads();
    if (MODE == 2) return;
    {
        f32x4 a1[8], a2[8];
#pragma unroll
        for (int i = 0; i < 8; ++i) { a1[i] = (f32x4){0.f, 0.f, 0.f, 0.f}; a2[i] = (f32x4){0.f, 0.f, 0.f, 0.f}; }
#pragma unroll
        for (int kk = 0; kk < 4; ++kk) { const bf16x8 ap = ldfrag(Ps, 16 * wave, 32 * kk, lane), aq = ldfrag(qs, 16 * wave, 32 * kk, lane);
#pragma unroll
            for (int eb = 0; eb < 8; ++eb) { a1[eb] = mfma16(ap, ldfrag(vT, 16 * eb, 32 * kk, lane), a1[eb]); a2[eb] = mfma16(aq, ldfrag(CT, 16 * eb, 32 * kk, lane), a2[eb]); } }
        MFMA_DRAIN8(a1); MFMA_DRAIN8(a2);
        float hv[8][4]; float ssq[4];
#pragma unroll
        for (int r = 0; r < 4; ++r) { const int t = 16 * wave + 4 * (lane >> 4) + r;
            const float dd = fmaxf(fabsf(den[t]), expf(-(bb[t] + gg[t]))); const float inv = 1.f / dd, wi = wint[t]; float s2 = 0.f;
#pragma unroll
            for (int eb = 0; eb < 8; ++eb) { const float x = (a1[eb][r] + wi * a2[eb][r]) * inv; hv[eb][r] = x; s2 += x * x;
            }
            s2 += __shfl_xor(s2, 1); s2 += __shfl_xor(s2, 2); s2 += __shfl_xor(s2, 4); s2 += __shfl_xor(s2, 8);
            ssq[r] = rsqrtf(s2 * (1.f / 128.f) + EPS); }
        float mov[8][4];
#pragma unroll
        for (int eb = 0; eb < 8; ++eb)
#pragma unroll
            for (int r = 0; r < 4; ++r) mov[eb][r] = bflo(PROJ[(size_t)(t0 + 16 * wave + 4 * (lane >> 4) + r) * NPROJ + 1536 + h * 128 + 16 * eb + (lane & 15)]);
#pragma unroll
        for (int eb = 0; eb < 8; ++eb) { const int e = 16 * eb + (lane & 15); const float ge = mlg[e];
#pragma unroll
            for (int r = 0; r < 4; ++r) { const int t = 16 * wave + 4 * (lane >> 4) + r;
                const float outv = hv[eb][r] * ssq[r] * ge * sigm(mov[eb][r]);
                if (MODE == 0) MIX[(size_t)(t0 + t) * DM + h * 128 + e] = (bf16_t)f2bf(outv); else asm volatile("" :: "v"(outv)); } }
    }
    __syncthreads();
}

__device__ __forceinline__ void qknorm_rows(const Args& a, const int tid) {
    const int lane = tid & 63, wave = tid >> 6;
    bf16_t* PROJ = (bf16_t*)(a.ws + WS_PROJ);
    const float* gq = a.in[9]; const float* gk = a.in[10];
    const float* g = (lane < 32) ? gq : gk; const float scl = (lane < 32) ? C2 : 1.f;
    float gv[16];
#pragma unroll
    for (int i = 0; i < 16; ++i) gv[i] = g[16 * (lane & 3) + i] * scl;
    const int gw = blockIdx.x * 8 + wave, NGW = gridDim.x * 8;
    for (int row = gw; row < T; row += NGW) {
        u32x4* p = (u32x4*)(PROJ + (size_t)row * NPROJ + 2048 + 16 * lane);
        float x[16]; { float t8[8]; unpack8(p[0], t8);
#pragma unroll
            for (int i = 0; i < 8; ++i) x[i] = t8[i]; unpack8(p[1], t8);
#pragma unroll
            for (int i = 0; i < 8; ++i) x[8 + i] = t8[i]; }
        float ss = 0.f;
#pragma unroll
        for (int i = 0; i < 16; ++i) ss += x[i] * x[i];
        ss += __shfl_xor(ss, 1); ss += __shfl_xor(ss, 2);
        const float rstd = rsqrtf(ss * (1.f / 64.f) + EPS);
        float y0[8], y1[8];
#pragma unroll
        for (int i = 0; i < 8; ++i) { y0[i] = x[i] * rstd * gv[i]; y1[i] = x[8 + i] * rstd * gv[8 + i]; }
        p[0] = pack8(y0); p[1] = pack8(y1);
    }
}

#include <hip/hip_bf16.h>
namespace attn_body {
using bf16=__hip_bfloat16;
using bf16x8=__attribute__((ext_vector_type(8)))short;
using s16x4=__attribute__((ext_vector_type(4)))short;
using f32x16=__attribute__((ext_vector_type(16)))float;
using u32x4=__attribute__((ext_vector_type(4)))unsigned;
constexpr int SEQ=8192,PQ=3584,KVBLK=64;
__device__ __forceinline__ int crow(int r,int hi){return (r&3)+8*(r>>2)+4*hi;}
#define SBAR() __builtin_amdgcn_sched_barrier(0)
__device__ __forceinline__ void cmask(f32x16&p0,f32x16&p1,int jb,int qrel,int hi){
  const float NEG=-INFINITY; int kb=64*jb+4*hi;
  #pragma unroll
  for(int r=0;r<16;++r){int kv=kb+(r&3)+8*(r>>2); if(kv>qrel)p0[r]=NEG; if(kv+32>qrel)p1[r]=NEG;}
}

__device__ __forceinline__ void glds16(const void*gsrc,unsigned lds_dst){unsigned keep;
  asm volatile("s_mov_b32 %0, m0\n\ts_mov_b32 m0, %2\n\ts_nop 0\n\tglobal_load_lds_dwordx4 %1, off\n\ts_mov_b32 m0, %0":"=&s"(keep):"v"(gsrc),"s"(lds_dst):"memory");}
typedef float f32x2_t __attribute__((ext_vector_type(2))); typedef __bf16 bf16x2_t __attribute__((ext_vector_type(2)));
__device__ __forceinline__ unsigned cvtpk_s(float lo,float hi){f32x2_t v={lo,hi};bf16x2_t b=__builtin_convertvector(v,bf16x2_t);return __builtin_bit_cast(unsigned,b);}

__device__ __forceinline__ void qkt(f32x16&p0,f32x16&p1,const char*Kslot,const bf16x8*qr,const f32x16&negm,int r32,int hi){
  const char*kb=Kslot+hi*1024+r32*16;
  #pragma unroll
  for(int d0=0;d0<4;++d0){
    const bf16x8 b0=*reinterpret_cast<const bf16x8*>(kb+d0*2048);
    const bf16x8 b1=*reinterpret_cast<const bf16x8*>(kb+d0*2048+512);
    if(d0==0){p0=__builtin_amdgcn_mfma_f32_32x32x16_bf16(b0,qr[0],negm,0,0,0);p1=__builtin_amdgcn_mfma_f32_32x32x16_bf16(b1,qr[0],negm,0,0,0);}
    else{p0=__builtin_amdgcn_mfma_f32_32x32x16_bf16(b0,qr[d0],p0,0,0,0);p1=__builtin_amdgcn_mfma_f32_32x32x16_bf16(b1,qr[d0],p1,0,0,0);}}
}

__device__ __forceinline__ void pv4(f32x16*o,int vb,bf16x8 pa0,bf16x8 pa1,bf16x8 pa2,bf16x8 pa3){
  s16x4 la[4],ha[4],lb[4],hb[4];
  #define PV_READ(L,H,OFF) do{ _Pragma("unroll") for(int ks=0;ks<4;++ks){ \
      asm volatile("ds_read_b64_tr_b16 %0,%1 offset:%c2":"=&v"(L[ks]):"v"(vb),"i"((OFF)+ks*1024):"memory"); \
      asm volatile("ds_read_b64_tr_b16 %0,%1 offset:%c2":"=&v"(H[ks]):"v"(vb),"i"((OFF)+ks*1024+512):"memory"); } }while(0)
  #define PV_PK(L,H,k) (bf16x8){L[k][0],L[k][1],L[k][2],L[k][3],H[k][0],H[k][1],H[k][2],H[k][3]}
  #define PV_MMA(dst,L,H) do{ dst=__builtin_amdgcn_mfma_f32_32x32x16_bf16(pa0,PV_PK(L,H,0),dst,0,0,0); dst=__builtin_amdgcn_mfma_f32_32x32x16_bf16(pa1,PV_PK(L,H,1),dst,0,0,0); \
      dst=__builtin_amdgcn_mfma_f32_32x32x16_bf16(pa2,PV_PK(L,H,2),dst,0,0,0); dst=__builtin_amdgcn_mfma_f32_32x32x16_bf16(pa3,PV_PK(L,H,3),dst,0,0,0); }while(0)
  PV_READ(la,ha,0); PV_READ(lb,hb,4096);
  asm volatile("s_waitcnt lgkmcnt(8)":::"memory");SBAR(); PV_MMA(o[0],la,ha); SBAR();
  PV_READ(la,ha,8192);
  asm volatile("s_waitcnt lgkmcnt(8)":::"memory");SBAR(); PV_MMA(o[1],lb,hb); SBAR();
  PV_READ(lb,hb,12288);
  asm volatile("s_waitcnt lgkmcnt(8)":::"memory");SBAR(); PV_MMA(o[2],la,ha); SBAR();
  asm volatile("s_waitcnt lgkmcnt(0)":::"memory");SBAR(); PV_MMA(o[3],lb,hb); SBAR();
  #undef PV_READ
  #undef PV_PK
  #undef PV_MMA
}

constexpr int A2_SLOT=32768, A2_NS=4, A2_K=0, A2_V=16384, A2_WS=131072, A2_STG=65536;
__device__ __forceinline__ void attn2_unit(const bf16*PROJ,const float*dg,bf16_t*MIX,char*shm,int bh,int qb,const float lam,const float m0){
  const int tid=threadIdx.x,lane=tid&63,r32=lane&31,hi=lane>>5; const int wid=__builtin_amdgcn_readfirstlane(tid>>6);
  const int c=wid&1,qblk=wid>>1,b=bh>>2,h=bh&3; const long rowbase=(long)b*SEQ; const int q0=qb*128;
  const float sl2=exp2f(-2.f*(float)(h+1))*1.4426950408889634f;
  int tbeg=0; { const float kmin=(float)q0-(2.f*m0+40.f)/sl2; if(kmin>0.f)tbeg=((int)kmin)>>6; }
  const int NT=(q0+128)/KVBLK-tbeg;
  const bf16*Qw=PROJ+(rowbase+q0+qblk*32)*PQ+2048+h*128+c*64;
  const bf16*ksrc=PROJ+(rowbase+(long)tbeg*KVBLK+lane)*PQ+2560+h*128+wid*8;
  const bf16*vsrc=PROJ+(rowbase+(long)tbeg*KVBLK+16*(wid&3)+(lane>>2))*PQ+3072+h*128+(wid>>2)*32+(lane&3)*8;
  const unsigned lds0=(unsigned)(uintptr_t)shm;
  const unsigned kdst=lds0+A2_K+wid*1024, vdst=lds0+A2_V+wid*1024;
  #define A2_DMA(t,s) do{ const bf16*kp_=ksrc+(long)(t)*KVBLK*PQ; const bf16*vp_=vsrc+(long)(t)*KVBLK*PQ; const unsigned so_=(unsigned)(s)*A2_SLOT; \
      glds16(kp_,(unsigned)__builtin_amdgcn_readfirstlane(kdst+so_)); glds16(kp_+64,(unsigned)__builtin_amdgcn_readfirstlane(kdst+so_+8192)); \
      glds16(vp_,(unsigned)__builtin_amdgcn_readfirstlane(vdst+so_)); glds16(vp_+64,(unsigned)__builtin_amdgcn_readfirstlane(vdst+so_+8192)); }while(0)
  A2_DMA(0,0); if(NT>1)A2_DMA(1,1); if(NT>2)A2_DMA(2,2);
  bf16x8 qr[4];
  #pragma unroll
  for(int d0=0;d0<4;++d0)qr[d0]=*reinterpret_cast<const bf16x8*>(&Qw[(long)r32*PQ+d0*16+hi*8]);
  const int qrel=qblk*32+r32;
  const float sl64=sl2*64.f,c32=sl2*32.f;
  float l_reg=0.f; f32x16 o[4]; o[0]=f32x16{};o[1]=f32x16{};o[2]=f32x16{};o[3]=f32x16{}; f32x16 negm;
  { const float nb0=sl2*(float)(4*hi+64*tbeg-q0-qrel)-m0;
    #pragma unroll
    for(int r=0;r<16;++r)negm[r]=__builtin_fmaf(sl2,(float)((r&3)+8*(r>>2)),nb0); }
  const int vb0=(int)(lds0+A2_V)+((lane>>4)&1)*32+(lane&3)*8+(4*hi+((lane&15)>>2))*64;
  { asm volatile("s_waitcnt vmcnt(0)":::"memory"); asm volatile("s_barrier":::"memory"); }
  const int grp=wid>>2;
  if(grp==1)asm volatile("s_barrier":::"memory");
  for(int t=0;t<NT;++t){
    const int s=t&3;
    f32x16 p0,p1;
    qkt(p0,p1,shm+A2_K+s*A2_SLOT+c*8192,qr,negm,r32,hi); asm volatile("s_nop 15\n\ts_nop 7":"+v"(p0),"+v"(p1));
    #pragma unroll
    for(int r=0;r<16;++r){p1[r]+=c32;negm[r]+=sl64;}
    { const int jb=t-(NT-2); if(jb>=0)cmask(p0,p1,jb,qrel,hi); }
    float sacc=0.f;
    #pragma unroll
    for(int r=0;r<16;++r){p0[r]=__builtin_amdgcn_exp2f(p0[r]);p1[r]=__builtin_amdgcn_exp2f(p1[r]);sacc+=p0[r]+p1[r];}
    l_reg+=sacc;
    u32x4 pw0,pw1,pw2,pw3;
    #define PKW(P,B) cvtpk_s(P[B],P[B+1])
    pw0=(u32x4){PKW(p0,0),PKW(p0,2),PKW(p0,4),PKW(p0,6)};pw1=(u32x4){PKW(p0,8),PKW(p0,10),PKW(p0,12),PKW(p0,14)};
    pw2=(u32x4){PKW(p1,0),PKW(p1,2),PKW(p1,4),PKW(p1,6)};pw3=(u32x4){PKW(p1,8),PKW(p1,10),PKW(p1,12),PKW(p1,14)};
    #undef PKW
    if(t+2<NT)asm volatile("s_waitcnt vmcnt(4) lgkmcnt(0)\n\ts_barrier":::"memory"); else asm volatile("s_waitcnt vmcnt(0) lgkmcnt(0)\n\ts_barrier":::"memory");
    if(t+3<NT)A2_DMA(t+3,(t+3)&3);
    SBAR();
    pv4(o,vb0+s*A2_SLOT,__builtin_bit_cast(bf16x8,pw0),__builtin_bit_cast(bf16x8,pw1),__builtin_bit_cast(bf16x8,pw2),__builtin_bit_cast(bf16x8,pw3));
    asm volatile("s_waitcnt lgkmcnt(0)\n\ts_barrier":::"memory");
  }
  if(grp==0)asm volatile("s_barrier":::"memory");
  asm volatile("s_waitcnt vmcnt(0)":::"memory");
  #undef A2_DMA
  {auto rr=__builtin_amdgcn_permlane32_swap(__float_as_uint(l_reg),__float_as_uint(l_reg),false,false);l_reg=__uint_as_float(rr[0])+__uint_as_float(rr[1]);}
  float*wsf=(float*)(shm+A2_WS)+wid*64;
  if(hi==0)wsf[r32]=l_reg; asm volatile("s_waitcnt lgkmcnt(0)":::"memory");
  float rli[16];
  #pragma unroll
  for(int r=0;r<16;++r)rli[r]=__builtin_amdgcn_rcpf(wsf[crow(r,hi)]);
  float*X=(float*)shm+qblk*4096;
  if(c==1){
    #pragma unroll
    for(int d0=0;d0<4;++d0)
      #pragma unroll
      for(int r=0;r<16;++r)X[(d0*16+r)*64+lane]=o[d0][r]*rli[r];
  }
  asm volatile("s_waitcnt lgkmcnt(0)\n\ts_barrier":::"memory");
  if(c==0){
    bf16_t*stg=(bf16_t*)(shm+A2_STG)+qblk*4096;
    #pragma unroll
    for(int d0=0;d0<4;++d0)
      #pragma unroll
      for(int r=0;r<16;++r){ const float v=o[d0][r]*rli[r]-lam*X[(d0*16+r)*64+lane]; stg[crow(r,hi)*128+d0*32+r32]=(bf16_t)(__builtin_bit_cast(unsigned short,__float2bfloat16(v))); }
    asm volatile("s_waitcnt lgkmcnt(0)":::"memory");
    const int row=lane>>1,half=lane&1; const bf16_t*sp=stg+row*128+half*64;
    float d[64]; float ss=0.f;
    #pragma unroll
    for(int i=0;i<8;++i){ const u32x4 w=*(const u32x4*)(sp+8*i);
      d[8*i+0]=__uint_as_float(w.x<<16);d[8*i+1]=__uint_as_float(w.x&0xffff0000u);d[8*i+2]=__uint_as_float(w.y<<16);d[8*i+3]=__uint_as_float(w.y&0xffff0000u);
      d[8*i+4]=__uint_as_float(w.z<<16);d[8*i+5]=__uint_as_float(w.z&0xffff0000u);d[8*i+6]=__uint_as_float(w.w<<16);d[8*i+7]=__uint_as_float(w.w&0xffff0000u); }
    #pragma unroll
    for(int i=0;i<64;++i)ss+=d[i]*d[i];
    ss+=__shfl_xor(ss,1);
    const float rs=rsqrtf(ss*(1.f/128.f)+1e-6f)*0.8f;
    bf16_t*mp=MIX+(rowbase+q0+qblk*32+row)*1024+512+h*128+half*64; const float*gp=dg+half*64;
    #pragma unroll
    for(int i=0;i<8;++i){ u32x4 w;
      w.x=cvtpk_s(d[8*i+0]*rs*gp[8*i+0],d[8*i+1]*rs*gp[8*i+1]); w.y=cvtpk_s(d[8*i+2]*rs*gp[8*i+2],d[8*i+3]*rs*gp[8*i+3]);
      w.z=cvtpk_s(d[8*i+4]*rs*gp[8*i+4],d[8*i+5]*rs*gp[8*i+5]); w.w=cvtpk_s(d[8*i+6]*rs*gp[8*i+6],d[8*i+7]*rs*gp[8*i+7]);
      *(u32x4*)(mp+8*i)=w; }
  }
  asm volatile("s_waitcnt lgkmcnt(0)\n\ts_barrier":::"memory");
}
constexpr int ATTN_LDS_BYTES=LDS_BYTES;
#undef SBAR
#undef WAIT_BAR
}

__device__ __forceinline__ unsigned wave_umax(unsigned x) {
    x = max(x, (unsigned)__builtin_amdgcn_update_dpp(0, (int)x, 0x111, 0xf, 0xf, false));
    x = max(x, (unsigned)__builtin_amdgcn_update_dpp(0, (int)x, 0x112, 0xf, 0xf, false));
    x = max(x, (unsigned)__builtin_amdgcn_update_dpp(0, (int)x, 0x114, 0xf, 0xf, false));
    x = max(x, (unsigned)__builtin_amdgcn_update_dpp(0, (int)x, 0x118, 0xf, 0xf, false));
    x = max(x, (unsigned)__builtin_amdgcn_update_dpp(0, (int)x, 0x142, 0xa, 0xf, false));
    x = max(x, (unsigned)__builtin_amdgcn_update_dpp(0, (int)x, 0x143, 0xc, 0xf, false));
    return (unsigned)__builtin_amdgcn_readlane((int)x, 63);
}
__device__ __forceinline__ unsigned sel_key(float v, int idx) { unsigned u = __float_as_uint(v); u = (u & 0x80000000u) ? ~u : (u | 0x80000000u); return (u & 0xffffff00u) | (unsigned)(255 - idx); }

__device__ __forceinline__ void ph_route(const Args& a, unsigned char* lds, const int tid) {
    const int lane = tid & 63, wave = tid >> 6;
    int* hist = (int*)lds;
    const float* LOG = (const float*)(a.ws + WS_LOGITS); const float* rb = a.in[18];
    int* IDX = (int*)(a.ws + WS_IDX); float* GATEV = (float*)(a.ws + WS_GATEV); int* HIST = (int*)(a.ws + WS_HIST);
    unsigned* TOT = (unsigned*)(a.ws + WS_BAR) + 3456;
    const f32x4 rb4 = *((const f32x4*)rb + lane);
    for (int tb = blockIdx.x; tb < 256; tb += gridDim.x) {
        if (tid < 256) hist[tid] = 0;
        __syncthreads();
        f32x4 lgn = *((const f32x4*)(LOG + (size_t)(tb * 128 + wave * 16) * 256) + lane);
        for (int i = 0; i < 16; ++i) {
            const int t = tb * 128 + wave * 16 + i;
            const f32x4 lg = lgn;
            if (i < 15) lgn = *((const f32x4*)(LOG + (size_t)(t + 1) * 256) + lane);
            float s[4], sel[4];
            s[0] = sigm(lg.x); s[1] = sigm(lg.y); s[2] = sigm(lg.z); s[3] = sigm(lg.w);
            sel[0] = s[0] + rb4.x; sel[1] = s[1] + rb4.y; sel[2] = s[2] + rb4.z; sel[3] = s[3] + rb4.w;
            float m1 = fmaxf(sel[0], sel[1]), m2 = fminf(sel[0], sel[1]);
            { const float x = sel[2]; const float n1 = fmaxf(m1, x); m2 = fmaxf(m2, fminf(m1, x)); m1 = n1; }
            { const float x = sel[3]; const float n1 = fmaxf(m1, x); m2 = fmaxf(m2, fminf(m1, x)); m1 = n1; }
#pragma unroll
            for (int off = 1; off < 8; off <<= 1) { const float o1 = __shfl_xor(m1, off), o2 = __shfl_xor(m2, off);
                const float n1 = fmaxf(m1, o1), n2 = fmaxf(fminf(m1, o1), fmaxf(m2, o2)); m1 = n1; m2 = n2; }
            const float gs = m1 + m2; const int grp = lane >> 3; int rank = 0;
#pragma unroll
            for (int g2 = 0; g2 < 8; ++g2) { const float v = __builtin_bit_cast(float, __builtin_amdgcn_readlane(__builtin_bit_cast(int, gs), 8 * g2)); rank += ((v > gs) || (v == gs && g2 < grp)) ? 1 : 0; }
            const bool gsel = rank < 4;
            unsigned key[4];
#pragma unroll
            for (int j = 0; j < 4; ++j) key[j] = gsel ? sel_key(sel[j], 4 * lane + j) : 0u;
            float gsum = 0.f; float myg = 0.f; int myidx = 0;
#pragma unroll
            for (int k = 0; k < 8; ++k) {
                const unsigned best = wave_umax(max(max(key[0], key[1]), max(key[2], key[3])));
                const int bi = 255 - (int)(best & 255u);
                const int owner = bi >> 2, sub = bi & 3;
                float sv = (sub == 0) ? s[0] : (sub == 1) ? s[1] : (sub == 2) ? s[2] : s[3];
                sv = __builtin_bit_cast(float, __builtin_amdgcn_readlane(__builtin_bit_cast(int, sv), owner));
                if (lane == owner) {
#pragma unroll
                    for (int j = 0; j < 4; ++j) if (j == sub) key[j] = 0u;
                }
                gsum += sv;
                if (lane == k) { myg = sv; myidx = bi; }
            }
            if (lane < 8) { IDX[(size_t)t * 8 + lane] = myidx; GATEV[(size_t)t * 8 + lane] = myg / gsum * 2.5f; atomicAdd(&hist[myidx], 1); }
        }
        __syncthreads();
        if (tid < 256) { const int hv = hist[tid]; HIST[tb * 256 + tid] = hv; if (hv) atomicAdd(TOT + tid, (unsigned)hv); }
        __syncthreads();
    }
}

__device__ __forceinline__ void ph_scatter(const Args& a, unsigned char* lds, const int tid) {
    int* tot = (int*)lds; int* cur = tot + 256; int* base = cur + 256; int* tstart = base + 256;
    const int* HIST = (const int*)(a.ws + WS_HIST); const int* IDX = (const int*)(a.ws + WS_IDX); const float* GATEV = (const float*)(a.ws + WS_GATEV);
    int* PSLOT = (int*)(a.ws + WS_PSLOT); int* SLOTTOK = (int*)(a.ws + WS_SLOTTOK); float* SLOTGATE = (float*)(a.ws + WS_SLOTGATE);
    int* TILE = (int*)(a.ws + WS_TILE);
    unsigned* TOT = (unsigned*)(a.ws + WS_BAR) + 3456; unsigned* CUR = TOT + 256;
    for (int tb = blockIdx.x; tb < 256; tb += gridDim.x) {
        __syncthreads();
        if (tid < 256) tot[tid] = (int)__hip_atomic_load(TOT + tid, __ATOMIC_RELAXED, __HIP_MEMORY_SCOPE_AGENT);
        __syncthreads();
        if (tid < 256) { int bs = 0, ts = 0; for (int j = 0; j < tid; ++j) { const int c = tot[j]; bs += c; ts += (c + 255) >> 8; } base[tid] = bs; tstart[tid] = ts;
            const int mine = HIST[tb * 256 + tid]; cur[tid] = bs + (mine ? (int)atomicAdd(CUR + tid, (unsigned)mine) : 0); }
        __syncthreads();
        for (int p = tid; p < 1024; p += 512) { const int t = tb * 128 + (p >> 3), k = p & 7; const int e = IDX[(size_t)t * 8 + k];
            const int slot = atomicAdd(&cur[e], 1); SLOTTOK[slot] = t; SLOTGATE[slot] = GATEV[(size_t)t * 8 + k]; PSLOT[(size_t)t * 8 + k] = slot; }
        if (tb == 0) {
            if (tid < 256) { const int cnt = tot[tid], b0 = base[tid]; int n = tstart[tid];
                for (int r0 = 0; r0 < cnt; r0 += 256) { TILE[64 + n] = tid; TILE[64 + 2048 + n] = b0 + r0; TILE[64 + 4096 + n] = b0 + cnt; ++n; }
                if (tid == 255) TILE[0] = n; }
            __syncthreads();
            if (tid < 128) { const int n = tstart[255] + ((tot[255] + 255) >> 8);
                TILE[64 + n + tid] = 256; TILE[64 + 2048 + n + tid] = SHARED_BASE + 256 * tid; TILE[64 + 4096 + n + tid] = SHARED_BASE + T; }
        }
    }
}

template <int MODE>
__device__ __forceinline__ void ph_final(const Args& a, const int tid) {
    const int lane = tid & 63, wave = tid >> 6;
    const unsigned char* YP = (const unsigned char*)(a.ws + WS_YP); const int* PSLOT = (const int*)(a.ws + WS_PSLOT); const float* MOD = (const float*)(a.ws + WS_MOD);
    float* out = a.out;
    const int gw = blockIdx.x * 8 + wave, NGW = gridDim.x * 8;
    const int sub = lane & 15, rsel = lane >> 4;
    int nslot = 0;
    { const int r0 = gw + (rsel == 1 ? NGW : 0); if (rsel < 2 && sub < 9 && r0 < T) nslot = sub < 8 ? PSLOT[(size_t)r0 * 8 + sub] : SHARED_BASE + r0; }
    for (int row = gw; row < T; row += 2 * NGW) {
        const int myslot = nslot;
        { const int r1 = row + 2 * NGW + (rsel == 1 ? NGW : 0); if (rsel < 2 && sub < 9 && r1 < T) nslot = sub < 8 ? PSLOT[(size_t)r1 * 8 + sub] : SHARED_BASE + r1; }
#pragma unroll
        for (int half = 0; half < 2; ++half) {
            const int rw = row + half * NGW;
            if (rw < T) {
                const int b = rw / SEQ;
                float* o0 = out + (size_t)rw * DM + 8 * lane; float* o1 = o0 + 512;
                const f32x4 xa = *(const f32x4*)o0, xb = *(const f32x4*)(o0 + 4), xc = *(const f32x4*)o1, xd = *(const f32x4*)(o1 + 4);
                float acc[16];
#pragma unroll
                for (int i = 0; i < 16; ++i) acc[i] = 0.f;
                u32x2 w0[9], w1[9];
#pragma unroll
                for (int k = 0; k < 9; ++k) { const int slot = __shfl(myslot, 16 * half + k); const unsigned char* yp = YP + (size_t)slot * DM; w0[k] = __builtin_nontemporal_load((const u32x2*)(yp + 8 * lane)); w1[k] = __builtin_nontemporal_load((const u32x2*)(yp + 512 + 8 * lane)); }
#pragma unroll
                for (int k = 0; k < 9; ++k) {
                    { const auto a0 = __builtin_amdgcn_cvt_pk_f32_fp8((int)w0[k].x, false), a1 = __builtin_amdgcn_cvt_pk_f32_fp8((int)w0[k].x, true), a2 = __builtin_amdgcn_cvt_pk_f32_fp8((int)w0[k].y, false), a3 = __builtin_amdgcn_cvt_pk_f32_fp8((int)w0[k].y, true);
                      acc[0] += a0[0]; acc[1] += a0[1]; acc[2] += a1[0]; acc[3] += a1[1]; acc[4] += a2[0]; acc[5] += a2[1]; acc[6] += a3[0]; acc[7] += a3[1]; }
                    { const auto a0 = __builtin_amdgcn_cvt_pk_f32_fp8((int)w1[k].x, false), a1 = __builtin_amdgcn_cvt_pk_f32_fp8((int)w1[k].x, true), a2 = __builtin_amdgcn_cvt_pk_f32_fp8((int)w1[k].y, false), a3 = __builtin_amdgcn_cvt_pk_f32_fp8((int)w1[k].y, true);
                      acc[8] += a0[0]; acc[9] += a0[1]; acc[10] += a1[0]; acc[11] += a1[1]; acc[12] += a2[0]; acc[13] += a2[1]; acc[14] += a3[0]; acc[15] += a3[1]; } }
                const float* gf = MOD + b * 6144 + 5 * 1024 + 8 * lane;
                const f32x4 g0 = *(const f32x4*)gf * (1.f / 16.f), g1 = *(const f32x4*)(gf + 4) * (1.f / 16.f), g2 = *(const f32x4*)(gf + 512) * (1.f / 16.f), g3 = *(const f32x4*)(gf + 516) * (1.f / 16.f);
                f32x4 ya = xa, yb = xb, yc = xc, yd = xd;
                ya.x += g0.x * acc[0]; ya.y += g0.y * acc[1]; ya.z += g0.z * acc[2]; ya.w += g0.w * acc[3];
                yb.x += g1.x * acc[4]; yb.y += g1.y * acc[5]; yb.z += g1.z * acc[6]; yb.w += g1.w * acc[7];
                yc.x += g2.x * acc[8]; yc.y += g2.y * acc[9]; yc.z += g2.z * acc[10]; yc.w += g2.w * acc[11];
                yd.x += g3.x * acc[12]; yd.y += g3.y * acc[13]; yd.z += g3.z * acc[14]; yd.w += g3.w * acc[15];
                if (MODE == 0) { __builtin_nontemporal_store(ya, (f32x4*)o0); __builtin_nontemporal_store(yb, (f32x4*)(o0 + 4)); __builtin_nontemporal_store(yc, (f32x4*)o1); __builtin_nontemporal_store(yd, (f32x4*)(o1 + 4)); }
                else asm volatile("" :: "v"(ya), "v"(yb), "v"(yc), "v"(yd));
            }
        }
    }
}

#define LAS __attribute__((address_space(3)))
#define XB_TMO      128
#define XB_XCNT(j)  (256  + 64 * (j))
#define XB_XSUB(j)  (1280 + 64 * (j))
#define XB_XGEN(j)  (2304 + 64 * (j))
#define XB_TOP      3328
#define XB_TOPGEN   3392
#define XB_SPIN_CAP (1u << 27)
__device__ __forceinline__ unsigned xb_ld(unsigned* p)              { return __hip_atomic_load(p, __ATOMIC_RELAXED, __HIP_MEMORY_SCOPE_AGENT); }
__device__ __forceinline__ unsigned xb_add(unsigned* p, unsigned v) { return __hip_atomic_fetch_add(p, v, __ATOMIC_RELAXED, __HIP_MEMORY_SCOPE_AGENT); }
__device__ __forceinline__ unsigned xb_xcc_id() { return (unsigned)__builtin_amdgcn_s_getreg((3 << 11) | 20) & 0xFu; }
#define XB_SPIN(cond, bar) do { unsigned _sp = 0; while (cond) { __builtin_amdgcn_s_sleep(1); \
    if ((++_sp & 255u) == 0u) { if (xb_ld(&(bar)[XB_TMO])) break; if (_sp > XB_SPIN_CAP) { atomicAdd(&(bar)[XB_TMO], 1u); break; } } } } while (0)
struct XcdBarrier { unsigned* bar; unsigned x; volatile LAS unsigned* st; };
__device__ __forceinline__ XcdBarrier xcd_barrier_post(unsigned* bar, volatile LAS unsigned* st, const bool t0) {
    XcdBarrier b; b.bar = bar; b.x = xb_xcc_id(); b.st = st;
    if (t0) (void)xb_add(&bar[XB_XCNT(b.x)], 1u);
    return b;
}
__device__ __forceinline__ void xcd_barrier_complete(unsigned* bar, unsigned x, unsigned& nloc, unsigned& nx) {
    const unsigned G = gridDim.x * gridDim.y * gridDim.z;
    unsigned sum, cnt, mine, sp = 0u;
    for (;;) {
        sum = 0u; cnt = 0u; mine = 0u;
#pragma unroll
        for (unsigned j = 0; j < 16; ++j) { const unsigned c = xb_ld(&bar[XB_XCNT(j)]); sum += c; cnt += (c > 0u) ? 1u : 0u; mine = (j == x) ? c : mine; }
        if (sum == G) break;
        __builtin_amdgcn_s_sleep(1);
        if ((++sp & 255u) == 0u) { if (xb_ld(&bar[XB_TMO])) break; if (sp > XB_SPIN_CAP) { atomicAdd(&bar[XB_TMO], 1u); break; } }
    }
    nloc = mine > 0u ? mine : 1u; nx = cnt > 0u ? cnt : 1u;
}
__device__ __forceinline__ void xcd_barrier(const XcdBarrier& b, const bool t0) {
    asm volatile("s_waitcnt vmcnt(0)" ::: "memory");
    __syncthreads();
    if (t0) {
        unsigned* bar = b.bar;
        __builtin_amdgcn_s_waitcnt(0);
        unsigned nloc = b.st[0], nx = b.st[1];
        if (nloc == 0u) { xcd_barrier_complete(bar, b.x, nloc, nx); b.st[0] = nloc; b.st[1] = nx; }
        const unsigned old = xb_add(&bar[XB_XSUB(b.x)], 1u);
        const unsigned gen = old / nloc;
        if (old + 1u == (gen + 1u) * nloc) {
            __builtin_amdgcn_fence(__ATOMIC_RELEASE, "agent");
            asm volatile("s_waitcnt vmcnt(0)" ::: "memory");
            const unsigned og = xb_add(&bar[XB_TOP], 1u);
            const unsigned tg = og / nx;
            if (og + 1u == (tg + 1u) * nx) xb_add(&bar[XB_TOPGEN], 1u);
            else XB_SPIN(xb_ld(&bar[XB_TOPGEN]) == tg, bar);
            __builtin_amdgcn_fence(__ATOMIC_ACQUIRE, "agent");
            xb_add(&bar[XB_XGEN(b.x)], 1u);
            asm volatile("s_waitcnt vmcnt(0)" ::: "memory");
        } else {
            XB_SPIN(xb_ld(&bar[XB_XGEN(b.x)]) == gen, bar);
            __builtin_amdgcn_fence(__ATOMIC_ACQUIRE, "agent");
            asm volatile("s_waitcnt vmcnt(0)" ::: "memory");
        }
    }
    __syncthreads();
}


__global__ void __launch_bounds__(512) mega(Args a) {
    extern __shared__ __attribute__((aligned(16))) unsigned char lds[];
    const int lo = a.ph_lo, hi = a.ph_hi;
    const int wave_s = __builtin_amdgcn_readfirstlane((int)threadIdx.x >> 6);
#define tid mk_tid(wave_s)
    volatile LAS unsigned* bst = (volatile LAS unsigned*)((LAS unsigned char*)lds + (LDS_BYTES - 64));
    if (tid < 16) bst[tid] = 0u;
    __syncthreads();
    XcdBarrier bar = xcd_barrier_post((unsigned*)(a.ws + WS_BAR), bst, tid == 0);
#define IN(k) (lo <= (k) && (k) < hi)
#define SEAM(k) do { if (IN(k) && IN((k) + 1)) xcd_barrier(bar, tid == 0); } while (0)

    if (IN(0)) { ph0(a, lds, tid); } SEAM(0);
    if (IN(1)) { ph_norm<true>(a, lds, a.in[0], 0, 1, tid); } SEAM(1);
    if (IN(2)) {
        const EpiProj E{(bf16_t*)(a.ws + WS_PROJ)};
        { pg8::DenseSched S; S.init(a.ws + WS_H8, a.ws + WS_WIN, T, NPROJ, DM, (int)gridDim.x, (int)blockIdx.x); __syncthreads();
          pg8::gemm_phase<false, true, 0x79797979, 0x7f7f7f7f, false>((PG8_LAS unsigned char*)lds, DM, S, E); }
    } SEAM(2);
    if (IN(3)) { qknorm_rows(a, tid); __syncthreads(); for (int u = blockIdx.x; u < 1024; u += gridDim.x) mlstm_m1_unit(a, lds, u, wave_s);
 } SEAM(3);
    if (IN(4)) { mlstm_m2(a, tid); } SEAM(4);
    if (IN(5)) {
        { float lam; { float s1 = 0.f, s2 = 0.f; const float* q1 = a.in[11]; const float* k1 = a.in[12]; const float* q2 = a.in[13]; const float* k2 = a.in[14];
              for (int i = 0; i < 64; ++i) { s1 += q1[i] * k1[i]; s2 += q2[i] * k2[i]; } lam = expf(s1) - expf(s2) + LAM_INIT; }
          float m0; { float gq = 0.f, gk = 0.f; for (int i = 0; i < 64; ++i) { gq = fmaxf(gq, fabsf(a.in[9][i])); gk = fmaxf(gk, fabsf(a.in[10][i])); } m0 = 64.f * C2 * gq * gk * 1.01f + 0.01f; }
          unsigned* qhead = (unsigned*)(a.ws + WS_BAR) + 4001;
          for (;;) {
              __syncthreads();
              if (tid == 0) bst[8] = atomicAdd(qhead, 1u);
              __syncthreads();
              const int idx = (int)bst[8];
              if (idx >= 1024) break;
              const int qb = 63 - (idx >> 4), j = idx & 15, bh = (j & 3) * 4 + (3 - (j >> 2));
              attn_body::attn2_unit((const attn_body::bf16*)(a.ws + WS_PROJ), a.in[15], (bf16_t*)(a.ws + WS_MIX), (char*)lds, bh, qb, lam, m0);
          }
          __syncthreads();
          for (int u = (int)blockIdx.x; u < 1024; u += (int)gridDim.x) mlstm_m3_unit<0>(a, lds, u, wave_s);
          __syncthreads(); }
    } SEAM(5);
    if (IN(6)) {
        const EpiOut E{a.in[0], a.out, (const float*)(a.ws + WS_MOD)};
        { pg8::DenseSched S; S.init(a.ws + WS_MIX, a.ws + WS_WOUT, T, DM, 2 * DM, (int)gridDim.x, (int)blockIdx.x); __syncthreads();
          pg8::gemm_phase<false, false, 0, 0, false>((PG8_LAS unsigned char*)lds, 2 * DM, S, E); }
    } SEAM(6);
    if (IN(7)) { ph_norm<false>(a, lds, a.out, 3, 4, tid); } SEAM(7);
    if (IN(8)) {
        const EpiRS E{(float*)(a.ws + WS_LOGITS), (bf16_t*)(a.ws + WS_ACT)};
        { pg8::DenseSched S; S.init(a.ws + WS_H, a.ws + WS_WRS, T, 768, 2 * DM, (int)gridDim.x, (int)blockIdx.x); __syncthreads();
          pg8::gemm_phase<false, false, 0, 0, false>((PG8_LAS unsigned char*)lds, 2 * DM, S, E); }
    } SEAM(8);
    if (IN(9)) { ph_route(a, lds, tid); } SEAM(9);
    if (IN(10)) { ph_scatter(a, lds, tid); } SEAM(10);
    if (IN(11)) {
        const int* TILE = (const int*)(a.ws + WS_TILE); const int ntile = TILE[0];
        const EpiG1 E{(const float*)(a.ws + WS_SLOTGATE), (bf16_t*)(a.ws + WS_ACT)};
        { const int G = (int)gridDim.x, bx = (int)blockIdx.x, vcu = (G % 8 == 0) ? (bx % 8) * (G / 8) + bx / 8 : bx;
          const pg8::ExpertSched S{TILE, ntile * 2, 2, (const char*)(a.ws + WS_H8), (const int*)(a.ws + WS_SLOTTOK), (const char*)(a.ws + WS_W13T), (size_t)512 * 1024, DM, G, vcu};
          __syncthreads(); pg8::gemm_phase<true, true, 0x79797979, 0x7f7f7f7f, false>((PG8_LAS unsigned char*)lds, DM, S, E); }
    } SEAM(11);
    if (IN(12)) {
        const int* TILE = (const int*)(a.ws + WS_TILE); const int ntile = TILE[0] + 128;
        const EpiG2 E{(bf16_t*)(a.ws + WS_YP)};
        { const int G = (int)gridDim.x, bx = (int)blockIdx.x, vcu = (G % 8 == 0) ? (bx % 8) * (G / 8) + bx / 8 : bx;
          const pg8::ExpertSched S{TILE, ntile * 4, 4, (const char*)(a.ws + WS_ACT), nullptr, (const char*)(a.ws + WS_W2T), (size_t)1024 * 256, 256, G, vcu};
          __syncthreads(); pg8::gemm_phase<false, true, 0x7a7a7a7a, 0x7c7c7c7c, true>((PG8_LAS unsigned char*)lds, 256, S, E); }
    } SEAM(12);
    if (IN(13)) {
        ph_final<0>(a, tid); }
#undef IN
#undef SEAM
#undef tid
}

extern "C" void kernel_launch(void* const* d_in, const int* in_sizes, int n_in, void* d_out, int out_size, void* d_ws, size_t ws_size, hipStream_t stream) {
    static int grid = 0;
    if (grid == 0) {
        if (n_in != 25 || in_sizes[0] != T * DM || out_size != T * DM || ws_size < WS_END) {
            fprintf(stderr, "kernel_launch: unexpected problem (n_in %d, in0 %d, out %d, ws %zu < %zu)\n", n_in, n_in > 0 ? in_sizes[0] : -1, out_size, ws_size, (size_t)WS_END); grid = -1; return; }
        int dev = 0, cus = 0, per_cu = 0;
        (void)hipGetDevice(&dev);
        (void)hipDeviceGetAttribute(&cus, hipDeviceAttributeMultiprocessorCount, dev);
        if (hipFuncSetAttribute((const void*)mega, hipFuncAttributeMaxDynamicSharedMemorySize, LDS_BYTES) != hipSuccess) { fprintf(stderr, "kernel_launch: hipFuncSetAttribute failed\n"); grid = -1; return; }
        if (hipOccupancyMaxActiveBlocksPerMultiprocessor(&per_cu, (const void*)mega, 512, LDS_BYTES) != hipSuccess || per_cu < 1) { fprintf(stderr, "kernel_launch: occupancy query says %d blocks/CU\n", per_cu); grid = -1; return; }
        grid = cus;
    }
    if (grid < 0) return;
    (void)hipMemsetAsync((char*)d_ws + WS_BAR, 0, BAR_BYTES, stream);
    Args a{};
    for (int i = 0; i < 25; ++i) a.in[i] = (const float*)d_in[i];
    a.out = (float*)d_out; a.ws = (unsigned char*)d_ws;
    a.ph_lo = 0; a.ph_hi = NPH;
    void* args[] = {&a};
    hipError_t e = hipLaunchCooperativeKernel((const void*)mega, dim3(grid), dim3(512), args, LDS_BYTES, stream);
    if (e != hipSuccess) fprintf(stderr, "cooperative launch failed: %s (grid %d)\n", hipGetErrorString(e), grid);
}
```

```cpp
#include <hip/hip_runtime.h>
#include <cstdio>
#include <cstdint>

typedef unsigned short bf16_t;
typedef short bf16x8 __attribute__((ext_vector_type(8)));
typedef float f32x4 __attribute__((ext_vector_type(4)));
typedef unsigned u32x4 __attribute__((ext_vector_type(4)));
typedef unsigned u32x2 __attribute__((ext_vector_type(2)));


constexpr int T = 32768, DM = 1024, SEQ = 8192;
constexpr int NPROJ = 3584, DIN = 3592;
constexpr int TOPK = 8, TK = T * TOPK;
constexpr int SHARED_BASE = TK;
constexpr float EPS = 1e-6f;
constexpr float LOG2E = 1.4426950408889634f;
constexpr float C2 = 0.125f * LOG2E;
constexpr float LAM_INIT = 0.2f;
constexpr int NPH = 14;
constexpr int LDS_BYTES = 155648;

constexpr size_t MiB = 1ull << 20;
constexpr size_t WS_MOD = 0;
constexpr size_t WS_TILE = 128 * 1024;
constexpr size_t WS_HIST = 256 * 1024;
constexpr size_t WS_BAR = 512 * 1024;
constexpr size_t BAR_BYTES = 16384;
constexpr size_t WS_IPRE = 1 * MiB, WS_FPRE = 1 * MiB + 512 * 1024;
constexpr size_t WS_IDX = 2 * MiB, WS_GATEV = 3 * MiB, WS_PSLOT = 4 * MiB, WS_SLOTTOK = 5 * MiB, WS_SLOTGATE = 7 * MiB;
constexpr size_t WS_MST = 9 * MiB;
constexpr size_t WS_WIN = 12 * MiB, WS_WOUT = 19 * MiB, WS_WRS = 21 * MiB, WS_W2T = 23 * MiB;
constexpr size_t WS_H = 152 * MiB, WS_ACT = 216 * MiB, WS_MIX = 361 * MiB, WS_PROJ = 425 * MiB, WS_CLOC = 649 * MiB, WS_CIN = 713 * MiB, WS_W13T = 745 * MiB, WS_END = 1001 * MiB;
constexpr size_t WS_H8 = 89 * MiB;
constexpr size_t WS_YP = WS_MIX;
constexpr size_t WS_LOGITS = WS_CLOC;
constexpr size_t WS_X1B = 681 * MiB;
constexpr size_t WS_TMP = WS_ACT;

struct Args { const float* in[25]; float* out; unsigned char* ws; int ph_lo, ph_hi; };

__device__ __forceinline__ int mk_tid(int wave_s) { int l; asm volatile("v_mbcnt_lo_u32_b32 %0, -1, 0\n\tv_mbcnt_hi_u32_b32 %0, -1, %0" : "=v"(l)); return (wave_s << 6) | l; }

__device__ __forceinline__ float bflo(unsigned v) { return __uint_as_float(v << 16); }
__device__ __forceinline__ float bfhi(unsigned v) { return __uint_as_float(v & 0xffff0000u); }
__device__ __forceinline__ unsigned f2bf(float f) { unsigned u = __float_as_uint(f); return (u + 0x7fffu + ((u >> 16) & 1u)) >> 16; }
__device__ __forceinline__ unsigned pk2(float lo, float hi) { return f2bf(lo) | (f2bf(hi) << 16); }
__device__ __forceinline__ float wave_sum(float v) {
    v += __builtin_bit_cast(float, __builtin_amdgcn_update_dpp(0, __builtin_bit_cast(int, v), 0x111, 0xf, 0xf, false));
    v += __builtin_bit_cast(float, __builtin_amdgcn_update_dpp(0, __builtin_bit_cast(int, v), 0x112, 0xf, 0xf, false));
    v += __builtin_bit_cast(float, __builtin_amdgcn_update_dpp(0, __builtin_bit_cast(int, v), 0x114, 0xf, 0xf, false));
    v += __builtin_bit_cast(float, __builtin_amdgcn_update_dpp(0, __builtin_bit_cast(int, v), 0x118, 0xf, 0xf, false));
    v += __builtin_bit_cast(float, __builtin_amdgcn_update_dpp(0, __builtin_bit_cast(int, v), 0x142, 0xa, 0xf, false));
    v += __builtin_bit_cast(float, __builtin_amdgcn_update_dpp(0, __builtin_bit_cast(int, v), 0x143, 0xc, 0xf, false));
    return __builtin_bit_cast(float, __builtin_amdgcn_readlane(__builtin_bit_cast(int, v), 63));
}
__device__ __forceinline__ float siluf(float x) { return x / (1.f + __expf(-x)); }
__device__ __forceinline__ float sigm(float x) { return 1.f / (1.f + __expf(-x)); }
__device__ __forceinline__ void unpack8(const u32x4 v, float (&x)[8]) {
    x[0] = bflo(v.x); x[1] = bfhi(v.x); x[2] = bflo(v.y); x[3] = bfhi(v.y); x[4] = bflo(v.z); x[5] = bfhi(v.z); x[6] = bflo(v.w); x[7] = bfhi(v.w);
}
__device__ __forceinline__ unsigned pk4_fp8(float a, float b, float c, float d) { int p = __builtin_amdgcn_cvt_pk_fp8_f32(a, b, 0, false); p = __builtin_amdgcn_cvt_pk_fp8_f32(c, d, p, true); return (unsigned)p; }
__device__ __forceinline__ u32x4 pack8(const float (&x)[8]) { u32x4 o; o.x = pk2(x[0], x[1]); o.y = pk2(x[2], x[3]); o.z = pk2(x[4], x[5]); o.w = pk2(x[6], x[7]); return o; }

__device__ __forceinline__ void conv_item(const float* __restrict__ s0, const float* __restrict__ s1, int ldn, int k0, int n0, bool inter,
                                          bf16_t* dst, int ldk, int c0, float* scr, int lane) {
    const float* p = (inter && lane >= 32) ? (s1 + n0 + (lane - 32)) : (s0 + n0 + lane);
    p += (size_t)k0 * ldn;
#pragma unroll 8
    for (int i = 0; i < 64; ++i) scr[i * 65 + lane] = __builtin_nontemporal_load(p + (size_t)i * ldn);
    const int c = lane & 7;
#pragma unroll
    for (int j = 0; j < 8; ++j) {
        const int n = (lane >> 3) + 8 * j;
        const float* s = scr + (8 * c) * 65 + n;
        u32x4 o; o.x = pk2(s[0], s[65]); o.y = pk2(s[130], s[195]); o.z = pk2(s[260], s[325]); o.w = pk2(s[390], s[455]);
        const int drow = inter ? (c0 + ((n & 31) >> 2) * 8 + (n >> 5) * 4 + (n & 3)) : (c0 + n);
        __builtin_nontemporal_store(o, (u32x4*)(dst + (size_t)drow * ldk + k0 + 8 * c));
    }
}


__device__ __forceinline__ void conv_item8(const float* __restrict__ s0, const float* __restrict__ s1, int ldn, int k0, int n0, bool inter,
                                           unsigned char* dst, int ldk, int c0, float* scr, int lane, float scale) {
    const float* p = (inter && lane >= 32) ? (s1 + n0 + (lane - 32)) : (s0 + n0 + lane);
    p += (size_t)k0 * ldn;
#pragma unroll 8
    for (int i = 0; i < 64; ++i) scr[i * 65 + lane] = __builtin_nontemporal_load(p + (size_t)i * ldn) * scale;
    const int c = lane & 7;
#pragma unroll
    for (int j = 0; j < 8; ++j) {
        const int n = (lane >> 3) + 8 * j;
        const float* s = scr + (8 * c) * 65 + n;
        u32x2 o; o.x = pk4_fp8(s[0], s[65], s[130], s[195]); o.y = pk4_fp8(s[260], s[325], s[390], s[455]);
        const int drow = inter ? (c0 + ((n & 31) >> 2) * 8 + (n >> 5) * 4 + (n & 3)) : (c0 + n);
        __builtin_nontemporal_store(o, (u32x2*)(dst + (size_t)drow * ldk + k0 + 8 * c));
    }
}

__device__ __forceinline__ void ph0(const Args& a, unsigned char* lds, const int tid) {
    const int lane = tid & 63, wave = tid >> 6;
    const float* c_in = a.in[1]; const float* w_ada = a.in[2]; const float* b_ada = a.in[3];
    float* MOD = (float*)(a.ws + WS_MOD);
    {
        float* sc = (float*)lds; float* red = sc + 4096;
        for (int i = tid; i < 4096; i += 512) sc[i] = siluf(c_in[i]);
        __syncthreads();
        for (int it = blockIdx.x; it < 192; it += gridDim.x) {
            const int cc = tid & 31, ks = tid >> 5, col = it * 32 + cc;
            float a0 = 0.f, a1 = 0.f, a2 = 0.f, a3 = 0.f;
            const float* wp = w_ada + (size_t)(ks * 64) * 6144 + col;
            float wv[64];
#pragma unroll
            for (int k = 0; k < 64; ++k) wv[k] = __builtin_nontemporal_load(wp + (size_t)k * 6144);
#pragma unroll
            for (int k = 0; k < 64; ++k) { const float w = wv[k]; const int kk = ks * 64 + k;
                a0 += sc[kk] * w; a1 += sc[1024 + kk] * w; a2 += sc[2048 + kk] * w; a3 += sc[3072 + kk] * w; }
            float* rp = red + (ks * 32 + cc) * 4; rp[0] = a0; rp[1] = a1; rp[2] = a2; rp[3] = a3;
            __syncthreads();
            if (tid < 128) { const int c2 = tid & 31, b = tid >> 5; float s = 0.f;
                for (int k2 = 0; k2 < 16; ++k2) s += red[(k2 * 32 + c2) * 4 + b];
                MOD[b * 6144 + it * 32 + c2] = s + b_ada[it * 32 + c2]; }
            __syncthreads();
        }
    }
    __syncthreads();
    float* scr = (float*)lds + wave * (64 * 65);
    const int gw = blockIdx.x * 8 + wave, NGW = gridDim.x * 8;
    const float* w_in = a.in[4]; const float* w_out = a.in[16]; const float* w_router = a.in[17];
    const float* w1 = a.in[19]; const float* w3 = a.in[20]; const float* w2 = a.in[21];
    const float* ws1 = a.in[22]; const float* ws3 = a.in[23]; const float* ws2 = a.in[24];
    bf16_t* WIN = (bf16_t*)(a.ws + WS_WIN); bf16_t* WOUT = (bf16_t*)(a.ws + WS_WOUT); bf16_t* WRS = (bf16_t*)(a.ws + WS_WRS);
    unsigned char* W2T8 = (unsigned char*)(a.ws + WS_W2T); unsigned char* W13T8 = (unsigned char*)(a.ws + WS_W13T);
    constexpr int IT_WIN = 56 * 16, IT_WOUT = 16 * 16, IT_WR = 4 * 16, IT_WS13 = 8 * 16, IT_WS2 = 4 * 16, IT_E13 = 256 * 128, IT_E2 = 256 * 64;
    constexpr int NITEMS = IT_WIN + IT_WOUT + IT_WR + IT_WS13 + IT_WS2 + IT_E13 + IT_E2;
    for (int it = gw; it < NITEMS; it += NGW) {
        int r = it;
        if (r < IT_WIN) { const int kb = r / 56, cb = r % 56, c0 = 64 * cb, n0 = c0 + (c0 >= 2048 ? 8 : 0);
            conv_item8(w_in, w_in, DIN, 64 * kb, n0, false, (unsigned char*)WIN, 1024, c0, scr, lane, 64.f); continue; } r -= IT_WIN;
        if (r < IT_WOUT) { const int kb = r / 16, cb = r % 16; conv_item(w_out, w_out, 1024, 64 * kb, 64 * cb, false, WOUT, 1024, 64 * cb, scr, lane); continue; } r -= IT_WOUT;
        if (r < IT_WR) { const int kb = r / 4, cb = r % 4; conv_item(w_router, w_router, 256, 64 * kb, 64 * cb, false, WRS, 1024, 64 * cb, scr, lane); continue; } r -= IT_WR;
        if (r < IT_WS13) { const int kb = r / 8, cb = r % 8; conv_item(ws1, ws3, 256, 64 * kb, 32 * cb, true, WRS + (size_t)256 * 1024, 1024, 64 * cb, scr, lane); continue; } r -= IT_WS13;
        if (r < IT_WS2) { const int kb = r / 16, cb = r % 16; conv_item8(ws2, ws2, 1024, 64 * kb, 64 * cb, false, W2T8 + (size_t)256 * 1024 * 256, 256, 64 * cb, scr, lane, 32.f); continue; } r -= IT_WS2;
        if (r < IT_E13) { const int e = r >> 7, rr = r & 127, kb = rr >> 3, cb = rr & 7;
            conv_item8(w1 + (size_t)e * 1024 * 256, w3 + (size_t)e * 1024 * 256, 256, 64 * kb, 32 * cb, true, W13T8 + (size_t)e * 512 * 1024, 1024, 64 * cb, scr, lane, 64.f); continue; } r -= IT_E13;
        { const int e = r >> 6, rr = r & 63, kb = rr >> 4, cb = rr & 15;
            conv_item8(w2 + (size_t)e * 256 * 1024, w2, 1024, 64 * kb, 64 * cb, false, W2T8 + (size_t)e * 1024 * 256, 256, 64 * cb, scr, lane, 32.f); }
    }
}

template <bool GATES>
__device__ __forceinline__ void ph_norm(const Args& a, unsigned char* lds, const float* X, int mod_shift, int mod_scale, const int tid) {
    const int lane = tid & 63, wave = tid >> 6;
    const float* MOD = (const float*)(a.ws + WS_MOD);
    bf16_t* H = (bf16_t*)(a.ws + WS_H);
    float* wg = (float*)lds;
    if (GATES) {
        const float* w_in = a.in[4];
        for (int i = tid; i < 8192; i += 512) { const int k = i >> 3, g = i & 7; wg[g * 1024 + k] = w_in[(size_t)k * DIN + 2048 + g]; }
        __syncthreads();
    }
    const float* gate_b = a.in[7];
    float* IPRE = (float*)(a.ws + WS_IPRE); float* FPRE = (float*)(a.ws + WS_FPRE);
    const int gw = blockIdx.x * 8 + wave, NGW = gridDim.x * 8;
    for (int row = gw; row < T; row += NGW) {
        const int b = row / SEQ;
        const f32x4* xr = (const f32x4*)(X + (size_t)row * DM) + lane;
        const u32x2* xb = (const u32x2*)((const bf16_t*)(a.ws + WS_X1B) + (size_t)row * DM) + lane;
        f32x4 v[4]; float ss = 0.f;
#pragma unroll
        for (int j = 0; j < 4; ++j) { if (GATES) v[j] = __builtin_nontemporal_load(xr + 64 * j); else { const u32x2 w = xb[64 * j]; v[j] = (f32x4){bflo(w.x), bfhi(w.x), bflo(w.y), bfhi(w.y)}; } ss += (v[j].x * v[j].x + v[j].y * v[j].y) + (v[j].z * v[j].z + v[j].w * v[j].w); }
        const float rstd = rsqrtf(wave_sum(ss) * (1.f / DM) + EPS);
        const f32x4* sh = (const f32x4*)(MOD + b * 6144 + mod_shift * 1024) + lane;
        const f32x4* sc = (const f32x4*)(MOD + b * 6144 + mod_scale * 1024) + lane;
        u32x2* o8 = (u32x2*)(H + (size_t)row * DM) + lane;
#pragma unroll
        for (int j = 0; j < 4; ++j) { const f32x4 s4 = sc[64 * j], h4 = sh[64 * j];
            v[j].x = v[j].x * rstd * (1.f + s4.x) + h4.x; v[j].y = v[j].y * rstd * (1.f + s4.y) + h4.y;
            v[j].z = v[j].z * rstd * (1.f + s4.z) + h4.z; v[j].w = v[j].w * rstd * (1.f + s4.w) + h4.w;
            if (!GATES) { u32x2 p; p.x = pk2(v[j].x, v[j].y); p.y = pk2(v[j].z, v[j].w); o8[64 * j] = p; }
            *((unsigned*)(a.ws + WS_H8 + (size_t)row * DM) + lane + 64 * j) = pk4_fp8(v[j].x, v[j].y, v[j].z, v[j].w); }
        if (GATES) {
            float g[8];
#pragma unroll
            for (int q = 0; q < 8; ++q) { float s = 0.f;
#pragma unroll
                for (int j = 0; j < 4; ++j) { const f32x4 w4 = *((const f32x4*)(wg + q * 1024) + lane + 64 * j);
                    s += (v[j].x * w4.x + v[j].y * w4.y) + (v[j].z * w4.z + v[j].w * w4.w); }
                g[q] = wave_sum(s); }
            if (lane == 0) {
#pragma unroll
                for (int q = 0; q < 4; ++q) { IPRE[(size_t)row * 4 + q] = g[q] + gate_b[q]; FPRE[(size_t)row * 4 + q] = g[4 + q] + gate_b[4 + q]; }
            }
        }
    }
}


namespace pg8 {
#define PG8_LAS __attribute__((address_space(3)))
typedef int i32x4 __attribute__((ext_vector_type(4)));
typedef int i32x8 __attribute__((ext_vector_type(8)));
constexpr int BM = 256, BK = 64, HALF = 128, HTB = HALF * BK * 2;
__device__ __forceinline__ int lds_byte(int r, int c) { const int st = (r >> 4) * 2 + (c >> 5), rr = r & 15, cc = c & 31, ob = rr * 64 + cc * 2; return st * 1024 + (ob ^ (((ob >> 9) & 1) << 5)); }
__device__ __forceinline__ void stage_rc(int b, int& R, int& C) { const int st = b / 1024, sb = b % 1024, swz = sb ^ (((sb >> 9) & 1) << 5); R = (st >> 1) * 16 + swz / 64; C = (st & 1) * 32 + (swz % 64) / 2; }
__device__ __forceinline__ int perm32(int rho) { const int n = rho >> 4, i = rho & 15; return 8 * (i >> 2) + 4 * n + (i & 3); }
struct Unit { const char* A; const char* B; const int* gather; int row0, rend, col0; };

template <bool P16, class RowEpi>
__device__ __forceinline__ void run_epi(const RowEpi& E, const f32x4 (&acc)[2][2][4][2], const Unit& u, int wr, int wc, int fr, int fq) {
#pragma unroll
    for (int ai = 0; ai < 2; ++ai)
#pragma unroll
        for (int m = 0; m < 4; ++m) { const int row = u.row0 + ai * HALF + wr * 64 + m * 16 + fr; const bool valid = row < u.rend;
            if constexpr (P16) { const float v16[16] = {acc[ai][0][m][0][0], acc[ai][0][m][0][1], acc[ai][0][m][0][2], acc[ai][0][m][0][3], acc[ai][0][m][1][0], acc[ai][0][m][1][1], acc[ai][0][m][1][2], acc[ai][0][m][1][3],
                                                 acc[ai][1][m][0][0], acc[ai][1][m][0][1], acc[ai][1][m][0][2], acc[ai][1][m][0][3], acc[ai][1][m][1][0], acc[ai][1][m][1][1], acc[ai][1][m][1][2], acc[ai][1][m][1][3]};
                E.row16(row, valid, u.col0 + 64 * wc + 16 * fq, v16); } else
#pragma unroll
            for (int bj = 0; bj < 2; ++bj) { const int col0 = u.col0 + bj * HALF + wc * 32 + 8 * fq;
                const float v[8] = {acc[ai][bj][m][0][0], acc[ai][bj][m][0][1], acc[ai][bj][m][0][2], acc[ai][bj][m][0][3], acc[ai][bj][m][1][0], acc[ai][bj][m][1][1], acc[ai][bj][m][1][2], acc[ai][bj][m][1][3]};
                E(row, valid, col0, v); } }
}

template <bool GATHER, bool FP8, int SCW, int SCX, bool P16, class RowEpi, class Sched>
__device__ __forceinline__ void gemm_phase(PG8_LAS unsigned char* lds, const int KB, const Sched& S, const RowEpi& E) {
    const int tid = threadIdx.x, wid = __builtin_amdgcn_readfirstlane(tid >> 6), lane = tid & 63, wr = wid >> 2, wc = wid & 3, fr = lane & 15, fq = lane >> 4;
    const int nt = KB / 128;
    int scw_ = SCW, scx_ = SCX; asm volatile("" : "+v"(scw_), "+v"(scx_));
    int Rr[2], Cc[2]; unsigned voffB[2][2];
#pragma unroll
    for (int i = 0; i < 2; ++i) { stage_rc(tid * 16 + i * 8192, Rr[i], Cc[i]);
#pragma unroll
        for (int h = 0; h < 2; ++h) { const int R = Rr[i];
            const int cperm = P16 ? 64 * (R >> 5) + 16 * ((R >> 2) & 3) + 8 * h + 4 * ((R >> 4) & 1) + (R & 3) : h * HALF + (R & ~31) + perm32(R & 31);
            voffB[h][i] = (unsigned)(cperm * KB + Cc[i] * 2); } }
    const size_t kstep = (size_t)(BK * 2);
    const unsigned ldsw = (unsigned)wid * 1024u;
    const int aoff = lds_byte(wr * 64 + fr, fq * 8), boff = lds_byte(wc * 32 + fr, fq * 8);
#define PG8_SA(b, h) (((b) * 2 + (h)) * HTB)
#define PG8_SB(b, h) ((4 + (b) * 2 + (h)) * HTB)
#define PG8_STAGE(bufoff, gbase, voff) do { _Pragma("unroll") for (int _i = 0; _i < 2; ++_i) \
        __builtin_amdgcn_global_load_lds((const unsigned*)((const char*)(gbase) + (voff)[_i]), (PG8_LAS unsigned*)(lds + (bufoff) + ldsw + _i * 8192), 16, 0, 0); } while (0)
#define PG8_LD8(dst, addr) do { const i32x4 lo_ = *(const PG8_LAS i32x4*)(addr), hi_ = *(const PG8_LAS i32x4*)((addr) + 1024); dst = __builtin_shufflevector(lo_, hi_, 0, 1, 2, 3, 4, 5, 6, 7); } while (0)
#define PG8_LDA(dst, b, h) do { _Pragma("unroll") for (int m = 0; m < 4; ++m) PG8_LD8(dst[m], lds + PG8_SA(b, h) + aoff + m * 2048); } while (0)
#define PG8_LDB(dst, b, h) do { _Pragma("unroll") for (int n = 0; n < 2; ++n) PG8_LD8(dst[n], lds + PG8_SB(b, h) + boff + n * 2048); } while (0)
#define PG8_HALF(v, k) __builtin_bit_cast(bf16x8, (k) ? __builtin_shufflevector(v, v, 4, 5, 6, 7) : __builtin_shufflevector(v, v, 0, 1, 2, 3))
#define PG8_MMA(ai, bj, At, Bt) do { __builtin_amdgcn_s_setprio(1); _Pragma("unroll") for (int m = 0; m < 4; ++m) _Pragma("unroll") for (int n = 0; n < 2; ++n) { \
        if (FP8) asm volatile("v_mfma_scale_f32_16x16x128_f8f6f4 %0, %1, %2, %0, %3, %4 op_sel_hi:[0,0,0]" : "+v"(acc[ai][bj][m][n]) : "v"(Bt[n]), "v"(At[m]), "v"(scw_), "v"(scx_)); \
        else { _Pragma("unroll") for (int k = 0; k < 2; ++k) acc[ai][bj][m][n] = __builtin_amdgcn_mfma_f32_16x16x32_bf16(PG8_HALF(Bt[n], k), PG8_HALF(At[m], k), acc[ai][bj][m][n], 0, 0, 0); } } \
        __builtin_amdgcn_s_setprio(0); } while (0)
#define PG8_WAIT_V(n) asm volatile("s_waitcnt vmcnt(" #n ")" ::: "memory")
#define PG8_WAIT_L(n) asm volatile("s_waitcnt lgkmcnt(" #n ")" ::: "memory")
#define PG8_BAR __builtin_amdgcn_s_barrier()
#define PG8_SCHED __builtin_amdgcn_sched_barrier(0)
#define PG8_FILLA(u, v) do { _Pragma("unroll") for (int _h = 0; _h < 2; ++_h) _Pragma("unroll") for (int _i = 0; _i < 2; ++_i) { const int _row = _h * HALF + Rr[_i]; \
        if (GATHER) { const int _ri = (u).row0 + _row; const int _src = (u).gather[_ri < (u).rend ? _ri : (u).row0]; (v)[_h][_i] = (unsigned)(_src * KB + Cc[_i] * 2); } \
        else (v)[_h][_i] = (unsigned)(_row * KB + Cc[_i] * 2); } } while (0)
    Unit cur, nxt; int ui = 0;
    if (!S.next(0, cur)) return;
    f32x4 acc[2][2][4][2];
#pragma unroll
    for (int a = 0; a < 2; ++a)
#pragma unroll
        for (int b = 0; b < 2; ++b)
#pragma unroll
            for (int m = 0; m < 4; ++m)
#pragma unroll
                for (int n = 0; n < 2; ++n) acc[a][b][m][n] = (f32x4){0.f, 0.f, 0.f, 0.f};
    i32x8 At[4], B0[2], B1[2];
    unsigned voffA[2][2], nvoffA[2][2];
    PG8_FILLA(cur, voffA);
    const char* cA = cur.A; const char* cB = cur.B;
    PG8_STAGE(PG8_SB(0, 0), cB, voffB[0]); PG8_STAGE(PG8_SB(0, 1), cB, voffB[1]); PG8_STAGE(PG8_SA(0, 0), cA, voffA[0]); PG8_STAGE(PG8_SA(0, 1), cA, voffA[1]);
    if (wr == 1) PG8_BAR;
    PG8_WAIT_V(2); PG8_BAR;
    PG8_STAGE(PG8_SB(1, 0), cB + kstep, voffB[0]); PG8_STAGE(PG8_SA(1, 0), cA + kstep, voffA[0]); PG8_STAGE(PG8_SB(1, 1), cB + kstep, voffB[1]);
    PG8_WAIT_V(6); PG8_BAR;
    for (;;) {
        const bool has_next = S.next(ui + 1, nxt);
        const char* nA = has_next ? nxt.A : cA; const char* nB = has_next ? nxt.B : cB;
        if (GATHER && has_next) { PG8_FILLA(nxt, nvoffA); }
        else {
#pragma unroll
            for (int h = 0; h < 2; ++h)
#pragma unroll
                for (int i = 0; i < 2; ++i) nvoffA[h][i] = voffA[h][i]; }
        for (int t = 0; t < nt; t += 2) {
            const bool last = (t == nt - 2);
            const char* a1 = cA + (size_t)(t + 1) * kstep;
            const char* a2 = last ? nA : cA + (size_t)(t + 2) * kstep; const char* b2 = last ? nB : cB + (size_t)(t + 2) * kstep;
            const char* a3 = a2 + kstep; const char* b3 = b2 + kstep;
            unsigned v2[2][2];
#pragma unroll
            for (int h = 0; h < 2; ++h)
#pragma unroll
                for (int i = 0; i < 2; ++i) v2[h][i] = last ? nvoffA[h][i] : voffA[h][i];
            PG8_LDB(B0, 0, 0); PG8_LDB(B1, 0, 1); PG8_SCHED; PG8_LDA(At, 0, 0); PG8_STAGE(PG8_SA(1, 1), a1, voffA[1]);
            PG8_WAIT_V(8); PG8_WAIT_L(0); PG8_BAR; PG8_MMA(0, 0, At, B0); PG8_MMA(0, 1, At, B1); PG8_BAR; PG8_SCHED;
            PG8_LDA(At, 0, 1); PG8_STAGE(PG8_SB(0, 0), b2, voffB[0]); PG8_STAGE(PG8_SB(0, 1), b2, voffB[1]); PG8_STAGE(PG8_SA(0, 0), a2, v2[0]);
            PG8_WAIT_V(8); PG8_WAIT_L(0); PG8_BAR; PG8_MMA(1, 0, At, B0); PG8_MMA(1, 1, At, B1); PG8_BAR; PG8_SCHED;
            PG8_LDB(B0, 1, 0); PG8_LDB(B1, 1, 1); PG8_SCHED; PG8_LDA(At, 1, 0); PG8_STAGE(PG8_SA(0, 1), a2, v2[1]);
            PG8_WAIT_V(8); PG8_WAIT_L(0); PG8_BAR; PG8_MMA(0, 0, At, B0); PG8_MMA(0, 1, At, B1); PG8_BAR; PG8_SCHED;
            PG8_LDA(At, 1, 1); PG8_STAGE(PG8_SB(1, 0), b3, voffB[0]); PG8_STAGE(PG8_SB(1, 1), b3, voffB[1]); PG8_STAGE(PG8_SA(1, 0), a3, v2[0]);
            PG8_WAIT_V(8); PG8_WAIT_L(0); PG8_BAR; PG8_MMA(1, 0, At, B0); PG8_MMA(1, 1, At, B1); PG8_BAR; PG8_SCHED;
        }
        if (wr == 0) PG8_BAR;
        if (FP8) { PG8_SCHED; asm volatile("s_nop 15\n\ts_nop 7" ::: "memory"); PG8_SCHED; }
        run_epi<P16>(E, acc, cur, wr, wc, fr, fq);
        if (!has_next) break;
#pragma unroll
        for (int a = 0; a < 2; ++a)
#pragma unroll
            for (int b = 0; b < 2; ++b)
#pragma unroll
                for (int m = 0; m < 4; ++m)
#pragma unroll
                    for (int n = 0; n < 2; ++n) acc[a][b][m][n] = (f32x4){0.f, 0.f, 0.f, 0.f};
        cur = nxt; cA = nA; cB = nB; ++ui;
#pragma unroll
        for (int h = 0; h < 2; ++h)
#pragma unroll
            for (int i = 0; i < 2; ++i) voffA[h][i] = nvoffA[h][i];
        if (wr == 1) PG8_BAR;
    }
    PG8_WAIT_V(0);
    PG8_BAR;
#undef PG8_SA
#undef PG8_SB
#undef PG8_STAGE
#undef PG8_LDA
#undef PG8_LD8
#undef PG8_HALF
#undef PG8_LDB
#undef PG8_MMA
#undef PG8_WAIT_V
#undef PG8_WAIT_L
#undef PG8_BAR
#undef PG8_SCHED
#undef PG8_FILLA
}

struct DenseSched {
    const char* A; const char* Bt; int KB, M, nM, nN, nwg, G, c;
    __device__ __forceinline__ void init(const void* A_, const void* Bt_, int M_, int N_, int KB_, int G_, int c_) { A = (const char*)A_; Bt = (const char*)Bt_; KB = KB_; M = M_; nM = M_ / BM; nN = N_ / BM; nwg = nM * nN; G = G_; c = c_; }
    __device__ __forceinline__ bool next(int i, Unit& u) const {
        const long L = (long)i * G + c; if (L >= nwg) return false;
        int wgid = (int)L; { const int q = nwg / 8, r = nwg % 8, xcd = wgid % 8, off = wgid / 8; wgid = (xcd < r ? xcd * (q + 1) : r * (q + 1) + (xcd - r) * q) + off; }
        const int nig = 8 * nN, gid = wgid / nig, fm = gid * 8, gsz = (nM - fm) < 8 ? (nM - fm) : 8;
        const int pm = fm + ((wgid % nig) % gsz), pn = (wgid % nig) / gsz;
        u.A = A + (size_t)pm * BM * KB; u.B = Bt + (size_t)pn * BM * KB; u.gather = nullptr; u.row0 = pm * BM; u.rend = M; u.col0 = pn * BM; return true;
    }
};
struct ExpertSched {
    const int* TILE; int nunits, NPN; const char* A; const int* gather; const char* Bt; size_t bstride; int KB, G, vcu;
    __device__ __forceinline__ bool next(int i, Unit& u) const {
        const int L = i * G + vcu; if (L >= nunits) return false;
        const int tl = L / NPN, pn = L % NPN;
        const int e = __builtin_amdgcn_readfirstlane(TILE[64 + tl]), r0 = __builtin_amdgcn_readfirstlane(TILE[64 + 2048 + tl]), re = __builtin_amdgcn_readfirstlane(TILE[64 + 4096 + tl]);
        u.B = Bt + (size_t)e * bstride + (size_t)pn * BM * KB; u.row0 = r0; u.rend = re; u.col0 = pn * BM;
        if (gather) { u.A = A; u.gather = gather; } else { u.A = A + (size_t)r0 * KB; u.gather = nullptr; }
        return true;
    }
};
}

struct EpiProj { bf16_t* P;
    __device__ __forceinline__ void operator()(int row, bool valid, int col0, const float (&v)[8]) const { if (valid) *(u32x4*)(P + (size_t)row * NPROJ + col0) = pack8(v); } };
struct EpiOut { const float* x; bf16_t* x1; const float* MOD;
    __device__ __forceinline__ void operator()(int row, bool valid, int col0, const float (&v)[8]) const {
        if (!valid) return; const int b = row / SEQ; const float* ga = MOD + b * 6144 + 2 * 1024 + col0;
        const f32x4 x0 = __builtin_nontemporal_load((const f32x4*)(x + (size_t)row * DM + col0)), x1v = __builtin_nontemporal_load((const f32x4*)(x + (size_t)row * DM + col0 + 4));
        const float o[8] = {x0.x + ga[0] * v[0], x0.y + ga[1] * v[1], x0.z + ga[2] * v[2], x0.w + ga[3] * v[3], x1v.x + ga[4] * v[4], x1v.y + ga[5] * v[5], x1v.z + ga[6] * v[6], x1v.w + ga[7] * v[7]};
        *(u32x4*)(x1 + (size_t)row * DM + col0) = pack8(o); } };
struct EpiRS { float* LOG; bf16_t* ACT;
    __device__ __forceinline__ void operator()(int row, bool valid, int col0, const float (&v)[8]) const {
        if (!valid) return;
        if (col0 < 256) { *(f32x4*)(LOG + (size_t)row * 256 + col0) = (f32x4){v[0], v[1], v[2], v[3]}; *(f32x4*)(LOG + (size_t)row * 256 + col0 + 4) = (f32x4){v[4], v[5], v[6], v[7]}; }
        else { const int j0 = (col0 - 256) >> 1;
            *(unsigned*)((unsigned char*)ACT + (size_t)(SHARED_BASE + row) * 256 + j0) = pk4_fp8(8.f * siluf(v[0]) * v[4], 8.f * siluf(v[1]) * v[5], 8.f * siluf(v[2]) * v[6], 8.f * siluf(v[3]) * v[7]); } } };
struct EpiG1 { const float* SG; bf16_t* ACT;
    __device__ __forceinline__ void operator()(int row, bool valid, int col0, const float (&v)[8]) const {
        if (!valid) return; const float g = 8.f * SG[row]; const int j0 = col0 >> 1;
        *(unsigned*)((unsigned char*)ACT + (size_t)row * 256 + j0) = pk4_fp8(siluf(v[0]) * v[4] * g, siluf(v[1]) * v[5] * g, siluf(v[2]) * v[6] * g, siluf(v[3]) * v[7] * g); } };
struct EpiG2 { bf16_t* YP;
    __device__ __forceinline__ void operator()(int row, bool valid, int col0, const float (&v)[8]) const { if (valid) { u32x2 p; p.x = pk4_fp8(16.f * v[0], 16.f * v[1], 16.f * v[2], 16.f * v[3]); p.y = pk4_fp8(16.f * v[4], 16.f * v[5], 16.f * v[6], 16.f * v[7]);
            *(u32x2*)((unsigned char*)YP + (size_t)row * DM + col0) = p; } }
    __device__ __forceinline__ void row16(int row, bool valid, int col0, const float (&v)[16]) const { if (valid) { u32x4 p;
            p.x = pk4_fp8(16.f * v[0], 16.f * v[1], 16.f * v[2], 16.f * v[3]); p.y = pk4_fp8(16.f * v[4], 16.f * v[5], 16.f * v[6], 16.f * v[7]);
            p.z = pk4_fp8(16.f * v[8], 16.f * v[9], 16.f * v[10], 16.f * v[11]); p.w = pk4_fp8(16.f * v[12], 16.f * v[13], 16.f * v[14], 16.f * v[15]);
            __builtin_nontemporal_store(p, (u32x4*)((unsigned char*)YP + (size_t)row * DM + col0)); } } };

constexpr int LR = 136;
__device__ __forceinline__ f32x4 mfma16(bf16x8 a, bf16x8 b, f32x4 c) {
    asm volatile("s_nop 1\n\tv_mfma_f32_16x16x32_bf16 %0, %1, %2, %0" : "+v"(c) : "v"(a), "v"(b)); return c; }
#define MFMA_DRAIN8(x) asm volatile("s_nop 15\n\ts_nop 3" : "+v"(x[0]), "+v"(x[1]), "+v"(x[2]), "+v"(x[3]), "+v"(x[4]), "+v"(x[5]), "+v"(x[6]), "+v"(x[7]))
__device__ __forceinline__ bf16x8 ldfrag(const bf16_t* base, int row, int k0, int lane) { return *(const bf16x8*)(base + (row + (lane & 15)) * LR + k0 + 8 * (lane >> 4)); }


__device__ __forceinline__ void conv8_lds(const bf16_t* R, int pitch, int s, int col, const float* cw, int wpitch, const float* cb, int ch, float (&o)[8]) {
    float acc[8];
    { const f32x4 b0 = *(const f32x4*)(cb + ch), b1 = *(const f32x4*)(cb + ch + 4); acc[0] = b0.x; acc[1] = b0.y; acc[2] = b0.z; acc[3] = b0.w; acc[4] = b1.x; acc[5] = b1.y; acc[6] = b1.z; acc[7] = b1.w; }
#pragma unroll
    for (int j = 0; j < 4; ++j) { float x[8]; unpack8(*(const u32x4*)(R + (s + j) * pitch + col), x);
        const f32x4 w0 = *(const f32x4*)(cw + j * wpitch + ch), w1 = *(const f32x4*)(cw + j * wpitch + ch + 4);
        acc[0] += w0.x * x[0]; acc[1] += w0.y * x[1]; acc[2] += w0.z * x[2]; acc[3] += w0.w * x[3];
        acc[4] += w1.x * x[4]; acc[5] += w1.y * x[5]; acc[6] += w1.z * x[6]; acc[7] += w1.w * x[7]; }
#pragma unroll
    for (int q = 0; q < 8; ++q) o[q] = siluf(acc[q]);
}
__device__ __forceinline__ void chunk_gates(const Args& a, float* bb, float* ii, float* tmp, int t0, int h, int tid) {
    const float* IPRE = (const float*)(a.ws + WS_IPRE); const float* FPRE = (const float*)(a.ws + WS_FPRE);
    if (tid < 128) { const float f = FPRE[(size_t)(t0 + tid) * 4 + h]; ii[tid] = IPRE[(size_t)(t0 + tid) * 4 + h];
        tmp[tid] = fminf(f, 0.f) - log1pf(expf(-fabsf(f))); }
    __syncthreads();
    if (tid < 128) { float s = 0.f;
#pragma unroll 4
        for (int j4 = 0; j4 < 32; ++j4) { const f32x4 v = *(const f32x4*)(tmp + 4 * j4); const int j = 4 * j4;
            s += (j <= tid ? v.x : 0.f); s += (j + 1 <= tid ? v.y : 0.f); s += (j + 2 <= tid ? v.z : 0.f); s += (j + 3 <= tid ? v.w : 0.f); }
        bb[tid] = s; }
    __syncthreads();
}

__device__ __forceinline__ void mlstm_m1_unit(const Args& a, unsigned char* lds, int unit, const int wave_s) {
    const int tid = mk_tid(wave_s);
    const int lane = tid & 63, wave = tid >> 6;
    const int bh = unit >> 6, c = unit & 63, b = bh >> 2, h = bh & 3, t0 = b * SEQ + c * 128;
    bf16_t* kT = (bf16_t*)lds; bf16_t* vT = kT + 128 * LR;
    float* sf = (float*)(lds + 2 * 128 * LR * 2); float* bb = sf; float* ii = sf + 128; float* tmp = sf + 256; float* wk = sf + 384;
    const bf16_t* PROJ = (const bf16_t*)(a.ws + WS_PROJ);
    const float* cw = a.in[5]; const float* cbias = a.in[6];
    bf16_t* R = (bf16_t*)(lds + 2 * 128 * LR * 2 + 2048);
    const int tl = tid;
    u32x4 rawk[5], vreg[4];
#pragma unroll
    for (int k = 0; k < 5; ++k) { const int idx = tl + 512 * k, row = idx >> 4, chunk = idx & 15; const int sp = c * 128 - 3 + row;
        rawk[k] = (u32x4){0u, 0u, 0u, 0u};
        if (idx < 131 * 16 && sp >= 0) rawk[k] = *(const u32x4*)(PROJ + (size_t)(b * SEQ + sp) * NPROJ + 512 + h * 128 + 8 * chunk); }
#pragma unroll
    for (int k = 0; k < 4; ++k) { const int it = tl + 512 * k, sidx = it & 127, ch = it >> 7; vreg[k] = *(const u32x4*)(PROJ + (size_t)(t0 + sidx) * NPROJ + 1024 + h * 128 + 8 * ch); }
    float* WL = (float*)(lds + 147456);
    float wl0 = 0.f, wl1 = 0.f; if (tl < 512) wl0 = cw[(tl >> 7) * 1024 + 512 + h * 128 + (tl & 127)]; if (tl < 128) wl1 = cbias[512 + h * 128 + tl];
    chunk_gates(a, bb, ii, tmp, t0, h, tid);
    if (tl < 512) WL[tl] = wl0; if (tl < 128) WL[512 + tl] = wl1;
#pragma unroll
    for (int k = 0; k < 5; ++k) { const int idx = tl + 512 * k; if (idx < 131 * 16) *(u32x4*)(R + (idx >> 4) * 136 + 8 * (idx & 15)) = rawk[k]; }
    const float blast = bb[127];
    if (tid < 128) tmp[tid] = blast - bb[tid] + ii[tid];
    __syncthreads();
    float mloc = -INFINITY;
#pragma unroll 4
    for (int j4 = 0; j4 < 32; ++j4) { const f32x4 v = *(const f32x4*)(tmp + 4 * j4); mloc = fmaxf(fmaxf(mloc, fmaxf(v.x, v.y)), fmaxf(v.z, v.w)); }
    if (tid < 128) wk[tid] = expf(tmp[tid] - mloc);
    __syncthreads();
#pragma unroll
    for (int k = 0; k < 4; ++k) { const int it = tl + 512 * k, sidx = it & 127, ch = it >> 7;
        float kv[8]; conv8_lds(R, 136, sidx, 8 * ch, WL, 128, WL + 512, 8 * ch, kv);
        const float sc = 0.08838834764831845f * wk[sidx];
#pragma unroll
        for (int q = 0; q < 8; ++q) kT[(8 * ch + q) * LR + sidx] = (bf16_t)f2bf(kv[q] * sc);
        float vv[8]; unpack8(vreg[k], vv);
#pragma unroll
        for (int q = 0; q < 8; ++q) vT[(8 * ch + q) * LR + sidx] = (bf16_t)f2bf(vv[q]);
    }
    __syncthreads();
    float* CLOC = (float*)(a.ws + WS_CLOC) + (size_t)unit * 16384;
    float* MST = (float*)(a.ws + WS_MST);
    {
        f32x4 acc[8];
#pragma unroll
        for (int i = 0; i < 8; ++i) acc[i] = (f32x4){0.f, 0.f, 0.f, 0.f};
#pragma unroll
        for (int ks = 0; ks < 4; ++ks) { const bf16x8 af = ldfrag(vT, 16 * wave, 32 * ks, lane);
#pragma unroll
            for (int db = 0; db < 8; ++db) acc[db] = mfma16(af, ldfrag(kT, 16 * db, 32 * ks, lane), acc[db]); }
        MFMA_DRAIN8(acc);
#pragma unroll
        for (int db = 0; db < 8; ++db)
#pragma unroll
            for (int r = 0; r < 4; ++r) CLOC[(16 * wave + 4 * (lane >> 4) + r) * 128 + 16 * db + (lane & 15)] = acc[db][r];
    }
    if (tid < 128) { float s = 0.f;
#pragma unroll 4
        for (int j8 = 0; j8 < 16; ++j8) { float x[8]; unpack8(*(const u32x4*)(kT + tid * LR + 8 * j8), x); s += ((x[0] + x[1]) + (x[2] + x[3])) + ((x[4] + x[5]) + (x[6] + x[7])); }
        MST[16384 + (size_t)unit * 128 + tid] = s; }
    if (tid == 0) { MST[unit] = mloc; MST[1024 + unit] = blast; }
    __syncthreads();
}

__device__ __forceinline__ void mlstm_m2(const Args& a, const int tid2) {
    const float* CLOC = (const float*)(a.ws + WS_CLOC); bf16_t* CIN = (bf16_t*)(a.ws + WS_CIN);
    float* MST = (float*)(a.ws + WS_MST);
    const float* NLOC = MST + 16384; float* NIN = MST + 16384 + 131072;
    for (int gid = blockIdx.x * 512 + tid2; gid < 16 * 8192; gid += gridDim.x * 512) {
        const int bh = gid >> 13, e2 = gid & 8191; const bool hasn = e2 < 128;
        const float* cl = CLOC + (size_t)(bh * 64) * 16384 + e2; const float* nl = NLOC + (size_t)(bh * 64) * 128 + e2;
        bf16_t* ci = CIN + (size_t)(bh * 64) * 16384 + e2; float* ni = NIN + (size_t)(bh * 64) * 128 + e2;
        const float* mlp = MST + bh * 64; const float* blp = MST + 1024 + bh * 64;
        float s0 = 0.f, s1 = 0.f, sn = 0.f, m = 0.f;
        float p0[4], p1[4], pn[4], pm[4], pb[4];
#pragma unroll
        for (int k = 0; k < 4; ++k) { p0[k] = __builtin_nontemporal_load(cl + (size_t)k * 16384); p1[k] = __builtin_nontemporal_load(cl + (size_t)k * 16384 + 8192); pn[k] = hasn ? nl[k * 128] : 0.f; pm[k] = mlp[k]; pb[k] = blp[k]; }
        for (int c0 = 0; c0 < 64; c0 += 4) {
            float q0[4], q1[4], qn[4], qm[4], qb[4];
            const bool more = c0 + 4 < 64;
#pragma unroll
            for (int k = 0; k < 4; ++k) { const int c = more ? c0 + 4 + k : c0 + k;
                q0[k] = __builtin_nontemporal_load(cl + (size_t)c * 16384); q1[k] = __builtin_nontemporal_load(cl + (size_t)c * 16384 + 8192); qn[k] = hasn ? nl[c * 128] : 0.f; qm[k] = mlp[c]; qb[k] = blp[c]; }
#pragma unroll
            for (int k = 0; k < 4; ++k) { const int c = c0 + k;
                ci[(size_t)c * 16384] = (bf16_t)f2bf(s0); ci[(size_t)c * 16384 + 8192] = (bf16_t)f2bf(s1);
                if (hasn) ni[c * 128] = sn;
                if (e2 == 0) MST[2048 + bh * 64 + c] = m;
                const float ml = pm[k], bl = pb[k];
                const float mn = fmaxf(bl + m, ml), ca = expf(bl + m - mn), cb = expf(ml - mn);
                s0 = ca * s0 + cb * p0[k]; s1 = ca * s1 + cb * p1[k]; sn = ca * sn + cb * pn[k]; m = mn; }
#pragma unroll
            for (int k = 0; k < 4; ++k) { p0[k] = q0[k]; p1[k] = q1[k]; pn[k] = qn[k]; pm[k] = qm[k]; pb[k] = qb[k]; }
        }
    }
}

template <int MODE>
__device__ __forceinline__ void mlstm_m3_unit(const Args& a, unsigned char* lds, int unit, const int wave_s) {
    const int tid = mk_tid(wave_s);
    const int lane = tid & 63, wave = tid >> 6;
    const int bh = unit >> 6, c = unit & 63, b = bh >> 2, h = bh & 3, t0 = b * SEQ + c * 128;
    bf16_t* qs = (bf16_t*)lds; bf16_t* ks = qs + 128 * LR; bf16_t* vT = ks + 128 * LR; bf16_t* CT = vT + 128 * LR; bf16_t* Ps = ks;
    float* sf = (float*)(lds + 4 * 128 * LR * 2);
    float* bb = sf; float* ii = sf + 128; float* tmp = sf + 256; float* gg = sf + 384; float* wint = sf + 512; float* nn = sf + 640; float* den = sf + 768; float* dint = sf + 896;
    const bf16_t* PROJ = (const bf16_t*)(a.ws + WS_PROJ); const bf16_t* CIN = (const bf16_t*)(a.ws + WS_CIN) + (size_t)unit * 16384;
    const float* MST = (const float*)(a.ws + WS_MST);
    const float* cw = a.in[5]; const float* cbias = a.in[6]; const float* mlg = a.in[8];
    bf16_t* MIX = (bf16_t*)(a.ws + WS_MIX);
    bf16_t* R = vT;
    const float m_in = MST[2048 + unit];
    const int tl = tid;
    u32x4 rawq[9], vreg[4], creg[4];
#pragma unroll
    for (int k = 0; k < 9; ++k) { const int idx = tl + 512 * k, row = idx >> 5, chunk = idx & 31; const int sp = c * 128 - 3 + row;
        rawq[k] = (u32x4){0u, 0u, 0u, 0u};
        if (idx < 131 * 32 && sp >= 0) rawq[k] = *(const u32x4*)(PROJ + (size_t)(b * SEQ + sp) * NPROJ + (chunk < 16 ? h * 128 + 8 * chunk : 512 + h * 128 + 8 * (chunk - 16))); }
#pragma unroll
    for (int k = 0; k < 4; ++k) { const int it = tl + 512 * k, sidx = it & 127, ch = it >> 7, s2 = it >> 4, c2 = it & 15;
        vreg[k] = *(const u32x4*)(PROJ + (size_t)(t0 + sidx) * NPROJ + 1024 + h * 128 + 8 * ch); creg[k] = *(const u32x4*)(CIN + s2 * 128 + 8 * c2); }
    float* WL = (float*)(lds + 147456);
    const float wl0 = cw[(tl >> 7) * 1024 + h * 128 + (tl & 127)], wl1 = cw[(tl >> 7) * 1024 + 512 + h * 128 + (tl & 127)]; float wl2 = 0.f; if (tl < 256) wl2 = cbias[(tl >> 7) * 512 + h * 128 + (tl & 127)];
    chunk_gates(a, bb, ii, tmp, t0, h, tid);
    WL[tl] = wl0; WL[512 + tl] = wl1; if (tl < 256) WL[1024 + tl] = wl2;
#pragma unroll
    for (int k = 0; k < 9; ++k) { const int idx = tl + 512 * k; if (idx < 131 * 32) *(u32x4*)(R + (idx >> 5) * 264 + 8 * (idx & 31)) = rawq[k]; }
    if (tid < 128) { float pm = -INFINITY;
#pragma unroll 4
        for (int j4 = 0; j4 < 32; ++j4) { const f32x4 vi = *(const f32x4*)(ii + 4 * j4), vb = *(const f32x4*)(bb + 4 * j4); const int j = 4 * j4;
            pm = fmaxf(pm, j <= tl ? vi.x - vb.x : -INFINITY); pm = fmaxf(pm, j + 1 <= tl ? vi.y - vb.y : -INFINITY);
            pm = fmaxf(pm, j + 2 <= tl ? vi.z - vb.z : -INFINITY); pm = fmaxf(pm, j + 3 <= tl ? vi.w - vb.w : -INFINITY); }
        const float g = fmaxf(m_in, pm); gg[tl] = g; wint[tl] = expf(m_in - g); tmp[tl] = ii[tl] - bb[tl];
        nn[tl] = MST[16384 + 131072 + (size_t)unit * 128 + tl]; }
    __syncthreads();
#pragma unroll 1
    for (int k = 0; k < 4; ++k) { const int it = tl + 512 * k, sidx = it & 127, ch = it >> 7;
        float qv[8], kv[8];
        conv8_lds(R, 264, sidx, 8 * ch, WL, 128, WL + 1024, 8 * ch, qv);
        conv8_lds(R, 264, sidx, 128 + 8 * ch, WL + 512, 128, WL + 1152, 8 * ch, kv);
#pragma unroll
        for (int q = 0; q < 8; ++q) kv[q] *= 0.08838834764831845f;
        *(u32x4*)(qs + sidx * LR + 8 * ch) = pack8(qv);
        *(u32x4*)(ks + sidx * LR + 8 * ch) = pack8(kv); }
    __syncthreads();
#pragma unroll
    for (int k = 0; k < 4; ++k) { const int it = tl + 512 * k, sidx = it & 127, ch = it >> 7, s2 = it >> 4, c2 = it & 15;
        float vv[8]; unpack8(vreg[k], vv);
#pragma unroll
        for (int q = 0; q < 8; ++q) vT[(8 * ch + q) * LR + sidx] = (bf16_t)f2bf(vv[q]);
        *(u32x4*)(CT + s2 * LR + 8 * c2) = creg[k]; }
    __syncthreads();
    if (MODE == 1) return;
    if (tid < 128) { float s = 0.f;
#pragma unroll 4
        for (int d8 = 0; d8 < 16; ++d8) { float x[8]; unpack8(*(const u32x4*)(qs + tl * LR + 8 * d8), x); const f32x4 n0 = *(const f32x4*)(nn + 8 * d8), n1 = *(const f32x4*)(nn + 8 * d8 + 4);
            s += (x[0] * n0.x + x[1] * n0.y) + (x[2] * n0.z + x[3] * n0.w) + (x[4] * n1.x + x[5] * n1.y) + (x[6] * n1.z + x[7] * n1.w); }
        dint[tl] = s * wint[tl]; }
    f32x4 sacc[8];
#pragma unroll
    for (int i = 0; i < 8; ++i) sacc[i] = (f32x4){0.f, 0.f, 0.f, 0.f};
#pragma unroll
    for (int kk = 0; kk < 4; ++kk) { const bf16x8 bq = ldfrag(qs, 16 * wave, 32 * kk, lane);
#pragma unroll
        for (int sb = 0; sb < 8; ++sb) sacc[sb] = mfma16(ldfrag(ks, 16 * sb, 32 * kk, lane), bq, sacc[sb]); }
    MFMA_DRAIN8(sacc);
    __syncthreads();
    {
        const int t = 16 * wave + (lane & 15); const float g = gg[t]; float rs = 0.f;
#pragma unroll
        for (int sb = 0; sb < 8; ++sb) { float p[4];
            const f32x4 u4 = *(const f32x4*)(tmp + 16 * sb + 4 * (lane >> 4));
#pragma unroll
            for (int r = 0; r < 4; ++r) { const int s = 16 * sb + 4 * (lane >> 4) + r;
                const float w = __builtin_amdgcn_exp2f(fminf(u4[r] - g, 0.f) * LOG2E);
                p[r] = (s <= t) ? sacc[sb][r] * w : 0.f; rs += p[r]; }
            u32x2 w; w.x = pk2(p[0], p[1]); w.y = pk2(p[2], p[3]);
            *(u32x2*)(Ps + t * LR + 16 * sb + 4 * (lane >> 4)) = w; }
        rs += __shfl_xor(rs, 16); rs += __shfl_xor(rs, 32);
        if (lane < 16) den[t] = rs + dint[t];
    }
    __syncthreads();
    if (MODE == 2) return;
    {
        f32x4 a1[8], a2[8];
#pragma unroll
        for (int i = 0; i < 8; ++i) { a1[i] = (f32x4){0.f, 0.f, 0.f, 0.f}; a2[i] = (f32x4){0.f, 0.f, 0.f, 0.f}; }
#pragma unroll
        for (int kk = 0; kk < 4; ++kk) { const bf16x8 ap = ldfrag(Ps, 16 * wave, 32 * kk, lane), aq = ldfrag(qs, 16 * wave, 32 * kk, lane);
#pragma unroll
            for (int eb = 0; eb < 8; ++eb) { a1[eb] = mfma16(ap, ldfrag(vT, 16 * eb, 32 * kk, lane), a1[eb]); a2[eb] = mfma16(aq, ldfrag(CT, 16 * eb, 32 * kk, lane), a2[eb]); } }
        MFMA_DRAIN8(a1); MFMA_DRAIN8(a2);
        float hv[8][4]; float ssq[4];
#pragma unroll
        for (int r = 0; r < 4; ++r) { const int t = 16 * wave + 4 * (lane >> 4) + r;
            const float dd = fmaxf(fabsf(den[t]), expf(-(bb[t] + gg[t]))); const float inv = 1.f / dd, wi = wint[t]; float s2 = 0.f;
#pragma unroll
            for (int eb = 0; eb < 8; ++eb) { const float x = (a1[eb][r] + wi * a2[eb][r]) * inv; hv[eb][r] = x; s2 += x * x;
            }
            s2 += __shfl_xor(s2, 1); s2 += __shfl_xor(s2, 2); s2 += __shfl_xor(s2, 4); s2 += __shfl_xor(s2, 8);
            ssq[r] = rsqrtf(s2 * (1.f / 128.f) + EPS); }
        float mov[8][4];
#pragma unroll
        for (int eb = 0; eb < 8; ++eb)
#pragma unroll
            for (int r = 0; r < 4; ++r) mov[eb][r] = bflo(PROJ[(size_t)(t0 + 16 * wave + 4 * (lane >> 4) + r) * NPROJ + 1536 + h * 128 + 16 * eb + (lane & 15)]);
#pragma unroll
        for (int eb = 0; eb < 8; ++eb) { const int e = 16 * eb + (lane & 15); const float ge = mlg[e];
#pragma unroll
            for (int r = 0; r < 4; ++r) { const int t = 16 * wave + 4 * (lane >> 4) + r;
                const float outv = hv[eb][r] * ssq[r] * ge * sigm(mov[eb][r]);
                if (MODE == 0) MIX[(size_t)(t0 + t) * DM + h * 128 + e] = (bf16_t)f2bf(outv); else asm volatile("" :: "v"(outv)); } }
    }
    __syncthreads();
}

__device__ __forceinline__ void qknorm_rows(const Args& a, const int tid) {
    const int lane = tid & 63, wave = tid >> 6;
    bf16_t* PROJ = (bf16_t*)(a.ws + WS_PROJ);
    const float* gq = a.in[9]; const float* gk = a.in[10];
    const float* g = (lane < 32) ? gq : gk; const float scl = (lane < 32) ? C2 : 1.f;
    float gv[16];
#pragma unroll
    for (int i = 0; i < 16; ++i) gv[i] = g[16 * (lane & 3) + i] * scl;
    const int gw = blockIdx.x * 8 + wave, NGW = gridDim.x * 8;
    for (int row = gw; row < T; row += NGW) {
        u32x4* p = (u32x4*)(PROJ + (size_t)row * NPROJ + 2048 + 16 * lane);
        float x[16]; { float t8[8]; unpack8(p[0], t8);
#pragma unroll
            for (int i = 0; i < 8; ++i) x[i] = t8[i]; unpack8(p[1], t8);
#pragma unroll
            for (int i = 0; i < 8; ++i) x[8 + i] = t8[i]; }
        float ss = 0.f;
#pragma unroll
        for (int i = 0; i < 16; ++i) ss += x[i] * x[i];
        ss += __shfl_xor(ss, 1); ss += __shfl_xor(ss, 2);
        const float rstd = rsqrtf(ss * (1.f / 64.f) + EPS);
        float y0[8], y1[8];
#pragma unroll
        for (int i = 0; i < 8; ++i) { y0[i] = x[i] * rstd * gv[i]; y1[i] = x[8 + i] * rstd * gv[8 + i]; }
        p[0] = pack8(y0); p[1] = pack8(y1);
    }
}

#include <hip/hip_bf16.h>
namespace attn_body {
using bf16=__hip_bfloat16;
using bf16x8=__attribute__((ext_vector_type(8)))short;
using s16x4=__attribute__((ext_vector_type(4)))short;
using f32x16=__attribute__((ext_vector_type(16)))float;
using u32x4=__attribute__((ext_vector_type(4)))unsigned;
constexpr int SEQ=8192,PQ=3584,KVBLK=64;
__device__ __forceinline__ int crow(int r,int hi){return (r&3)+8*(r>>2)+4*hi;}
#define SBAR() __builtin_amdgcn_sched_barrier(0)
__device__ __forceinline__ void cmask(f32x16&p0,f32x16&p1,int jb,int qrel,int hi){
  const float NEG=-INFINITY; int kb=64*jb+4*hi;
  #pragma unroll
  for(int r=0;r<16;++r){int kv=kb+(r&3)+8*(r>>2); if(kv>qrel)p0[r]=NEG; if(kv+32>qrel)p1[r]=NEG;}
}

__device__ __forceinline__ void glds16(const void*gsrc,unsigned lds_dst){unsigned keep;
  asm volatile("s_mov_b32 %0, m0\n\ts_mov_b32 m0, %2\n\ts_nop 0\n\tglobal_load_lds_dwordx4 %1, off\n\ts_mov_b32 m0, %0":"=&s"(keep):"v"(gsrc),"s"(lds_dst):"memory");}
typedef float f32x2_t __attribute__((ext_vector_type(2))); typedef __bf16 bf16x2_t __attribute__((ext_vector_type(2)));
__device__ __forceinline__ unsigned cvtpk_s(float lo,float hi){f32x2_t v={lo,hi};bf16x2_t b=__builtin_convertvector(v,bf16x2_t);return __builtin_bit_cast(unsigned,b);}

__device__ __forceinline__ void qkt(f32x16&p0,f32x16&p1,const char*Kslot,const bf16x8*qr,const f32x16&negm,int r32,int hi){
  const char*kb=Kslot+hi*1024+r32*16;
  #pragma unroll
  for(int d0=0;d0<4;++d0){
    const bf16x8 b0=*reinterpret_cast<const bf16x8*>(kb+d0*2048);
    const bf16x8 b1=*reinterpret_cast<const bf16x8*>(kb+d0*2048+512);
    if(d0==0){p0=__builtin_amdgcn_mfma_f32_32x32x16_bf16(b0,qr[0],negm,0,0,0);p1=__builtin_amdgcn_mfma_f32_32x32x16_bf16(b1,qr[0],negm,0,0,0);}
    else{p0=__builtin_amdgcn_mfma_f32_32x32x16_bf16(b0,qr[d0],p0,0,0,0);p1=__builtin_amdgcn_mfma_f32_32x32x16_bf16(b1,qr[d0],p1,0,0,0);}}
}

__device__ __forceinline__ void pv4(f32x16*o,int vb,bf16x8 pa0,bf16x8 pa1,bf16x8 pa2,bf16x8 pa3){
  s16x4 la[4],ha[4],lb[4],hb[4];
  #define PV_READ(L,H,OFF) do{ _Pragma("unroll") for(int ks=0;ks<4;++ks){ \
      asm volatile("ds_read_b64_tr_b16 %0,%1 offset:%c2":"=&v"(L[ks]):"v"(vb),"i"((OFF)+ks*1024):"memory"); \
      asm volatile("ds_read_b64_tr_b16 %0,%1 offset:%c2":"=&v"(H[ks]):"v"(vb),"i"((OFF)+ks*1024+512):"memory"); } }while(0)
  #define PV_PK(L,H,k) (bf16x8){L[k][0],L[k][1],L[k][2],L[k][3],H[k][0],H[k][1],H[k][2],H[k][3]}
  #define PV_MMA(dst,L,H) do{ dst=__builtin_amdgcn_mfma_f32_32x32x16_bf16(pa0,PV_PK(L,H,0),dst,0,0,0); dst=__builtin_amdgcn_mfma_f32_32x32x16_bf16(pa1,PV_PK(L,H,1),dst,0,0,0); \
      dst=__builtin_amdgcn_mfma_f32_32x32x16_bf16(pa2,PV_PK(L,H,2),dst,0,0,0); dst=__builtin_amdgcn_mfma_f32_32x32x16_bf16(pa3,PV_PK(L,H,3),dst,0,0,0); }while(0)
  PV_READ(la,ha,0); PV_READ(lb,hb,4096);
  asm volatile("s_waitcnt lgkmcnt(8)":::"memory");SBAR(); PV_MMA(o[0],la,ha); SBAR();
  PV_READ(la,ha,8192);
  asm volatile("s_waitcnt lgkmcnt(8)":::"memory");SBAR(); PV_MMA(o[1],lb,hb); SBAR();
  PV_READ(lb,hb,12288);
  asm volatile("s_waitcnt lgkmcnt(8)":::"memory");SBAR(); PV_MMA(o[2],la,ha); SBAR();
  asm volatile("s_waitcnt lgkmcnt(0)":::"memory");SBAR(); PV_MMA(o[3],lb,hb); SBAR();
  #undef PV_READ
  #undef PV_PK
  #undef PV_MMA
}

constexpr int A2_SLOT=32768, A2_NS=4, A2_K=0, A2_V=16384, A2_WS=131072, A2_STG=65536;
__device__ __forceinline__ void attn2_unit(const bf16*PROJ,const float*dg,bf16_t*MIX,char*shm,int bh,int qb,const float lam,const float m0){
  const int tid=threadIdx.x,lane=tid&63,r32=lane&31,hi=lane>>5; const int wid=__builtin_amdgcn_readfirstlane(tid>>6);
  const int c=wid&1,qblk=wid>>1,b=bh>>2,h=bh&3; const long rowbase=(long)b*SEQ; const int q0=qb*128;
  const float sl2=exp2f(-2.f*(float)(h+1))*1.4426950408889634f;
  int tbeg=0; { const float kmin=(float)q0-(2.f*m0+40.f)/sl2; if(kmin>0.f)tbeg=((int)kmin)>>6; }
  const int NT=(q0+128)/KVBLK-tbeg;
  const bf16*Qw=PROJ+(rowbase+q0+qblk*32)*PQ+2048+h*128+c*64;
  const bf16*ksrc=PROJ+(rowbase+(long)tbeg*KVBLK+lane)*PQ+2560+h*128+wid*8;
  const bf16*vsrc=PROJ+(rowbase+(long)tbeg*KVBLK+16*(wid&3)+(lane>>2))*PQ+3072+h*128+(wid>>2)*32+(lane&3)*8;
  const unsigned lds0=(unsigned)(uintptr_t)shm;
  const unsigned kdst=lds0+A2_K+wid*1024, vdst=lds0+A2_V+wid*1024;
  #define A2_DMA(t,s) do{ const bf16*kp_=ksrc+(long)(t)*KVBLK*PQ; const bf16*vp_=vsrc+(long)(t)*KVBLK*PQ; const unsigned so_=(unsigned)(s)*A2_SLOT; \
      glds16(kp_,(unsigned)__builtin_amdgcn_readfirstlane(kdst+so_)); glds16(kp_+64,(unsigned)__builtin_amdgcn_readfirstlane(kdst+so_+8192)); \
      glds16(vp_,(unsigned)__builtin_amdgcn_readfirstlane(vdst+so_)); glds16(vp_+64,(unsigned)__builtin_amdgcn_readfirstlane(vdst+so_+8192)); }while(0)
  A2_DMA(0,0); if(NT>1)A2_DMA(1,1); if(NT>2)A2_DMA(2,2);
  bf16x8 qr[4];
  #pragma unroll
  for(int d0=0;d0<4;++d0)qr[d0]=*reinterpret_cast<const bf16x8*>(&Qw[(long)r32*PQ+d0*16+hi*8]);
  const int qrel=qblk*32+r32;
  const float sl64=sl2*64.f,c32=sl2*32.f;
  float l_reg=0.f; f32x16 o[4]; o[0]=f32x16{};o[1]=f32x16{};o[2]=f32x16{};o[3]=f32x16{}; f32x16 negm;
  { const float nb0=sl2*(float)(4*hi+64*tbeg-q0-qrel)-m0;
    #pragma unroll
    for(int r=0;r<16;++r)negm[r]=__builtin_fmaf(sl2,(float)((r&3)+8*(r>>2)),nb0); }
  const int vb0=(int)(lds0+A2_V)+((lane>>4)&1)*32+(lane&3)*8+(4*hi+((lane&15)>>2))*64;
  { asm volatile("s_waitcnt vmcnt(0)":::"memory"); asm volatile("s_barrier":::"memory"); }
  const int grp=wid>>2;
  if(grp==1)asm volatile("s_barrier":::"memory");
  for(int t=0;t<NT;++t){
    const int s=t&3;
    f32x16 p0,p1;
    qkt(p0,p1,shm+A2_K+s*A2_SLOT+c*8192,qr,negm,r32,hi); asm volatile("s_nop 15\n\ts_nop 7":"+v"(p0),"+v"(p1));
    #pragma unroll
    for(int r=0;r<16;++r){p1[r]+=c32;negm[r]+=sl64;}
    { const int jb=t-(NT-2); if(jb>=0)cmask(p0,p1,jb,qrel,hi); }
    float sacc=0.f;
    #pragma unroll
    for(int r=0;r<16;++r){p0[r]=__builtin_amdgcn_exp2f(p0[r]);p1[r]=__builtin_amdgcn_exp2f(p1[r]);sacc+=p0[r]+p1[r];}
    l_reg+=sacc;
    u32x4 pw0,pw1,pw2,pw3;
    #define PKW(P,B) cvtpk_s(P[B],P[B+1])
    pw0=(u32x4){PKW(p0,0),PKW(p0,2),PKW(p0,4),PKW(p0,6)};pw1=(u32x4){PKW(p0,8),PKW(p0,10),PKW(p0,12),PKW(p0,14)};
    pw2=(u32x4){PKW(p1,0),PKW(p1,2),PKW(p1,4),PKW(p1,6)};pw3=(u32x4){PKW(p1,8),PKW(p1,10),PKW(p1,12),PKW(p1,14)};
    #undef PKW
    if(t+2<NT)asm volatile("s_waitcnt vmcnt(4) lgkmcnt(0)\n\ts_barrier":::"memory"); else asm volatile("s_waitcnt vmcnt(0) lgkmcnt(0)\n\ts_barrier":::"memory");
    if(t+3<NT)A2_DMA(t+3,(t+3)&3);
    SBAR();
    pv4(o,vb0+s*A2_SLOT,__builtin_bit_cast(bf16x8,pw0),__builtin_bit_cast(bf16x8,pw1),__builtin_bit_cast(bf16x8,pw2),__builtin_bit_cast(bf16x8,pw3));
    asm volatile("s_waitcnt lgkmcnt(0)\n\ts_barrier":::"memory");
  }
  if(grp==0)asm volatile("s_barrier":::"memory");
  asm volatile("s_waitcnt vmcnt(0)":::"memory");
  #undef A2_DMA
  {auto rr=__builtin_amdgcn_permlane32_swap(__float_as_uint(l_reg),__float_as_uint(l_reg),false,false);l_reg=__uint_as_float(rr[0])+__uint_as_float(rr[1]);}
  float*wsf=(float*)(shm+A2_WS)+wid*64;
  if(hi==0)wsf[r32]=l_reg; asm volatile("s_waitcnt lgkmcnt(0)":::"memory");
  float rli[16];
  #pragma unroll
  for(int r=0;r<16;++r)rli[r]=__builtin_amdgcn_rcpf(wsf[crow(r,hi)]);
  float*X=(float*)shm+qblk*4096;
  if(c==1){
    #pragma unroll
    for(int d0=0;d0<4;++d0)
      #pragma unroll
      for(int r=0;r<16;++r)X[(d0*16+r)*64+lane]=o[d0][r]*rli[r];
  }
  asm volatile("s_waitcnt lgkmcnt(0)\n\ts_barrier":::"memory");
  if(c==0){
    bf16_t*stg=(bf16_t*)(shm+A2_STG)+qblk*4096;
    #pragma unroll
    for(int d0=0;d0<4;++d0)
      #pragma unroll
      for(int r=0;r<16;++r){ const float v=o[d0][r]*rli[r]-lam*X[(d0*16+r)*64+lane]; stg[crow(r,hi)*128+d0*32+r32]=(bf16_t)(__builtin_bit_cast(unsigned short,__float2bfloat16(v))); }
    asm volatile("s_waitcnt lgkmcnt(0)":::"memory");
    const int row=lane>>1,half=lane&1; const bf16_t*sp=stg+row*128+half*64;
    float d[64]; float ss=0.f;
    #pragma unroll
    for(int i=0;i<8;++i){ const u32x4 w=*(const u32x4*)(sp+8*i);
      d[8*i+0]=__uint_as_float(w.x<<16);d[8*i+1]=__uint_as_float(w.x&0xffff0000u);d[8*i+2]=__uint_as_float(w.y<<16);d[8*i+3]=__uint_as_float(w.y&0xffff0000u);
      d[8*i+4]=__uint_as_float(w.z<<16);d[8*i+5]=__uint_as_float(w.z&0xffff0000u);d[8*i+6]=__uint_as_float(w.w<<16);d[8*i+7]=__uint_as_float(w.w&0xffff0000u); }
    #pragma unroll
    for(int i=0;i<64;++i)ss+=d[i]*d[i];
    ss+=__shfl_xor(ss,1);
    const float rs=rsqrtf(ss*(1.f/128.f)+1e-6f)*0.8f;
    bf16_t*mp=MIX+(rowbase+q0+qblk*32+row)*1024+512+h*128+half*64; const float*gp=dg+half*64;
    #pragma unroll
    for(int i=0;i<8;++i){ u32x4 w;
      w.x=cvtpk_s(d[8*i+0]*rs*gp[8*i+0],d[8*i+1]*rs*gp[8*i+1]); w.y=cvtpk_s(d[8*i+2]*rs*gp[8*i+2],d[8*i+3]*rs*gp[8*i+3]);
      w.z=cvtpk_s(d[8*i+4]*rs*gp[8*i+4],d[8*i+5]*rs*gp[8*i+5]); w.w=cvtpk_s(d[8*i+6]*rs*gp[8*i+6],d[8*i+7]*rs*gp[8*i+7]);
      *(u32x4*)(mp+8*i)=w; }
  }
  asm volatile("s_waitcnt lgkmcnt(0)\n\ts_barrier":::"memory");
}
constexpr int ATTN_LDS_BYTES=LDS_BYTES;
#undef SBAR
#undef WAIT_BAR
}

__device__ __forceinline__ unsigned wave_umax(unsigned x) {
    x = max(x, (unsigned)__builtin_amdgcn_update_dpp(0, (int)x, 0x111, 0xf, 0xf, false));
    x = max(x, (unsigned)__builtin_amdgcn_update_dpp(0, (int)x, 0x112, 0xf, 0xf, false));
    x = max(x, (unsigned)__builtin_amdgcn_update_dpp(0, (int)x, 0x114, 0xf, 0xf, false));
    x = max(x, (unsigned)__builtin_amdgcn_update_dpp(0, (int)x, 0x118, 0xf, 0xf, false));
    x = max(x, (unsigned)__builtin_amdgcn_update_dpp(0, (int)x, 0x142, 0xa, 0xf, false));
    x = max(x, (unsigned)__builtin_amdgcn_update_dpp(0, (int)x, 0x143, 0xc, 0xf, false));
    return (unsigned)__builtin_amdgcn_readlane((int)x, 63);
}
__device__ __forceinline__ unsigned sel_key(float v, int idx) { unsigned u = __float_as_uint(v); u = (u & 0x80000000u) ? ~u : (u | 0x80000000u); return (u & 0xffffff00u) | (unsigned)(255 - idx); }

__device__ __forceinline__ void ph_route(const Args& a, unsigned char* lds, const int tid) {
    const int lane = tid & 63, wave = tid >> 6;
    int* hist = (int*)lds;
    const float* LOG = (const float*)(a.ws + WS_LOGITS); const float* rb = a.in[18];
    int* IDX = (int*)(a.ws + WS_IDX); float* GATEV = (float*)(a.ws + WS_GATEV); int* HIST = (int*)(a.ws + WS_HIST);
    unsigned* TOT = (unsigned*)(a.ws + WS_BAR) + 3456;
    const f32x4 rb4 = *((const f32x4*)rb + lane);
    for (int tb = blockIdx.x; tb < 256; tb += gridDim.x) {
        if (tid < 256) hist[tid] = 0;
        __syncthreads();
        f32x4 lgn = *((const f32x4*)(LOG + (size_t)(tb * 128 + wave * 16) * 256) + lane);
        for (int i = 0; i < 16; ++i) {
            const int t = tb * 128 + wave * 16 + i;
            const f32x4 lg = lgn;
            if (i < 15) lgn = *((const f32x4*)(LOG + (size_t)(t + 1) * 256) + lane);
            float s[4], sel[4];
            s[0] = sigm(lg.x); s[1] = sigm(lg.y); s[2] = sigm(lg.z); s[3] = sigm(lg.w);
            sel[0] = s[0] + rb4.x; sel[1] = s[1] + rb4.y; sel[2] = s[2] + rb4.z; sel[3] = s[3] + rb4.w;
            float m1 = fmaxf(sel[0], sel[1]), m2 = fminf(sel[0], sel[1]);
            { const float x = sel[2]; const float n1 = fmaxf(m1, x); m2 = fmaxf(m2, fminf(m1, x)); m1 = n1; }
            { const float x = sel[3]; const float n1 = fmaxf(m1, x); m2 = fmaxf(m2, fminf(m1, x)); m1 = n1; }
#pragma unroll
            for (int off = 1; off < 8; off <<= 1) { const float o1 = __shfl_xor(m1, off), o2 = __shfl_xor(m2, off);
                const float n1 = fmaxf(m1, o1), n2 = fmaxf(fminf(m1, o1), fmaxf(m2, o2)); m1 = n1; m2 = n2; }
            const float gs = m1 + m2; const int grp = lane >> 3; int rank = 0;
#pragma unroll
            for (int g2 = 0; g2 < 8; ++g2) { const float v = __builtin_bit_cast(float, __builtin_amdgcn_readlane(__builtin_bit_cast(int, gs), 8 * g2)); rank += ((v > gs) || (v == gs && g2 < grp)) ? 1 : 0; }
            const bool gsel = rank < 4;
            unsigned key[4];
#pragma unroll
            for (int j = 0; j < 4; ++j) key[j] = gsel ? sel_key(sel[j], 4 * lane + j) : 0u;
            float gsum = 0.f; float myg = 0.f; int myidx = 0;
#pragma unroll
            for (int k = 0; k < 8; ++k) {
                const unsigned best = wave_umax(max(max(key[0], key[1]), max(key[2], key[3])));
                const int bi = 255 - (int)(best & 255u);
                const int owner = bi >> 2, sub = bi & 3;
                float sv = (sub == 0) ? s[0] : (sub == 1) ? s[1] : (sub == 2) ? s[2] : s[3];
                sv = __builtin_bit_cast(float, __builtin_amdgcn_readlane(__builtin_bit_cast(int, sv), owner));
                if (lane == owner) {
#pragma unroll
                    for (int j = 0; j < 4; ++j) if (j == sub) key[j] = 0u;
                }
                gsum += sv;
                if (lane == k) { myg = sv; myidx = bi; }
            }
            if (lane < 8) { IDX[(size_t)t * 8 + lane] = myidx; GATEV[(size_t)t * 8 + lane] = myg / gsum * 2.5f; atomicAdd(&hist[myidx], 1); }
        }
        __syncthreads();
        if (tid < 256) { const int hv = hist[tid]; HIST[tb * 256 + tid] = hv; if (hv) atomicAdd(TOT + tid, (unsigned)hv); }
        __syncthreads();
    }
}

__device__ __forceinline__ void ph_scatter(const Args& a, unsigned char* lds, const int tid) {
    int* tot = (int*)lds; int* cur = tot + 256; int* base = cur + 256; int* tstart = base + 256;
    const int* HIST = (const int*)(a.ws + WS_HIST); const int* IDX = (const int*)(a.ws + WS_IDX); const float* GATEV = (const float*)(a.ws + WS_GATEV);
    int* PSLOT = (int*)(a.ws + WS_PSLOT); int* SLOTTOK = (int*)(a.ws + WS_SLOTTOK); float* SLOTGATE = (float*)(a.ws + WS_SLOTGATE);
    int* TILE = (int*)(a.ws + WS_TILE);
    unsigned* TOT = (unsigned*)(a.ws + WS_BAR) + 3456; unsigned* CUR = TOT + 256;
    for (int tb = blockIdx.x; tb < 256; tb += gridDim.x) {
        __syncthreads();
        if (tid < 256) tot[tid] = (int)__hip_atomic_load(TOT + tid, __ATOMIC_RELAXED, __HIP_MEMORY_SCOPE_AGENT);
        __syncthreads();
        if (tid < 256) { int bs = 0, ts = 0; for (int j = 0; j < tid; ++j) { const int c = tot[j]; bs += c; ts += (c + 255) >> 8; } base[tid] = bs; tstart[tid] = ts;
            const int mine = HIST[tb * 256 + tid]; cur[tid] = bs + (mine ? (int)atomicAdd(CUR + tid, (unsigned)mine) : 0); }
        __syncthreads();
        for (int p = tid; p < 1024; p += 512) { const int t = tb * 128 + (p >> 3), k = p & 7; const int e = IDX[(size_t)t * 8 + k];
            const int slot = atomicAdd(&cur[e], 1); SLOTTOK[slot] = t; SLOTGATE[slot] = GATEV[(size_t)t * 8 + k]; PSLOT[(size_t)t * 8 + k] = slot; }
        if (tb == 0) {
            if (tid < 256) { const int cnt = tot[tid], b0 = base[tid]; int n = tstart[tid];
                for (int r0 = 0; r0 < cnt; r0 += 256) { TILE[64 + n] = tid; TILE[64 + 2048 + n] = b0 + r0; TILE[64 + 4096 + n] = b0 + cnt; ++n; }
                if (tid == 255) TILE[0] = n; }
            __syncthreads();
            if (tid < 128) { const int n = tstart[255] + ((tot[255] + 255) >> 8);
                TILE[64 + n + tid] = 256; TILE[64 + 2048 + n + tid] = SHARED_BASE + 256 * tid; TILE[64 + 4096 + n + tid] = SHARED_BASE + T; }
        }
    }
}

template <int MODE>
__device__ __forceinline__ void ph_final(const Args& a, const int tid) {
    const int lane = tid & 63, wave = tid >> 6;
    const unsigned char* YP = (const unsigned char*)(a.ws + WS_YP); const int* PSLOT = (const int*)(a.ws + WS_PSLOT); const float* MOD = (const float*)(a.ws + WS_MOD);
    float* out = a.out;
    const int gw = blockIdx.x * 8 + wave, NGW = gridDim.x * 8;
    const int sub = lane & 15, rsel = lane >> 4;
    int nslot = 0;
    { const int r0 = gw + (rsel == 1 ? NGW : 0); if (rsel < 2 && sub < 9 && r0 < T) nslot = sub < 8 ? PSLOT[(size_t)r0 * 8 + sub] : SHARED_BASE + r0; }
    for (int row = gw; row < T; row += 2 * NGW) {
        const int myslot = nslot;
        { const int r1 = row + 2 * NGW + (rsel == 1 ? NGW : 0); if (rsel < 2 && sub < 9 && r1 < T) nslot = sub < 8 ? PSLOT[(size_t)r1 * 8 + sub] : SHARED_BASE + r1; }
#pragma unroll
        for (int half = 0; half < 2; ++half) {
            const int rw = row + half * NGW;
            if (rw < T) {
                const int b = rw / SEQ;
                float* o0 = out + (size_t)rw * DM + 8 * lane; float* o1 = o0 + 512;
                const bf16_t* xr = (const bf16_t*)(a.ws + WS_X1B) + (size_t)rw * DM + 8 * lane;
                const u32x4 xw0 = __builtin_nontemporal_load((const u32x4*)xr), xw1 = __builtin_nontemporal_load((const u32x4*)(xr + 512));
                const f32x4 xa = {bflo(xw0.x), bfhi(xw0.x), bflo(xw0.y), bfhi(xw0.y)}, xb = {bflo(xw0.z), bfhi(xw0.z), bflo(xw0.w), bfhi(xw0.w)}, xc = {bflo(xw1.x), bfhi(xw1.x), bflo(xw1.y), bfhi(xw1.y)}, xd = {bflo(xw1.z), bfhi(xw1.z), bflo(xw1.w), bfhi(xw1.w)};
                float acc[16];
#pragma unroll
                for (int i = 0; i < 16; ++i) acc[i] = 0.f;
                u32x2 w0[9], w1[9];
#pragma unroll
                for (int k = 0; k < 9; ++k) { const int slot = __shfl(myslot, 16 * half + k); const unsigned char* yp = YP + (size_t)slot * DM; w0[k] = __builtin_nontemporal_load((const u32x2*)(yp + 8 * lane)); w1[k] = __builtin_nontemporal_load((const u32x2*)(yp + 512 + 8 * lane)); }
#pragma unroll
                for (int k = 0; k < 9; ++k) {
                    { const auto a0 = __builtin_amdgcn_cvt_pk_f32_fp8((int)w0[k].x, false), a1 = __builtin_amdgcn_cvt_pk_f32_fp8((int)w0[k].x, true), a2 = __builtin_amdgcn_cvt_pk_f32_fp8((int)w0[k].y, false), a3 = __builtin_amdgcn_cvt_pk_f32_fp8((int)w0[k].y, true);
                      acc[0] += a0[0]; acc[1] += a0[1]; acc[2] += a1[0]; acc[3] += a1[1]; acc[4] += a2[0]; acc[5] += a2[1]; acc[6] += a3[0]; acc[7] += a3[1]; }
                    { const auto a0 = __builtin_amdgcn_cvt_pk_f32_fp8((int)w1[k].x, false), a1 = __builtin_amdgcn_cvt_pk_f32_fp8((int)w1[k].x, true), a2 = __builtin_amdgcn_cvt_pk_f32_fp8((int)w1[k].y, false), a3 = __builtin_amdgcn_cvt_pk_f32_fp8((int)w1[k].y, true);
                      acc[8] += a0[0]; acc[9] += a0[1]; acc[10] += a1[0]; acc[11] += a1[1]; acc[12] += a2[0]; acc[13] += a2[1]; acc[14] += a3[0]; acc[15] += a3[1]; } }
                const float* gf = MOD + b * 6144 + 5 * 1024 + 8 * lane;
                const f32x4 g0 = *(const f32x4*)gf * (1.f / 16.f), g1 = *(const f32x4*)(gf + 4) * (1.f / 16.f), g2 = *(const f32x4*)(gf + 512) * (1.f / 16.f), g3 = *(const f32x4*)(gf + 516) * (1.f / 16.f);
                f32x4 ya = xa, yb = xb, yc = xc, yd = xd;
                ya.x += g0.x * acc[0]; ya.y += g0.y * acc[1]; ya.z += g0.z * acc[2]; ya.w += g0.w * acc[3];
                yb.x += g1.x * acc[4]; yb.y += g1.y * acc[5]; yb.z += g1.z * acc[6]; yb.w += g1.w * acc[7];
                yc.x += g2.x * acc[8]; yc.y += g2.y * acc[9]; yc.z += g2.z * acc[10]; yc.w += g2.w * acc[11];
                yd.x += g3.x * acc[12]; yd.y += g3.y * acc[13]; yd.z += g3.z * acc[14]; yd.w += g3.w * acc[15];
                if (MODE == 0) { __builtin_nontemporal_store(ya, (f32x4*)o0); __builtin_nontemporal_store(yb, (f32x4*)(o0 + 4)); __builtin_nontemporal_store(yc, (f32x4*)o1); __builtin_nontemporal_store(yd, (f32x4*)(o1 + 4)); }
                else asm volatile("" :: "v"(ya), "v"(yb), "v"(yc), "v"(yd));
            }
        }
    }
}

#define LAS __attribute__((address_space(3)))
#define XB_TMO      128
#define XB_XCNT(j)  (256  + 64 * (j))
#define XB_XSUB(j)  (1280 + 64 * (j))
#define XB_XGEN(j)  (2304 + 64 * (j))
#define XB_TOP      3328
#define XB_TOPGEN   3392
#define XB_SPIN_CAP (1u << 27)
__device__ __forceinline__ unsigned xb_ld(unsigned* p)              { return __hip_atomic_load(p, __ATOMIC_RELAXED, __HIP_MEMORY_SCOPE_AGENT); }
__device__ __forceinline__ unsigned xb_add(unsigned* p, unsigned v) { return __hip_atomic_fetch_add(p, v, __ATOMIC_RELAXED, __HIP_MEMORY_SCOPE_AGENT); }
__device__ __forceinline__ unsigned xb_xcc_id() { return (unsigned)__builtin_amdgcn_s_getreg((3 << 11) | 20) & 0xFu; }
#define XB_SPIN(cond, bar) do { unsigned _sp = 0; while (cond) { __builtin_amdgcn_s_sleep(1); \
    if ((++_sp & 255u) == 0u) { if (xb_ld(&(bar)[XB_TMO])) break; if (_sp > XB_SPIN_CAP) { atomicAdd(&(bar)[XB_TMO], 1u); break; } } } } while (0)
struct XcdBarrier { unsigned* bar; unsigned x; volatile LAS unsigned* st; };
__device__ __forceinline__ XcdBarrier xcd_barrier_post(unsigned* bar, volatile LAS unsigned* st, const bool t0) {
    XcdBarrier b; b.bar = bar; b.x = xb_xcc_id(); b.st = st;
    if (t0) (void)xb_add(&bar[XB_XCNT(b.x)], 1u);
    return b;
}
__device__ __forceinline__ void xcd_barrier_complete(unsigned* bar, unsigned x, unsigned& nloc, unsigned& nx) {
    const unsigned G = gridDim.x * gridDim.y * gridDim.z;
    unsigned sum, cnt, mine, sp = 0u;
    for (;;) {
        sum = 0u; cnt = 0u; mine = 0u;
#pragma unroll
        for (unsigned j = 0; j < 16; ++j) { const unsigned c = xb_ld(&bar[XB_XCNT(j)]); sum += c; cnt += (c > 0u) ? 1u : 0u; mine = (j == x) ? c : mine; }
        if (sum == G) break;
        __builtin_amdgcn_s_sleep(1);
        if ((++sp & 255u) == 0u) { if (xb_ld(&bar[XB_TMO])) break; if (sp > XB_SPIN_CAP) { atomicAdd(&bar[XB_TMO], 1u); break; } }
    }
    nloc = mine > 0u ? mine : 1u; nx = cnt > 0u ? cnt : 1u;
}
__device__ __forceinline__ void xcd_barrier(const XcdBarrier& b, const bool t0) {
    asm volatile("s_waitcnt vmcnt(0)" ::: "memory");
    __syncthreads();
    if (t0) {
        unsigned* bar = b.bar;
        __builtin_amdgcn_s_waitcnt(0);
        unsigned nloc = b.st[0], nx = b.st[1];
        if (nloc == 0u) { xcd_barrier_complete(bar, b.x, nloc, nx); b.st[0] = nloc; b.st[1] = nx; }
        const unsigned old = xb_add(&bar[XB_XSUB(b.x)], 1u);
        const unsigned gen = old / nloc;
        if (old + 1u == (gen + 1u) * nloc) {
            __builtin_amdgcn_fence(__ATOMIC_RELEASE, "agent");
            asm volatile("s_waitcnt vmcnt(0)" ::: "memory");
            const unsigned og = xb_add(&bar[XB_TOP], 1u);
            const unsigned tg = og / nx;
            if (og + 1u == (tg + 1u) * nx) xb_add(&bar[XB_TOPGEN], 1u);
            else XB_SPIN(xb_ld(&bar[XB_TOPGEN]) == tg, bar);
            __builtin_amdgcn_fence(__ATOMIC_ACQUIRE, "agent");
            xb_add(&bar[XB_XGEN(b.x)], 1u);
            asm volatile("s_waitcnt vmcnt(0)" ::: "memory");
        } else {
            XB_SPIN(xb_ld(&bar[XB_XGEN(b.x)]) == gen, bar);
            __builtin_amdgcn_fence(__ATOMIC_ACQUIRE, "agent");
            asm volatile("s_waitcnt vmcnt(0)" ::: "memory");
        }
    }
    __syncthreads();
}


__global__ void __launch_bounds__(512) mega(Args a) {
    extern __shared__ __attribute__((aligned(16))) unsigned char lds[];
    const int lo = a.ph_lo, hi = a.ph_hi;
    const int wave_s = __builtin_amdgcn_readfirstlane((int)threadIdx.x >> 6);
#define tid mk_tid(wave_s)
    volatile LAS unsigned* bst = (volatile LAS unsigned*)((LAS unsigned char*)lds + (LDS_BYTES - 64));
    if (tid < 16) bst[tid] = 0u;
    __syncthreads();
    XcdBarrier bar = xcd_barrier_post((unsigned*)(a.ws + WS_BAR), bst, tid == 0);
#define IN(k) (lo <= (k) && (k) < hi)
#define SEAM(k) do { if (IN(k) && IN((k) + 1)) xcd_barrier(bar, tid == 0); } while (0)

    if (IN(0)) { ph0(a, lds, tid); } SEAM(0);
    if (IN(1)) { ph_norm<true>(a, lds, a.in[0], 0, 1, tid); } SEAM(1);
    if (IN(2)) {
        const EpiProj E{(bf16_t*)(a.ws + WS_PROJ)};
        { pg8::DenseSched S; S.init(a.ws + WS_H8, a.ws + WS_WIN, T, NPROJ, DM, (int)gridDim.x, (int)blockIdx.x); __syncthreads();
          pg8::gemm_phase<false, true, 0x79797979, 0x7f7f7f7f, false>((PG8_LAS unsigned char*)lds, DM, S, E); }
    } SEAM(2);
    if (IN(3)) { qknorm_rows(a, tid); __syncthreads(); for (int u = blockIdx.x; u < 1024; u += gridDim.x) mlstm_m1_unit(a, lds, u, wave_s);
 } SEAM(3);
    if (IN(4)) { mlstm_m2(a, tid); } SEAM(4);
    if (IN(5)) {
        { float lam; { float s1 = 0.f, s2 = 0.f; const float* q1 = a.in[11]; const float* k1 = a.in[12]; const float* q2 = a.in[13]; const float* k2 = a.in[14];
              for (int i = 0; i < 64; ++i) { s1 += q1[i] * k1[i]; s2 += q2[i] * k2[i]; } lam = expf(s1) - expf(s2) + LAM_INIT; }
          float m0; { float gq = 0.f, gk = 0.f; for (int i = 0; i < 64; ++i) { gq = fmaxf(gq, fabsf(a.in[9][i])); gk = fmaxf(gk, fabsf(a.in[10][i])); } m0 = 64.f * C2 * gq * gk * 1.01f + 0.01f; }
          unsigned* qhead = (unsigned*)(a.ws + WS_BAR) + 4001;
          for (;;) {
              __syncthreads();
              if (tid == 0) bst[8] = atomicAdd(qhead, 1u);
              __syncthreads();
              const int idx = (int)bst[8];
              if (idx >= 1024) break;
              const int qb = 63 - (idx >> 4), j = idx & 15, bh = (j & 3) * 4 + (3 - (j >> 2));
              attn_body::attn2_unit((const attn_body::bf16*)(a.ws + WS_PROJ), a.in[15], (bf16_t*)(a.ws + WS_MIX), (char*)lds, bh, qb, lam, m0);
          }
          __syncthreads();
          for (int u = (int)blockIdx.x; u < 1024; u += (int)gridDim.x) mlstm_m3_unit<0>(a, lds, u, wave_s);
          __syncthreads(); }
    } SEAM(5);
    if (IN(6)) {
        const EpiOut E{a.in[0], (bf16_t*)(a.ws + WS_X1B), (const float*)(a.ws + WS_MOD)};
        { pg8::DenseSched S; S.init(a.ws + WS_MIX, a.ws + WS_WOUT, T, DM, 2 * DM, (int)gridDim.x, (int)blockIdx.x); __syncthreads();
          pg8::gemm_phase<false, false, 0, 0, false>((PG8_LAS unsigned char*)lds, 2 * DM, S, E); }
    } SEAM(6);
    if (IN(7)) { ph_norm<false>(a, lds, a.out, 3, 4, tid); } SEAM(7);
    if (IN(8)) {
        const EpiRS E{(float*)(a.ws + WS_LOGITS), (bf16_t*)(a.ws + WS_ACT)};
        { pg8::DenseSched S; S.init(a.ws + WS_H, a.ws + WS_WRS, T, 768, 2 * DM, (int)gridDim.x, (int)blockIdx.x); __syncthreads();
          pg8::gemm_phase<false, false, 0, 0, false>((PG8_LAS unsigned char*)lds, 2 * DM, S, E); }
    } SEAM(8);
    if (IN(9)) { ph_route(a, lds, tid); } SEAM(9);
    if (IN(10)) { ph_scatter(a, lds, tid); } SEAM(10);
    if (IN(11)) {
        const int* TILE = (const int*)(a.ws + WS_TILE); const int ntile = TILE[0];
        const EpiG1 E{(const float*)(a.ws + WS_SLOTGATE), (bf16_t*)(a.ws + WS_ACT)};
        { const int G = (int)gridDim.x, bx = (int)blockIdx.x, vcu = (G % 8 == 0) ? (bx % 8) * (G / 8) + bx / 8 : bx;
          const pg8::ExpertSched S{TILE, ntile * 2, 2, (const char*)(a.ws + WS_H8), (const int*)(a.ws + WS_SLOTTOK), (const char*)(a.ws + WS_W13T), (size_t)512 * 1024, DM, G, vcu};
          __syncthreads(); pg8::gemm_phase<true, true, 0x79797979, 0x7f7f7f7f, false>((PG8_LAS unsigned char*)lds, DM, S, E); }
    } SEAM(11);
    if (IN(12)) {
        const int* TILE = (const int*)(a.ws + WS_TILE); const int ntile = TILE[0] + 128;
        const EpiG2 E{(bf16_t*)(a.ws + WS_YP)};
        { const int G = (int)gridDim.x, bx = (int)blockIdx.x, vcu = (G % 8 == 0) ? (bx % 8) * (G / 8) + bx / 8 : bx;
          const pg8::ExpertSched S{TILE, ntile * 4, 4, (const char*)(a.ws + WS_ACT), nullptr, (const char*)(a.ws + WS_W2T), (size_t)1024 * 256, 256, G, vcu};
          __syncthreads(); pg8::gemm_phase<false, true, 0x7a7a7a7a, 0x7c7c7c7c, true>((PG8_LAS unsigned char*)lds, 256, S, E); }
    } SEAM(12);
    if (IN(13)) {
        ph_final<0>(a, tid); }
#undef IN
#undef SEAM
#undef tid
}

extern "C" void kernel_launch(void* const* d_in, const int* in_sizes, int n_in, void* d_out, int out_size, void* d_ws, size_t ws_size, hipStream_t stream) {
    static int grid = 0;
    if (grid == 0) {
        if (n_in != 25 || in_sizes[0] != T * DM || out_size != T * DM || ws_size < WS_END) {
            fprintf(stderr, "kernel_launch: unexpected problem (n_in %d, in0 %d, out %d, ws %zu < %zu)\n", n_in, n_in > 0 ? in_sizes[0] : -1, out_size, ws_size, (size_t)WS_END); grid = -1; return; }
        int dev = 0, cus = 0, per_cu = 0;
        (void)hipGetDevice(&dev);
        (void)hipDeviceGetAttribute(&cus, hipDeviceAttributeMultiprocessorCount, dev);
        if (hipFuncSetAttribute((const void*)mega, hipFuncAttributeMaxDynamicSharedMemorySize, LDS_BYTES) != hipSuccess) { fprintf(stderr, "kernel_launch: hipFuncSetAttribute failed\n"); grid = -1; return; }
        if (hipOccupancyMaxActiveBlocksPerMultiprocessor(&per_cu, (const void*)mega, 512, LDS_BYTES) != hipSuccess || per_cu < 1) { fprintf(stderr, "kernel_launch: occupancy query says %d blocks/CU\n", per_cu); grid = -1; return; }
        grid = cus;
    }
    if (grid < 0) return;
    (void)hipMemsetAsync((char*)d_ws + WS_BAR, 0, BAR_BYTES, stream);
    Args a{};
    for (int i = 0; i < 25; ++i) a.in[i] = (const float*)d_in[i];
    a.out = (float*)d_out; a.ws = (unsigned char*)d_ws;
    a.ph_lo = 0; a.ph_hi = NPH;
    void* args[] = {&a};
    hipError_t e = hipLaunchCooperativeKernel((const void*)mega, dim3(grid), dim3(512), args, LDS_BYTES, stream);
    if (e != hipSuccess) fprintf(stderr, "cooperative launch failed: %s (grid %d)\n", hipGetErrorString(e), grid);
}
```

```cpp
#include <hip/hip_runtime.h>
#include <cstdio>
#include <cstdint>

typedef unsigned short bf16_t;
typedef short bf16x8 __attribute__((ext_vector_type(8)));
typedef float f32x4 __attribute__((ext_vector_type(4)));
typedef unsigned u32x4 __attribute__((ext_vector_type(4)));
typedef unsigned u32x2 __attribute__((ext_vector_type(2)));


constexpr int T = 32768, DM = 1024, SEQ = 8192;
constexpr int NPROJ = 3584, DIN = 3592;
constexpr int TOPK = 8, TK = T * TOPK;
constexpr int SHARED_BASE = TK;
constexpr float EPS = 1e-6f;
constexpr float LOG2E = 1.4426950408889634f;
constexpr float C2 = 0.125f * LOG2E;
constexpr float LAM_INIT = 0.2f;
constexpr int NPH = 14;
constexpr int LDS_BYTES = 155648;

constexpr size_t MiB = 1ull << 20;
constexpr size_t WS_MOD = 0;
constexpr size_t WS_TILE = 128 * 1024;
constexpr size_t WS_HIST = 256 * 1024;
constexpr size_t WS_BAR = 512 * 1024;
constexpr size_t BAR_BYTES = 16384;
constexpr size_t WS_IPRE = 1 * MiB, WS_FPRE = 1 * MiB + 512 * 1024;
constexpr size_t WS_IDX = 2 * MiB, WS_GATEV = 3 * MiB, WS_PSLOT = 4 * MiB, WS_SLOTTOK = 5 * MiB, WS_SLOTGATE = 7 * MiB;
constexpr size_t WS_MST = 9 * MiB;
constexpr size_t WS_WIN = 12 * MiB, WS_WOUT = 19 * MiB, WS_WRS = 21 * MiB, WS_W2T = 23 * MiB;
constexpr size_t WS_H = 152 * MiB, WS_ACT = 216 * MiB, WS_MIX = 361 * MiB, WS_PROJ = 425 * MiB, WS_CLOC = 649 * MiB, WS_CIN = 713 * MiB, WS_W13T = 745 * MiB, WS_END = 1001 * MiB;
constexpr size_t WS_H8 = 89 * MiB;
constexpr size_t WS_YP = WS_MIX;
constexpr size_t WS_LOGITS = WS_CLOC;
constexpr size_t WS_X1B = 681 * MiB;
constexpr size_t WS_TMP = WS_ACT;

struct Args { const float* in[25]; float* out; unsigned char* ws; int ph_lo, ph_hi; };

__device__ __forceinline__ int mk_tid(int wave_s) { int l; asm volatile("v_mbcnt_lo_u32_b32 %0, -1, 0\n\tv_mbcnt_hi_u32_b32 %0, -1, %0" : "=v"(l)); return (wave_s << 6) | l; }

__device__ __forceinline__ float bflo(unsigned v) { return __uint_as_float(v << 16); }
__device__ __forceinline__ float bfhi(unsigned v) { return __uint_as_float(v & 0xffff0000u); }
__device__ __forceinline__ unsigned f2bf(float f) { unsigned u = __float_as_uint(f); return (u + 0x7fffu + ((u >> 16) & 1u)) >> 16; }
__device__ __forceinline__ unsigned pk2(float lo, float hi) { return f2bf(lo) | (f2bf(hi) << 16); }
__device__ __forceinline__ float wave_sum(float v) {
    v += __builtin_bit_cast(float, __builtin_amdgcn_update_dpp(0, __builtin_bit_cast(int, v), 0x111, 0xf, 0xf, false));
    v += __builtin_bit_cast(float, __builtin_amdgcn_update_dpp(0, __builtin_bit_cast(int, v), 0x112, 0xf, 0xf, false));
    v += __builtin_bit_cast(float, __builtin_amdgcn_update_dpp(0, __builtin_bit_cast(int, v), 0x114, 0xf, 0xf, false));
    v += __builtin_bit_cast(float, __builtin_amdgcn_update_dpp(0, __builtin_bit_cast(int, v), 0x118, 0xf, 0xf, false));
    v += __builtin_bit_cast(float, __builtin_amdgcn_update_dpp(0, __builtin_bit_cast(int, v), 0x142, 0xa, 0xf, false));
    v += __builtin_bit_cast(float, __builtin_amdgcn_update_dpp(0, __builtin_bit_cast(int, v), 0x143, 0xc, 0xf, false));
    return __builtin_bit_cast(float, __builtin_amdgcn_readlane(__builtin_bit_cast(int, v), 63));
}
__device__ __forceinline__ float siluf(float x) { return x / (1.f + __expf(-x)); }
__device__ __forceinline__ float sigm(float x) { return 1.f / (1.f + __expf(-x)); }
__device__ __forceinline__ void unpack8(const u32x4 v, float (&x)[8]) {
    x[0] = bflo(v.x); x[1] = bfhi(v.x); x[2] = bflo(v.y); x[3] = bfhi(v.y); x[4] = bflo(v.z); x[5] = bfhi(v.z); x[6] = bflo(v.w); x[7] = bfhi(v.w);
}
__device__ __forceinline__ unsigned pk4_fp8(float a, float b, float c, float d) { int p = __builtin_amdgcn_cvt_pk_fp8_f32(a, b, 0, false); p = __builtin_amdgcn_cvt_pk_fp8_f32(c, d, p, true); return (unsigned)p; }
__device__ __forceinline__ u32x4 pack8(const float (&x)[8]) { u32x4 o; o.x = pk2(x[0], x[1]); o.y = pk2(x[2], x[3]); o.z = pk2(x[4], x[5]); o.w = pk2(x[6], x[7]); return o; }

__device__ __forceinline__ void conv_item(const float* __restrict__ s0, const float* __restrict__ s1, int ldn, int k0, int n0, bool inter,
                                          bf16_t* dst, int ldk, int c0, float* scr, int lane) {
    const float* p = (inter && lane >= 32) ? (s1 + n0 + (lane - 32)) : (s0 + n0 + lane);
    p += (size_t)k0 * ldn;
#pragma unroll 8
    for (int i = 0; i < 64; ++i) scr[i * 65 + lane] = __builtin_nontemporal_load(p + (size_t)i * ldn);
    const int c = lane & 7;
#pragma unroll
    for (int j = 0; j < 8; ++j) {
        const int n = (lane >> 3) + 8 * j;
        const float* s = scr + (8 * c) * 65 + n;
        u32x4 o; o.x = pk2(s[0], s[65]); o.y = pk2(s[130], s[195]); o.z = pk2(s[260], s[325]); o.w = pk2(s[390], s[455]);
        const int drow = inter ? (c0 + ((n & 31) >> 2) * 8 + (n >> 5) * 4 + (n & 3)) : (c0 + n);
        __builtin_nontemporal_store(o, (u32x4*)(dst + (size_t)drow * ldk + k0 + 8 * c));
    }
}


__device__ __forceinline__ void conv_item8(const float* __restrict__ s0, const float* __restrict__ s1, int ldn, int k0, int n0, bool inter,
                                           unsigned char* dst, int ldk, int c0, float* scr, int lane, float scale) {
    const float* p = (inter && lane >= 32) ? (s1 + n0 + (lane - 32)) : (s0 + n0 + lane);
    p += (size_t)k0 * ldn;
#pragma unroll 8
    for (int i = 0; i < 64; ++i) scr[i * 65 + lane] = __builtin_nontemporal_load(p + (size_t)i * ldn) * scale;
    const int c = lane & 7;
#pragma unroll
    for (int j = 0; j < 8; ++j) {
        const int n = (lane >> 3) + 8 * j;
        const float* s = scr + (8 * c) * 65 + n;
        u32x2 o; o.x = pk4_fp8(s[0], s[65], s[130], s[195]); o.y = pk4_fp8(s[260], s[325], s[390], s[455]);
        const int drow = inter ? (c0 + ((n & 31) >> 2) * 8 + (n >> 5) * 4 + (n & 3)) : (c0 + n);
        __builtin_nontemporal_store(o, (u32x2*)(dst + (size_t)drow * ldk + k0 + 8 * c));
    }
}

__device__ __forceinline__ void ph0(const Args& a, unsigned char* lds, const int tid) {
    const int lane = tid & 63, wave = tid >> 6;
    const float* c_in = a.in[1]; const float* w_ada = a.in[2]; const float* b_ada = a.in[3];
    float* MOD = (float*)(a.ws + WS_MOD);
    {
        float* sc = (float*)lds; float* red = sc + 4096;
        for (int i = tid; i < 4096; i += 512) sc[i] = siluf(c_in[i]);
        __syncthreads();
        for (int it = blockIdx.x; it < 192; it += gridDim.x) {
            const int cc = tid & 31, ks = tid >> 5, col = it * 32 + cc;
            float a0 = 0.f, a1 = 0.f, a2 = 0.f, a3 = 0.f;
            const float* wp = w_ada + (size_t)(ks * 64) * 6144 + col;
            float wv[64];
#pragma unroll
            for (int k = 0; k < 64; ++k) wv[k] = __builtin_nontemporal_load(wp + (size_t)k * 6144);
#pragma unroll
            for (int k = 0; k < 64; ++k) { const float w = wv[k]; const int kk = ks * 64 + k;
                a0 += sc[kk] * w; a1 += sc[1024 + kk] * w; a2 += sc[2048 + kk] * w; a3 += sc[3072 + kk] * w; }
            float* rp = red + (ks * 32 + cc) * 4; rp[0] = a0; rp[1] = a1; rp[2] = a2; rp[3] = a3;
            __syncthreads();
            if (tid < 128) { const int c2 = tid & 31, b = tid >> 5; float s = 0.f;
                for (int k2 = 0; k2 < 16; ++k2) s += red[(k2 * 32 + c2) * 4 + b];
                MOD[b * 6144 + it * 32 + c2] = s + b_ada[it * 32 + c2]; }
            __syncthreads();
        }
    }
    __syncthreads();
    float* scr = (float*)lds + wave * (64 * 65);
    const int gw = blockIdx.x * 8 + wave, NGW = gridDim.x * 8;
    const float* w_in = a.in[4]; const float* w_out = a.in[16]; const float* w_router = a.in[17];
    const float* w1 = a.in[19]; const float* w3 = a.in[20]; const float* w2 = a.in[21];
    const float* ws1 = a.in[22]; const float* ws3 = a.in[23]; const float* ws2 = a.in[24];
    bf16_t* WIN = (bf16_t*)(a.ws + WS_WIN); bf16_t* WOUT = (bf16_t*)(a.ws + WS_WOUT); bf16_t* WRS = (bf16_t*)(a.ws + WS_WRS);
    unsigned char* W2T8 = (unsigned char*)(a.ws + WS_W2T); unsigned char* W13T8 = (unsigned char*)(a.ws + WS_W13T);
    constexpr int IT_WIN = 56 * 16, IT_WOUT = 16 * 16, IT_WR = 4 * 16, IT_WS13 = 8 * 16, IT_WS2 = 4 * 16, IT_E13 = 256 * 128, IT_E2 = 256 * 64;
    constexpr int NITEMS = IT_WIN + IT_WOUT + IT_WR + IT_WS13 + IT_WS2 + IT_E13 + IT_E2;
    for (int it = gw; it < NITEMS; it += NGW) {
        int r = it;
        if (r < IT_WIN) { const int kb = r / 56, cb = r % 56, c0 = 64 * cb, n0 = c0 + (c0 >= 2048 ? 8 : 0);
            conv_item8(w_in, w_in, DIN, 64 * kb, n0, false, (unsigned char*)WIN, 1024, c0, scr, lane, 64.f); continue; } r -= IT_WIN;
        if (r < IT_WOUT) { const int kb = r / 16, cb = r % 16; conv_item(w_out, w_out, 1024, 64 * kb, 64 * cb, false, WOUT, 1024, 64 * cb, scr, lane); continue; } r -= IT_WOUT;
        if (r < IT_WR) { const int kb = r / 4, cb = r % 4; conv_item(w_router, w_router, 256, 64 * kb, 64 * cb, false, WRS, 1024, 64 * cb, scr, lane); continue; } r -= IT_WR;
        if (r < IT_WS13) { const int kb = r / 8, cb = r % 8; conv_item(ws1, ws3, 256, 64 * kb, 32 * cb, true, WRS + (size_t)256 * 1024, 1024, 64 * cb, scr, lane); continue; } r -= IT_WS13;
        if (r < IT_WS2) { const int kb = r / 16, cb = r % 16; conv_item8(ws2, ws2, 1024, 64 * kb, 64 * cb, false, W2T8 + (size_t)256 * 1024 * 256, 256, 64 * cb, scr, lane, 32.f); continue; } r -= IT_WS2;
        if (r < IT_E13) { const int e = r >> 7, rr = r & 127, kb = rr >> 3, cb = rr & 7;
            conv_item8(w1 + (size_t)e * 1024 * 256, w3 + (size_t)e * 1024 * 256, 256, 64 * kb, 32 * cb, true, W13T8 + (size_t)e * 512 * 1024, 1024, 64 * cb, scr, lane, 64.f); continue; } r -= IT_E13;
        { const int e = r >> 6, rr = r & 63, kb = rr >> 4, cb = rr & 15;
            conv_item8(w2 + (size_t)e * 256 * 1024, w2, 1024, 64 * kb, 64 * cb, false, W2T8 + (size_t)e * 1024 * 256, 256, 64 * cb, scr, lane, 32.f); }
    }
}

template <bool GATES>
__device__ __forceinline__ void ph_norm(const Args& a, unsigned char* lds, const float* X, int mod_shift, int mod_scale, const int tid) {
    const int lane = tid & 63, wave = tid >> 6;
    const float* MOD = (const float*)(a.ws + WS_MOD);
    bf16_t* H = (bf16_t*)(a.ws + WS_H);
    float* wg = (float*)lds;
    if (GATES) {
        const float* w_in = a.in[4];
        for (int i = tid; i < 8192; i += 512) { const int k = i >> 3, g = i & 7; wg[g * 1024 + k] = w_in[(size_t)k * DIN + 2048 + g]; }
        __syncthreads();
    }
    const float* gate_b = a.in[7];
    float* IPRE = (float*)(a.ws + WS_IPRE); float* FPRE = (float*)(a.ws + WS_FPRE);
    const int gw = blockIdx.x * 8 + wave, NGW = gridDim.x * 8;
    for (int row = gw; row < T; row += NGW) {
        const int b = row / SEQ;
        const f32x4* xr = (const f32x4*)(X + (size_t)row * DM) + lane;
        const u32x2* xb = (const u32x2*)((const bf16_t*)(a.ws + WS_X1B) + (size_t)row * DM) + lane;
        f32x4 v[4]; float ss = 0.f;
#pragma unroll
        for (int j = 0; j < 4; ++j) { if (GATES) v[j] = __builtin_nontemporal_load(xr + 64 * j); else { const u32x2 w = xb[64 * j]; v[j] = (f32x4){bflo(w.x), bfhi(w.x), bflo(w.y), bfhi(w.y)}; } ss += (v[j].x * v[j].x + v[j].y * v[j].y) + (v[j].z * v[j].z + v[j].w * v[j].w); }
        const float rstd = rsqrtf(wave_sum(ss) * (1.f / DM) + EPS);
        const f32x4* sh = (const f32x4*)(MOD + b * 6144 + mod_shift * 1024) + lane;
        const f32x4* sc = (const f32x4*)(MOD + b * 6144 + mod_scale * 1024) + lane;
        u32x2* o8 = (u32x2*)(H + (size_t)row * DM) + lane;
#pragma unroll
        for (int j = 0; j < 4; ++j) { const f32x4 s4 = sc[64 * j], h4 = sh[64 * j];
            v[j].x = v[j].x * rstd * (1.f + s4.x) + h4.x; v[j].y = v[j].y * rstd * (1.f + s4.y) + h4.y;
            v[j].z = v[j].z * rstd * (1.f + s4.z) + h4.z; v[j].w = v[j].w * rstd * (1.f + s4.w) + h4.w;
            if (!GATES) { u32x2 p; p.x = pk2(v[j].x, v[j].y); p.y = pk2(v[j].z, v[j].w); o8[64 * j] = p; }
            *((unsigned*)(a.ws + WS_H8 + (size_t)row * DM) + lane + 64 * j) = pk4_fp8(v[j].x, v[j].y, v[j].z, v[j].w); }
        if (GATES) {
            float g[8];
#pragma unroll
            for (int q = 0; q < 8; ++q) { float s = 0.f;
#pragma unroll
                for (int j = 0; j < 4; ++j) { const f32x4 w4 = *((const f32x4*)(wg + q * 1024) + lane + 64 * j);
                    s += (v[j].x * w4.x + v[j].y * w4.y) + (v[j].z * w4.z + v[j].w * w4.w); }
                g[q] = wave_sum(s); }
            if (lane == 0) {
#pragma unroll
                for (int q = 0; q < 4; ++q) { IPRE[(size_t)row * 4 + q] = g[q] + gate_b[q]; FPRE[(size_t)row * 4 + q] = g[4 + q] + gate_b[4 + q]; }
            }
        }
    }
}


namespace pg8 {
#define PG8_LAS __attribute__((address_space(3)))
typedef int i32x4 __attribute__((ext_vector_type(4)));
typedef int i32x8 __attribute__((ext_vector_type(8)));
constexpr int BM = 256, BK = 64, HALF = 128, HTB = HALF * BK * 2;
__device__ __forceinline__ int lds_byte(int r, int c) { const int st = (r >> 4) * 2 + (c >> 5), rr = r & 15, cc = c & 31, ob = rr * 64 + cc * 2; return st * 1024 + (ob ^ (((ob >> 9) & 1) << 5)); }
__device__ __forceinline__ void stage_rc(int b, int& R, int& C) { const int st = b / 1024, sb = b % 1024, swz = sb ^ (((sb >> 9) & 1) << 5); R = (st >> 1) * 16 + swz / 64; C = (st & 1) * 32 + (swz % 64) / 2; }
__device__ __forceinline__ int perm32(int rho) { const int n = rho >> 4, i = rho & 15; return 8 * (i >> 2) + 4 * n + (i & 3); }
struct Unit { const char* A; const char* B; const int* gather; int row0, rend, col0; };

template <int PM, class RowEpi>
__device__ __forceinline__ void run_epi(const RowEpi& E, const f32x4 (&acc)[2][2][4][2], const Unit& u, int wr, int wc, int fr, int fq) {
#pragma unroll
    for (int ai = 0; ai < 2; ++ai)
#pragma unroll
        for (int m = 0; m < 4; ++m) { const int row = u.row0 + ai * HALF + wr * 64 + m * 16 + fr; const bool valid = row < u.rend;
            if constexpr (PM != 0) { const float v16[16] = {acc[ai][0][m][0][0], acc[ai][0][m][0][1], acc[ai][0][m][0][2], acc[ai][0][m][0][3], acc[ai][0][m][1][0], acc[ai][0][m][1][1], acc[ai][0][m][1][2], acc[ai][0][m][1][3],
                                                 acc[ai][1][m][0][0], acc[ai][1][m][0][1], acc[ai][1][m][0][2], acc[ai][1][m][0][3], acc[ai][1][m][1][0], acc[ai][1][m][1][1], acc[ai][1][m][1][2], acc[ai][1][m][1][3]};
                if constexpr (PM == 1) E.row16(row, valid, u.col0 + 64 * wc + 16 * fq, v16); else E.rowg(row, valid, u.col0 + 64 * wc + 8 * fq, v16); } else
#pragma unroll
            for (int bj = 0; bj < 2; ++bj) { const int col0 = u.col0 + bj * HALF + wc * 32 + 8 * fq;
                const float v[8] = {acc[ai][bj][m][0][0], acc[ai][bj][m][0][1], acc[ai][bj][m][0][2], acc[ai][bj][m][0][3], acc[ai][bj][m][1][0], acc[ai][bj][m][1][1], acc[ai][bj][m][1][2], acc[ai][bj][m][1][3]};
                E(row, valid, col0, v); } }
}

template <bool GATHER, bool FP8, int SCW, int SCX, int PM, class RowEpi, class Sched>
__device__ __forceinline__ void gemm_phase(PG8_LAS unsigned char* lds, const int KB, const Sched& S, const RowEpi& E) {
    const int tid = threadIdx.x, wid = __builtin_amdgcn_readfirstlane(tid >> 6), lane = tid & 63, wr = wid >> 2, wc = wid & 3, fr = lane & 15, fq = lane >> 4;
    const int nt = KB / 128;
    int scw_ = SCW, scx_ = SCX; asm volatile("" : "+v"(scw_), "+v"(scx_));
    int Rr[2], Cc[2]; unsigned voffB[2][2];
#pragma unroll
    for (int i = 0; i < 2; ++i) { stage_rc(tid * 16 + i * 8192, Rr[i], Cc[i]);
#pragma unroll
        for (int h = 0; h < 2; ++h) { const int R = Rr[i];
            const int cperm = PM == 1 ? 64 * (R >> 5) + 16 * ((R >> 2) & 3) + 8 * h + 4 * ((R >> 4) & 1) + (R & 3)
                            : PM == 2 ? 64 * (R >> 5) + 32 * h + 8 * ((R >> 2) & 3) + 4 * ((R >> 4) & 1) + (R & 3)
                            : h * HALF + (R & ~31) + perm32(R & 31);
            voffB[h][i] = (unsigned)(cperm * KB + Cc[i] * 2); } }
    const size_t kstep = (size_t)(BK * 2);
    const unsigned ldsw = (unsigned)wid * 1024u;
    const int aoff = lds_byte(wr * 64 + fr, fq * 8), boff = lds_byte(wc * 32 + fr, fq * 8);
#define PG8_SA(b, h) (((b) * 2 + (h)) * HTB)
#define PG8_SB(b, h) ((4 + (b) * 2 + (h)) * HTB)
#define PG8_STAGE(bufoff, gbase, voff) do { _Pragma("unroll") for (int _i = 0; _i < 2; ++_i) \
        __builtin_amdgcn_global_load_lds((const unsigned*)((const char*)(gbase) + (voff)[_i]), (PG8_LAS unsigned*)(lds + (bufoff) + ldsw + _i * 8192), 16, 0, 0); } while (0)
#define PG8_LD8(dst, addr) do { const i32x4 lo_ = *(const PG8_LAS i32x4*)(addr), hi_ = *(const PG8_LAS i32x4*)((addr) + 1024); dst = __builtin_shufflevector(lo_, hi_, 0, 1, 2, 3, 4, 5, 6, 7); } while (0)
#define PG8_LDA(dst, b, h) do { _Pragma("unroll") for (int m = 0; m < 4; ++m) PG8_LD8(dst[m], lds + PG8_SA(b, h) + aoff + m * 2048); } while (0)
#define PG8_LDB(dst, b, h) do { _Pragma("unroll") for (int n = 0; n < 2; ++n) PG8_LD8(dst[n], lds + PG8_SB(b, h) + boff + n * 2048); } while (0)
#define PG8_HALF(v, k) __builtin_bit_cast(bf16x8, (k) ? __builtin_shufflevector(v, v, 4, 5, 6, 7) : __builtin_shufflevector(v, v, 0, 1, 2, 3))
#define PG8_MMA(ai, bj, At, Bt) do { __builtin_amdgcn_s_setprio(1); _Pragma("unroll") for (int m = 0; m < 4; ++m) _Pragma("unroll") for (int n = 0; n < 2; ++n) { \
        if (FP8) asm volatile("v_mfma_scale_f32_16x16x128_f8f6f4 %0, %1, %2, %0, %3, %4 op_sel_hi:[0,0,0]" : "+v"(acc[ai][bj][m][n]) : "v"(Bt[n]), "v"(At[m]), "v"(scw_), "v"(scx_)); \
        else { _Pragma("unroll") for (int k = 0; k < 2; ++k) acc[ai][bj][m][n] = __builtin_amdgcn_mfma_f32_16x16x32_bf16(PG8_HALF(Bt[n], k), PG8_HALF(At[m], k), acc[ai][bj][m][n], 0, 0, 0); } } \
        __builtin_amdgcn_s_setprio(0); } while (0)
#define PG8_WAIT_V(n) asm volatile("s_waitcnt vmcnt(" #n ")" ::: "memory")
#define PG8_WAIT_L(n) asm volatile("s_waitcnt lgkmcnt(" #n ")" ::: "memory")
#define PG8_BAR __builtin_amdgcn_s_barrier()
#define PG8_SCHED __builtin_amdgcn_sched_barrier(0)
#define PG8_FILLA(u, v) do { _Pragma("unroll") for (int _h = 0; _h < 2; ++_h) _Pragma("unroll") for (int _i = 0; _i < 2; ++_i) { const int _row = _h * HALF + Rr[_i]; \
        if (GATHER) { const int _ri = (u).row0 + _row; const int _src = (u).gather[_ri < (u).rend ? _ri : (u).row0]; (v)[_h][_i] = (unsigned)(_src * KB + Cc[_i] * 2); } \
        else (v)[_h][_i] = (unsigned)(_row * KB + Cc[_i] * 2); } } while (0)
    Unit cur, nxt; int ui = 0;
    if (!S.next(0, cur)) return;
    f32x4 acc[2][2][4][2];
#pragma unroll
    for (int a = 0; a < 2; ++a)
#pragma unroll
        for (int b = 0; b < 2; ++b)
#pragma unroll
            for (int m = 0; m < 4; ++m)
#pragma unroll
                for (int n = 0; n < 2; ++n) acc[a][b][m][n] = (f32x4){0.f, 0.f, 0.f, 0.f};
    i32x8 At[4], B0[2], B1[2];
    unsigned voffA[2][2], nvoffA[2][2];
    PG8_FILLA(cur, voffA);
    const char* cA = cur.A; const char* cB = cur.B;
    PG8_STAGE(PG8_SB(0, 0), cB, voffB[0]); PG8_STAGE(PG8_SB(0, 1), cB, voffB[1]); PG8_STAGE(PG8_SA(0, 0), cA, voffA[0]); PG8_STAGE(PG8_SA(0, 1), cA, voffA[1]);
    if (wr == 1) PG8_BAR;
    PG8_WAIT_V(2); PG8_BAR;
    PG8_STAGE(PG8_SB(1, 0), cB + kstep, voffB[0]); PG8_STAGE(PG8_SA(1, 0), cA + kstep, voffA[0]); PG8_STAGE(PG8_SB(1, 1), cB + kstep, voffB[1]);
    PG8_WAIT_V(6); PG8_BAR;
    for (;;) {
        const bool has_next = S.next(ui + 1, nxt);
        const char* nA = has_next ? nxt.A : cA; const char* nB = has_next ? nxt.B : cB;
        if (GATHER && has_next) { PG8_FILLA(nxt, nvoffA); }
        else {
#pragma unroll
            for (int h = 0; h < 2; ++h)
#pragma unroll
                for (int i = 0; i < 2; ++i) nvoffA[h][i] = voffA[h][i]; }
        for (int t = 0; t < nt; t += 2) {
            const bool last = (t == nt - 2);
            const char* a1 = cA + (size_t)(t + 1) * kstep;
            const char* a2 = last ? nA : cA + (size_t)(t + 2) * kstep; const char* b2 = last ? nB : cB + (size_t)(t + 2) * kstep;
            const char* a3 = a2 + kstep; const char* b3 = b2 + kstep;
            unsigned v2[2][2];
#pragma unroll
            for (int h = 0; h < 2; ++h)
#pragma unroll
                for (int i = 0; i < 2; ++i) v2[h][i] = last ? nvoffA[h][i] : voffA[h][i];
            PG8_LDB(B0, 0, 0); PG8_LDB(B1, 0, 1); PG8_SCHED; PG8_LDA(At, 0, 0); PG8_STAGE(PG8_SA(1, 1), a1, voffA[1]);
            PG8_WAIT_V(8); PG8_WAIT_L(0); PG8_BAR; PG8_MMA(0, 0, At, B0); PG8_MMA(0, 1, At, B1); PG8_BAR; PG8_SCHED;
            PG8_LDA(At, 0, 1); PG8_STAGE(PG8_SB(0, 0), b2, voffB[0]); PG8_STAGE(PG8_SB(0, 1), b2, voffB[1]); PG8_STAGE(PG8_SA(0, 0), a2, v2[0]);
            PG8_WAIT_V(8); PG8_WAIT_L(0); PG8_BAR; PG8_MMA(1, 0, At, B0); PG8_MMA(1, 1, At, B1); PG8_BAR; PG8_SCHED;
            PG8_LDB(B0, 1, 0); PG8_LDB(B1, 1, 1); PG8_SCHED; PG8_LDA(At, 1, 0); PG8_STAGE(PG8_SA(0, 1), a2, v2[1]);
            PG8_WAIT_V(8); PG8_WAIT_L(0); PG8_BAR; PG8_MMA(0, 0, At, B0); PG8_MMA(0, 1, At, B1); PG8_BAR; PG8_SCHED;
            PG8_LDA(At, 1, 1); PG8_STAGE(PG8_SB(1, 0), b3, voffB[0]); PG8_STAGE(PG8_SB(1, 1), b3, voffB[1]); PG8_STAGE(PG8_SA(1, 0), a3, v2[0]);
            PG8_WAIT_V(8); PG8_WAIT_L(0); PG8_BAR; PG8_MMA(1, 0, At, B0); PG8_MMA(1, 1, At, B1); PG8_BAR; PG8_SCHED;
        }
        if (wr == 0) PG8_BAR;
        if (FP8) { PG8_SCHED; asm volatile("s_nop 15\n\ts_nop 7" ::: "memory"); PG8_SCHED; }
        run_epi<PM>(E, acc, cur, wr, wc, fr, fq);
        if (!has_next) break;
#pragma unroll
        for (int a = 0; a < 2; ++a)
#pragma unroll
            for (int b = 0; b < 2; ++b)
#pragma unroll
                for (int m = 0; m < 4; ++m)
#pragma unroll
                    for (int n = 0; n < 2; ++n) acc[a][b][m][n] = (f32x4){0.f, 0.f, 0.f, 0.f};
        cur = nxt; cA = nA; cB = nB; ++ui;
#pragma unroll
        for (int h = 0; h < 2; ++h)
#pragma unroll
            for (int i = 0; i < 2; ++i) voffA[h][i] = nvoffA[h][i];
        if (wr == 1) PG8_BAR;
    }
    PG8_WAIT_V(0);
    PG8_BAR;
#undef PG8_SA
#undef PG8_SB
#undef PG8_STAGE
#undef PG8_LDA
#undef PG8_LD8
#undef PG8_HALF
#undef PG8_LDB
#undef PG8_MMA
#undef PG8_WAIT_V
#undef PG8_WAIT_L
#undef PG8_BAR
#undef PG8_SCHED
#undef PG8_FILLA
}

struct DenseSched {
    const char* A; const char* Bt; int KB, M, nM, nN, nwg, G, c;
    __device__ __forceinline__ void init(const void* A_, const void* Bt_, int M_, int N_, int KB_, int G_, int c_) { A = (const char*)A_; Bt = (const char*)Bt_; KB = KB_; M = M_; nM = M_ / BM; nN = N_ / BM; nwg = nM * nN; G = G_; c = c_; }
    __device__ __forceinline__ bool next(int i, Unit& u) const {
        const long L = (long)i * G + c; if (L >= nwg) return false;
        int wgid = (int)L; { const int q = nwg / 8, r = nwg % 8, xcd = wgid % 8, off = wgid / 8; wgid = (xcd < r ? xcd * (q + 1) : r * (q + 1) + (xcd - r) * q) + off; }
        const int nig = 8 * nN, gid = wgid / nig, fm = gid * 8, gsz = (nM - fm) < 8 ? (nM - fm) : 8;
        const int pm = fm + ((wgid % nig) % gsz), pn = (wgid % nig) / gsz;
        u.A = A + (size_t)pm * BM * KB; u.B = Bt + (size_t)pn * BM * KB; u.gather = nullptr; u.row0 = pm * BM; u.rend = M; u.col0 = pn * BM; return true;
    }
};
struct ExpertSched {
    const int* TILE; int nunits, NPN; const char* A; const int* gather; const char* Bt; size_t bstride; int KB, G, vcu;
    __device__ __forceinline__ bool next(int i, Unit& u) const {
        const int L = i * G + vcu; if (L >= nunits) return false;
        const int tl = L / NPN, pn = L % NPN;
        const int e = __builtin_amdgcn_readfirstlane(TILE[64 + tl]), r0 = __builtin_amdgcn_readfirstlane(TILE[64 + 2048 + tl]), re = __builtin_amdgcn_readfirstlane(TILE[64 + 4096 + tl]);
        u.B = Bt + (size_t)e * bstride + (size_t)pn * BM * KB; u.row0 = r0; u.rend = re; u.col0 = pn * BM;
        if (gather) { u.A = A; u.gather = gather; } else { u.A = A + (size_t)r0 * KB; u.gather = nullptr; }
        return true;
    }
};
}

struct EpiProj { bf16_t* P; const float* gt;
    __device__ __forceinline__ void rowg(int row, bool valid, int colA, const float (&v)[16]) const {
        float y[16];
        if (colA >= 2048 && colA < 3072) {
            float ss = 0.f;
#pragma unroll
            for (int i = 0; i < 16; ++i) ss += v[i] * v[i];
            ss += __shfl_xor(ss, 16); ss += __shfl_xor(ss, 32);
            const float rstd = rsqrtf(ss * (1.f / 64.f) + EPS);
            const float* g = gt + (colA < 2560 ? 0 : 64) + (colA & 63);
            const f32x4 g0 = *(const f32x4*)g, g1 = *(const f32x4*)(g + 4), g2 = *(const f32x4*)(g + 32), g3 = *(const f32x4*)(g + 36);
            y[0] = v[0] * rstd * g0.x; y[1] = v[1] * rstd * g0.y; y[2] = v[2] * rstd * g0.z; y[3] = v[3] * rstd * g0.w; y[4] = v[4] * rstd * g1.x; y[5] = v[5] * rstd * g1.y; y[6] = v[6] * rstd * g1.z; y[7] = v[7] * rstd * g1.w;
            y[8] = v[8] * rstd * g2.x; y[9] = v[9] * rstd * g2.y; y[10] = v[10] * rstd * g2.z; y[11] = v[11] * rstd * g2.w; y[12] = v[12] * rstd * g3.x; y[13] = v[13] * rstd * g3.y; y[14] = v[14] * rstd * g3.z; y[15] = v[15] * rstd * g3.w;
        } else {
#pragma unroll
            for (int i = 0; i < 16; ++i) y[i] = v[i];
        }
        if (valid) { const float y0[8] = {y[0], y[1], y[2], y[3], y[4], y[5], y[6], y[7]}, y1[8] = {y[8], y[9], y[10], y[11], y[12], y[13], y[14], y[15]};
            *(u32x4*)(P + (size_t)row * NPROJ + colA) = pack8(y0); *(u32x4*)(P + (size_t)row * NPROJ + colA + 32) = pack8(y1); } } };
struct EpiOut { const float* x; bf16_t* x1; const float* MOD;
    __device__ __forceinline__ void operator()(int row, bool valid, int col0, const float (&v)[8]) const {
        if (!valid) return; const int b = row / SEQ; const float* ga = MOD + b * 6144 + 2 * 1024 + col0;
        const f32x4 x0 = __builtin_nontemporal_load((const f32x4*)(x + (size_t)row * DM + col0)), x1v = __builtin_nontemporal_load((const f32x4*)(x + (size_t)row * DM + col0 + 4));
        const float o[8] = {x0.x + ga[0] * v[0], x0.y + ga[1] * v[1], x0.z + ga[2] * v[2], x0.w + ga[3] * v[3], x1v.x + ga[4] * v[4], x1v.y + ga[5] * v[5], x1v.z + ga[6] * v[6], x1v.w + ga[7] * v[7]};
        *(u32x4*)(x1 + (size_t)row * DM + col0) = pack8(o); } };
struct EpiRS { float* LOG; bf16_t* ACT;
    __device__ __forceinline__ void operator()(int row, bool valid, int col0, const float (&v)[8]) const {
        if (!valid) return;
        if (col0 < 256) { *(f32x4*)(LOG + (size_t)row * 256 + col0) = (f32x4){v[0], v[1], v[2], v[3]}; *(f32x4*)(LOG + (size_t)row * 256 + col0 + 4) = (f32x4){v[4], v[5], v[6], v[7]}; }
        else { const int j0 = (col0 - 256) >> 1;
            *(unsigned*)((unsigned char*)ACT + (size_t)(SHARED_BASE + row) * 256 + j0) = pk4_fp8(8.f * siluf(v[0]) * v[4], 8.f * siluf(v[1]) * v[5], 8.f * siluf(v[2]) * v[6], 8.f * siluf(v[3]) * v[7]); } } };
struct EpiG1 { const float* SG; bf16_t* ACT;
    __device__ __forceinline__ void operator()(int row, bool valid, int col0, const float (&v)[8]) const {
        if (!valid) return; const float g = 8.f * SG[row]; const int j0 = col0 >> 1;
        *(unsigned*)((unsigned char*)ACT + (size_t)row * 256 + j0) = pk4_fp8(siluf(v[0]) * v[4] * g, siluf(v[1]) * v[5] * g, siluf(v[2]) * v[6] * g, siluf(v[3]) * v[7] * g); } };
struct EpiG2 { bf16_t* YP;
    __device__ __forceinline__ void operator()(int row, bool valid, int col0, const float (&v)[8]) const { if (valid) { u32x2 p; p.x = pk4_fp8(16.f * v[0], 16.f * v[1], 16.f * v[2], 16.f * v[3]); p.y = pk4_fp8(16.f * v[4], 16.f * v[5], 16.f * v[6], 16.f * v[7]);
            *(u32x2*)((unsigned char*)YP + (size_t)row * DM + col0) = p; } }
    __device__ __forceinline__ void row16(int row, bool valid, int col0, const float (&v)[16]) const { if (valid) { u32x4 p;
            p.x = pk4_fp8(16.f * v[0], 16.f * v[1], 16.f * v[2], 16.f * v[3]); p.y = pk4_fp8(16.f * v[4], 16.f * v[5], 16.f * v[6], 16.f * v[7]);
            p.z = pk4_fp8(16.f * v[8], 16.f * v[9], 16.f * v[10], 16.f * v[11]); p.w = pk4_fp8(16.f * v[12], 16.f * v[13], 16.f * v[14], 16.f * v[15]);
            __builtin_nontemporal_store(p, (u32x4*)((unsigned char*)YP + (size_t)row * DM + col0)); } } };

constexpr int LR = 136;
__device__ __forceinline__ f32x4 mfma16(bf16x8 a, bf16x8 b, f32x4 c) {
    asm volatile("s_nop 1\n\tv_mfma_f32_16x16x32_bf16 %0, %1, %2, %0" : "+v"(c) : "v"(a), "v"(b)); return c; }
#define MFMA_DRAIN8(x) asm volatile("s_nop 15\n\ts_nop 3" : "+v"(x[0]), "+v"(x[1]), "+v"(x[2]), "+v"(x[3]), "+v"(x[4]), "+v"(x[5]), "+v"(x[6]), "+v"(x[7]))
__device__ __forceinline__ bf16x8 ldfrag(const bf16_t* base, int row, int k0, int lane) { return *(const bf16x8*)(base + (row + (lane & 15)) * LR + k0 + 8 * (lane >> 4)); }


__device__ __forceinline__ void conv8_lds(const bf16_t* R, int pitch, int s, int col, const float* cw, int wpitch, const float* cb, int ch, float (&o)[8]) {
    float acc[8];
    { const f32x4 b0 = *(const f32x4*)(cb + ch), b1 = *(const f32x4*)(cb + ch + 4); acc[0] = b0.x; acc[1] = b0.y; acc[2] = b0.z; acc[3] = b0.w; acc[4] = b1.x; acc[5] = b1.y; acc[6] = b1.z; acc[7] = b1.w; }
#pragma unroll
    for (int j = 0; j < 4; ++j) { float x[8]; unpack8(*(const u32x4*)(R + (s + j) * pitch + col), x);
        const f32x4 w0 = *(const f32x4*)(cw + j * wpitch + ch), w1 = *(const f32x4*)(cw + j * wpitch + ch + 4);
        acc[0] += w0.x * x[0]; acc[1] += w0.y * x[1]; acc[2] += w0.z * x[2]; acc[3] += w0.w * x[3];
        acc[4] += w1.x * x[4]; acc[5] += w1.y * x[5]; acc[6] += w1.z * x[6]; acc[7] += w1.w * x[7]; }
#pragma unroll
    for (int q = 0; q < 8; ++q) o[q] = siluf(acc[q]);
}
__device__ __forceinline__ void chunk_gates(const Args& a, float* bb, float* ii, float* tmp, int t0, int h, int tid) {
    const float* IPRE = (const float*)(a.ws + WS_IPRE); const float* FPRE = (const float*)(a.ws + WS_FPRE);
    if (tid < 128) { const float f = FPRE[(size_t)(t0 + tid) * 4 + h]; ii[tid] = IPRE[(size_t)(t0 + tid) * 4 + h];
        tmp[tid] = fminf(f, 0.f) - log1pf(expf(-fabsf(f))); }
    __syncthreads();
    if (tid < 128) { float s = 0.f;
#pragma unroll 4
        for (int j4 = 0; j4 < 32; ++j4) { const f32x4 v = *(const f32x4*)(tmp + 4 * j4); const int j = 4 * j4;
            s += (j <= tid ? v.x : 0.f); s += (j + 1 <= tid ? v.y : 0.f); s += (j + 2 <= tid ? v.z : 0.f); s += (j + 3 <= tid ? v.w : 0.f); }
        bb[tid] = s; }
    __syncthreads();
}

__device__ __forceinline__ void mlstm_m1_unit(const Args& a, unsigned char* lds, int unit, const int wave_s) {
    const int tid = mk_tid(wave_s);
    const int lane = tid & 63, wave = tid >> 6;
    const int bh = unit >> 6, c = unit & 63, b = bh >> 2, h = bh & 3, t0 = b * SEQ + c * 128;
    bf16_t* kT = (bf16_t*)lds; bf16_t* vT = kT + 128 * LR;
    float* sf = (float*)(lds + 2 * 128 * LR * 2); float* bb = sf; float* ii = sf + 128; float* tmp = sf + 256; float* wk = sf + 384;
    const bf16_t* PROJ = (const bf16_t*)(a.ws + WS_PROJ);
    const float* cw = a.in[5]; const float* cbias = a.in[6];
    bf16_t* R = (bf16_t*)(lds + 2 * 128 * LR * 2 + 2048);
    const int tl = tid;
    u32x4 rawk[5], vreg[4];
#pragma unroll
    for (int k = 0; k < 5; ++k) { const int idx = tl + 512 * k, row = idx >> 4, chunk = idx & 15; const int sp = c * 128 - 3 + row;
        rawk[k] = (u32x4){0u, 0u, 0u, 0u};
        if (idx < 131 * 16 && sp >= 0) rawk[k] = *(const u32x4*)(PROJ + (size_t)(b * SEQ + sp) * NPROJ + 512 + h * 128 + 8 * chunk); }
#pragma unroll
    for (int k = 0; k < 4; ++k) { const int it = tl + 512 * k, sidx = it & 127, ch = it >> 7; vreg[k] = *(const u32x4*)(PROJ + (size_t)(t0 + sidx) * NPROJ + 1024 + h * 128 + 8 * ch); }
    float* WL = (float*)(lds + 147456);
    float wl0 = 0.f, wl1 = 0.f; if (tl < 512) wl0 = cw[(tl >> 7) * 1024 + 512 + h * 128 + (tl & 127)]; if (tl < 128) wl1 = cbias[512 + h * 128 + tl];
    chunk_gates(a, bb, ii, tmp, t0, h, tid);
    if (tl < 512) WL[tl] = wl0; if (tl < 128) WL[512 + tl] = wl1;
#pragma unroll
    for (int k = 0; k < 5; ++k) { const int idx = tl + 512 * k; if (idx < 131 * 16) *(u32x4*)(R + (idx >> 4) * 136 + 8 * (idx & 15)) = rawk[k]; }
    const float blast = bb[127];
    if (tid < 128) tmp[tid] = blast - bb[tid] + ii[tid];
    __syncthreads();
    float mloc = -INFINITY;
#pragma unroll 4
    for (int j4 = 0; j4 < 32; ++j4) { const f32x4 v = *(const f32x4*)(tmp + 4 * j4); mloc = fmaxf(fmaxf(mloc, fmaxf(v.x, v.y)), fmaxf(v.z, v.w)); }
    if (tid < 128) wk[tid] = expf(tmp[tid] - mloc);
    __syncthreads();
#pragma unroll
    for (int k = 0; k < 4; ++k) { const int it = tl + 512 * k, sidx = it & 127, ch = it >> 7;
        float kv[8]; conv8_lds(R, 136, sidx, 8 * ch, WL, 128, WL + 512, 8 * ch, kv);
        const float sc = 0.08838834764831845f * wk[sidx];
#pragma unroll
        for (int q = 0; q < 8; ++q) kT[(8 * ch + q) * LR + sidx] = (bf16_t)f2bf(kv[q] * sc);
        float vv[8]; unpack8(vreg[k], vv);
#pragma unroll
        for (int q = 0; q < 8; ++q) vT[(8 * ch + q) * LR + sidx] = (bf16_t)f2bf(vv[q]);
    }
    __syncthreads();
    float* CLOC = (float*)(a.ws + WS_CLOC) + (size_t)unit * 16384;
    float* MST = (float*)(a.ws + WS_MST);
    {
        f32x4 acc[8];
#pragma unroll
        for (int i = 0; i < 8; ++i) acc[i] = (f32x4){0.f, 0.f, 0.f, 0.f};
#pragma unroll
        for (int ks = 0; ks < 4; ++ks) { const bf16x8 af = ldfrag(vT, 16 * wave, 32 * ks, lane);
#pragma unroll
            for (int db = 0; db < 8; ++db) acc[db] = mfma16(af, ldfrag(kT, 16 * db, 32 * ks, lane), acc[db]); }
        MFMA_DRAIN8(acc);
#pragma unroll
        for (int db = 0; db < 8; ++db)
#pragma unroll
            for (int r = 0; r < 4; ++r) CLOC[(16 * wave + 4 * (lane >> 4) + r) * 128 + 16 * db + (lane & 15)] = acc[db][r];
    }
    if (tid < 128) { float s = 0.f;
#pragma unroll 4
        for (int j8 = 0; j8 < 16; ++j8) { float x[8]; unpack8(*(const u32x4*)(kT + tid * LR + 8 * j8), x); s += ((x[0] + x[1]) + (x[2] + x[3])) + ((x[4] + x[5]) + (x[6] + x[7])); }
        MST[16384 + (size_t)unit * 128 + tid] = s; }
    if (tid == 0) { MST[unit] = mloc; MST[1024 + unit] = blast; }
    __syncthreads();
}

__device__ __forceinline__ void mlstm_m2(const Args& a, const int tid2) {
    const float* CLOC = (const float*)(a.ws + WS_CLOC); bf16_t* CIN = (bf16_t*)(a.ws + WS_CIN);
    float* MST = (float*)(a.ws + WS_MST);
    const float* NLOC = MST + 16384; float* NIN = MST + 16384 + 131072;
    for (int gid = blockIdx.x * 512 + tid2; gid < 16 * 8192; gid += gridDim.x * 512) {
        const int bh = gid >> 13, e2 = gid & 8191; const bool hasn = e2 < 128;
        const float* cl = CLOC + (size_t)(bh * 64) * 16384 + e2; const float* nl = NLOC + (size_t)(bh * 64) * 128 + e2;
        bf16_t* ci = CIN + (size_t)(bh * 64) * 16384 + e2; float* ni = NIN + (size_t)(bh * 64) * 128 + e2;
        const float* mlp = MST + bh * 64; const float* blp = MST + 1024 + bh * 64;
        float s0 = 0.f, s1 = 0.f, sn = 0.f, m = 0.f;
        float p0[4], p1[4], pn[4], pm[4], pb[4];
#pragma unroll
        for (int k = 0; k < 4; ++k) { p0[k] = __builtin_nontemporal_load(cl + (size_t)k * 16384); p1[k] = __builtin_nontemporal_load(cl + (size_t)k * 16384 + 8192); pn[k] = hasn ? nl[k * 128] : 0.f; pm[k] = mlp[k]; pb[k] = blp[k]; }
        for (int c0 = 0; c0 < 64; c0 += 4) {
            float q0[4], q1[4], qn[4], qm[4], qb[4];
            const bool more = c0 + 4 < 64;
#pragma unroll
            for (int k = 0; k < 4; ++k) { const int c = more ? c0 + 4 + k : c0 + k;
                q0[k] = __builtin_nontemporal_load(cl + (size_t)c * 16384); q1[k] = __builtin_nontemporal_load(cl + (size_t)c * 16384 + 8192); qn[k] = hasn ? nl[c * 128] : 0.f; qm[k] = mlp[c]; qb[k] = blp[c]; }
#pragma unroll
            for (int k = 0; k < 4; ++k) { const int c = c0 + k;
                ci[(size_t)c * 16384] = (bf16_t)f2bf(s0); ci[(size_t)c * 16384 + 8192] = (bf16_t)f2bf(s1);
                if (hasn) ni[c * 128] = sn;
                if (e2 == 0) MST[2048 + bh * 64 + c] = m;
                const float ml = pm[k], bl = pb[k];
                const float mn = fmaxf(bl + m, ml), ca = expf(bl + m - mn), cb = expf(ml - mn);
                s0 = ca * s0 + cb * p0[k]; s1 = ca * s1 + cb * p1[k]; sn = ca * sn + cb * pn[k]; m = mn; }
#pragma unroll
            for (int k = 0; k < 4; ++k) { p0[k] = q0[k]; p1[k] = q1[k]; pn[k] = qn[k]; pm[k] = qm[k]; pb[k] = qb[k]; }
        }
    }
}

template <int MODE>
__device__ __forceinline__ void mlstm_m3_unit(const Args& a, unsigned char* lds, int unit, const int wave_s) {
    const int tid = mk_tid(wave_s);
    const int lane = tid & 63, wave = tid >> 6;
    const int bh = unit >> 6, c = unit & 63, b = bh >> 2, h = bh & 3, t0 = b * SEQ + c * 128;
    bf16_t* qs = (bf16_t*)lds; bf16_t* ks = qs + 128 * LR; bf16_t* vT = ks + 128 * LR; bf16_t* CT = vT + 128 * LR; bf16_t* Ps = ks;
    float* sf = (float*)(lds + 4 * 128 * LR * 2);
    float* bb = sf; float* ii = sf + 128; float* tmp = sf + 256; float* gg = sf + 384; float* wint = sf + 512; float* nn = sf + 640; float* den = sf + 768; float* dint = sf + 896;
    const bf16_t* PROJ = (const bf16_t*)(a.ws + WS_PROJ); const bf16_t* CIN = (const bf16_t*)(a.ws + WS_CIN) + (size_t)unit * 16384;
    const float* MST = (const float*)(a.ws + WS_MST);
    const float* cw = a.in[5]; const float* cbias = a.in[6]; const float* mlg = a.in[8];
    bf16_t* MIX = (bf16_t*)(a.ws + WS_MIX);
    bf16_t* R = vT;
    const float m_in = MST[2048 + unit];
    const int tl = tid;
    u32x4 rawq[9], vreg[4], creg[4];
#pragma unroll
    for (int k = 0; k < 9; ++k) { const int idx = tl + 512 * k, row = idx >> 5, chunk = idx & 31; const int sp = c * 128 - 3 + row;
        rawq[k] = (u32x4){0u, 0u, 0u, 0u};
        if (idx < 131 * 32 && sp >= 0) rawq[k] = *(const u32x4*)(PROJ + (size_t)(b * SEQ + sp) * NPROJ + (chunk < 16 ? h * 128 + 8 * chunk : 512 + h * 128 + 8 * (chunk - 16))); }
#pragma unroll
    for (int k = 0; k < 4; ++k) { const int it = tl + 512 * k, sidx = it & 127, ch = it >> 7, s2 = it >> 4, c2 = it & 15;
        vreg[k] = *(const u32x4*)(PROJ + (size_t)(t0 + sidx) * NPROJ + 1024 + h * 128 + 8 * ch); creg[k] = *(const u32x4*)(CIN + s2 * 128 + 8 * c2); }
    float* WL = (float*)(lds + 147456);
    const float wl0 = cw[(tl >> 7) * 1024 + h * 128 + (tl & 127)], wl1 = cw[(tl >> 7) * 1024 + 512 + h * 128 + (tl & 127)]; float wl2 = 0.f; if (tl < 256) wl2 = cbias[(tl >> 7) * 512 + h * 128 + (tl & 127)];
    chunk_gates(a, bb, ii, tmp, t0, h, tid);
    WL[tl] = wl0; WL[512 + tl] = wl1; if (tl < 256) WL[1024 + tl] = wl2;
#pragma unroll
    for (int k = 0; k < 9; ++k) { const int idx = tl + 512 * k; if (idx < 131 * 32) *(u32x4*)(R + (idx >> 5) * 264 + 8 * (idx & 31)) = rawq[k]; }
    if (tid < 128) { float pm = -INFINITY;
#pragma unroll 4
        for (int j4 = 0; j4 < 32; ++j4) { const f32x4 vi = *(const f32x4*)(ii + 4 * j4), vb = *(const f32x4*)(bb + 4 * j4); const int j = 4 * j4;
            pm = fmaxf(pm, j <= tl ? vi.x - vb.x : -INFINITY); pm = fmaxf(pm, j + 1 <= tl ? vi.y - vb.y : -INFINITY);
            pm = fmaxf(pm, j + 2 <= tl ? vi.z - vb.z : -INFINITY); pm = fmaxf(pm, j + 3 <= tl ? vi.w - vb.w : -INFINITY); }
        const float g = fmaxf(m_in, pm); gg[tl] = g; wint[tl] = expf(m_in - g); tmp[tl] = ii[tl] - bb[tl];
        nn[tl] = MST[16384 + 131072 + (size_t)unit * 128 + tl]; }
    __syncthreads();
#pragma unroll 1
    for (int k = 0; k < 4; ++k) { const int it = tl + 512 * k, sidx = it & 127, ch = it >> 7;
        float qv[8], kv[8];
        conv8_lds(R, 264, sidx, 8 * ch, WL, 128, WL + 1024, 8 * ch, qv);
        conv8_lds(R, 264, sidx, 128 + 8 * ch, WL + 512, 128, WL + 1152, 8 * ch, kv);
#pragma unroll
        for (int q = 0; q < 8; ++q) kv[q] *= 0.08838834764831845f;
        *(u32x4*)(qs + sidx * LR + 8 * ch) = pack8(qv);
        *(u32x4*)(ks + sidx * LR + 8 * ch) = pack8(kv); }
    __syncthreads();
#pragma unroll
    for (int k = 0; k < 4; ++k) { const int it = tl + 512 * k, sidx = it & 127, ch = it >> 7, s2 = it >> 4, c2 = it & 15;
        float vv[8]; unpack8(vreg[k], vv);
#pragma unroll
        for (int q = 0; q < 8; ++q) vT[(8 * ch + q) * LR + sidx] = (bf16_t)f2bf(vv[q]);
        *(u32x4*)(CT + s2 * LR + 8 * c2) = creg[k]; }
    __syncthreads();
    if (MODE == 1) return;
    if (tid < 128) { float s = 0.f;
#pragma unroll 4
        for (int d8 = 0; d8 < 16; ++d8) { float x[8]; unpack8(*(const u32x4*)(qs + tl * LR + 8 * d8), x); const f32x4 n0 = *(const f32x4*)(nn + 8 * d8), n1 = *(const f32x4*)(nn + 8 * d8 + 4);
            s += (x[0] * n0.x + x[1] * n0.y) + (x[2] * n0.z + x[3] * n0.w) + (x[4] * n1.x + x[5] * n1.y) + (x[6] * n1.z + x[7] * n1.w); }
        dint[tl] = s * wint[tl]; }
    f32x4 sacc[8];
#pragma unroll
    for (int i = 0; i < 8; ++i) sacc[i] = (f32x4){0.f, 0.f, 0.f, 0.f};
#pragma unroll
    for (int kk = 0; kk < 4; ++kk) { const bf16x8 bq = ldfrag(qs, 16 * wave, 32 * kk, lane);
#pragma unroll
        for (int sb = 0; sb < 8; ++sb) sacc[sb] = mfma16(ldfrag(ks, 16 * sb, 32 * kk, lane), bq, sacc[sb]); }
    MFMA_DRAIN8(sacc);
    __syncthreads();
    {
        const int t = 16 * wave + (lane & 15); const float g = gg[t]; float rs = 0.f;
#pragma unroll
        for (int sb = 0; sb < 8; ++sb) { float p[4];
            const f32x4 u4 = *(const f32x4*)(tmp + 16 * sb + 4 * (lane >> 4));
#pragma unroll
            for (int r = 0; r < 4; ++r) { const int s = 16 * sb + 4 * (lane >> 4) + r;
                const float w = __builtin_amdgcn_exp2f(fminf(u4[r] - g, 0.f) * LOG2E);
                p[r] = (s <= t) ? sacc[sb][r] * w : 0.f; rs += p[r]; }
            u32x2 w; w.x = pk2(p[0], p[1]); w.y = pk2(p[2], p[3]);
            *(u32x2*)(Ps + t * LR + 16 * sb + 4 * (lane >> 4)) = w; }
        rs += __shfl_xor(rs, 16); rs += __shfl_xor(rs, 32);
        if (lane < 16) den[t] = rs + dint[t];
    }
    __syncthreads();
    if (MODE == 2) return;
    {
        f32x4 a1[8], a2[8];
#pragma unroll
        for (int i = 0; i < 8; ++i) { a1[i] = (f32x4){0.f, 0.f, 0.f, 0.f}; a2[i] = (f32x4){0.f, 0.f, 0.f, 0.f}; }
#pragma unroll
        for (int kk = 0; kk < 4; ++kk) { const bf16x8 ap = ldfrag(Ps, 16 * wave, 32 * kk, lane), aq = ldfrag(qs, 16 * wave, 32 * kk, lane);
#pragma unroll
            for (int eb = 0; eb < 8; ++eb) { a1[eb] = mfma16(ap, ldfrag(vT, 16 * eb, 32 * kk, lane), a1[eb]); a2[eb] = mfma16(aq, ldfrag(CT, 16 * eb, 32 * kk, lane), a2[eb]); } }
        MFMA_DRAIN8(a1); MFMA_DRAIN8(a2);
        float hv[8][4]; float ssq[4];
#pragma unroll
        for (int r = 0; r < 4; ++r) { const int t = 16 * wave + 4 * (lane >> 4) + r;
            const float dd = fmaxf(fabsf(den[t]), expf(-(bb[t] + gg[t]))); const float inv = 1.f / dd, wi = wint[t]; float s2 = 0.f;
#pragma unroll
            for (int eb = 0; eb < 8; ++eb) { const float x = (a1[eb][r] + wi * a2[eb][r]) * inv; hv[eb][r] = x; s2 += x * x;
            }
            s2 += __shfl_xor(s2, 1); s2 += __shfl_xor(s2, 2); s2 += __shfl_xor(s2, 4); s2 += __shfl_xor(s2, 8);
            ssq[r] = rsqrtf(s2 * (1.f / 128.f) + EPS); }
        float mov[8][4];
#pragma unroll
        for (int eb = 0; eb < 8; ++eb)
#pragma unroll
            for (int r = 0; r < 4; ++r) mov[eb][r] = bflo(PROJ[(size_t)(t0 + 16 * wave + 4 * (lane >> 4) + r) * NPROJ + 1536 + h * 128 + 16 * eb + (lane & 15)]);
#pragma unroll
        for (int eb = 0; eb < 8; ++eb) { const int e = 16 * eb + (lane & 15); const float ge = mlg[e];
#pragma unroll
            for (int r = 0; r < 4; ++r) { const int t = 16 * wave + 4 * (lane >> 4) + r;
                const float outv = hv[eb][r] * ssq[r] * ge * sigm(mov[eb][r]);
                if (MODE == 0) MIX[(size_t)(t0 + t) * DM + h * 128 + e] = (bf16_t)f2bf(outv); else asm volatile("" :: "v"(outv)); } }
    }
    __syncthreads();
}

__device__ __forceinline__ void qknorm_rows(const Args& a, const int tid) {
    const int lane = tid & 63, wave = tid >> 6;
    bf16_t* PROJ = (bf16_t*)(a.ws + WS_PROJ);
    const float* gq = a.in[9]; const float* gk = a.in[10];
    const float* g = (lane < 32) ? gq : gk; const float scl = (lane < 32) ? C2 : 1.f;
    float gv[16];
#pragma unroll
    for (int i = 0; i < 16; ++i) gv[i] = g[16 * (lane & 3) + i] * scl;
    const int gw = blockIdx.x * 8 + wave, NGW = gridDim.x * 8;
    for (int row = gw; row < T; row += NGW) {
        u32x4* p = (u32x4*)(PROJ + (size_t)row * NPROJ + 2048 + 16 * lane);
        float x[16]; { float t8[8]; unpack8(p[0], t8);
#pragma unroll
            for (int i = 0; i < 8; ++i) x[i] = t8[i]; unpack8(p[1], t8);
#pragma unroll
            for (int i = 0; i < 8; ++i) x[8 + i] = t8[i]; }
        float ss = 0.f;
#pragma unroll
        for (int i = 0; i < 16; ++i) ss += x[i] * x[i];
        ss += __shfl_xor(ss, 1); ss += __shfl_xor(ss, 2);
        const float rstd = rsqrtf(ss * (1.f / 64.f) + EPS);
        float y0[8], y1[8];
#pragma unroll
        for (int i = 0; i < 8; ++i) { y0[i] = x[i] * rstd * gv[i]; y1[i] = x[8 + i] * rstd * gv[8 + i]; }
        p[0] = pack8(y0); p[1] = pack8(y1);
    }
}

#include <hip/hip_bf16.h>
namespace attn_body {
using bf16=__hip_bfloat16;
using bf16x8=__attribute__((ext_vector_type(8)))short;
using s16x4=__attribute__((ext_vector_type(4)))short;
using f32x16=__attribute__((ext_vector_type(16)))float;
using u32x4=__attribute__((ext_vector_type(4)))unsigned;
constexpr int SEQ=8192,PQ=3584,KVBLK=64;
__device__ __forceinline__ int crow(int r,int hi){return (r&3)+8*(r>>2)+4*hi;}
#define SBAR() __builtin_amdgcn_sched_barrier(0)
__device__ __forceinline__ void cmask(f32x16&p0,f32x16&p1,int jb,int qrel,int hi){
  const float NEG=-INFINITY; int kb=64*jb+4*hi;
  #pragma unroll
  for(int r=0;r<16;++r){int kv=kb+(r&3)+8*(r>>2); if(kv>qrel)p0[r]=NEG; if(kv+32>qrel)p1[r]=NEG;}
}

__device__ __forceinline__ void glds16(const void*gsrc,unsigned lds_dst){unsigned keep;
  asm volatile("s_mov_b32 %0, m0\n\ts_mov_b32 m0, %2\n\ts_nop 0\n\tglobal_load_lds_dwordx4 %1, off\n\ts_mov_b32 m0, %0":"=&s"(keep):"v"(gsrc),"s"(lds_dst):"memory");}
typedef float f32x2_t __attribute__((ext_vector_type(2))); typedef __bf16 bf16x2_t __attribute__((ext_vector_type(2)));
__device__ __forceinline__ unsigned cvtpk_s(float lo,float hi){f32x2_t v={lo,hi};bf16x2_t b=__builtin_convertvector(v,bf16x2_t);return __builtin_bit_cast(unsigned,b);}

__device__ __forceinline__ void qkt(f32x16&p0,f32x16&p1,unsigned kb,const bf16x8*qr,const f32x16&negm){
  bf16x8 k0,k1,k2,k3,k4,k5,k6,k7;
  #define QK_RD(K,OFF) asm volatile("ds_read_b128 %0,%1 offset:%c2":"=&v"(K):"v"(kb),"i"(OFF):"memory")
  QK_RD(k0,0);QK_RD(k1,512);QK_RD(k2,2048);QK_RD(k3,2560);QK_RD(k4,4096);QK_RD(k5,4608);QK_RD(k6,6144);QK_RD(k7,6656);
  #undef QK_RD
  asm volatile("s_waitcnt lgkmcnt(6)":::"memory");SBAR();
  p0=__builtin_amdgcn_mfma_f32_32x32x16_bf16(k0,qr[0],negm,0,0,0);p1=__builtin_amdgcn_mfma_f32_32x32x16_bf16(k1,qr[0],negm,0,0,0);SBAR();
  asm volatile("s_waitcnt lgkmcnt(4)":::"memory");SBAR();
  p0=__builtin_amdgcn_mfma_f32_32x32x16_bf16(k2,qr[1],p0,0,0,0);p1=__builtin_amdgcn_mfma_f32_32x32x16_bf16(k3,qr[1],p1,0,0,0);SBAR();
  asm volatile("s_waitcnt lgkmcnt(2)":::"memory");SBAR();
  p0=__builtin_amdgcn_mfma_f32_32x32x16_bf16(k4,qr[2],p0,0,0,0);p1=__builtin_amdgcn_mfma_f32_32x32x16_bf16(k5,qr[2],p1,0,0,0);SBAR();
  asm volatile("s_waitcnt lgkmcnt(0)":::"memory");SBAR();
  p0=__builtin_amdgcn_mfma_f32_32x32x16_bf16(k6,qr[3],p0,0,0,0);p1=__builtin_amdgcn_mfma_f32_32x32x16_bf16(k7,qr[3],p1,0,0,0);SBAR();
}

__device__ __forceinline__ void pv4(f32x16*o,int vb,bf16x8 pa0,bf16x8 pa1,bf16x8 pa2,bf16x8 pa3){
  s16x4 la[4],ha[4],lb[4],hb[4];
  #define PV_READ(L,H,OFF) do{ _Pragma("unroll") for(int ks=0;ks<4;++ks){ \
      asm volatile("ds_read_b64_tr_b16 %0,%1 offset:%c2":"=&v"(L[ks]):"v"(vb),"i"((OFF)+ks*1024):"memory"); \
      asm volatile("ds_read_b64_tr_b16 %0,%1 offset:%c2":"=&v"(H[ks]):"v"(vb),"i"((OFF)+ks*1024+512):"memory"); } }while(0)
  #define PV_PK(L,H,k) (bf16x8){L[k][0],L[k][1],L[k][2],L[k][3],H[k][0],H[k][1],H[k][2],H[k][3]}
  #define PV_MMA(dst,L,H) do{ dst=__builtin_amdgcn_mfma_f32_32x32x16_bf16(pa0,PV_PK(L,H,0),dst,0,0,0); dst=__builtin_amdgcn_mfma_f32_32x32x16_bf16(pa1,PV_PK(L,H,1),dst,0,0,0); \
      dst=__builtin_amdgcn_mfma_f32_32x32x16_bf16(pa2,PV_PK(L,H,2),dst,0,0,0); dst=__builtin_amdgcn_mfma_f32_32x32x16_bf16(pa3,PV_PK(L,H,3),dst,0,0,0); }while(0)
  PV_READ(la,ha,0); PV_READ(lb,hb,4096);
  asm volatile("s_waitcnt lgkmcnt(8)":::"memory");SBAR(); PV_MMA(o[0],la,ha); SBAR();
  PV_READ(la,ha,8192);
  asm volatile("s_waitcnt lgkmcnt(8)":::"memory");SBAR(); PV_MMA(o[1],lb,hb); SBAR();
  PV_READ(lb,hb,12288);
  asm volatile("s_waitcnt lgkmcnt(8)":::"memory");SBAR(); PV_MMA(o[2],la,ha); SBAR();
  asm volatile("s_waitcnt lgkmcnt(0)":::"memory");SBAR(); PV_MMA(o[3],lb,hb); SBAR();
  #undef PV_READ
  #undef PV_PK
  #undef PV_MMA
}

constexpr int A2_SLOT=32768, A2_NS=4, A2_K=0, A2_V=16384, A2_WS=131072, A2_STG=65536;
__device__ __forceinline__ void attn2_unit(const bf16*PROJ,const float*dg,bf16_t*MIX,char*shm,int bh,int qb,const float lam,const float m0){
  const int tid=threadIdx.x,lane=tid&63,r32=lane&31,hi=lane>>5; const int wid=__builtin_amdgcn_readfirstlane(tid>>6);
  const int c=wid&1,qblk=wid>>1,b=bh>>2,h=bh&3; const long rowbase=(long)b*SEQ; const int q0=qb*128;
  const float sl2=exp2f(-2.f*(float)(h+1))*1.4426950408889634f;
  int tbeg=0; { const float kmin=(float)q0-(2.f*m0+40.f)/sl2; if(kmin>0.f)tbeg=((int)kmin)>>6; }
  const int NT=(q0+128)/KVBLK-tbeg;
  const bf16*Qw=PROJ+(rowbase+q0+qblk*32)*PQ+2048+h*128+c*64;
  const bf16*ksrc=PROJ+(rowbase+(long)tbeg*KVBLK+lane)*PQ+2560+h*128+wid*8;
  const bf16*vsrc=PROJ+(rowbase+(long)tbeg*KVBLK+16*(wid&3)+(lane>>2))*PQ+3072+h*128+(wid>>2)*32+(lane&3)*8;
  const unsigned lds0=(unsigned)(uintptr_t)shm;
  const unsigned kdst=lds0+A2_K+wid*1024, vdst=lds0+A2_V+wid*1024;
  #define A2_DMA(t,s) do{ const bf16*kp_=ksrc+(long)(t)*KVBLK*PQ; const bf16*vp_=vsrc+(long)(t)*KVBLK*PQ; const unsigned so_=(unsigned)(s)*A2_SLOT; \
      glds16(kp_,(unsigned)__builtin_amdgcn_readfirstlane(kdst+so_)); glds16(kp_+64,(unsigned)__builtin_amdgcn_readfirstlane(kdst+so_+8192)); \
      glds16(vp_,(unsigned)__builtin_amdgcn_readfirstlane(vdst+so_)); glds16(vp_+64,(unsigned)__builtin_amdgcn_readfirstlane(vdst+so_+8192)); }while(0)
  A2_DMA(0,0); if(NT>1)A2_DMA(1,1); if(NT>2)A2_DMA(2,2);
  bf16x8 qr[4];
  #pragma unroll
  for(int d0=0;d0<4;++d0)qr[d0]=*reinterpret_cast<const bf16x8*>(&Qw[(long)r32*PQ+d0*16+hi*8]);
  const int qrel=qblk*32+r32;
  const float sl64=sl2*64.f,c32=sl2*32.f;
  float l_reg=0.f; f32x16 o[4]; o[0]=f32x16{};o[1]=f32x16{};o[2]=f32x16{};o[3]=f32x16{}; f32x16 negm;
  { const float nb0=sl2*(float)(4*hi+64*tbeg-q0-qrel)-m0;
    #pragma unroll
    for(int r=0;r<16;++r)negm[r]=__builtin_fmaf(sl2,(float)((r&3)+8*(r>>2)),nb0); }
  const int vb0=(int)(lds0+A2_V)+((lane>>4)&1)*32+(lane&3)*8+(4*hi+((lane&15)>>2))*64;
  const unsigned kb0=lds0+A2_K+c*8192+hi*1024+r32*16;
  asm volatile(""::"v"(qr[0]),"v"(qr[1]),"v"(qr[2]),"v"(qr[3]));
  { asm volatile("s_waitcnt vmcnt(0)":::"memory"); asm volatile("s_barrier":::"memory"); }
  const int grp=wid>>2;
  if(grp==1)asm volatile("s_barrier":::"memory");
  for(int t=0;t<NT;++t){
    const int s=t&3;
    f32x16 p0,p1;
    qkt(p0,p1,kb0+(unsigned)s*A2_SLOT,qr,negm); asm volatile("s_nop 15\n\ts_nop 7":"+v"(p0),"+v"(p1));
    #pragma unroll
    for(int r=0;r<16;++r){p1[r]+=c32;negm[r]+=sl64;}
    { const int jb=t-(NT-2); if(jb>=0)cmask(p0,p1,jb,qrel,hi); }
    float sacc=0.f;
    #pragma unroll
    for(int r=0;r<16;++r){p0[r]=__builtin_amdgcn_exp2f(p0[r]);p1[r]=__builtin_amdgcn_exp2f(p1[r]);sacc+=p0[r]+p1[r];}
    l_reg+=sacc;
    u32x4 pw0,pw1,pw2,pw3;
    #define PKW(P,B) cvtpk_s(P[B],P[B+1])
    pw0=(u32x4){PKW(p0,0),PKW(p0,2),PKW(p0,4),PKW(p0,6)};pw1=(u32x4){PKW(p0,8),PKW(p0,10),PKW(p0,12),PKW(p0,14)};
    pw2=(u32x4){PKW(p1,0),PKW(p1,2),PKW(p1,4),PKW(p1,6)};pw3=(u32x4){PKW(p1,8),PKW(p1,10),PKW(p1,12),PKW(p1,14)};
    #undef PKW
    if(t+2<NT)asm volatile("s_waitcnt vmcnt(4) lgkmcnt(0)\n\ts_barrier":::"memory"); else asm volatile("s_waitcnt vmcnt(0) lgkmcnt(0)\n\ts_barrier":::"memory");
    if(t+3<NT)A2_DMA(t+3,(t+3)&3);
    SBAR();
    pv4(o,vb0+s*A2_SLOT,__builtin_bit_cast(bf16x8,pw0),__builtin_bit_cast(bf16x8,pw1),__builtin_bit_cast(bf16x8,pw2),__builtin_bit_cast(bf16x8,pw3));
    asm volatile("s_waitcnt lgkmcnt(0)\n\ts_barrier":::"memory");
  }
  if(grp==0)asm volatile("s_barrier":::"memory");
  asm volatile("s_waitcnt vmcnt(0)":::"memory");
  #undef A2_DMA
  {auto rr=__builtin_amdgcn_permlane32_swap(__float_as_uint(l_reg),__float_as_uint(l_reg),false,false);l_reg=__uint_as_float(rr[0])+__uint_as_float(rr[1]);}
  float*wsf=(float*)(shm+A2_WS)+wid*64;
  if(hi==0)wsf[r32]=l_reg; asm volatile("s_waitcnt lgkmcnt(0)":::"memory");
  float rli[16];
  #pragma unroll
  for(int r=0;r<16;++r)rli[r]=__builtin_amdgcn_rcpf(wsf[crow(r,hi)]);
  float*X=(float*)shm+qblk*4096;
  if(c==1){
    #pragma unroll
    for(int d0=0;d0<4;++d0)
      #pragma unroll
      for(int r=0;r<16;++r)X[(d0*16+r)*64+lane]=o[d0][r]*rli[r];
  }
  asm volatile("s_waitcnt lgkmcnt(0)\n\ts_barrier":::"memory");
  if(c==0){
    bf16_t*stg=(bf16_t*)(shm+A2_STG)+qblk*4096;
    #pragma unroll
    for(int d0=0;d0<4;++d0)
      #pragma unroll
      for(int r=0;r<16;++r){ const float v=o[d0][r]*rli[r]-lam*X[(d0*16+r)*64+lane]; stg[crow(r,hi)*128+d0*32+r32]=(bf16_t)(__builtin_bit_cast(unsigned short,__float2bfloat16(v))); }
    asm volatile("s_waitcnt lgkmcnt(0)":::"memory");
    const int row=lane>>1,half=lane&1; const bf16_t*sp=stg+row*128+half*64;
    float d[64]; float ss=0.f;
    #pragma unroll
    for(int i=0;i<8;++i){ const u32x4 w=*(const u32x4*)(sp+8*i);
      d[8*i+0]=__uint_as_float(w.x<<16);d[8*i+1]=__uint_as_float(w.x&0xffff0000u);d[8*i+2]=__uint_as_float(w.y<<16);d[8*i+3]=__uint_as_float(w.y&0xffff0000u);
      d[8*i+4]=__uint_as_float(w.z<<16);d[8*i+5]=__uint_as_float(w.z&0xffff0000u);d[8*i+6]=__uint_as_float(w.w<<16);d[8*i+7]=__uint_as_float(w.w&0xffff0000u); }
    #pragma unroll
    for(int i=0;i<64;++i)ss+=d[i]*d[i];
    ss+=__shfl_xor(ss,1);
    const float rs=rsqrtf(ss*(1.f/128.f)+1e-6f)*0.8f;
    bf16_t*mp=MIX+(rowbase+q0+qblk*32+row)*1024+512+h*128+half*64; const float*gp=dg+half*64;
    #pragma unroll
    for(int i=0;i<8;++i){ u32x4 w;
      w.x=cvtpk_s(d[8*i+0]*rs*gp[8*i+0],d[8*i+1]*rs*gp[8*i+1]); w.y=cvtpk_s(d[8*i+2]*rs*gp[8*i+2],d[8*i+3]*rs*gp[8*i+3]);
      w.z=cvtpk_s(d[8*i+4]*rs*gp[8*i+4],d[8*i+5]*rs*gp[8*i+5]); w.w=cvtpk_s(d[8*i+6]*rs*gp[8*i+6],d[8*i+7]*rs*gp[8*i+7]);
      *(u32x4*)(mp+8*i)=w; }
  }
  asm volatile("s_waitcnt lgkmcnt(0)\n\ts_barrier":::"memory");
}
constexpr int ATTN_LDS_BYTES=LDS_BYTES;
#undef SBAR
#undef WAIT_BAR
}

__device__ __forceinline__ unsigned wave_umax(unsigned x) {
    x = max(x, (unsigned)__builtin_amdgcn_update_dpp(0, (int)x, 0x111, 0xf, 0xf, false));
    x = max(x, (unsigned)__builtin_amdgcn_update_dpp(0, (int)x, 0x112, 0xf, 0xf, false));
    x = max(x, (unsigned)__builtin_amdgcn_update_dpp(0, (int)x, 0x114, 0xf, 0xf, false));
    x = max(x, (unsigned)__builtin_amdgcn_update_dpp(0, (int)x, 0x118, 0xf, 0xf, false));
    x = max(x, (unsigned)__builtin_amdgcn_update_dpp(0, (int)x, 0x142, 0xa, 0xf, false));
    x = max(x, (unsigned)__builtin_amdgcn_update_dpp(0, (int)x, 0x143, 0xc, 0xf, false));
    return (unsigned)__builtin_amdgcn_readlane((int)x, 63);
}
__device__ __forceinline__ unsigned sel_key(float v, int idx) { unsigned u = __float_as_uint(v); u = (u & 0x80000000u) ? ~u : (u | 0x80000000u); return (u & 0xffffff00u) | (unsigned)(255 - idx); }

__device__ __forceinline__ void ph_route(const Args& a, unsigned char* lds, const int tid) {
    const int lane = tid & 63, wave = tid >> 6;
    int* hist = (int*)lds;
    const float* LOG = (const float*)(a.ws + WS_LOGITS); const float* rb = a.in[18];
    int* IDX = (int*)(a.ws + WS_IDX); float* GATEV = (float*)(a.ws + WS_GATEV); int* HIST = (int*)(a.ws + WS_HIST);
    unsigned* TOT = (unsigned*)(a.ws + WS_BAR) + 3456;
    const f32x4 rb4 = *((const f32x4*)rb + lane);
    for (int tb = blockIdx.x; tb < 256; tb += gridDim.x) {
        if (tid < 256) hist[tid] = 0;
        __syncthreads();
        f32x4 lgn = *((const f32x4*)(LOG + (size_t)(tb * 128 + wave * 16) * 256) + lane);
        for (int i = 0; i < 16; ++i) {
            const int t = tb * 128 + wave * 16 + i;
            const f32x4 lg = lgn;
            if (i < 15) lgn = *((const f32x4*)(LOG + (size_t)(t + 1) * 256) + lane);
            float s[4], sel[4];
            s[0] = sigm(lg.x); s[1] = sigm(lg.y); s[2] = sigm(lg.z); s[3] = sigm(lg.w);
            sel[0] = s[0] + rb4.x; sel[1] = s[1] + rb4.y; sel[2] = s[2] + rb4.z; sel[3] = s[3] + rb4.w;
            float m1 = fmaxf(sel[0], sel[1]), m2 = fminf(sel[0], sel[1]);
            { const float x = sel[2]; const float n1 = fmaxf(m1, x); m2 = fmaxf(m2, fminf(m1, x)); m1 = n1; }
            { const float x = sel[3]; const float n1 = fmaxf(m1, x); m2 = fmaxf(m2, fminf(m1, x)); m1 = n1; }
#pragma unroll
            for (int off = 1; off < 8; off <<= 1) { const float o1 = __shfl_xor(m1, off), o2 = __shfl_xor(m2, off);
                const float n1 = fmaxf(m1, o1), n2 = fmaxf(fminf(m1, o1), fmaxf(m2, o2)); m1 = n1; m2 = n2; }
            const float gs = m1 + m2; const int grp = lane >> 3; int rank = 0;
#pragma unroll
            for (int g2 = 0; g2 < 8; ++g2) { const float v = __builtin_bit_cast(float, __builtin_amdgcn_readlane(__builtin_bit_cast(int, gs), 8 * g2)); rank += ((v > gs) || (v == gs && g2 < grp)) ? 1 : 0; }
            const bool gsel = rank < 4;
            unsigned key[4];
#pragma unroll
            for (int j = 0; j < 4; ++j) key[j] = gsel ? sel_key(sel[j], 4 * lane + j) : 0u;
            float gsum = 0.f; float myg = 0.f; int myidx = 0;
#pragma unroll
            for (int k = 0; k < 8; ++k) {
                const unsigned best = wave_umax(max(max(key[0], key[1]), max(key[2], key[3])));
                const int bi = 255 - (int)(best & 255u);
                const int owner = bi >> 2, sub = bi & 3;
                float sv = (sub == 0) ? s[0] : (sub == 1) ? s[1] : (sub == 2) ? s[2] : s[3];
                sv = __builtin_bit_cast(float, __builtin_amdgcn_readlane(__builtin_bit_cast(int, sv), owner));
                if (lane == owner) {
#pragma unroll
                    for (int j = 0; j < 4; ++j) if (j == sub) key[j] = 0u;
                }
                gsum += sv;
                if (lane == k) { myg = sv; myidx = bi; }
            }
            if (lane < 8) { IDX[(size_t)t * 8 + lane] = myidx; GATEV[(size_t)t * 8 + lane] = myg / gsum * 2.5f; atomicAdd(&hist[myidx], 1); }
        }
        __syncthreads();
        if (tid < 256) { const int hv = hist[tid]; HIST[tb * 256 + tid] = hv; if (hv) atomicAdd(TOT + tid, (unsigned)hv); }
        __syncthreads();
    }
}

__device__ __forceinline__ void ph_scatter(const Args& a, unsigned char* lds, const int tid) {
    int* tot = (int*)lds; int* cur = tot + 256; int* base = cur + 256; int* tstart = base + 256;
    const int* HIST = (const int*)(a.ws + WS_HIST); const int* IDX = (const int*)(a.ws + WS_IDX); const float* GATEV = (const float*)(a.ws + WS_GATEV);
    int* PSLOT = (int*)(a.ws + WS_PSLOT); int* SLOTTOK = (int*)(a.ws + WS_SLOTTOK); float* SLOTGATE = (float*)(a.ws + WS_SLOTGATE);
    int* TILE = (int*)(a.ws + WS_TILE);
    unsigned* TOT = (unsigned*)(a.ws + WS_BAR) + 3456; unsigned* CUR = TOT + 256;
    for (int tb = blockIdx.x; tb < 256; tb += gridDim.x) {
        __syncthreads();
        if (tid < 256) tot[tid] = (int)__hip_atomic_load(TOT + tid, __ATOMIC_RELAXED, __HIP_MEMORY_SCOPE_AGENT);
        __syncthreads();
        if (tid < 256) { int bs = 0, ts = 0; for (int j = 0; j < tid; ++j) { const int c = tot[j]; bs += c; ts += (c + 255) >> 8; } base[tid] = bs; tstart[tid] = ts;
            const int mine = HIST[tb * 256 + tid]; cur[tid] = bs + (mine ? (int)atomicAdd(CUR + tid, (unsigned)mine) : 0); }
        __syncthreads();
        for (int p = tid; p < 1024; p += 512) { const int t = tb * 128 + (p >> 3), k = p & 7; const int e = IDX[(size_t)t * 8 + k];
            const int slot = atomicAdd(&cur[e], 1); SLOTTOK[slot] = t; SLOTGATE[slot] = GATEV[(size_t)t * 8 + k]; PSLOT[(size_t)t * 8 + k] = slot; }
        if (tb == 0) {
            if (tid < 256) { const int cnt = tot[tid], b0 = base[tid]; int n = tstart[tid];
                for (int r0 = 0; r0 < cnt; r0 += 256) { TILE[64 + n] = tid; TILE[64 + 2048 + n] = b0 + r0; TILE[64 + 4096 + n] = b0 + cnt; ++n; }
                if (tid == 255) TILE[0] = n; }
            __syncthreads();
            if (tid < 128) { const int n = tstart[255] + ((tot[255] + 255) >> 8);
                TILE[64 + n + tid] = 256; TILE[64 + 2048 + n + tid] = SHARED_BASE + 256 * tid; TILE[64 + 4096 + n + tid] = SHARED_BASE + T; }
        }
    }
}

template <int MODE>
__device__ __forceinline__ void ph_final(const Args& a, const int tid) {
    const int lane = tid & 63, wave = tid >> 6;
    const unsigned char* YP = (const unsigned char*)(a.ws + WS_YP); const int* PSLOT = (const int*)(a.ws + WS_PSLOT); const float* MOD = (const float*)(a.ws + WS_MOD);
    float* out = a.out;
    const int gw = blockIdx.x * 8 + wave, NGW = gridDim.x * 8;
    const int sub = lane & 15, rsel = lane >> 4;
    int nslot = 0;
    { const int r0 = gw + (rsel == 1 ? NGW : 0); if (rsel < 2 && sub < 9 && r0 < T) nslot = sub < 8 ? PSLOT[(size_t)r0 * 8 + sub] : SHARED_BASE + r0; }
    for (int row = gw; row < T; row += 2 * NGW) {
        const int myslot = nslot;
        { const int r1 = row + 2 * NGW + (rsel == 1 ? NGW : 0); if (rsel < 2 && sub < 9 && r1 < T) nslot = sub < 8 ? PSLOT[(size_t)r1 * 8 + sub] : SHARED_BASE + r1; }
#pragma unroll
        for (int half = 0; half < 2; ++half) {
            const int rw = row + half * NGW;
            if (rw < T) {
                const int b = rw / SEQ;
                float* o0 = out + (size_t)rw * DM + 8 * lane; float* o1 = o0 + 512;
                const bf16_t* xr = (const bf16_t*)(a.ws + WS_X1B) + (size_t)rw * DM + 8 * lane;
                const u32x4 xw0 = __builtin_nontemporal_load((const u32x4*)xr), xw1 = __builtin_nontemporal_load((const u32x4*)(xr + 512));
                const f32x4 xa = {bflo(xw0.x), bfhi(xw0.x), bflo(xw0.y), bfhi(xw0.y)}, xb = {bflo(xw0.z), bfhi(xw0.z), bflo(xw0.w), bfhi(xw0.w)}, xc = {bflo(xw1.x), bfhi(xw1.x), bflo(xw1.y), bfhi(xw1.y)}, xd = {bflo(xw1.z), bfhi(xw1.z), bflo(xw1.w), bfhi(xw1.w)};
                float acc[16];
#pragma unroll
                for (int i = 0; i < 16; ++i) acc[i] = 0.f;
                u32x2 w0[9], w1[9];
#pragma unroll
                for (int k = 0; k < 9; ++k) { const int slot = __shfl(myslot, 16 * half + k); const unsigned char* yp = YP + (size_t)slot * DM; w0[k] = __builtin_nontemporal_load((const u32x2*)(yp + 8 * lane)); w1[k] = __builtin_nontemporal_load((const u32x2*)(yp + 512 + 8 * lane)); }
#pragma unroll
                for (int k = 0; k < 9; ++k) {
                    { const auto a0 = __builtin_amdgcn_cvt_pk_f32_fp8((int)w0[k].x, false), a1 = __builtin_amdgcn_cvt_pk_f32_fp8((int)w0[k].x, true), a2 = __builtin_amdgcn_cvt_pk_f32_fp8((int)w0[k].y, false), a3 = __builtin_amdgcn_cvt_pk_f32_fp8((int)w0[k].y, true);
                      acc[0] += a0[0]; acc[1] += a0[1]; acc[2] += a1[0]; acc[3] += a1[1]; acc[4] += a2[0]; acc[5] += a2[1]; acc[6] += a3[0]; acc[7] += a3[1]; }
                    { const auto a0 = __builtin_amdgcn_cvt_pk_f32_fp8((int)w1[k].x, false), a1 = __builtin_amdgcn_cvt_pk_f32_fp8((int)w1[k].x, true), a2 = __builtin_amdgcn_cvt_pk_f32_fp8((int)w1[k].y, false), a3 = __builtin_amdgcn_cvt_pk_f32_fp8((int)w1[k].y, true);
                      acc[8] += a0[0]; acc[9] += a0[1]; acc[10] += a1[0]; acc[11] += a1[1]; acc[12] += a2[0]; acc[13] += a2[1]; acc[14] += a3[0]; acc[15] += a3[1]; } }
                const float* gf = MOD + b * 6144 + 5 * 1024 + 8 * lane;
                const f32x4 g0 = *(const f32x4*)gf * (1.f / 16.f), g1 = *(const f32x4*)(gf + 4) * (1.f / 16.f), g2 = *(const f32x4*)(gf + 512) * (1.f / 16.f), g3 = *(const f32x4*)(gf + 516) * (1.f / 16.f);
                f32x4 ya = xa, yb = xb, yc = xc, yd = xd;
                ya.x += g0.x * acc[0]; ya.y += g0.y * acc[1]; ya.z += g0.z * acc[2]; ya.w += g0.w * acc[3];
                yb.x += g1.x * acc[4]; yb.y += g1.y * acc[5]; yb.z += g1.z * acc[6]; yb.w += g1.w * acc[7];
                yc.x += g2.x * acc[8]; yc.y += g2.y * acc[9]; yc.z += g2.z * acc[10]; yc.w += g2.w * acc[11];
                yd.x += g3.x * acc[12]; yd.y += g3.y * acc[13]; yd.z += g3.z * acc[14]; yd.w += g3.w * acc[15];
                if (MODE == 0) { __builtin_nontemporal_store(ya, (f32x4*)o0); __builtin_nontemporal_store(yb, (f32x4*)(o0 + 4)); __builtin_nontemporal_store(yc, (f32x4*)o1); __builtin_nontemporal_store(yd, (f32x4*)(o1 + 4)); }
                else asm volatile("" :: "v"(ya), "v"(yb), "v"(yc), "v"(yd));
            }
        }
    }
}

#define LAS __attribute__((address_space(3)))
#define XB_TMO      128
#define XB_XCNT(j)  (256  + 64 * (j))
#define XB_XSUB(j)  (1280 + 64 * (j))
#define XB_XGEN(j)  (2304 + 64 * (j))
#define XB_TOP      3328
#define XB_TOPGEN   3392
#define XB_SPIN_CAP (1u << 27)
__device__ __forceinline__ unsigned xb_ld(unsigned* p)              { return __hip_atomic_load(p, __ATOMIC_RELAXED, __HIP_MEMORY_SCOPE_AGENT); }
__device__ __forceinline__ unsigned xb_add(unsigned* p, unsigned v) { return __hip_atomic_fetch_add(p, v, __ATOMIC_RELAXED, __HIP_MEMORY_SCOPE_AGENT); }
__device__ __forceinline__ unsigned xb_xcc_id() { return (unsigned)__builtin_amdgcn_s_getreg((3 << 11) | 20) & 0xFu; }
#define XB_SPIN(cond, bar) do { unsigned _sp = 0; while (cond) { __builtin_amdgcn_s_sleep(1); \
    if ((++_sp & 255u) == 0u) { if (xb_ld(&(bar)[XB_TMO])) break; if (_sp > XB_SPIN_CAP) { atomicAdd(&(bar)[XB_TMO], 1u); break; } } } } while (0)
struct XcdBarrier { unsigned* bar; unsigned x; volatile LAS unsigned* st; };
__device__ __forceinline__ XcdBarrier xcd_barrier_post(unsigned* bar, volatile LAS unsigned* st, const bool t0) {
    XcdBarrier b; b.bar = bar; b.x = xb_xcc_id(); b.st = st;
    if (t0) (void)xb_add(&bar[XB_XCNT(b.x)], 1u);
    return b;
}
__device__ __forceinline__ void xcd_barrier_complete(unsigned* bar, unsigned x, unsigned& nloc, unsigned& nx) {
    const unsigned G = gridDim.x * gridDim.y * gridDim.z;
    unsigned sum, cnt, mine, sp = 0u;
    for (;;) {
        sum = 0u; cnt = 0u; mine = 0u;
#pragma unroll
        for (unsigned j = 0; j < 16; ++j) { const unsigned c = xb_ld(&bar[XB_XCNT(j)]); sum += c; cnt += (c > 0u) ? 1u : 0u; mine = (j == x) ? c : mine; }
        if (sum == G) break;
        __builtin_amdgcn_s_sleep(1);
        if ((++sp & 255u) == 0u) { if (xb_ld(&bar[XB_TMO])) break; if (sp > XB_SPIN_CAP) { atomicAdd(&bar[XB_TMO], 1u); break; } }
    }
    nloc = mine > 0u ? mine : 1u; nx = cnt > 0u ? cnt : 1u;
}
__device__ __forceinline__ void xcd_barrier(const XcdBarrier& b, const bool t0) {
    asm volatile("s_waitcnt vmcnt(0)" ::: "memory");
    __syncthreads();
    if (t0) {
        unsigned* bar = b.bar;
        __builtin_amdgcn_s_waitcnt(0);
        unsigned nloc = b.st[0], nx = b.st[1];
        if (nloc == 0u) { xcd_barrier_complete(bar, b.x, nloc, nx); b.st[0] = nloc; b.st[1] = nx; }
        const unsigned old = xb_add(&bar[XB_XSUB(b.x)], 1u);
        const unsigned gen = old / nloc;
        if (old + 1u == (gen + 1u) * nloc) {
            __builtin_amdgcn_fence(__ATOMIC_RELEASE, "agent");
            asm volatile("s_waitcnt vmcnt(0)" ::: "memory");
            const unsigned og = xb_add(&bar[XB_TOP], 1u);
            const unsigned tg = og / nx;
            if (og + 1u == (tg + 1u) * nx) xb_add(&bar[XB_TOPGEN], 1u);
            else XB_SPIN(xb_ld(&bar[XB_TOPGEN]) == tg, bar);
            __builtin_amdgcn_fence(__ATOMIC_ACQUIRE, "agent");
            xb_add(&bar[XB_XGEN(b.x)], 1u);
            asm volatile("s_waitcnt vmcnt(0)" ::: "memory");
        } else {
            XB_SPIN(xb_ld(&bar[XB_XGEN(b.x)]) == gen, bar);
            __builtin_amdgcn_fence(__ATOMIC_ACQUIRE, "agent");
            asm volatile("s_waitcnt vmcnt(0)" ::: "memory");
        }
    }
    __syncthreads();
}


__global__ void __launch_bounds__(512) mega(Args a) {
    extern __shared__ __attribute__((aligned(16))) unsigned char lds[];
    const int lo = a.ph_lo, hi = a.ph_hi;
    const int wave_s = __builtin_amdgcn_readfirstlane((int)threadIdx.x >> 6);
#define tid mk_tid(wave_s)
    volatile LAS unsigned* bst = (volatile LAS unsigned*)((LAS unsigned char*)lds + (LDS_BYTES - 64));
    if (tid < 16) bst[tid] = 0u;
    __syncthreads();
    XcdBarrier bar = xcd_barrier_post((unsigned*)(a.ws + WS_BAR), bst, tid == 0);
#define IN(k) (lo <= (k) && (k) < hi)
#define SEAM(k) do { if (IN(k) && IN((k) + 1)) xcd_barrier(bar, tid == 0); } while (0)

    if (IN(0)) { ph0(a, lds, tid); } SEAM(0);
    if (IN(1)) { ph_norm<true>(a, lds, a.in[0], 0, 1, tid); } SEAM(1);
    if (IN(2)) {
        float* gtab = (float*)(lds + 135168);
        { const int t_ = tid; if (t_ < 64) gtab[t_] = a.in[9][t_] * C2; else if (t_ < 128) gtab[t_] = a.in[10][t_ - 64]; }
        const EpiProj E{(bf16_t*)(a.ws + WS_PROJ), gtab};
        { pg8::DenseSched S; S.init(a.ws + WS_H8, a.ws + WS_WIN, T, NPROJ, DM, (int)gridDim.x, (int)blockIdx.x); __syncthreads();
          pg8::gemm_phase<false, true, 0x79797979, 0x7f7f7f7f, 2>((PG8_LAS unsigned char*)lds, DM, S, E); }
    } SEAM(2);
    if (IN(3)) { for (int u = blockIdx.x; u < 1024; u += gridDim.x) mlstm_m1_unit(a, lds, u, wave_s);
 } SEAM(3);
    if (IN(4)) { mlstm_m2(a, tid); } SEAM(4);
    if (IN(5)) {
        { float lam; { float s1 = 0.f, s2 = 0.f; const float* q1 = a.in[11]; const float* k1 = a.in[12]; const float* q2 = a.in[13]; const float* k2 = a.in[14];
              for (int i = 0; i < 64; ++i) { s1 += q1[i] * k1[i]; s2 += q2[i] * k2[i]; } lam = expf(s1) - expf(s2) + LAM_INIT; }
          float m0; { float gq = 0.f, gk = 0.f; for (int i = 0; i < 64; ++i) { gq = fmaxf(gq, fabsf(a.in[9][i])); gk = fmaxf(gk, fabsf(a.in[10][i])); } m0 = 64.f * C2 * gq * gk * 1.01f + 0.01f; }
          unsigned* qhead = (unsigned*)(a.ws + WS_BAR) + 4001;
          for (;;) {
              __syncthreads();
              if (tid == 0) bst[8] = atomicAdd(qhead, 1u);
              __syncthreads();
              const int idx = (int)bst[8];
              if (idx >= 1024) break;
              const int qb = 63 - (idx >> 4), j = idx & 15, bh = (j & 3) * 4 + (3 - (j >> 2));
              attn_body::attn2_unit((const attn_body::bf16*)(a.ws + WS_PROJ), a.in[15], (bf16_t*)(a.ws + WS_MIX), (char*)lds, bh, qb, lam, m0);
          }
          __syncthreads();
          for (int u = (int)blockIdx.x; u < 1024; u += (int)gridDim.x) mlstm_m3_unit<0>(a, lds, u, wave_s);
          __syncthreads(); }
    } SEAM(5);
    if (IN(6)) {
        const EpiOut E{a.in[0], (bf16_t*)(a.ws + WS_X1B), (const float*)(a.ws + WS_MOD)};
        { pg8::DenseSched S; S.init(a.ws + WS_MIX, a.ws + WS_WOUT, T, DM, 2 * DM, (int)gridDim.x, (int)blockIdx.x); __syncthreads();
          pg8::gemm_phase<false, false, 0, 0, 0>((PG8_LAS unsigned char*)lds, 2 * DM, S, E); }
    } SEAM(6);
    if (IN(7)) { ph_norm<false>(a, lds, a.out, 3, 4, tid); } SEAM(7);
    if (IN(8)) {
        const EpiRS E{(float*)(a.ws + WS_LOGITS), (bf16_t*)(a.ws + WS_ACT)};
        { pg8::DenseSched S; S.init(a.ws + WS_H, a.ws + WS_WRS, T, 768, 2 * DM, (int)gridDim.x, (int)blockIdx.x); __syncthreads();
          pg8::gemm_phase<false, false, 0, 0, 0>((PG8_LAS unsigned char*)lds, 2 * DM, S, E); }
    } SEAM(8);
    if (IN(9)) { ph_route(a, lds, tid); } SEAM(9);
    if (IN(10)) { ph_scatter(a, lds, tid); } SEAM(10);
    if (IN(11)) {
        const int* TILE = (const int*)(a.ws + WS_TILE); const int ntile = TILE[0];
        const EpiG1 E{(const float*)(a.ws + WS_SLOTGATE), (bf16_t*)(a.ws + WS_ACT)};
        { const int G = (int)gridDim.x, bx = (int)blockIdx.x, vcu = (G % 8 == 0) ? (bx % 8) * (G / 8) + bx / 8 : bx;
          const pg8::ExpertSched S{TILE, ntile * 2, 2, (const char*)(a.ws + WS_H8), (const int*)(a.ws + WS_SLOTTOK), (const char*)(a.ws + WS_W13T), (size_t)512 * 1024, DM, G, vcu};
          __syncthreads(); pg8::gemm_phase<true, true, 0x79797979, 0x7f7f7f7f, 0>((PG8_LAS unsigned char*)lds, DM, S, E); }
    } SEAM(11);
    if (IN(12)) {
        const int* TILE = (const int*)(a.ws + WS_TILE); const int ntile = TILE[0] + 128;
        const EpiG2 E{(bf16_t*)(a.ws + WS_YP)};
        { const int G = (int)gridDim.x, bx = (int)blockIdx.x, vcu = (G % 8 == 0) ? (bx % 8) * (G / 8) + bx / 8 : bx;
          const pg8::ExpertSched S{TILE, ntile * 4, 4, (const char*)(a.ws + WS_ACT), nullptr, (const char*)(a.ws + WS_W2T), (size_t)1024 * 256, 256, G, vcu};
          __syncthreads(); pg8::gemm_phase<false, true, 0x7a7a7a7a, 0x7c7c7c7c, 1>((PG8_LAS unsigned char*)lds, 256, S, E); }
    } SEAM(12);
    if (IN(13)) {
        ph_final<0>(a, tid); }
#undef IN
#undef SEAM
#undef tid
}

extern "C" void kernel_launch(void* const* d_in, const int* in_sizes, int n_in, void* d_out, int out_size, void* d_ws, size_t ws_size, hipStream_t stream) {
    static int grid = 0;
    if (grid == 0) {
        if (n_in != 25 || in_sizes[0] != T * DM || out_size != T * DM || ws_size < WS_END) {
            fprintf(stderr, "kernel_launch: unexpected problem (n_in %d, in0 %d, out %d, ws %zu < %zu)\n", n_in, n_in > 0 ? in_sizes[0] : -1, out_size, ws_size, (size_t)WS_END); grid = -1; return; }
        int dev = 0, cus = 0, per_cu = 0;
        (void)hipGetDevice(&dev);
        (void)hipDeviceGetAttribute(&cus, hipDeviceAttributeMultiprocessorCount, dev);
        if (hipFuncSetAttribute((const void*)mega, hipFuncAttributeMaxDynamicSharedMemorySize, LDS_BYTES) != hipSuccess) { fprintf(stderr, "kernel_launch: hipFuncSetAttribute failed\n"); grid = -1; return; }
        if (hipOccupancyMaxActiveBlocksPerMultiprocessor(&per_cu, (const void*)mega, 512, LDS_BYTES) != hipSuccess || per_cu < 1) { fprintf(stderr, "kernel_launch: occupancy query says %d blocks/CU\n", per_cu); grid = -1; return; }
        grid = cus;
    }
    if (grid < 0) return;
    (void)hipMemsetAsync((char*)d_ws + WS_BAR, 0, BAR_BYTES, stream);
    Args a{};
    for (int i = 0; i < 25; ++i) a.in[i] = (const float*)d_in[i];
    a.out = (float*)d_out; a.ws = (unsigned char*)d_ws;
    a.ph_lo = 0; a.ph_hi = NPH;
    void* args[] = {&a};
    hipError_t e = hipLaunchCooperativeKernel((const void*)mega, dim3(grid), dim3(512), args, LDS_BYTES, stream);
    if (e != hipSuccess) fprintf(stderr, "cooperative launch failed: %s (grid %d)\n", hipGetErrorString(e), grid);
}
```

```cpp
#include <hip/hip_runtime.h>
#include <cstdio>
#include <cstdint>

typedef unsigned short bf16_t;
typedef short bf16x8 __attribute__((ext_vector_type(8)));
typedef float f32x4 __attribute__((ext_vector_type(4)));
typedef unsigned u32x4 __attribute__((ext_vector_type(4)));
typedef unsigned u32x2 __attribute__((ext_vector_type(2)));


constexpr int T = 32768, DM = 1024, SEQ = 8192;
constexpr int NPROJ = 3584, DIN = 3592;
constexpr int TOPK = 8, TK = T * TOPK;
constexpr int SHARED_BASE = TK;
constexpr float EPS = 1e-6f;
constexpr float LOG2E = 1.4426950408889634f;
constexpr float C2 = 0.125f * LOG2E;
constexpr float LAM_INIT = 0.2f;
constexpr int NPH = 14;
constexpr int LDS_BYTES = 155648;

constexpr size_t MiB = 1ull << 20;
constexpr size_t WS_MOD = 0;
constexpr size_t WS_TILE = 128 * 1024;
constexpr size_t WS_HIST = 256 * 1024;
constexpr size_t WS_BAR = 512 * 1024;
constexpr size_t BAR_BYTES = 16384;
constexpr size_t WS_IPRE = 1 * MiB, WS_FPRE = 1 * MiB + 512 * 1024;
constexpr size_t WS_IDX = 2 * MiB, WS_GATEV = 3 * MiB, WS_PSLOT = 4 * MiB, WS_SLOTTOK = 5 * MiB, WS_SLOTGATE = 7 * MiB;
constexpr size_t WS_MST = 9 * MiB;
constexpr size_t WS_WIN = 12 * MiB, WS_WOUT = 19 * MiB, WS_WRS = 21 * MiB, WS_W2T = 23 * MiB;
constexpr size_t WS_H = 152 * MiB, WS_ACT = 216 * MiB, WS_MIX = 361 * MiB, WS_PROJ = 425 * MiB, WS_CLOC = 649 * MiB, WS_CIN = 713 * MiB, WS_W13T = 745 * MiB, WS_END = 1001 * MiB;
constexpr size_t WS_H8 = 89 * MiB;
constexpr size_t WS_YP = WS_MIX;
constexpr size_t WS_LOGITS = WS_CLOC;
constexpr size_t WS_X1B = 681 * MiB;
constexpr size_t WS_TMP = WS_ACT;

struct Args { const float* in[25]; float* out; unsigned char* ws; int ph_lo, ph_hi; };

__device__ __forceinline__ int mk_tid(int wave_s) { int l; asm volatile("v_mbcnt_lo_u32_b32 %0, -1, 0\n\tv_mbcnt_hi_u32_b32 %0, -1, %0" : "=v"(l)); return (wave_s << 6) | l; }

__device__ __forceinline__ float bflo(unsigned v) { return __uint_as_float(v << 16); }
__device__ __forceinline__ float bfhi(unsigned v) { return __uint_as_float(v & 0xffff0000u); }
__device__ __forceinline__ unsigned f2bf(float f) { unsigned u = __float_as_uint(f); return (u + 0x7fffu + ((u >> 16) & 1u)) >> 16; }
__device__ __forceinline__ unsigned pk2(float lo, float hi) { return f2bf(lo) | (f2bf(hi) << 16); }
__device__ __forceinline__ float wave_sum(float v) {
    v += __builtin_bit_cast(float, __builtin_amdgcn_update_dpp(0, __builtin_bit_cast(int, v), 0x111, 0xf, 0xf, false));
    v += __builtin_bit_cast(float, __builtin_amdgcn_update_dpp(0, __builtin_bit_cast(int, v), 0x112, 0xf, 0xf, false));
    v += __builtin_bit_cast(float, __builtin_amdgcn_update_dpp(0, __builtin_bit_cast(int, v), 0x114, 0xf, 0xf, false));
    v += __builtin_bit_cast(float, __builtin_amdgcn_update_dpp(0, __builtin_bit_cast(int, v), 0x118, 0xf, 0xf, false));
    v += __builtin_bit_cast(float, __builtin_amdgcn_update_dpp(0, __builtin_bit_cast(int, v), 0x142, 0xa, 0xf, false));
    v += __builtin_bit_cast(float, __builtin_amdgcn_update_dpp(0, __builtin_bit_cast(int, v), 0x143, 0xc, 0xf, false));
    return __builtin_bit_cast(float, __builtin_amdgcn_readlane(__builtin_bit_cast(int, v), 63));
}
__device__ __forceinline__ float siluf(float x) { return x / (1.f + __expf(-x)); }
__device__ __forceinline__ float sigm(float x) { return 1.f / (1.f + __expf(-x)); }
__device__ __forceinline__ void unpack8(const u32x4 v, float (&x)[8]) {
    x[0] = bflo(v.x); x[1] = bfhi(v.x); x[2] = bflo(v.y); x[3] = bfhi(v.y); x[4] = bflo(v.z); x[5] = bfhi(v.z); x[6] = bflo(v.w); x[7] = bfhi(v.w);
}
__device__ __forceinline__ unsigned pk4_fp8(float a, float b, float c, float d) { int p = __builtin_amdgcn_cvt_pk_fp8_f32(a, b, 0, false); p = __builtin_amdgcn_cvt_pk_fp8_f32(c, d, p, true); return (unsigned)p; }
__device__ __forceinline__ u32x4 pack8(const float (&x)[8]) { u32x4 o; o.x = pk2(x[0], x[1]); o.y = pk2(x[2], x[3]); o.z = pk2(x[4], x[5]); o.w = pk2(x[6], x[7]); return o; }

__device__ __forceinline__ void conv_item(const float* __restrict__ s0, const float* __restrict__ s1, int ldn, int k0, int n0, bool inter,
                                          bf16_t* dst, int ldk, int c0, float* scr, int lane) {
    const float* p = (inter && lane >= 32) ? (s1 + n0 + (lane - 32)) : (s0 + n0 + lane);
    p += (size_t)k0 * ldn;
#pragma unroll 8
    for (int i = 0; i < 64; ++i) scr[i * 65 + lane] = __builtin_nontemporal_load(p + (size_t)i * ldn);
    const int c = lane & 7;
#pragma unroll
    for (int j = 0; j < 8; ++j) {
        const int n = (lane >> 3) + 8 * j;
        const float* s = scr + (8 * c) * 65 + n;
        u32x4 o; o.x = pk2(s[0], s[65]); o.y = pk2(s[130], s[195]); o.z = pk2(s[260], s[325]); o.w = pk2(s[390], s[455]);
        const int drow = inter ? (c0 + ((n & 31) >> 2) * 8 + (n >> 5) * 4 + (n & 3)) : (c0 + n);
        __builtin_nontemporal_store(o, (u32x4*)(dst + (size_t)drow * ldk + k0 + 8 * c));
    }
}


__device__ __forceinline__ void conv_item8(const float* __restrict__ s0, const float* __restrict__ s1, int ldn, int k0, int n0, bool inter,
                                           unsigned char* dst, int ldk, int c0, float* scr, int lane, float scale) {
    const float* p = (inter && lane >= 32) ? (s1 + n0 + (lane - 32)) : (s0 + n0 + lane);
    p += (size_t)k0 * ldn;
#pragma unroll 8
    for (int i = 0; i < 64; ++i) scr[i * 65 + lane] = __builtin_nontemporal_load(p + (size_t)i * ldn) * scale;
    const int c = lane & 7;
#pragma unroll
    for (int j = 0; j < 8; ++j) {
        const int n = (lane >> 3) + 8 * j;
        const float* s = scr + (8 * c) * 65 + n;
        u32x2 o; o.x = pk4_fp8(s[0], s[65], s[130], s[195]); o.y = pk4_fp8(s[260], s[325], s[390], s[455]);
        const int drow = inter ? (c0 + ((n & 31) >> 2) * 8 + (n >> 5) * 4 + (n & 3)) : (c0 + n);
        __builtin_nontemporal_store(o, (u32x2*)(dst + (size_t)drow * ldk + k0 + 8 * c));
    }
}

__device__ __forceinline__ void ph0(const Args& a, unsigned char* lds, const int tid) {
    const int lane = tid & 63, wave = tid >> 6;
    const float* c_in = a.in[1]; const float* w_ada = a.in[2]; const float* b_ada = a.in[3];
    float* MOD = (float*)(a.ws + WS_MOD);
    {
        float* sc = (float*)lds; float* red = sc + 4096;
        for (int i = tid; i < 4096; i += 512) sc[i] = siluf(c_in[i]);
        __syncthreads();
        for (int it = blockIdx.x; it < 192; it += gridDim.x) {
            const int cc = tid & 31, ks = tid >> 5, col = it * 32 + cc;
            float a0 = 0.f, a1 = 0.f, a2 = 0.f, a3 = 0.f;
            const float* wp = w_ada + (size_t)(ks * 64) * 6144 + col;
            float wv[64];
#pragma unroll
            for (int k = 0; k < 64; ++k) wv[k] = __builtin_nontemporal_load(wp + (size_t)k * 6144);
#pragma unroll
            for (int k = 0; k < 64; ++k) { const float w = wv[k]; const int kk = ks * 64 + k;
                a0 += sc[kk] * w; a1 += sc[1024 + kk] * w; a2 += sc[2048 + kk] * w; a3 += sc[3072 + kk] * w; }
            float* rp = red + (ks * 32 + cc) * 4; rp[0] = a0; rp[1] = a1; rp[2] = a2; rp[3] = a3;
            __syncthreads();
            if (tid < 128) { const int c2 = tid & 31, b = tid >> 5; float s = 0.f;
                for (int k2 = 0; k2 < 16; ++k2) s += red[(k2 * 32 + c2) * 4 + b];
                MOD[b * 6144 + it * 32 + c2] = s + b_ada[it * 32 + c2]; }
            __syncthreads();
        }
    }
    __syncthreads();
    float* scr = (float*)lds + wave * (64 * 65);
    const int gw = blockIdx.x * 8 + wave, NGW = gridDim.x * 8;
    const float* w_in = a.in[4]; const float* w_out = a.in[16]; const float* w_router = a.in[17];
    const float* ws1 = a.in[22]; const float* ws3 = a.in[23]; const float* ws2 = a.in[24];
    bf16_t* WIN = (bf16_t*)(a.ws + WS_WIN); bf16_t* WOUT = (bf16_t*)(a.ws + WS_WOUT); bf16_t* WRS = (bf16_t*)(a.ws + WS_WRS);
    unsigned char* W2T8 = (unsigned char*)(a.ws + WS_W2T);
    constexpr int IT_WIN = 56 * 16, IT_WOUT = 16 * 16, IT_WR = 4 * 16, IT_WS13 = 8 * 16, IT_WS2 = 4 * 16;
    constexpr int NITEMS = IT_WIN + IT_WOUT + IT_WR + IT_WS13 + IT_WS2;
    for (int it = gw; it < NITEMS; it += NGW) {
        int r = it;
        if (r < IT_WIN) { const int kb = r / 56, cb = r % 56, c0 = 64 * cb, n0 = c0 + (c0 >= 2048 ? 8 : 0);
            conv_item8(w_in, w_in, DIN, 64 * kb, n0, false, (unsigned char*)WIN, 1024, c0, scr, lane, 64.f); continue; } r -= IT_WIN;
        if (r < IT_WOUT) { const int kb = r / 16, cb = r % 16; conv_item(w_out, w_out, 1024, 64 * kb, 64 * cb, false, WOUT, 1024, 64 * cb, scr, lane); continue; } r -= IT_WOUT;
        if (r < IT_WR) { const int kb = r / 4, cb = r % 4; conv_item(w_router, w_router, 256, 64 * kb, 64 * cb, false, WRS, 1024, 64 * cb, scr, lane); continue; } r -= IT_WR;
        if (r < IT_WS13) { const int kb = r / 8, cb = r % 8; conv_item(ws1, ws3, 256, 64 * kb, 32 * cb, true, WRS + (size_t)256 * 1024, 1024, 64 * cb, scr, lane); continue; } r -= IT_WS13;
        { const int kb = r / 16, cb = r % 16; conv_item8(ws2, ws2, 1024, 64 * kb, 64 * cb, false, W2T8 + (size_t)256 * 1024 * 256, 256, 64 * cb, scr, lane, 64.f); }
    }
}

template <bool GATES>
__device__ __forceinline__ void ph_norm(const Args& a, unsigned char* lds, const float* X, int mod_shift, int mod_scale, const int tid) {
    const int lane = tid & 63, wave = tid >> 6;
    const float* MOD = (const float*)(a.ws + WS_MOD);
    bf16_t* H = (bf16_t*)(a.ws + WS_H);
    float* wg = (float*)lds;
    if (GATES) {
        const float* w_in = a.in[4];
        for (int i = tid; i < 8192; i += 512) { const int k = i >> 3, g = i & 7; wg[g * 1024 + k] = w_in[(size_t)k * DIN + 2048 + g]; }
        __syncthreads();
    }
    const float* gate_b = a.in[7];
    float* IPRE = (float*)(a.ws + WS_IPRE); float* FPRE = (float*)(a.ws + WS_FPRE);
    const int gw = blockIdx.x * 8 + wave, NGW = gridDim.x * 8;
    for (int row = gw; row < T; row += NGW) {
        const int b = row / SEQ;
        const f32x4* xr = (const f32x4*)(X + (size_t)row * DM) + lane;
        const u32x2* xb = (const u32x2*)((const bf16_t*)(a.ws + WS_X1B) + (size_t)row * DM) + lane;
        f32x4 v[4]; float ss = 0.f;
#pragma unroll
        for (int j = 0; j < 4; ++j) { if (GATES) v[j] = __builtin_nontemporal_load(xr + 64 * j); else { const u32x2 w = xb[64 * j]; v[j] = (f32x4){bflo(w.x), bfhi(w.x), bflo(w.y), bfhi(w.y)}; } ss += (v[j].x * v[j].x + v[j].y * v[j].y) + (v[j].z * v[j].z + v[j].w * v[j].w); }
        const float rstd = rsqrtf(wave_sum(ss) * (1.f / DM) + EPS);
        const f32x4* sh = (const f32x4*)(MOD + b * 6144 + mod_shift * 1024) + lane;
        const f32x4* sc = (const f32x4*)(MOD + b * 6144 + mod_scale * 1024) + lane;
        u32x2* o8 = (u32x2*)(H + (size_t)row * DM) + lane;
#pragma unroll
        for (int j = 0; j < 4; ++j) { const f32x4 s4 = sc[64 * j], h4 = sh[64 * j];
            v[j].x = v[j].x * rstd * (1.f + s4.x) + h4.x; v[j].y = v[j].y * rstd * (1.f + s4.y) + h4.y;
            v[j].z = v[j].z * rstd * (1.f + s4.z) + h4.z; v[j].w = v[j].w * rstd * (1.f + s4.w) + h4.w;
            if (!GATES) { u32x2 p; p.x = pk2(v[j].x, v[j].y); p.y = pk2(v[j].z, v[j].w); o8[64 * j] = p; }
            *((unsigned*)(a.ws + WS_H8 + (size_t)row * DM) + lane + 64 * j) = pk4_fp8(v[j].x, v[j].y, v[j].z, v[j].w); }
        if (GATES) {
            float g[8];
#pragma unroll
            for (int q = 0; q < 8; ++q) { float s = 0.f;
#pragma unroll
                for (int j = 0; j < 4; ++j) { const f32x4 w4 = *((const f32x4*)(wg + q * 1024) + lane + 64 * j);
                    s += (v[j].x * w4.x + v[j].y * w4.y) + (v[j].z * w4.z + v[j].w * w4.w); }
                g[q] = wave_sum(s); }
            if (lane == 0) {
#pragma unroll
                for (int q = 0; q < 4; ++q) { IPRE[(size_t)row * 4 + q] = g[q] + gate_b[q]; FPRE[(size_t)row * 4 + q] = g[4 + q] + gate_b[4 + q]; }
            }
        }
    }
}


namespace pg8 {
#define PG8_LAS __attribute__((address_space(3)))
typedef int i32x4 __attribute__((ext_vector_type(4)));
typedef int i32x8 __attribute__((ext_vector_type(8)));
constexpr int BM = 256, BK = 64, HALF = 128, HTB = HALF * BK * 2;
__device__ __forceinline__ int lds_byte(int r, int c) { const int st = (r >> 4) * 2 + (c >> 5), rr = r & 15, cc = c & 31, ob = rr * 64 + cc * 2; return st * 1024 + (ob ^ (((ob >> 9) & 1) << 5)); }
__device__ __forceinline__ void stage_rc(int b, int& R, int& C) { const int st = b / 1024, sb = b % 1024, swz = sb ^ (((sb >> 9) & 1) << 5); R = (st >> 1) * 16 + swz / 64; C = (st & 1) * 32 + (swz % 64) / 2; }
__device__ __forceinline__ int perm32(int rho) { const int n = rho >> 4, i = rho & 15; return 8 * (i >> 2) + 4 * n + (i & 3); }
struct Unit { const char* A; const char* B; const int* gather; int row0, rend, col0; };

template <int PM, class RowEpi>
__device__ __forceinline__ void run_epi(const RowEpi& E, const f32x4 (&acc)[2][2][4][2], const Unit& u, int wr, int wc, int fr, int fq) {
#pragma unroll
    for (int ai = 0; ai < 2; ++ai)
#pragma unroll
        for (int m = 0; m < 4; ++m) { const int row = u.row0 + ai * HALF + wr * 64 + m * 16 + fr; const bool valid = row < u.rend;
            if constexpr (PM != 0) { const float v16[16] = {acc[ai][0][m][0][0], acc[ai][0][m][0][1], acc[ai][0][m][0][2], acc[ai][0][m][0][3], acc[ai][0][m][1][0], acc[ai][0][m][1][1], acc[ai][0][m][1][2], acc[ai][0][m][1][3],
                                                 acc[ai][1][m][0][0], acc[ai][1][m][0][1], acc[ai][1][m][0][2], acc[ai][1][m][0][3], acc[ai][1][m][1][0], acc[ai][1][m][1][1], acc[ai][1][m][1][2], acc[ai][1][m][1][3]};
                if constexpr (PM == 1) E.row16(row, valid, u.col0 + 64 * wc + 16 * fq, v16); else E.rowg(row, valid, u.col0 + 64 * wc + 8 * fq, v16); } else
#pragma unroll
            for (int bj = 0; bj < 2; ++bj) { const int col0 = u.col0 + bj * HALF + wc * 32 + 8 * fq;
                const float v[8] = {acc[ai][bj][m][0][0], acc[ai][bj][m][0][1], acc[ai][bj][m][0][2], acc[ai][bj][m][0][3], acc[ai][bj][m][1][0], acc[ai][bj][m][1][1], acc[ai][bj][m][1][2], acc[ai][bj][m][1][3]};
                E(row, valid, col0, v); } }
}

template <bool GATHER, bool FP8, int SCW, int SCX, int PM, class RowEpi, class Sched>
__device__ __forceinline__ void gemm_phase(PG8_LAS unsigned char* lds, const int KB, const Sched& S, const RowEpi& E) {
    const int tid = threadIdx.x, wid = __builtin_amdgcn_readfirstlane(tid >> 6), lane = tid & 63, wr = wid >> 2, wc = wid & 3, fr = lane & 15, fq = lane >> 4;
    const int nt = KB / 128;
    int scw_ = SCW, scx_ = SCX; asm volatile("" : "+v"(scw_), "+v"(scx_));
    int Rr[2], Cc[2]; unsigned voffB[2][2];
#pragma unroll
    for (int i = 0; i < 2; ++i) { stage_rc(tid * 16 + i * 8192, Rr[i], Cc[i]);
#pragma unroll
        for (int h = 0; h < 2; ++h) { const int R = Rr[i];
            const int cperm = PM == 1 ? 64 * (R >> 5) + 16 * ((R >> 2) & 3) + 8 * h + 4 * ((R >> 4) & 1) + (R & 3)
                            : PM == 2 ? 64 * (R >> 5) + 32 * h + 8 * ((R >> 2) & 3) + 4 * ((R >> 4) & 1) + (R & 3)
                            : h * HALF + (R & ~31) + perm32(R & 31);
            voffB[h][i] = (unsigned)(cperm * KB + Cc[i] * 2); } }
    const size_t kstep = (size_t)(BK * 2);
    const unsigned ldsw = (unsigned)wid * 1024u;
    const int aoff = lds_byte(wr * 64 + fr, fq * 8), boff = lds_byte(wc * 32 + fr, fq * 8);
#define PG8_SA(b, h) (((b) * 2 + (h)) * HTB)
#define PG8_SB(b, h) ((4 + (b) * 2 + (h)) * HTB)
#define PG8_STAGE(bufoff, gbase, voff) do { _Pragma("unroll") for (int _i = 0; _i < 2; ++_i) \
        __builtin_amdgcn_global_load_lds((const unsigned*)((const char*)(gbase) + (voff)[_i]), (PG8_LAS unsigned*)(lds + (bufoff) + ldsw + _i * 8192), 16, 0, 0); } while (0)
#define PG8_LD8(dst, addr) do { const i32x4 lo_ = *(const PG8_LAS i32x4*)(addr), hi_ = *(const PG8_LAS i32x4*)((addr) + 1024); dst = __builtin_shufflevector(lo_, hi_, 0, 1, 2, 3, 4, 5, 6, 7); } while (0)
#define PG8_LDA(dst, b, h) do { _Pragma("unroll") for (int m = 0; m < 4; ++m) PG8_LD8(dst[m], lds + PG8_SA(b, h) + aoff + m * 2048); } while (0)
#define PG8_LDB(dst, b, h) do { _Pragma("unroll") for (int n = 0; n < 2; ++n) PG8_LD8(dst[n], lds + PG8_SB(b, h) + boff + n * 2048); } while (0)
#define PG8_HALF(v, k) __builtin_bit_cast(bf16x8, (k) ? __builtin_shufflevector(v, v, 4, 5, 6, 7) : __builtin_shufflevector(v, v, 0, 1, 2, 3))
#define PG8_MMA(ai, bj, At, Bt) do { __builtin_amdgcn_s_setprio(1); _Pragma("unroll") for (int m = 0; m < 4; ++m) _Pragma("unroll") for (int n = 0; n < 2; ++n) { \
        if (FP8) asm volatile("v_mfma_scale_f32_16x16x128_f8f6f4 %0, %1, %2, %0, %3, %4 op_sel_hi:[0,0,0]" : "+v"(acc[ai][bj][m][n]) : "v"(Bt[n]), "v"(At[m]), "v"(scw_), "v"(scx_)); \
        else { _Pragma("unroll") for (int k = 0; k < 2; ++k) acc[ai][bj][m][n] = __builtin_amdgcn_mfma_f32_16x16x32_bf16(PG8_HALF(Bt[n], k), PG8_HALF(At[m], k), acc[ai][bj][m][n], 0, 0, 0); } } \
        __builtin_amdgcn_s_setprio(0); } while (0)
#define PG8_WAIT_V(n) asm volatile("s_waitcnt vmcnt(" #n ")" ::: "memory")
#define PG8_WAIT_L(n) asm volatile("s_waitcnt lgkmcnt(" #n ")" ::: "memory")
#define PG8_BAR __builtin_amdgcn_s_barrier()
#define PG8_SCHED __builtin_amdgcn_sched_barrier(0)
#define PG8_FILLA(u, v) do { _Pragma("unroll") for (int _h = 0; _h < 2; ++_h) _Pragma("unroll") for (int _i = 0; _i < 2; ++_i) { const int _row = _h * HALF + Rr[_i]; \
        if (GATHER) { const int _ri = (u).row0 + _row; const int _src = (u).gather[_ri < (u).rend ? _ri : (u).row0]; (v)[_h][_i] = (unsigned)(_src * KB + Cc[_i] * 2); } \
        else (v)[_h][_i] = (unsigned)(_row * KB + Cc[_i] * 2); } } while (0)
    Unit cur, nxt; int ui = 0;
    if (!S.next(0, cur)) return;
    f32x4 acc[2][2][4][2];
#pragma unroll
    for (int a = 0; a < 2; ++a)
#pragma unroll
        for (int b = 0; b < 2; ++b)
#pragma unroll
            for (int m = 0; m < 4; ++m)
#pragma unroll
                for (int n = 0; n < 2; ++n) acc[a][b][m][n] = (f32x4){0.f, 0.f, 0.f, 0.f};
    i32x8 At[4], B0[2], B1[2];
    unsigned voffA[2][2], nvoffA[2][2];
    PG8_FILLA(cur, voffA);
    const char* cA = cur.A; const char* cB = cur.B;
    PG8_STAGE(PG8_SB(0, 0), cB, voffB[0]); PG8_STAGE(PG8_SB(0, 1), cB, voffB[1]); PG8_STAGE(PG8_SA(0, 0), cA, voffA[0]); PG8_STAGE(PG8_SA(0, 1), cA, voffA[1]);
    if (wr == 1) PG8_BAR;
    PG8_WAIT_V(2); PG8_BAR;
    PG8_STAGE(PG8_SB(1, 0), cB + kstep, voffB[0]); PG8_STAGE(PG8_SA(1, 0), cA + kstep, voffA[0]); PG8_STAGE(PG8_SB(1, 1), cB + kstep, voffB[1]);
    PG8_WAIT_V(6); PG8_BAR;
    for (;;) {
        const bool has_next = S.next(ui + 1, nxt);
        const char* nA = has_next ? nxt.A : cA; const char* nB = has_next ? nxt.B : cB;
        if (GATHER && has_next) { PG8_FILLA(nxt, nvoffA); }
        else {
#pragma unroll
            for (int h = 0; h < 2; ++h)
#pragma unroll
                for (int i = 0; i < 2; ++i) nvoffA[h][i] = voffA[h][i]; }
        for (int t = 0; t < nt; t += 2) {
            const bool last = (t == nt - 2);
            const char* a1 = cA + (size_t)(t + 1) * kstep;
            const char* a2 = last ? nA : cA + (size_t)(t + 2) * kstep; const char* b2 = last ? nB : cB + (size_t)(t + 2) * kstep;
            const char* a3 = a2 + kstep; const char* b3 = b2 + kstep;
            unsigned v2[2][2];
#pragma unroll
            for (int h = 0; h < 2; ++h)
#pragma unroll
                for (int i = 0; i < 2; ++i) v2[h][i] = last ? nvoffA[h][i] : voffA[h][i];
            PG8_LDB(B0, 0, 0); PG8_LDB(B1, 0, 1); PG8_SCHED; PG8_LDA(At, 0, 0); PG8_STAGE(PG8_SA(1, 1), a1, voffA[1]);
            PG8_WAIT_V(8); PG8_WAIT_L(0); PG8_BAR; PG8_MMA(0, 0, At, B0); PG8_MMA(0, 1, At, B1); PG8_BAR; PG8_SCHED;
            PG8_LDA(At, 0, 1); PG8_STAGE(PG8_SB(0, 0), b2, voffB[0]); PG8_STAGE(PG8_SB(0, 1), b2, voffB[1]); PG8_STAGE(PG8_SA(0, 0), a2, v2[0]);
            PG8_WAIT_V(8); PG8_WAIT_L(0); PG8_BAR; PG8_MMA(1, 0, At, B0); PG8_MMA(1, 1, At, B1); PG8_BAR; PG8_SCHED;
            PG8_LDB(B0, 1, 0); PG8_LDB(B1, 1, 1); PG8_SCHED; PG8_LDA(At, 1, 0); PG8_STAGE(PG8_SA(0, 1), a2, v2[1]);
            PG8_WAIT_V(8); PG8_WAIT_L(0); PG8_BAR; PG8_MMA(0, 0, At, B0); PG8_MMA(0, 1, At, B1); PG8_BAR; PG8_SCHED;
            PG8_LDA(At, 1, 1); PG8_STAGE(PG8_SB(1, 0), b3, voffB[0]); PG8_STAGE(PG8_SB(1, 1), b3, voffB[1]); PG8_STAGE(PG8_SA(1, 0), a3, v2[0]);
            PG8_WAIT_V(8); PG8_WAIT_L(0); PG8_BAR; PG8_MMA(1, 0, At, B0); PG8_MMA(1, 1, At, B1); PG8_BAR; PG8_SCHED;
        }
        if (wr == 0) PG8_BAR;
        if (FP8) { PG8_SCHED; asm volatile("s_nop 15\n\ts_nop 7" ::: "memory"); PG8_SCHED; }
        run_epi<PM>(E, acc, cur, wr, wc, fr, fq);
        if (!has_next) break;
#pragma unroll
        for (int a = 0; a < 2; ++a)
#pragma unroll
            for (int b = 0; b < 2; ++b)
#pragma unroll
                for (int m = 0; m < 4; ++m)
#pragma unroll
                    for (int n = 0; n < 2; ++n) acc[a][b][m][n] = (f32x4){0.f, 0.f, 0.f, 0.f};
        cur = nxt; cA = nA; cB = nB; ++ui;
#pragma unroll
        for (int h = 0; h < 2; ++h)
#pragma unroll
            for (int i = 0; i < 2; ++i) voffA[h][i] = nvoffA[h][i];
        if (wr == 1) PG8_BAR;
    }
    PG8_WAIT_V(0);
    PG8_BAR;
#undef PG8_SA
#undef PG8_SB
#undef PG8_STAGE
#undef PG8_LDA
#undef PG8_LD8
#undef PG8_HALF
#undef PG8_LDB
#undef PG8_MMA
#undef PG8_WAIT_V
#undef PG8_WAIT_L
#undef PG8_BAR
#undef PG8_SCHED
#undef PG8_FILLA
}

struct DenseSched {
    const char* A; const char* Bt; int KB, M, nM, nN, nwg, G, c;
    __device__ __forceinline__ void init(const void* A_, const void* Bt_, int M_, int N_, int KB_, int G_, int c_) { A = (const char*)A_; Bt = (const char*)Bt_; KB = KB_; M = M_; nM = M_ / BM; nN = N_ / BM; nwg = nM * nN; G = G_; c = c_; }
    __device__ __forceinline__ bool next(int i, Unit& u) const {
        const long L = (long)i * G + c; if (L >= nwg) return false;
        int wgid = (int)L; { const int q = nwg / 8, r = nwg % 8, xcd = wgid % 8, off = wgid / 8; wgid = (xcd < r ? xcd * (q + 1) : r * (q + 1) + (xcd - r) * q) + off; }
        const int nig = 8 * nN, gid = wgid / nig, fm = gid * 8, gsz = (nM - fm) < 8 ? (nM - fm) : 8;
        const int pm = fm + ((wgid % nig) % gsz), pn = (wgid % nig) / gsz;
        u.A = A + (size_t)pm * BM * KB; u.B = Bt + (size_t)pn * BM * KB; u.gather = nullptr; u.row0 = pm * BM; u.rend = M; u.col0 = pn * BM; return true;
    }
};
struct ExpertSched {
    const int* TILE; int nunits, NPN; const char* A; const int* gather; const char* Bt; size_t bstride; int KB, G, vcu;
    __device__ __forceinline__ bool next(int i, Unit& u) const {
        const int L = i * G + vcu; if (L >= nunits) return false;
        const int tl = L / NPN, pn = L % NPN;
        const int e = __builtin_amdgcn_readfirstlane(TILE[64 + tl]), r0 = __builtin_amdgcn_readfirstlane(TILE[64 + 2048 + tl]), re = __builtin_amdgcn_readfirstlane(TILE[64 + 4096 + tl]);
        u.B = Bt + (size_t)e * bstride + (size_t)pn * BM * KB; u.row0 = r0; u.rend = re; u.col0 = pn * BM;
        if (gather) { u.A = A; u.gather = gather; } else { u.A = A + (size_t)r0 * KB; u.gather = nullptr; }
        return true;
    }
};
}

struct EpiProj { bf16_t* P; const float* gt;
    __device__ __forceinline__ void rowg(int row, bool valid, int colA, const float (&v)[16]) const {
        float y[16];
        if (colA >= 2048 && colA < 3072) {
            float ss = 0.f;
#pragma unroll
            for (int i = 0; i < 16; ++i) ss += v[i] * v[i];
            ss += __shfl_xor(ss, 16); ss += __shfl_xor(ss, 32);
            const float rstd = rsqrtf(ss * (1.f / 64.f) + EPS);
            const float* g = gt + (colA < 2560 ? 0 : 64) + (colA & 63);
            const f32x4 g0 = *(const f32x4*)g, g1 = *(const f32x4*)(g + 4), g2 = *(const f32x4*)(g + 32), g3 = *(const f32x4*)(g + 36);
            y[0] = v[0] * rstd * g0.x; y[1] = v[1] * rstd * g0.y; y[2] = v[2] * rstd * g0.z; y[3] = v[3] * rstd * g0.w; y[4] = v[4] * rstd * g1.x; y[5] = v[5] * rstd * g1.y; y[6] = v[6] * rstd * g1.z; y[7] = v[7] * rstd * g1.w;
            y[8] = v[8] * rstd * g2.x; y[9] = v[9] * rstd * g2.y; y[10] = v[10] * rstd * g2.z; y[11] = v[11] * rstd * g2.w; y[12] = v[12] * rstd * g3.x; y[13] = v[13] * rstd * g3.y; y[14] = v[14] * rstd * g3.z; y[15] = v[15] * rstd * g3.w;
        } else {
#pragma unroll
            for (int i = 0; i < 16; ++i) y[i] = v[i];
        }
        if (valid) { const float y0[8] = {y[0], y[1], y[2], y[3], y[4], y[5], y[6], y[7]}, y1[8] = {y[8], y[9], y[10], y[11], y[12], y[13], y[14], y[15]};
            *(u32x4*)(P + (size_t)row * NPROJ + colA) = pack8(y0); *(u32x4*)(P + (size_t)row * NPROJ + colA + 32) = pack8(y1); } } };
struct EpiOut { const float* x; bf16_t* x1; const float* MOD;
    __device__ __forceinline__ void operator()(int row, bool valid, int col0, const float (&v)[8]) const {
        if (!valid) return; const int b = row / SEQ; const float* ga = MOD + b * 6144 + 2 * 1024 + col0;
        const f32x4 x0 = __builtin_nontemporal_load((const f32x4*)(x + (size_t)row * DM + col0)), x1v = __builtin_nontemporal_load((const f32x4*)(x + (size_t)row * DM + col0 + 4));
        const float o[8] = {x0.x + ga[0] * v[0], x0.y + ga[1] * v[1], x0.z + ga[2] * v[2], x0.w + ga[3] * v[3], x1v.x + ga[4] * v[4], x1v.y + ga[5] * v[5], x1v.z + ga[6] * v[6], x1v.w + ga[7] * v[7]};
        *(u32x4*)(x1 + (size_t)row * DM + col0) = pack8(o); } };
struct EpiRS { float* LOG; bf16_t* ACT;
    __device__ __forceinline__ void operator()(int row, bool valid, int col0, const float (&v)[8]) const {
        if (!valid) return;
        if (col0 < 256) { *(f32x4*)(LOG + (size_t)row * 256 + col0) = (f32x4){v[0], v[1], v[2], v[3]}; *(f32x4*)(LOG + (size_t)row * 256 + col0 + 4) = (f32x4){v[4], v[5], v[6], v[7]}; }
        else { const int j0 = (col0 - 256) >> 1;
            *(unsigned*)((unsigned char*)ACT + (size_t)(SHARED_BASE + row) * 256 + j0) = pk4_fp8(8.f * siluf(v[0]) * v[4], 8.f * siluf(v[1]) * v[5], 8.f * siluf(v[2]) * v[6], 8.f * siluf(v[3]) * v[7]); } } };
struct EpiG1 { const float* SG; bf16_t* ACT;
    __device__ __forceinline__ void operator()(int row, bool valid, int col0, const float (&v)[8]) const {
        if (!valid) return; const float g = 8.f * SG[row]; const int j0 = col0 >> 1;
        *(unsigned*)((unsigned char*)ACT + (size_t)row * 256 + j0) = pk4_fp8(siluf(v[0]) * v[4] * g, siluf(v[1]) * v[5] * g, siluf(v[2]) * v[6] * g, siluf(v[3]) * v[7] * g); } };
struct EpiG2 { bf16_t* YP;
    __device__ __forceinline__ void operator()(int row, bool valid, int col0, const float (&v)[8]) const { if (valid) { u32x2 p; p.x = pk4_fp8(16.f * v[0], 16.f * v[1], 16.f * v[2], 16.f * v[3]); p.y = pk4_fp8(16.f * v[4], 16.f * v[5], 16.f * v[6], 16.f * v[7]);
            *(u32x2*)((unsigned char*)YP + (size_t)row * DM + col0) = p; } }
    __device__ __forceinline__ void row16(int row, bool valid, int col0, const float (&v)[16]) const { if (valid) { u32x4 p;
            p.x = pk4_fp8(16.f * v[0], 16.f * v[1], 16.f * v[2], 16.f * v[3]); p.y = pk4_fp8(16.f * v[4], 16.f * v[5], 16.f * v[6], 16.f * v[7]);
            p.z = pk4_fp8(16.f * v[8], 16.f * v[9], 16.f * v[10], 16.f * v[11]); p.w = pk4_fp8(16.f * v[12], 16.f * v[13], 16.f * v[14], 16.f * v[15]);
            __builtin_nontemporal_store(p, (u32x4*)((unsigned char*)YP + (size_t)row * DM + col0)); } } };

constexpr int LR = 136;
__device__ __forceinline__ f32x4 mfma16(bf16x8 a, bf16x8 b, f32x4 c) {
    asm volatile("s_nop 1\n\tv_mfma_f32_16x16x32_bf16 %0, %1, %2, %0" : "+v"(c) : "v"(a), "v"(b)); return c; }
#define MFMA_DRAIN8(x) asm volatile("s_nop 15\n\ts_nop 3" : "+v"(x[0]), "+v"(x[1]), "+v"(x[2]), "+v"(x[3]), "+v"(x[4]), "+v"(x[5]), "+v"(x[6]), "+v"(x[7]))
__device__ __forceinline__ bf16x8 ldfrag(const bf16_t* base, int row, int k0, int lane) { return *(const bf16x8*)(base + (row + (lane & 15)) * LR + k0 + 8 * (lane >> 4)); }


__device__ __forceinline__ void conv8_lds(const bf16_t* R, int pitch, int s, int col, const float* cw, int wpitch, const float* cb, int ch, float (&o)[8]) {
    float acc[8];
    { const f32x4 b0 = *(const f32x4*)(cb + ch), b1 = *(const f32x4*)(cb + ch + 4); acc[0] = b0.x; acc[1] = b0.y; acc[2] = b0.z; acc[3] = b0.w; acc[4] = b1.x; acc[5] = b1.y; acc[6] = b1.z; acc[7] = b1.w; }
#pragma unroll
    for (int j = 0; j < 4; ++j) { float x[8]; unpack8(*(const u32x4*)(R + (s + j) * pitch + col), x);
        const f32x4 w0 = *(const f32x4*)(cw + j * wpitch + ch), w1 = *(const f32x4*)(cw + j * wpitch + ch + 4);
        acc[0] += w0.x * x[0]; acc[1] += w0.y * x[1]; acc[2] += w0.z * x[2]; acc[3] += w0.w * x[3];
        acc[4] += w1.x * x[4]; acc[5] += w1.y * x[5]; acc[6] += w1.z * x[6]; acc[7] += w1.w * x[7]; }
#pragma unroll
    for (int q = 0; q < 8; ++q) o[q] = siluf(acc[q]);
}
__device__ __forceinline__ void chunk_gates(const Args& a, float* bb, float* ii, float* tmp, int t0, int h, int tid) {
    const float* IPRE = (const float*)(a.ws + WS_IPRE); const float* FPRE = (const float*)(a.ws + WS_FPRE);
    if (tid < 128) { const float f = FPRE[(size_t)(t0 + tid) * 4 + h]; ii[tid] = IPRE[(size_t)(t0 + tid) * 4 + h];
        tmp[tid] = fminf(f, 0.f) - log1pf(expf(-fabsf(f))); }
    __syncthreads();
    if (tid < 128) { float s = 0.f;
#pragma unroll 4
        for (int j4 = 0; j4 < 32; ++j4) { const f32x4 v = *(const f32x4*)(tmp + 4 * j4); const int j = 4 * j4;
            s += (j <= tid ? v.x : 0.f); s += (j + 1 <= tid ? v.y : 0.f); s += (j + 2 <= tid ? v.z : 0.f); s += (j + 3 <= tid ? v.w : 0.f); }
        bb[tid] = s; }
    __syncthreads();
}

__device__ __forceinline__ void mlstm_m1_unit(const Args& a, unsigned char* lds, int unit, const int wave_s) {
    const int tid = mk_tid(wave_s);
    const int lane = tid & 63, wave = tid >> 6;
    const int bh = unit >> 6, c = unit & 63, b = bh >> 2, h = bh & 3, t0 = b * SEQ + c * 128;
    bf16_t* kT = (bf16_t*)lds; bf16_t* vT = kT + 128 * LR;
    float* sf = (float*)(lds + 2 * 128 * LR * 2); float* bb = sf; float* ii = sf + 128; float* tmp = sf + 256; float* wk = sf + 384;
    const bf16_t* PROJ = (const bf16_t*)(a.ws + WS_PROJ);
    const float* cw = a.in[5]; const float* cbias = a.in[6];
    bf16_t* R = (bf16_t*)(lds + 2 * 128 * LR * 2 + 2048);
    const int tl = tid;
    u32x4 rawk[5], vreg[4];
#pragma unroll
    for (int k = 0; k < 5; ++k) { const int idx = tl + 512 * k, row = idx >> 4, chunk = idx & 15; const int sp = c * 128 - 3 + row;
        rawk[k] = (u32x4){0u, 0u, 0u, 0u};
        if (idx < 131 * 16 && sp >= 0) rawk[k] = *(const u32x4*)(PROJ + (size_t)(b * SEQ + sp) * NPROJ + 512 + h * 128 + 8 * chunk); }
#pragma unroll
    for (int k = 0; k < 4; ++k) { const int it = tl + 512 * k, sidx = it & 127, ch = it >> 7; vreg[k] = *(const u32x4*)(PROJ + (size_t)(t0 + sidx) * NPROJ + 1024 + h * 128 + 8 * ch); }
    float* WL = (float*)(lds + 147456);
    float wl0 = 0.f, wl1 = 0.f; if (tl < 512) wl0 = cw[(tl >> 7) * 1024 + 512 + h * 128 + (tl & 127)]; if (tl < 128) wl1 = cbias[512 + h * 128 + tl];
    chunk_gates(a, bb, ii, tmp, t0, h, tid);
    if (tl < 512) WL[tl] = wl0; if (tl < 128) WL[512 + tl] = wl1;
#pragma unroll
    for (int k = 0; k < 5; ++k) { const int idx = tl + 512 * k; if (idx < 131 * 16) *(u32x4*)(R + (idx >> 4) * 136 + 8 * (idx & 15)) = rawk[k]; }
    const float blast = bb[127];
    if (tid < 128) tmp[tid] = blast - bb[tid] + ii[tid];
    __syncthreads();
    float mloc = -INFINITY;
#pragma unroll 4
    for (int j4 = 0; j4 < 32; ++j4) { const f32x4 v = *(const f32x4*)(tmp + 4 * j4); mloc = fmaxf(fmaxf(mloc, fmaxf(v.x, v.y)), fmaxf(v.z, v.w)); }
    if (tid < 128) wk[tid] = expf(tmp[tid] - mloc);
    __syncthreads();
#pragma unroll
    for (int k = 0; k < 4; ++k) { const int it = tl + 512 * k, sidx = it & 127, ch = it >> 7;
        float kv[8]; conv8_lds(R, 136, sidx, 8 * ch, WL, 128, WL + 512, 8 * ch, kv);
        const float sc = 0.08838834764831845f * wk[sidx];
#pragma unroll
        for (int q = 0; q < 8; ++q) kT[(8 * ch + q) * LR + sidx] = (bf16_t)f2bf(kv[q] * sc);
        float vv[8]; unpack8(vreg[k], vv);
#pragma unroll
        for (int q = 0; q < 8; ++q) vT[(8 * ch + q) * LR + sidx] = (bf16_t)f2bf(vv[q]);
    }
    __syncthreads();
    float* CLOC = (float*)(a.ws + WS_CLOC) + (size_t)unit * 16384;
    float* MST = (float*)(a.ws + WS_MST);
    {
        f32x4 acc[8];
#pragma unroll
        for (int i = 0; i < 8; ++i) acc[i] = (f32x4){0.f, 0.f, 0.f, 0.f};
#pragma unroll
        for (int ks = 0; ks < 4; ++ks) { const bf16x8 af = ldfrag(vT, 16 * wave, 32 * ks, lane);
#pragma unroll
            for (int db = 0; db < 8; ++db) acc[db] = mfma16(af, ldfrag(kT, 16 * db, 32 * ks, lane), acc[db]); }
        MFMA_DRAIN8(acc);
#pragma unroll
        for (int db = 0; db < 8; ++db)
#pragma unroll
            for (int r = 0; r < 4; ++r) CLOC[(16 * wave + 4 * (lane >> 4) + r) * 128 + 16 * db + (lane & 15)] = acc[db][r];
    }
    if (tid < 128) { float s = 0.f;
#pragma unroll 4
        for (int j8 = 0; j8 < 16; ++j8) { float x[8]; unpack8(*(const u32x4*)(kT + tid * LR + 8 * j8), x); s += ((x[0] + x[1]) + (x[2] + x[3])) + ((x[4] + x[5]) + (x[6] + x[7])); }
        MST[16384 + (size_t)unit * 128 + tid] = s; }
    if (tid == 0) { MST[unit] = mloc; MST[1024 + unit] = blast; }
    __syncthreads();
}

__device__ __forceinline__ void mlstm_m2(const Args& a, const int tid2) {
    const float* CLOC = (const float*)(a.ws + WS_CLOC); bf16_t* CIN = (bf16_t*)(a.ws + WS_CIN);
    float* MST = (float*)(a.ws + WS_MST);
    const float* NLOC = MST + 16384; float* NIN = MST + 16384 + 131072;
    for (int gid = blockIdx.x * 512 + tid2; gid < 16 * 8192; gid += gridDim.x * 512) {
        const int bh = gid >> 13, e2 = gid & 8191; const bool hasn = e2 < 128;
        const float* cl = CLOC + (size_t)(bh * 64) * 16384 + e2; const float* nl = NLOC + (size_t)(bh * 64) * 128 + e2;
        bf16_t* ci = CIN + (size_t)(bh * 64) * 16384 + e2; float* ni = NIN + (size_t)(bh * 64) * 128 + e2;
        const float* mlp = MST + bh * 64; const float* blp = MST + 1024 + bh * 64;
        float s0 = 0.f, s1 = 0.f, sn = 0.f, m = 0.f;
        float p0[4], p1[4], pn[4], pm[4], pb[4];
#pragma unroll
        for (int k = 0; k < 4; ++k) { p0[k] = __builtin_nontemporal_load(cl + (size_t)k * 16384); p1[k] = __builtin_nontemporal_load(cl + (size_t)k * 16384 + 8192); pn[k] = hasn ? nl[k * 128] : 0.f; pm[k] = mlp[k]; pb[k] = blp[k]; }
        for (int c0 = 0; c0 < 64; c0 += 4) {
            float q0[4], q1[4], qn[4], qm[4], qb[4];
            const bool more = c0 + 4 < 64;
#pragma unroll
            for (int k = 0; k < 4; ++k) { const int c = more ? c0 + 4 + k : c0 + k;
                q0[k] = __builtin_nontemporal_load(cl + (size_t)c * 16384); q1[k] = __builtin_nontemporal_load(cl + (size_t)c * 16384 + 8192); qn[k] = hasn ? nl[c * 128] : 0.f; qm[k] = mlp[c]; qb[k] = blp[c]; }
#pragma unroll
            for (int k = 0; k < 4; ++k) { const int c = c0 + k;
                ci[(size_t)c * 16384] = (bf16_t)f2bf(s0); ci[(size_t)c * 16384 + 8192] = (bf16_t)f2bf(s1);
                if (hasn) ni[c * 128] = sn;
                if (e2 == 0) MST[2048 + bh * 64 + c] = m;
                const float ml = pm[k], bl = pb[k];
                const float mn = fmaxf(bl + m, ml), ca = expf(bl + m - mn), cb = expf(ml - mn);
                s0 = ca * s0 + cb * p0[k]; s1 = ca * s1 + cb * p1[k]; sn = ca * sn + cb * pn[k]; m = mn; }
#pragma unroll
            for (int k = 0; k < 4; ++k) { p0[k] = q0[k]; p1[k] = q1[k]; pn[k] = qn[k]; pm[k] = qm[k]; pb[k] = qb[k]; }
        }
    }
}

struct M3In { u32x4 rawq[9], vreg[4], creg[4]; float fpre, ipre, wl0, wl1, wl2, m_in, nnv; };
__device__ __forceinline__ void m3_issue(const Args& a, int unit, const int tid, M3In& r) {
    const int bh = unit >> 6, c = unit & 63, b = bh >> 2, h = bh & 3, t0 = b * SEQ + c * 128; const int tl = tid;
    const bf16_t* PROJ = (const bf16_t*)(a.ws + WS_PROJ); const bf16_t* CIN = (const bf16_t*)(a.ws + WS_CIN) + (size_t)unit * 16384;
    const float* MST = (const float*)(a.ws + WS_MST); const float* IPRE = (const float*)(a.ws + WS_IPRE); const float* FPRE = (const float*)(a.ws + WS_FPRE);
    const float* cw = a.in[5]; const float* cbias = a.in[6];
    r.m_in = MST[2048 + unit];
#pragma unroll
    for (int k = 0; k < 9; ++k) { const int idx = tl + 512 * k, row = idx >> 5, chunk = idx & 31; const int sp = c * 128 - 3 + row;
        r.rawq[k] = (u32x4){0u, 0u, 0u, 0u};
        if (idx < 131 * 32 && sp >= 0) r.rawq[k] = *(const u32x4*)(PROJ + (size_t)(b * SEQ + sp) * NPROJ + (chunk < 16 ? h * 128 + 8 * chunk : 512 + h * 128 + 8 * (chunk - 16))); }
#pragma unroll
    for (int k = 0; k < 4; ++k) { const int it = tl + 512 * k, sidx = it & 127, ch = it >> 7, s2 = it >> 4, c2 = it & 15;
        r.vreg[k] = *(const u32x4*)(PROJ + (size_t)(t0 + sidx) * NPROJ + 1024 + h * 128 + 8 * ch); r.creg[k] = *(const u32x4*)(CIN + s2 * 128 + 8 * c2); }
    r.wl0 = cw[(tl >> 7) * 1024 + h * 128 + (tl & 127)]; r.wl1 = cw[(tl >> 7) * 1024 + 512 + h * 128 + (tl & 127)]; r.wl2 = 0.f; if (tl < 256) r.wl2 = cbias[(tl >> 7) * 512 + h * 128 + (tl & 127)];
    r.fpre = 0.f; r.ipre = 0.f; r.nnv = 0.f;
    if (tid < 128) { r.fpre = FPRE[(size_t)(t0 + tid) * 4 + h]; r.ipre = IPRE[(size_t)(t0 + tid) * 4 + h]; r.nnv = MST[16384 + 131072 + (size_t)unit * 128 + tl]; }
}
__device__ __forceinline__ void mlstm_m3_unit(const Args& a, unsigned char* lds, int unit, const int wave_s, M3In& r, unsigned* qnext, volatile PG8_LAS unsigned* nextp) {
    const int tid = mk_tid(wave_s);
    const int lane = tid & 63, wave = tid >> 6;
    const int bh = unit >> 6, c = unit & 63, b = bh >> 2, h = bh & 3, t0 = b * SEQ + c * 128;
    bf16_t* qs = (bf16_t*)lds; bf16_t* ks = qs + 128 * LR; bf16_t* vT = ks + 128 * LR; bf16_t* CT = vT + 128 * LR; bf16_t* Ps = ks;
    float* sf = (float*)(lds + 4 * 128 * LR * 2);
    float* bb = sf; float* ii = sf + 128; float* tmp = sf + 256; float* gg = sf + 384; float* wint = sf + 512; float* nn = sf + 640; float* den = sf + 768; float* dint = sf + 896;
    const bf16_t* PROJ = (const bf16_t*)(a.ws + WS_PROJ);
    const float* mlg = a.in[8];
    bf16_t* MIX = (bf16_t*)(a.ws + WS_MIX);
    bf16_t* R = vT;
    const float m_in = r.m_in;
    const int tl = tid;
    unsigned tk = 0u; if (tid == 0) tk = atomicAdd(qnext, 1u);
    float* WL = (float*)(lds + 147456);
    if (tid < 128) { const float f = r.fpre; ii[tid] = r.ipre; tmp[tid] = fminf(f, 0.f) - log1pf(expf(-fabsf(f))); }
    __syncthreads();
    if (tid < 128) { float s = 0.f;
#pragma unroll 4
        for (int j4 = 0; j4 < 32; ++j4) { const f32x4 v = *(const f32x4*)(tmp + 4 * j4); const int j = 4 * j4;
            s += (j <= tid ? v.x : 0.f); s += (j + 1 <= tid ? v.y : 0.f); s += (j + 2 <= tid ? v.z : 0.f); s += (j + 3 <= tid ? v.w : 0.f); }
        bb[tid] = s; }
    __syncthreads();
    WL[tl] = r.wl0; WL[512 + tl] = r.wl1; if (tl < 256) WL[1024 + tl] = r.wl2;
#pragma unroll
    for (int k = 0; k < 9; ++k) { const int idx = tl + 512 * k; if (idx < 131 * 32) *(u32x4*)(R + (idx >> 5) * 264 + 8 * (idx & 31)) = r.rawq[k]; }
    if (tid < 128) { float pm = -INFINITY;
#pragma unroll 4
        for (int j4 = 0; j4 < 32; ++j4) { const f32x4 vi = *(const f32x4*)(ii + 4 * j4), vb = *(const f32x4*)(bb + 4 * j4); const int j = 4 * j4;
            pm = fmaxf(pm, j <= tl ? vi.x - vb.x : -INFINITY); pm = fmaxf(pm, j + 1 <= tl ? vi.y - vb.y : -INFINITY);
            pm = fmaxf(pm, j + 2 <= tl ? vi.z - vb.z : -INFINITY); pm = fmaxf(pm, j + 3 <= tl ? vi.w - vb.w : -INFINITY); }
        const float g = fmaxf(m_in, pm); gg[tl] = g; wint[tl] = expf(m_in - g); tmp[tl] = ii[tl] - bb[tl];
        nn[tl] = r.nnv; }
    if (tid == 0) *nextp = tk;
    __syncthreads();
#pragma unroll 1
    for (int k = 0; k < 4; ++k) { const int it = tl + 512 * k, sidx = it & 127, ch = it >> 7;
        float qv[8], kv[8];
        conv8_lds(R, 264, sidx, 8 * ch, WL, 128, WL + 1024, 8 * ch, qv);
        conv8_lds(R, 264, sidx, 128 + 8 * ch, WL + 512, 128, WL + 1152, 8 * ch, kv);
#pragma unroll
        for (int q = 0; q < 8; ++q) kv[q] *= 0.08838834764831845f;
        *(u32x4*)(qs + sidx * LR + 8 * ch) = pack8(qv);
        *(u32x4*)(ks + sidx * LR + 8 * ch) = pack8(kv); }
    __syncthreads();
#pragma unroll
    for (int k = 0; k < 4; ++k) { const int it = tl + 512 * k, sidx = it & 127, ch = it >> 7, s2 = it >> 4, c2 = it & 15;
        float vv[8]; unpack8(r.vreg[k], vv);
#pragma unroll
        for (int q = 0; q < 8; ++q) vT[(8 * ch + q) * LR + sidx] = (bf16_t)f2bf(vv[q]);
        *(u32x4*)(CT + s2 * LR + 8 * c2) = r.creg[k]; }
    __syncthreads();
    { const int nxt = (int)*nextp; if (nxt < 1024) m3_issue(a, nxt, tid, r); }
    if (tid < 128) { float s = 0.f;
#pragma unroll 4
        for (int d8 = 0; d8 < 16; ++d8) { float x[8]; unpack8(*(const u32x4*)(qs + tl * LR + 8 * d8), x); const f32x4 n0 = *(const f32x4*)(nn + 8 * d8), n1 = *(const f32x4*)(nn + 8 * d8 + 4);
            s += (x[0] * n0.x + x[1] * n0.y) + (x[2] * n0.z + x[3] * n0.w) + (x[4] * n1.x + x[5] * n1.y) + (x[6] * n1.z + x[7] * n1.w); }
        dint[tl] = s * wint[tl]; }
    f32x4 sacc[8];
#pragma unroll
    for (int i = 0; i < 8; ++i) sacc[i] = (f32x4){0.f, 0.f, 0.f, 0.f};
#pragma unroll
    for (int kk = 0; kk < 4; ++kk) { const bf16x8 bq = ldfrag(qs, 16 * wave, 32 * kk, lane);
#pragma unroll
        for (int sb = 0; sb < 8; ++sb) sacc[sb] = mfma16(ldfrag(ks, 16 * sb, 32 * kk, lane), bq, sacc[sb]); }
    MFMA_DRAIN8(sacc);
    __syncthreads();
    {
        const int t = 16 * wave + (lane & 15); const float g = gg[t]; float rs = 0.f;
#pragma unroll
        for (int sb = 0; sb < 8; ++sb) { float p[4];
            const f32x4 u4 = *(const f32x4*)(tmp + 16 * sb + 4 * (lane >> 4));
#pragma unroll
            for (int r = 0; r < 4; ++r) { const int s = 16 * sb + 4 * (lane >> 4) + r;
                const float w = __builtin_amdgcn_exp2f(fminf(u4[r] - g, 0.f) * LOG2E);
                p[r] = (s <= t) ? sacc[sb][r] * w : 0.f; rs += p[r]; }
            u32x2 w; w.x = pk2(p[0], p[1]); w.y = pk2(p[2], p[3]);
            *(u32x2*)(Ps + t * LR + 16 * sb + 4 * (lane >> 4)) = w; }
        rs += __shfl_xor(rs, 16); rs += __shfl_xor(rs, 32);
        if (lane < 16) den[t] = rs + dint[t];
    }
    __syncthreads();
    {
        f32x4 a1[8], a2[8];
#pragma unroll
        for (int i = 0; i < 8; ++i) { a1[i] = (f32x4){0.f, 0.f, 0.f, 0.f}; a2[i] = (f32x4){0.f, 0.f, 0.f, 0.f}; }
#pragma unroll
        for (int kk = 0; kk < 4; ++kk) { const bf16x8 ap = ldfrag(Ps, 16 * wave, 32 * kk, lane), aq = ldfrag(qs, 16 * wave, 32 * kk, lane);
#pragma unroll
            for (int eb = 0; eb < 8; ++eb) { a1[eb] = mfma16(ap, ldfrag(vT, 16 * eb, 32 * kk, lane), a1[eb]); a2[eb] = mfma16(aq, ldfrag(CT, 16 * eb, 32 * kk, lane), a2[eb]); } }
        MFMA_DRAIN8(a1); MFMA_DRAIN8(a2);
        float hv[8][4]; float ssq[4];
#pragma unroll
        for (int r = 0; r < 4; ++r) { const int t = 16 * wave + 4 * (lane >> 4) + r;
            const float dd = fmaxf(fabsf(den[t]), expf(-(bb[t] + gg[t]))); const float inv = 1.f / dd, wi = wint[t]; float s2 = 0.f;
#pragma unroll
            for (int eb = 0; eb < 8; ++eb) { const float x = (a1[eb][r] + wi * a2[eb][r]) * inv; hv[eb][r] = x; s2 += x * x;
            }
            s2 += __shfl_xor(s2, 1); s2 += __shfl_xor(s2, 2); s2 += __shfl_xor(s2, 4); s2 += __shfl_xor(s2, 8);
            ssq[r] = rsqrtf(s2 * (1.f / 128.f) + EPS); }
        float mov[8][4];
#pragma unroll
        for (int eb = 0; eb < 8; ++eb)
#pragma unroll
            for (int r = 0; r < 4; ++r) mov[eb][r] = bflo(PROJ[(size_t)(t0 + 16 * wave + 4 * (lane >> 4) + r) * NPROJ + 1536 + h * 128 + 16 * eb + (lane & 15)]);
#pragma unroll
        for (int eb = 0; eb < 8; ++eb) { const int e = 16 * eb + (lane & 15); const float ge = mlg[e];
#pragma unroll
            for (int r = 0; r < 4; ++r) { const int t = 16 * wave + 4 * (lane >> 4) + r;
                const float outv = hv[eb][r] * ssq[r] * ge * sigm(mov[eb][r]);
                MIX[(size_t)(t0 + t) * DM + h * 128 + e] = (bf16_t)f2bf(outv); } }
    }
    __syncthreads();
}

__device__ __forceinline__ void qknorm_rows(const Args& a, const int tid) {
    const int lane = tid & 63, wave = tid >> 6;
    bf16_t* PROJ = (bf16_t*)(a.ws + WS_PROJ);
    const float* gq = a.in[9]; const float* gk = a.in[10];
    const float* g = (lane < 32) ? gq : gk; const float scl = (lane < 32) ? C2 : 1.f;
    float gv[16];
#pragma unroll
    for (int i = 0; i < 16; ++i) gv[i] = g[16 * (lane & 3) + i] * scl;
    const int gw = blockIdx.x * 8 + wave, NGW = gridDim.x * 8;
    for (int row = gw; row < T; row += NGW) {
        u32x4* p = (u32x4*)(PROJ + (size_t)row * NPROJ + 2048 + 16 * lane);
        float x[16]; { float t8[8]; unpack8(p[0], t8);
#pragma unroll
            for (int i = 0; i < 8; ++i) x[i] = t8[i]; unpack8(p[1], t8);
#pragma unroll
            for (int i = 0; i < 8; ++i) x[8 + i] = t8[i]; }
        float ss = 0.f;
#pragma unroll
        for (int i = 0; i < 16; ++i) ss += x[i] * x[i];
        ss += __shfl_xor(ss, 1); ss += __shfl_xor(ss, 2);
        const float rstd = rsqrtf(ss * (1.f / 64.f) + EPS);
        float y0[8], y1[8];
#pragma unroll
        for (int i = 0; i < 8; ++i) { y0[i] = x[i] * rstd * gv[i]; y1[i] = x[8 + i] * rstd * gv[8 + i]; }
        p[0] = pack8(y0); p[1] = pack8(y1);
    }
}

#include <hip/hip_bf16.h>
namespace attn_body {
using bf16=__hip_bfloat16;
using bf16x8=__attribute__((ext_vector_type(8)))short;
using s16x4=__attribute__((ext_vector_type(4)))short;
using f32x16=__attribute__((ext_vector_type(16)))float;
using u32x4=__attribute__((ext_vector_type(4)))unsigned;
constexpr int SEQ=8192,PQ=3584,KVBLK=64;
__device__ __forceinline__ int crow(int r,int hi){return (r&3)+8*(r>>2)+4*hi;}
#define SBAR() __builtin_amdgcn_sched_barrier(0)
__device__ __forceinline__ void cmask(f32x16&p0,f32x16&p1,int jb,int qrel,int hi){
  const float NEG=-INFINITY; int kb=64*jb+4*hi;
  #pragma unroll
  for(int r=0;r<16;++r){int kv=kb+(r&3)+8*(r>>2); if(kv>qrel)p0[r]=NEG; if(kv+32>qrel)p1[r]=NEG;}
}

__device__ __forceinline__ void glds16(const void*gsrc,unsigned lds_dst){unsigned keep;
  asm volatile("s_mov_b32 %0, m0\n\ts_mov_b32 m0, %2\n\ts_nop 0\n\tglobal_load_lds_dwordx4 %1, off\n\ts_mov_b32 m0, %0":"=&s"(keep):"v"(gsrc),"s"(lds_dst):"memory");}
typedef float f32x2_t __attribute__((ext_vector_type(2))); typedef __bf16 bf16x2_t __attribute__((ext_vector_type(2)));
__device__ __forceinline__ unsigned cvtpk_s(float lo,float hi){f32x2_t v={lo,hi};bf16x2_t b=__builtin_convertvector(v,bf16x2_t);return __builtin_bit_cast(unsigned,b);}

__device__ __forceinline__ void qkt(f32x16&p0,f32x16&p1,unsigned kb,const bf16x8*qr,const f32x16&negm){
  bf16x8 k0,k1,k2,k3,k4,k5,k6,k7;
  #define QK_RD(K,OFF) asm volatile("ds_read_b128 %0,%1 offset:%c2":"=&v"(K):"v"(kb),"i"(OFF):"memory")
  QK_RD(k0,0);QK_RD(k1,512);QK_RD(k2,2048);QK_RD(k3,2560);QK_RD(k4,4096);QK_RD(k5,4608);QK_RD(k6,6144);QK_RD(k7,6656);
  #undef QK_RD
  asm volatile("s_waitcnt lgkmcnt(6)":::"memory");SBAR();
  p0=__builtin_amdgcn_mfma_f32_32x32x16_bf16(k0,qr[0],negm,0,0,0);p1=__builtin_amdgcn_mfma_f32_32x32x16_bf16(k1,qr[0],negm,0,0,0);SBAR();
  asm volatile("s_waitcnt lgkmcnt(4)":::"memory");SBAR();
  p0=__builtin_amdgcn_mfma_f32_32x32x16_bf16(k2,qr[1],p0,0,0,0);p1=__builtin_amdgcn_mfma_f32_32x32x16_bf16(k3,qr[1],p1,0,0,0);SBAR();
  asm volatile("s_waitcnt lgkmcnt(2)":::"memory");SBAR();
  p0=__builtin_amdgcn_mfma_f32_32x32x16_bf16(k4,qr[2],p0,0,0,0);p1=__builtin_amdgcn_mfma_f32_32x32x16_bf16(k5,qr[2],p1,0,0,0);SBAR();
  asm volatile("s_waitcnt lgkmcnt(0)":::"memory");SBAR();
  p0=__builtin_amdgcn_mfma_f32_32x32x16_bf16(k6,qr[3],p0,0,0,0);p1=__builtin_amdgcn_mfma_f32_32x32x16_bf16(k7,qr[3],p1,0,0,0);SBAR();
}

__device__ __forceinline__ void pv4(f32x16*o,int vb,bf16x8 pa0,bf16x8 pa1,bf16x8 pa2,bf16x8 pa3){
  s16x4 la[4],ha[4],lb[4],hb[4];
  #define PV_READ(L,H,OFF) do{ _Pragma("unroll") for(int ks=0;ks<4;++ks){ \
      asm volatile("ds_read_b64_tr_b16 %0,%1 offset:%c2":"=&v"(L[ks]):"v"(vb),"i"((OFF)+ks*1024):"memory"); \
      asm volatile("ds_read_b64_tr_b16 %0,%1 offset:%c2":"=&v"(H[ks]):"v"(vb),"i"((OFF)+ks*1024+512):"memory"); } }while(0)
  #define PV_PK(L,H,k) (bf16x8){L[k][0],L[k][1],L[k][2],L[k][3],H[k][0],H[k][1],H[k][2],H[k][3]}
  #define PV_MMA(dst,L,H) do{ dst=__builtin_amdgcn_mfma_f32_32x32x16_bf16(pa0,PV_PK(L,H,0),dst,0,0,0); dst=__builtin_amdgcn_mfma_f32_32x32x16_bf16(pa1,PV_PK(L,H,1),dst,0,0,0); \
      dst=__builtin_amdgcn_mfma_f32_32x32x16_bf16(pa2,PV_PK(L,H,2),dst,0,0,0); dst=__builtin_amdgcn_mfma_f32_32x32x16_bf16(pa3,PV_PK(L,H,3),dst,0,0,0); }while(0)
  PV_READ(la,ha,0); PV_READ(lb,hb,4096);
  asm volatile("s_waitcnt lgkmcnt(8)":::"memory");SBAR(); PV_MMA(o[0],la,ha); SBAR();
  PV_READ(la,ha,8192);
  asm volatile("s_waitcnt lgkmcnt(8)":::"memory");SBAR(); PV_MMA(o[1],lb,hb); SBAR();
  PV_READ(lb,hb,12288);
  asm volatile("s_waitcnt lgkmcnt(8)":::"memory");SBAR(); PV_MMA(o[2],la,ha); SBAR();
  asm volatile("s_waitcnt lgkmcnt(0)":::"memory");SBAR(); PV_MMA(o[3],lb,hb); SBAR();
  #undef PV_READ
  #undef PV_PK
  #undef PV_MMA
}


constexpr int CV_GROUPS=24576;
struct CvCtx { const float*w1; const float*w3; const float*w2; unsigned char*d13; unsigned char*d2; };
__device__ __forceinline__ const u32x4* cv_src(const CvCtx cx,int g,int wid,int lane){
  const int r=lane&31,h=lane>>5; const int krow=16*((r>>2)&1)+(r&3)+4*(r>>3);
  const float*src; int ldn,kb,n0;
  if(g<16384){ const int e=g>>6,rr=g&63; src=((rr>>5)?cx.w3:cx.w1)+(size_t)e*1024*256; ldn=256; kb=rr&31; n0=32*wid; }
  else{ const int g2=g-16384,e=g2>>5,rr=g2&31; src=cx.w2+(size_t)e*256*1024; ldn=1024; kb=rr&7; n0=32*(8*(rr>>3)+wid); }
  return (const u32x4*)(src+(size_t)(32*kb+krow)*ldn+n0+8*h);
}
__device__ __forceinline__ void cv_issue(const CvCtx cx,int g,int wid,int lane,u32x4&c0,u32x4&c1,u32x4&c2,u32x4&c3){
  const u32x4*p=cv_src(cx,g,wid,lane);
  c0=__builtin_nontemporal_load(p); c1=__builtin_nontemporal_load(p+1); c2=__builtin_nontemporal_load(p+4); c3=__builtin_nontemporal_load(p+5);
}
__device__ __forceinline__ void cv_issue_lds(const CvCtx cx,int g,int wid,unsigned loff,unsigned wt){
  const char*base; unsigned voff,pstep;
  if(g<16384){ const int e=g>>6,rr=g&63; base=(const char*)(((rr>>5)?cx.w3:cx.w1)+(size_t)e*1024*256+(size_t)(32*(rr&31))*256+32*wid); voff=loff; pstep=8u*1024u; }
  else{ const int g2=g-16384,e=g2>>5,rr=g2&31; base=(const char*)(cx.w2+(size_t)e*256*1024+(size_t)(32*(rr&7))*1024+32*(8*(rr>>3)+wid)); voff=((loff&~1023u)<<2)+(loff&1023u); pstep=8u*4096u; }
  unsigned keep; const unsigned v1=voff+pstep,v2=v1+pstep,v3=v2+pstep;
  asm volatile("s_mov_b32 %0, m0\n\ts_mov_b32 m0, %6\n\ts_nop 0\n\tglobal_load_lds_dwordx4 %1, %5\n\ts_add_u32 m0, m0, 0x400\n\ts_nop 0\n\tglobal_load_lds_dwordx4 %2, %5\n\t"
               "s_add_u32 m0, m0, 0x400\n\ts_nop 0\n\tglobal_load_lds_dwordx4 %3, %5\n\ts_add_u32 m0, m0, 0x400\n\ts_nop 0\n\tglobal_load_lds_dwordx4 %4, %5\n\ts_mov_b32 m0, %0"
               :"=&s"(keep):"v"(voff),"v"(v1),"v"(v2),"v"(v3),"s"(base),"s"(wt):"memory","scc");
}
__device__ __forceinline__ unsigned char* cv_dst(const CvCtx cx,int g,int wid,int lane){
  const int c=lane&31,h=lane>>5;
  if(g<16384){ const int e=g>>6,rr=g&63; return cx.d13+((size_t)e*512*1024+(size_t)(64*wid+4*(rr>>5))*1024+32*(rr&31))+(unsigned)(((c>>2)*8+(c&3))*1024+16*h); }
  const int g2=g-16384,e=g2>>5,rr=g2&31; return cx.d2+((size_t)e*1024*256+(size_t)(32*(8*(rr>>3)+wid))*256+32*(rr&7))+(unsigned)(c*256+16*h);
}
__device__ __forceinline__ void cv_consume(const CvCtx cx,int g,int wid,int lane,const u32x4 c0,const u32x4 c1,const u32x4 c2,const u32x4 c3,const bf16x8 id0,const bf16x8 id1){
  const int c=lane&31,h=lane>>5;
  #define CVF(u) __uint_as_float(u)
  const u32x4 a0={cvtpk_s(CVF(c0.x),CVF(c0.y)),cvtpk_s(CVF(c0.z),CVF(c0.w)),cvtpk_s(CVF(c1.x),CVF(c1.y)),cvtpk_s(CVF(c1.z),CVF(c1.w))};
  const u32x4 a1={cvtpk_s(CVF(c2.x),CVF(c2.y)),cvtpk_s(CVF(c2.z),CVF(c2.w)),cvtpk_s(CVF(c3.x),CVF(c3.y)),cvtpk_s(CVF(c3.z),CVF(c3.w))};
  #undef CVF
  f32x16 d=f32x16{};
  d=__builtin_amdgcn_mfma_f32_32x32x16_bf16(__builtin_bit_cast(bf16x8,a0),id0,d,0,0,0);
  d=__builtin_amdgcn_mfma_f32_32x32x16_bf16(__builtin_bit_cast(bf16x8,a1),id1,d,0,0,0);
  u32x4 o; o.x=pk4_fp8(d[0],d[1],d[2],d[3]); o.y=pk4_fp8(d[4],d[5],d[6],d[7]); o.z=pk4_fp8(d[8],d[9],d[10],d[11]); o.w=pk4_fp8(d[12],d[13],d[14],d[15]);
  unsigned char*dst=cv_dst(cx,g,wid,lane);
  *(u32x4*)dst=o;
}
constexpr int A2_KS=16384, A2_K=0, A2_V=32768, A2_WT=65536, A2_WS=131072, A2_IDT=133120, A2_STG=65536;
__device__ __forceinline__ int attn2_unit(const bf16*PROJ,const float*dg,bf16_t*MIX,char*shm,int bh,int qb,const float lam,const float m0,const CvCtx cx,int cnext,const int cend){
  const int tid=threadIdx.x,lane=tid&63,r32=lane&31,hi=lane>>5; const int wid=__builtin_amdgcn_readfirstlane(tid>>6);
  const int c=wid&1,qblk=wid>>1,b=bh>>2,h=bh&3; const long rowbase=(long)b*SEQ; const int q0=qb*128;
  const float sl2=exp2f(-2.f*(float)(h+1))*1.4426950408889634f;
  int tbeg=0; { const float kmin=(float)q0-(2.f*m0+40.f)/sl2; if(kmin>0.f)tbeg=((int)kmin)>>6; }
  const int NT=(q0+128)/KVBLK-tbeg;
  const bf16*Qw=PROJ+(rowbase+q0+qblk*32)*PQ+2048+h*128+c*64;
  const bf16*ksrc=PROJ+(rowbase+(long)tbeg*KVBLK+lane)*PQ+2560+h*128+wid*8;
  const bf16*vsrc=PROJ+(rowbase+(long)tbeg*KVBLK+16*(wid&3)+(lane>>2))*PQ+3072+h*128+(wid>>2)*32+(lane&3)*8;
  const unsigned lds0=(unsigned)(uintptr_t)shm;
  const unsigned kdst=lds0+A2_K+wid*1024, vdst=lds0+A2_V+wid*1024;
  #define A2_DMAK(t) do{ const bf16*kp_=ksrc+(long)(t)*KVBLK*PQ; const unsigned so_=(unsigned)((t)&1)*A2_KS; \
      glds16(kp_,(unsigned)__builtin_amdgcn_readfirstlane(kdst+so_)); glds16(kp_+64,(unsigned)__builtin_amdgcn_readfirstlane(kdst+so_+8192)); }while(0)
  #define A2_DMAV(t) do{ const bf16*vp_=vsrc+(long)(t)*KVBLK*PQ; const unsigned so_=(unsigned)((t)&1)*A2_KS; \
      glds16(vp_,(unsigned)__builtin_amdgcn_readfirstlane(vdst+so_)); glds16(vp_+64,(unsigned)__builtin_amdgcn_readfirstlane(vdst+so_+8192)); }while(0)
  A2_DMAK(0); A2_DMAV(0); A2_DMAK(1);
  bf16x8 qr[4];
  #pragma unroll
  for(int d0=0;d0<4;++d0)qr[d0]=*reinterpret_cast<const bf16x8*>(&Qw[(long)r32*PQ+d0*16+hi*8]);
  const int qrel=qblk*32+r32;
  const float sl64=sl2*64.f,c32=sl2*32.f;
  float l_reg=0.f; f32x16 o[4]; o[0]=f32x16{};o[1]=f32x16{};o[2]=f32x16{};o[3]=f32x16{}; f32x16 negm;
  { const float nb0=sl2*(float)(4*hi+64*tbeg-q0-qrel)-m0;
    #pragma unroll
    for(int r=0;r<16;++r)negm[r]=__builtin_fmaf(sl2,(float)((r&3)+8*(r>>2)),nb0); }
  const int vb0=(int)(lds0+A2_V)+((lane>>4)&1)*32+(lane&3)*8+(4*hi+((lane&15)>>2))*64;
  const unsigned kb0=lds0+A2_K+c*8192+hi*1024+r32*16;
  asm volatile(""::"v"(qr[0]),"v"(qr[1]),"v"(qr[2]),"v"(qr[3]));
  { asm volatile("s_waitcnt vmcnt(0)":::"memory"); asm volatile("s_barrier":::"memory"); }
  #define MF(A_,B_,C_) __builtin_amdgcn_mfma_f32_32x32x16_bf16(A_,B_,C_,0,0,0)
  #define PKW(P,B) cvtpk_s(P[B],P[B+1])
  #define A2_PACK(P0,P1) do{ float sacc=0.f; _Pragma("unroll") for(int r=0;r<16;++r)sacc+=P0[r]+P1[r]; l_reg+=sacc; \
      pw0=(u32x4){PKW(P0,0),PKW(P0,2),PKW(P0,4),PKW(P0,6)};pw1=(u32x4){PKW(P0,8),PKW(P0,10),PKW(P0,12),PKW(P0,14)}; \
      pw2=(u32x4){PKW(P1,0),PKW(P1,2),PKW(P1,4),PKW(P1,6)};pw3=(u32x4){PKW(P1,8),PKW(P1,10),PKW(P1,12),PKW(P1,14)}; }while(0)
  u32x4 pw0,pw1,pw2,pw3;
  { f32x16 p0,p1;
    qkt(p0,p1,kb0,qr,negm); asm volatile("s_nop 15\n\ts_nop 7":"+v"(p0),"+v"(p1));
    #pragma unroll
    for(int r=0;r<16;++r){p1[r]+=c32;negm[r]+=sl64;}
    { const int jb=0-(NT-2); if(jb>=0)cmask(p0,p1,jb,qrel,hi); }
    #pragma unroll
    for(int r=0;r<16;++r){p0[r]=__builtin_amdgcn_exp2f(p0[r]);p1[r]=__builtin_amdgcn_exp2f(p1[r]);}
    A2_PACK(p0,p1); }
  const unsigned wtl=(unsigned)__builtin_amdgcn_readfirstlane(lds0+A2_WT+wid*8192);
  const unsigned loff=(unsigned)((lane>>3)*1024+16*((lane&7)^(lane>>3)));
  const int prow=16*((r32>>2)&1)+(r32&3)+4*(r32>>3);
  const unsigned rd0=(unsigned)((prow>>3)*1024+(prow&7)*128+16*((2*hi)^(prow&7)));
  int cgA=-1,cgB=-1;
  asm volatile("s_waitcnt lgkmcnt(0)\n\ts_barrier":::"memory");
  if(NT>2)A2_DMAK(2);
  A2_DMAV(1);
  if(0<=NT-3&&cnext<cend){ cgA=cnext++; cv_issue_lds(cx,cgA,wid,loff,wtl); }
  for(int t=0;t+1<NT;++t){
    const unsigned kb=kb0+(unsigned)((t+1)&1)*A2_KS; const int vb=vb0+(t&1)*A2_KS;
    const bf16x8 pa0=__builtin_bit_cast(bf16x8,pw0),pa1=__builtin_bit_cast(bf16x8,pw1),pa2=__builtin_bit_cast(bf16x8,pw2),pa3=__builtin_bit_cast(bf16x8,pw3);
    bf16x8 k0,k1,k2,k3,k4,k5,k6,k7; s16x4 la[4],ha[4],lb[4],hb[4]; f32x16 n0,n1;
    #define QK_RD(K,OFF) asm volatile("ds_read_b128 %0,%1 offset:%c2":"=&v"(K):"v"(kb),"i"(OFF):"memory")
    #define PV_READ(L,H,OFF) do{ _Pragma("unroll") for(int ks=0;ks<4;++ks){ \
        asm volatile("ds_read_b64_tr_b16 %0,%1 offset:%c2":"=&v"(L[ks]):"v"(vb),"i"((OFF)+ks*1024):"memory"); \
        asm volatile("ds_read_b64_tr_b16 %0,%1 offset:%c2":"=&v"(H[ks]):"v"(vb),"i"((OFF)+ks*1024+512):"memory"); } }while(0)
    #define PV_PK(L,H,k) (bf16x8){L[k][0],L[k][1],L[k][2],L[k][3],H[k][0],H[k][1],H[k][2],H[k][3]}
    #define WK(N,A_,B_) asm volatile("s_waitcnt lgkmcnt(" #N ")":"+v"(A_),"+v"(B_)::"memory")
    #define WV(N,L,H) asm volatile("s_waitcnt lgkmcnt(" #N ")":"+v"(L[0]),"+v"(L[1]),"+v"(L[2]),"+v"(L[3]),"+v"(H[0]),"+v"(H[1]),"+v"(H[2]),"+v"(H[3])::"memory")
    #define PIN(X_) asm volatile("":"+v"(X_))
    #define EX(P,i) P[i]=__builtin_amdgcn_exp2f(P[i])
    QK_RD(k0,0);QK_RD(k1,512);QK_RD(k2,2048);QK_RD(k3,2560);QK_RD(k4,4096);QK_RD(k5,4608);QK_RD(k6,6144);QK_RD(k7,6656);
    PV_READ(la,ha,0);
    WK(14,k0,k1);SBAR(); n0=MF(k0,qr[0],negm);n1=MF(k1,qr[0],negm);PIN(n0);PIN(n1);SBAR();
    WK(12,k2,k3);SBAR(); n0=MF(k2,qr[1],n0);n1=MF(k3,qr[1],n1);PIN(n0);PIN(n1);SBAR();
    WK(10,k4,k5);SBAR(); n0=MF(k4,qr[2],n0);n1=MF(k5,qr[2],n1);PIN(n0);PIN(n1);SBAR();
    WK(8,k6,k7);SBAR();  n0=MF(k6,qr[3],n0);n1=MF(k7,qr[3],n1);PIN(n0);PIN(n1);SBAR();
    PV_READ(lb,hb,4096);
    WV(8,la,ha);SBAR();
    o[0]=MF(pa0,PV_PK(la,ha,0),o[0]);PIN(o[0]); negm[0]+=sl64;negm[1]+=sl64;negm[2]+=sl64;negm[3]+=sl64;negm[4]+=sl64;negm[5]+=sl64;negm[6]+=sl64;negm[7]+=sl64;PIN(negm); SBAR();
    o[0]=MF(pa1,PV_PK(la,ha,1),o[0]);PIN(o[0]); negm[8]+=sl64;negm[9]+=sl64;negm[10]+=sl64;negm[11]+=sl64;negm[12]+=sl64;negm[13]+=sl64;negm[14]+=sl64;negm[15]+=sl64;PIN(negm); SBAR();
    o[0]=MF(pa2,PV_PK(la,ha,2),o[0]);PIN(o[0]); n1[0]+=c32;n1[1]+=c32;n1[2]+=c32;n1[3]+=c32;n1[4]+=c32;n1[5]+=c32;n1[6]+=c32;n1[7]+=c32;PIN(n1); SBAR();
    o[0]=MF(pa3,PV_PK(la,ha,3),o[0]);PIN(o[0]); n1[8]+=c32;n1[9]+=c32;n1[10]+=c32;n1[11]+=c32;n1[12]+=c32;n1[13]+=c32;n1[14]+=c32;n1[15]+=c32;PIN(n1); SBAR();
    PV_READ(la,ha,8192);
    { const int jb=t+1-(NT-2); if(jb>=0){cmask(n0,n1,jb,qrel,hi);PIN(n0);PIN(n1);} }
    WV(8,lb,hb);SBAR();
    o[1]=MF(pa0,PV_PK(lb,hb,0),o[1]);PIN(o[1]); EX(n0,0);EX(n0,1);EX(n0,2);PIN(n0); SBAR();
    o[1]=MF(pa1,PV_PK(lb,hb,1),o[1]);PIN(o[1]); EX(n0,3);EX(n0,4);EX(n0,5);PIN(n0); SBAR();
    o[1]=MF(pa2,PV_PK(lb,hb,2),o[1]);PIN(o[1]); EX(n0,6);EX(n0,7);PIN(n0); SBAR();
    o[1]=MF(pa3,PV_PK(lb,hb,3),o[1]);PIN(o[1]); EX(n0,8);EX(n0,9);EX(n0,10);PIN(n0); SBAR();
    PV_READ(lb,hb,12288);
    WV(8,la,ha);SBAR();
    o[2]=MF(pa0,PV_PK(la,ha,0),o[2]);PIN(o[2]); EX(n0,11);EX(n0,12);EX(n0,13);PIN(n0); SBAR();
    o[2]=MF(pa1,PV_PK(la,ha,1),o[2]);PIN(o[2]); EX(n0,14);EX(n0,15);PIN(n0); SBAR();
    o[2]=MF(pa2,PV_PK(la,ha,2),o[2]);PIN(o[2]); EX(n1,0);EX(n1,1);EX(n1,2);PIN(n1); SBAR();
    o[2]=MF(pa3,PV_PK(la,ha,3),o[2]);PIN(o[2]); EX(n1,3);EX(n1,4);EX(n1,5);PIN(n1); SBAR();
    WV(0,lb,hb);SBAR();
    o[3]=MF(pa0,PV_PK(lb,hb,0),o[3]);PIN(o[3]); EX(n1,6);EX(n1,7);PIN(n1); SBAR();
    o[3]=MF(pa1,PV_PK(lb,hb,1),o[3]);PIN(o[3]); EX(n1,8);EX(n1,9);EX(n1,10);PIN(n1); SBAR();
    o[3]=MF(pa2,PV_PK(lb,hb,2),o[3]);PIN(o[3]); EX(n1,11);EX(n1,12);EX(n1,13);PIN(n1); SBAR();
    o[3]=MF(pa3,PV_PK(lb,hb,3),o[3]);PIN(o[3]); EX(n1,14);EX(n1,15);PIN(n1); SBAR();
    #undef WK
    #undef WV
    #undef PIN
    #undef QK_RD
    #undef PV_READ
    #undef PV_PK
    #undef EX
    A2_PACK(n0,n1);
    if(cgA>=0)asm volatile("s_waitcnt vmcnt(4)":::"memory"); else asm volatile("s_waitcnt vmcnt(0)":::"memory");
    if(cgB>=0){ const bf16x8*idt=(const bf16x8*)(shm+A2_IDT)+2*lane; const char*wt=shm+A2_WT+wid*8192+((t+1)&1)*4096;
      cv_consume(cx,cgB,wid,lane,*(const u32x4*)(wt+rd0),*(const u32x4*)(wt+(rd0^16)),*(const u32x4*)(wt+(rd0^64)),*(const u32x4*)(wt+(rd0^80)),idt[0],idt[1]); }
    asm volatile("s_waitcnt lgkmcnt(0)\n\ts_barrier":::"memory");
    if(t+3<NT)A2_DMAK(t+3);
    if(t+2<NT)A2_DMAV(t+2);
    cgB=cgA; cgA=-1;
    if(t+1<=NT-3&&cnext<cend){ cgA=cnext++; cv_issue_lds(cx,cgA,wid,loff,wtl+(unsigned)((t+1)&1)*4096u); }
  }
  pv4(o,vb0+((NT-1)&1)*A2_KS,__builtin_bit_cast(bf16x8,pw0),__builtin_bit_cast(bf16x8,pw1),__builtin_bit_cast(bf16x8,pw2),__builtin_bit_cast(bf16x8,pw3));
  asm volatile("s_waitcnt lgkmcnt(0)\n\ts_barrier":::"memory");
  #undef MF
  #undef PKW
  #undef A2_PACK
  asm volatile("s_waitcnt vmcnt(0)":::"memory");
  #undef A2_DMAK
  #undef A2_DMAV
  {auto rr=__builtin_amdgcn_permlane32_swap(__float_as_uint(l_reg),__float_as_uint(l_reg),false,false);l_reg=__uint_as_float(rr[0])+__uint_as_float(rr[1]);}
  float*wsf=(float*)(shm+A2_WS)+wid*64;
  if(hi==0)wsf[r32]=l_reg; asm volatile("s_waitcnt lgkmcnt(0)":::"memory");
  float rli[16];
  #pragma unroll
  for(int r=0;r<16;++r)rli[r]=__builtin_amdgcn_rcpf(wsf[crow(r,hi)]);
  float*X=(float*)shm+qblk*4096;
  if(c==1){
    #pragma unroll
    for(int d0=0;d0<4;++d0)
      #pragma unroll
      for(int r=0;r<16;++r)X[(d0*16+r)*64+lane]=o[d0][r]*rli[r];
  }
  asm volatile("s_waitcnt lgkmcnt(0)\n\ts_barrier":::"memory");
  if(c==0){
    bf16_t*stg=(bf16_t*)(shm+A2_STG)+qblk*4096;
    #pragma unroll
    for(int d0=0;d0<4;++d0)
      #pragma unroll
      for(int r=0;r<16;++r){ const float v=o[d0][r]*rli[r]-lam*X[(d0*16+r)*64+lane]; stg[crow(r,hi)*128+d0*32+r32]=(bf16_t)(__builtin_bit_cast(unsigned short,__float2bfloat16(v))); }
    asm volatile("s_waitcnt lgkmcnt(0)":::"memory");
    const int row=lane>>1,half=lane&1; const bf16_t*sp=stg+row*128+half*64;
    float d[64]; float ss=0.f;
    #pragma unroll
    for(int i=0;i<8;++i){ const u32x4 w=*(const u32x4*)(sp+8*i);
      d[8*i+0]=__uint_as_float(w.x<<16);d[8*i+1]=__uint_as_float(w.x&0xffff0000u);d[8*i+2]=__uint_as_float(w.y<<16);d[8*i+3]=__uint_as_float(w.y&0xffff0000u);
      d[8*i+4]=__uint_as_float(w.z<<16);d[8*i+5]=__uint_as_float(w.z&0xffff0000u);d[8*i+6]=__uint_as_float(w.w<<16);d[8*i+7]=__uint_as_float(w.w&0xffff0000u); }
    #pragma unroll
    for(int i=0;i<64;++i)ss+=d[i]*d[i];
    ss+=__shfl_xor(ss,1);
    const float rs=rsqrtf(ss*(1.f/128.f)+1e-6f)*0.8f;
    bf16_t*mp=MIX+(rowbase+q0+qblk*32+row)*1024+512+h*128+half*64; const float*gp=dg+half*64;
    #pragma unroll
    for(int i=0;i<8;++i){ u32x4 w;
      w.x=cvtpk_s(d[8*i+0]*rs*gp[8*i+0],d[8*i+1]*rs*gp[8*i+1]); w.y=cvtpk_s(d[8*i+2]*rs*gp[8*i+2],d[8*i+3]*rs*gp[8*i+3]);
      w.z=cvtpk_s(d[8*i+4]*rs*gp[8*i+4],d[8*i+5]*rs*gp[8*i+5]); w.w=cvtpk_s(d[8*i+6]*rs*gp[8*i+6],d[8*i+7]*rs*gp[8*i+7]);
      *(u32x4*)(mp+8*i)=w; }
  }
  asm volatile("s_waitcnt lgkmcnt(0)\n\ts_barrier":::"memory");
  return cnext;
}
constexpr int ATTN_LDS_BYTES=LDS_BYTES;
#undef SBAR
#undef WAIT_BAR
}

__device__ __forceinline__ unsigned wave_umax(unsigned x) {
    x = max(x, (unsigned)__builtin_amdgcn_update_dpp(0, (int)x, 0x111, 0xf, 0xf, false));
    x = max(x, (unsigned)__builtin_amdgcn_update_dpp(0, (int)x, 0x112, 0xf, 0xf, false));
    x = max(x, (unsigned)__builtin_amdgcn_update_dpp(0, (int)x, 0x114, 0xf, 0xf, false));
    x = max(x, (unsigned)__builtin_amdgcn_update_dpp(0, (int)x, 0x118, 0xf, 0xf, false));
    x = max(x, (unsigned)__builtin_amdgcn_update_dpp(0, (int)x, 0x142, 0xa, 0xf, false));
    x = max(x, (unsigned)__builtin_amdgcn_update_dpp(0, (int)x, 0x143, 0xc, 0xf, false));
    return (unsigned)__builtin_amdgcn_readlane((int)x, 63);
}
__device__ __forceinline__ unsigned sel_key(float v, int idx) { unsigned u = __float_as_uint(v); u = (u & 0x80000000u) ? ~u : (u | 0x80000000u); return (u & 0xffffff00u) | (unsigned)(255 - idx); }

__device__ __forceinline__ void ph_route(const Args& a, unsigned char* lds, const int tid) {
    const int lane = tid & 63, wave = tid >> 6;
    int* hist = (int*)lds;
    const float* LOG = (const float*)(a.ws + WS_LOGITS); const float* rb = a.in[18];
    int* IDX = (int*)(a.ws + WS_IDX); float* GATEV = (float*)(a.ws + WS_GATEV); int* HIST = (int*)(a.ws + WS_HIST);
    unsigned* TOT = (unsigned*)(a.ws + WS_BAR) + 3456;
    const f32x4 rb4 = *((const f32x4*)rb + lane);
    for (int tb = blockIdx.x; tb < 256; tb += gridDim.x) {
        if (tid < 256) hist[tid] = 0;
        __syncthreads();
        f32x4 lgn = *((const f32x4*)(LOG + (size_t)(tb * 128 + wave * 16) * 256) + lane);
        for (int i = 0; i < 16; ++i) {
            const int t = tb * 128 + wave * 16 + i;
            const f32x4 lg = lgn;
            if (i < 15) lgn = *((const f32x4*)(LOG + (size_t)(t + 1) * 256) + lane);
            float s[4], sel[4];
            s[0] = sigm(lg.x); s[1] = sigm(lg.y); s[2] = sigm(lg.z); s[3] = sigm(lg.w);
            sel[0] = s[0] + rb4.x; sel[1] = s[1] + rb4.y; sel[2] = s[2] + rb4.z; sel[3] = s[3] + rb4.w;
            float m1 = fmaxf(sel[0], sel[1]), m2 = fminf(sel[0], sel[1]);
            { const float x = sel[2]; const float n1 = fmaxf(m1, x); m2 = fmaxf(m2, fminf(m1, x)); m1 = n1; }
            { const float x = sel[3]; const float n1 = fmaxf(m1, x); m2 = fmaxf(m2, fminf(m1, x)); m1 = n1; }
#pragma unroll
            for (int off = 1; off < 8; off <<= 1) { const float o1 = __shfl_xor(m1, off), o2 = __shfl_xor(m2, off);
                const float n1 = fmaxf(m1, o1), n2 = fmaxf(fminf(m1, o1), fmaxf(m2, o2)); m1 = n1; m2 = n2; }
            const float gs = m1 + m2; const int grp = lane >> 3; int rank = 0;
#pragma unroll
            for (int g2 = 0; g2 < 8; ++g2) { const float v = __builtin_bit_cast(float, __builtin_amdgcn_readlane(__builtin_bit_cast(int, gs), 8 * g2)); rank += ((v > gs) || (v == gs && g2 < grp)) ? 1 : 0; }
            const bool gsel = rank < 4;
            unsigned key[4];
#pragma unroll
            for (int j = 0; j < 4; ++j) key[j] = gsel ? sel_key(sel[j], 4 * lane + j) : 0u;
            float gsum = 0.f; float myg = 0.f; int myidx = 0;
#pragma unroll
            for (int k = 0; k < 8; ++k) {
                const unsigned best = wave_umax(max(max(key[0], key[1]), max(key[2], key[3])));
                const int bi = 255 - (int)(best & 255u);
                const int owner = bi >> 2, sub = bi & 3;
                float sv = (sub == 0) ? s[0] : (sub == 1) ? s[1] : (sub == 2) ? s[2] : s[3];
                sv = __builtin_bit_cast(float, __builtin_amdgcn_readlane(__builtin_bit_cast(int, sv), owner));
                if (lane == owner) {
#pragma unroll
                    for (int j = 0; j < 4; ++j) if (j == sub) key[j] = 0u;
                }
                gsum += sv;
                if (lane == k) { myg = sv; myidx = bi; }
            }
            if (lane < 8) { IDX[(size_t)t * 8 + lane] = myidx; GATEV[(size_t)t * 8 + lane] = myg / gsum * 2.5f; atomicAdd(&hist[myidx], 1); }
        }
        __syncthreads();
        if (tid < 256) { const int hv = hist[tid]; HIST[tb * 256 + tid] = hv; if (hv) atomicAdd(TOT + tid, (unsigned)hv); }
        __syncthreads();
    }
}

__device__ __forceinline__ void ph_scatter(const Args& a, unsigned char* lds, const int tid) {
    int* tot = (int*)lds; int* cur = tot + 256; int* base = cur + 256; int* tstart = base + 256;
    const int* HIST = (const int*)(a.ws + WS_HIST); const int* IDX = (const int*)(a.ws + WS_IDX); const float* GATEV = (const float*)(a.ws + WS_GATEV);
    int* PSLOT = (int*)(a.ws + WS_PSLOT); int* SLOTTOK = (int*)(a.ws + WS_SLOTTOK); float* SLOTGATE = (float*)(a.ws + WS_SLOTGATE);
    int* TILE = (int*)(a.ws + WS_TILE);
    unsigned* TOT = (unsigned*)(a.ws + WS_BAR) + 3456; unsigned* CUR = TOT + 256;
    for (int tb = blockIdx.x; tb < 256; tb += gridDim.x) {
        __syncthreads();
        if (tid < 256) tot[tid] = (int)__hip_atomic_load(TOT + tid, __ATOMIC_RELAXED, __HIP_MEMORY_SCOPE_AGENT);
        __syncthreads();
        if (tid < 256) { int bs = 0, ts = 0; for (int j = 0; j < tid; ++j) { const int c = tot[j]; bs += c; ts += (c + 255) >> 8; } base[tid] = bs; tstart[tid] = ts;
            const int mine = HIST[tb * 256 + tid]; cur[tid] = bs + (mine ? (int)atomicAdd(CUR + tid, (unsigned)mine) : 0); }
        __syncthreads();
        for (int p = tid; p < 1024; p += 512) { const int t = tb * 128 + (p >> 3), k = p & 7; const int e = IDX[(size_t)t * 8 + k];
            const int slot = atomicAdd(&cur[e], 1); SLOTTOK[slot] = t; SLOTGATE[slot] = GATEV[(size_t)t * 8 + k]; PSLOT[(size_t)t * 8 + k] = slot; }
        if (tb == 0) {
            if (tid < 256) { const int cnt = tot[tid], b0 = base[tid]; int n = tstart[tid];
                for (int r0 = 0; r0 < cnt; r0 += 256) { TILE[64 + n] = tid; TILE[64 + 2048 + n] = b0 + r0; TILE[64 + 4096 + n] = b0 + cnt; ++n; }
                if (tid == 255) TILE[0] = n; }
            __syncthreads();
            if (tid < 128) { const int n = tstart[255] + ((tot[255] + 255) >> 8);
                TILE[64 + n + tid] = 256; TILE[64 + 2048 + n + tid] = SHARED_BASE + 256 * tid; TILE[64 + 4096 + n + tid] = SHARED_BASE + T; }
        }
    }
}

template <int MODE>
__device__ __forceinline__ void ph_final(const Args& a, const int tid) {
    const int lane = tid & 63, wave = tid >> 6;
    const unsigned char* YP = (const unsigned char*)(a.ws + WS_YP); const int* PSLOT = (const int*)(a.ws + WS_PSLOT); const float* MOD = (const float*)(a.ws + WS_MOD);
    float* out = a.out;
    const int gw = blockIdx.x * 8 + wave, NGW = gridDim.x * 8;
    const int sub = lane & 15, rsel = lane >> 4;
    int nslot = 0;
    { const int r0 = gw + (rsel == 1 ? NGW : 0); if (rsel < 2 && sub < 9 && r0 < T) nslot = sub < 8 ? PSLOT[(size_t)r0 * 8 + sub] : SHARED_BASE + r0; }
    for (int row = gw; row < T; row += 2 * NGW) {
        const int myslot = nslot;
        { const int r1 = row + 2 * NGW + (rsel == 1 ? NGW : 0); if (rsel < 2 && sub < 9 && r1 < T) nslot = sub < 8 ? PSLOT[(size_t)r1 * 8 + sub] : SHARED_BASE + r1; }
#pragma unroll
        for (int half = 0; half < 2; ++half) {
            const int rw = row + half * NGW;
            if (rw < T) {
                const int b = rw / SEQ;
                float* o0 = out + (size_t)rw * DM + 8 * lane; float* o1 = o0 + 512;
                const bf16_t* xr = (const bf16_t*)(a.ws + WS_X1B) + (size_t)rw * DM + 8 * lane;
                const u32x4 xw0 = __builtin_nontemporal_load((const u32x4*)xr), xw1 = __builtin_nontemporal_load((const u32x4*)(xr + 512));
                const f32x4 xa = {bflo(xw0.x), bfhi(xw0.x), bflo(xw0.y), bfhi(xw0.y)}, xb = {bflo(xw0.z), bfhi(xw0.z), bflo(xw0.w), bfhi(xw0.w)}, xc = {bflo(xw1.x), bfhi(xw1.x), bflo(xw1.y), bfhi(xw1.y)}, xd = {bflo(xw1.z), bfhi(xw1.z), bflo(xw1.w), bfhi(xw1.w)};
                float acc[16];
#pragma unroll
                for (int i = 0; i < 16; ++i) acc[i] = 0.f;
                u32x2 w0[9], w1[9];
#pragma unroll
                for (int k = 0; k < 9; ++k) { const int slot = __shfl(myslot, 16 * half + k); const unsigned char* yp = YP + (size_t)slot * DM; w0[k] = __builtin_nontemporal_load((const u32x2*)(yp + 8 * lane)); w1[k] = __builtin_nontemporal_load((const u32x2*)(yp + 512 + 8 * lane)); }
#pragma unroll
                for (int k = 0; k < 9; ++k) {
                    { const auto a0 = __builtin_amdgcn_cvt_pk_f32_fp8((int)w0[k].x, false), a1 = __builtin_amdgcn_cvt_pk_f32_fp8((int)w0[k].x, true), a2 = __builtin_amdgcn_cvt_pk_f32_fp8((int)w0[k].y, false), a3 = __builtin_amdgcn_cvt_pk_f32_fp8((int)w0[k].y, true);
                      acc[0] += a0[0]; acc[1] += a0[1]; acc[2] += a1[0]; acc[3] += a1[1]; acc[4] += a2[0]; acc[5] += a2[1]; acc[6] += a3[0]; acc[7] += a3[1]; }
                    { const auto a0 = __builtin_amdgcn_cvt_pk_f32_fp8((int)w1[k].x, false), a1 = __builtin_amdgcn_cvt_pk_f32_fp8((int)w1[k].x, true), a2 = __builtin_amdgcn_cvt_pk_f32_fp8((int)w1[k].y, false), a3 = __builtin_amdgcn_cvt_pk_f32_fp8((int)w1[k].y, true);
                      acc[8] += a0[0]; acc[9] += a0[1]; acc[10] += a1[0]; acc[11] += a1[1]; acc[12] += a2[0]; acc[13] += a2[1]; acc[14] += a3[0]; acc[15] += a3[1]; } }
                const float* gf = MOD + b * 6144 + 5 * 1024 + 8 * lane;
                const f32x4 g0 = *(const f32x4*)gf * (1.f / 16.f), g1 = *(const f32x4*)(gf + 4) * (1.f / 16.f), g2 = *(const f32x4*)(gf + 512) * (1.f / 16.f), g3 = *(const f32x4*)(gf + 516) * (1.f / 16.f);
                f32x4 ya = xa, yb = xb, yc = xc, yd = xd;
                ya.x += g0.x * acc[0]; ya.y += g0.y * acc[1]; ya.z += g0.z * acc[2]; ya.w += g0.w * acc[3];
                yb.x += g1.x * acc[4]; yb.y += g1.y * acc[5]; yb.z += g1.z * acc[6]; yb.w += g1.w * acc[7];
                yc.x += g2.x * acc[8]; yc.y += g2.y * acc[9]; yc.z += g2.z * acc[10]; yc.w += g2.w * acc[11];
                yd.x += g3.x * acc[12]; yd.y += g3.y * acc[13]; yd.z += g3.z * acc[14]; yd.w += g3.w * acc[15];
                if (MODE == 0) { __builtin_nontemporal_store(ya, (f32x4*)o0); __builtin_nontemporal_store(yb, (f32x4*)(o0 + 4)); __builtin_nontemporal_store(yc, (f32x4*)o1); __builtin_nontemporal_store(yd, (f32x4*)(o1 + 4)); }
                else asm volatile("" :: "v"(ya), "v"(yb), "v"(yc), "v"(yd));
            }
        }
    }
}

#define LAS __attribute__((address_space(3)))
#define XB_TMO      128
#define XB_XCNT(j)  (256  + 64 * (j))
#define XB_XSUB(j)  (1280 + 64 * (j))
#define XB_XGEN(j)  (2304 + 64 * (j))
#define XB_TOP      3328
#define XB_TOPGEN   3392
#define XB_SPIN_CAP (1u << 27)
__device__ __forceinline__ unsigned xb_ld(unsigned* p)              { return __hip_atomic_load(p, __ATOMIC_RELAXED, __HIP_MEMORY_SCOPE_AGENT); }
__device__ __forceinline__ unsigned xb_add(unsigned* p, unsigned v) { return __hip_atomic_fetch_add(p, v, __ATOMIC_RELAXED, __HIP_MEMORY_SCOPE_AGENT); }
__device__ __forceinline__ unsigned xb_xcc_id() { return (unsigned)__builtin_amdgcn_s_getreg((3 << 11) | 20) & 0xFu; }
#define XB_SPIN(cond, bar) do { unsigned _sp = 0; while (cond) { __builtin_amdgcn_s_sleep(1); \
    if ((++_sp & 255u) == 0u) { if (xb_ld(&(bar)[XB_TMO])) break; if (_sp > XB_SPIN_CAP) { atomicAdd(&(bar)[XB_TMO], 1u); break; } } } } while (0)
struct XcdBarrier { unsigned* bar; unsigned x; volatile LAS unsigned* st; };
__device__ __forceinline__ XcdBarrier xcd_barrier_post(unsigned* bar, volatile LAS unsigned* st, const bool t0) {
    XcdBarrier b; b.bar = bar; b.x = xb_xcc_id(); b.st = st;
    if (t0) (void)xb_add(&bar[XB_XCNT(b.x)], 1u);
    return b;
}
__device__ __forceinline__ void xcd_barrier_complete(unsigned* bar, unsigned x, unsigned& nloc, unsigned& nx) {
    const unsigned G = gridDim.x * gridDim.y * gridDim.z;
    unsigned sum, cnt, mine, sp = 0u;
    for (;;) {
        sum = 0u; cnt = 0u; mine = 0u;
#pragma unroll
        for (unsigned j = 0; j < 16; ++j) { const unsigned c = xb_ld(&bar[XB_XCNT(j)]); sum += c; cnt += (c > 0u) ? 1u : 0u; mine = (j == x) ? c : mine; }
        if (sum == G) break;
        __builtin_amdgcn_s_sleep(1);
        if ((++sp & 255u) == 0u) { if (xb_ld(&bar[XB_TMO])) break; if (sp > XB_SPIN_CAP) { atomicAdd(&bar[XB_TMO], 1u); break; } }
    }
    nloc = mine > 0u ? mine : 1u; nx = cnt > 0u ? cnt : 1u;
}
__device__ __forceinline__ void xcd_barrier(const XcdBarrier& b, const bool t0) {
    asm volatile("s_waitcnt vmcnt(0)" ::: "memory");
    __syncthreads();
    if (t0) {
        unsigned* bar = b.bar;
        __builtin_amdgcn_s_waitcnt(0);
        unsigned nloc = b.st[0], nx = b.st[1];
        if (nloc == 0u) { xcd_barrier_complete(bar, b.x, nloc, nx); b.st[0] = nloc; b.st[1] = nx; }
        const unsigned old = xb_add(&bar[XB_XSUB(b.x)], 1u);
        const unsigned gen = old / nloc;
        if (old + 1u == (gen + 1u) * nloc) {
            __builtin_amdgcn_fence(__ATOMIC_RELEASE, "agent");
            asm volatile("s_waitcnt vmcnt(0)" ::: "memory");
            const unsigned og = xb_add(&bar[XB_TOP], 1u);
            const unsigned tg = og / nx;
            if (og + 1u == (tg + 1u) * nx) xb_add(&bar[XB_TOPGEN], 1u);
            else XB_SPIN(xb_ld(&bar[XB_TOPGEN]) == tg, bar);
            __builtin_amdgcn_fence(__ATOMIC_ACQUIRE, "agent");
            xb_add(&bar[XB_XGEN(b.x)], 1u);
            asm volatile("s_waitcnt vmcnt(0)" ::: "memory");
        } else {
            XB_SPIN(xb_ld(&bar[XB_XGEN(b.x)]) == gen, bar);
            __builtin_amdgcn_fence(__ATOMIC_ACQUIRE, "agent");
            asm volatile("s_waitcnt vmcnt(0)" ::: "memory");
        }
    }
    __syncthreads();
}


__global__ void __launch_bounds__(512) mega(Args a) {
    extern __shared__ __attribute__((aligned(16))) unsigned char lds[];
    const int lo = a.ph_lo, hi = a.ph_hi;
    const int wave_s = __builtin_amdgcn_readfirstlane((int)threadIdx.x >> 6);
#define tid mk_tid(wave_s)
    volatile LAS unsigned* bst = (volatile LAS unsigned*)((LAS unsigned char*)lds + (LDS_BYTES - 64));
    if (tid < 16) bst[tid] = 0u;
    __syncthreads();
    XcdBarrier bar = xcd_barrier_post((unsigned*)(a.ws + WS_BAR), bst, tid == 0);
#define IN(k) (lo <= (k) && (k) < hi)
#define SEAM(k) do { if (IN(k) && IN((k) + 1)) xcd_barrier(bar, tid == 0); } while (0)

    if (IN(0)) { ph0(a, lds, tid); } SEAM(0);
    if (IN(1)) { ph_norm<true>(a, lds, a.in[0], 0, 1, tid); } SEAM(1);
    if (IN(2)) {
        float* gtab = (float*)(lds + 135168);
        { const int t_ = tid; if (t_ < 64) gtab[t_] = a.in[9][t_] * C2; else if (t_ < 128) gtab[t_] = a.in[10][t_ - 64]; }
        const EpiProj E{(bf16_t*)(a.ws + WS_PROJ), gtab};
        { pg8::DenseSched S; S.init(a.ws + WS_H8, a.ws + WS_WIN, T, NPROJ, DM, (int)gridDim.x, (int)blockIdx.x); __syncthreads();
          pg8::gemm_phase<false, true, 0x79797979, 0x7f7f7f7f, 2>((PG8_LAS unsigned char*)lds, DM, S, E); }
    } SEAM(2);
    if (IN(3)) { for (int u = blockIdx.x; u < 1024; u += gridDim.x) mlstm_m1_unit(a, lds, u, wave_s);
 } SEAM(3);
    if (IN(4)) { mlstm_m2(a, tid); } SEAM(4);
    if (IN(5)) {
        { float lam; { float s1 = 0.f, s2 = 0.f; const float* q1 = a.in[11]; const float* k1 = a.in[12]; const float* q2 = a.in[13]; const float* k2 = a.in[14];
              for (int i = 0; i < 64; ++i) { s1 += q1[i] * k1[i]; s2 += q2[i] * k2[i]; } lam = expf(s1) - expf(s2) + LAM_INIT; }
          float m0; { float gq = 0.f, gk = 0.f; for (int i = 0; i < 64; ++i) { gq = fmaxf(gq, fabsf(a.in[9][i])); gk = fmaxf(gk, fabsf(a.in[10][i])); } m0 = 64.f * C2 * gq * gk * 1.01f + 0.01f; }
          unsigned* qhead = (unsigned*)(a.ws + WS_BAR) + 4001;
          const attn_body::CvCtx cx{a.in[19], a.in[20], a.in[21], (unsigned char*)(a.ws + WS_W13T), (unsigned char*)(a.ws + WS_W2T)};
          const int cper = (attn_body::CV_GROUPS + (int)gridDim.x - 1) / (int)gridDim.x;
          int cnext = min(attn_body::CV_GROUPS, (int)blockIdx.x * cper); const int cend = min(attn_body::CV_GROUPS, cnext + cper);
          if (tid < 64) {
              const int jj0 = (tid & 31) - 8 * (tid >> 5), jj1 = jj0 - 16; u32x4 w0, w1;
#define IDW(jj, q) (((jj) >= 0 && (jj) < 8 && ((jj) >> 1) == (q)) ? (((jj) & 1) ? 0x42800000u : 0x00004280u) : 0u)
              w0 = (u32x4){IDW(jj0, 0), IDW(jj0, 1), IDW(jj0, 2), IDW(jj0, 3)}; w1 = (u32x4){IDW(jj1, 0), IDW(jj1, 1), IDW(jj1, 2), IDW(jj1, 3)};
#undef IDW
              u32x4* idt = (u32x4*)((char*)lds + attn_body::A2_IDT) + 2 * tid; idt[0] = w0; idt[1] = w1; }
          for (;;) {
              __syncthreads();
              if (tid == 0) bst[8] = atomicAdd(qhead, 1u);
              __syncthreads();
              const int idx = (int)bst[8];
              if (idx >= 1024) break;
              const int qb = 63 - (idx >> 4), j = idx & 15, bh = (j & 3) * 4 + (3 - (j >> 2));
              cnext = attn_body::attn2_unit((const attn_body::bf16*)(a.ws + WS_PROJ), a.in[15], (bf16_t*)(a.ws + WS_MIX), (char*)lds, bh, qb, lam, m0, cx, cnext, cend);
          }
          {
              const int lane = tid & 63, wid = __builtin_amdgcn_readfirstlane(tid >> 6); const int r32 = lane & 31, hi = lane >> 5;
              if (cnext < cend) {
                  const attn_body::bf16x8* idt = (const attn_body::bf16x8*)((char*)lds + attn_body::A2_IDT) + 2 * lane; const attn_body::bf16x8 id0 = idt[0], id1 = idt[1];
#pragma unroll 1
                  for (; cnext < cend; ++cnext) { u32x4 c0, c1, c2, c3; attn_body::cv_issue(cx, cnext, wid, lane, c0, c1, c2, c3); attn_body::cv_consume(cx, cnext, wid, lane, c0, c1, c2, c3, id0, id1); }
              }
          }
          __syncthreads();
          {
              __syncthreads();
              if (tid == 0) bst[8] = atomicAdd(qhead + 1, 1u);
              __syncthreads();
              int u = (int)bst[8];
              M3In r;
              if (u < 1024) m3_issue(a, u, tid, r);
              while (u < 1024) { mlstm_m3_unit(a, lds, u, wave_s, r, qhead + 1, bst + 9); u = (int)bst[9]; __syncthreads(); }
          }
          __syncthreads(); }
    } SEAM(5);
    if (IN(6)) {
        const EpiOut E{a.in[0], (bf16_t*)(a.ws + WS_X1B), (const float*)(a.ws + WS_MOD)};
        { pg8::DenseSched S; S.init(a.ws + WS_MIX, a.ws + WS_WOUT, T, DM, 2 * DM, (int)gridDim.x, (int)blockIdx.x); __syncthreads();
          pg8::gemm_phase<false, false, 0, 0, 0>((PG8_LAS unsigned char*)lds, 2 * DM, S, E); }
    } SEAM(6);
    if (IN(7)) { ph_norm<false>(a, lds, a.out, 3, 4, tid); } SEAM(7);
    if (IN(8)) {
        const EpiRS E{(float*)(a.ws + WS_LOGITS), (bf16_t*)(a.ws + WS_ACT)};
        { pg8::DenseSched S; S.init(a.ws + WS_H, a.ws + WS_WRS, T, 768, 2 * DM, (int)gridDim.x, (int)blockIdx.x); __syncthreads();
          pg8::gemm_phase<false, false, 0, 0, 0>((PG8_LAS unsigned char*)lds, 2 * DM, S, E); }
    } SEAM(8);
    if (IN(9)) { ph_route(a, lds, tid); } SEAM(9);
    if (IN(10)) { ph_scatter(a, lds, tid); } SEAM(10);
    if (IN(11)) {
        const int* TILE = (const int*)(a.ws + WS_TILE); const int ntile = TILE[0];
        const EpiG1 E{(const float*)(a.ws + WS_SLOTGATE), (bf16_t*)(a.ws + WS_ACT)};
        { const int G = (int)gridDim.x, bx = (int)blockIdx.x, vcu = (G % 8 == 0) ? (bx % 8) * (G / 8) + bx / 8 : bx;
          const pg8::ExpertSched S{TILE, ntile * 2, 2, (const char*)(a.ws + WS_H8), (const int*)(a.ws + WS_SLOTTOK), (const char*)(a.ws + WS_W13T), (size_t)512 * 1024, DM, G, vcu};
          __syncthreads(); pg8::gemm_phase<true, true, 0x79797979, 0x7f7f7f7f, 0>((PG8_LAS unsigned char*)lds, DM, S, E); }
    } SEAM(11);
    if (IN(12)) {
        const int* TILE = (const int*)(a.ws + WS_TILE); const int ntile = TILE[0] + 128;
        const EpiG2 E{(bf16_t*)(a.ws + WS_YP)};
        { const int G = (int)gridDim.x, bx = (int)blockIdx.x, vcu = (G % 8 == 0) ? (bx % 8) * (G / 8) + bx / 8 : bx;
          const pg8::ExpertSched S{TILE, ntile * 4, 4, (const char*)(a.ws + WS_ACT), nullptr, (const char*)(a.ws + WS_W2T), (size_t)1024 * 256, 256, G, vcu};
          __syncthreads(); pg8::gemm_phase<false, true, 0x79797979, 0x7c7c7c7c, 1>((PG8_LAS unsigned char*)lds, 256, S, E); }
    } SEAM(12);
    if (IN(13)) {
        ph_final<0>(a, tid); }
#undef IN
#undef SEAM
#undef tid
}

extern "C" void kernel_launch(void* const* d_in, const int* in_sizes, int n_in, void* d_out, int out_size, void* d_ws, size_t ws_size, hipStream_t stream) {
    static int grid = 0;
    if (grid == 0) {
        if (n_in != 25 || in_sizes[0] != T * DM || out_size != T * DM || ws_size < WS_END) {
            fprintf(stderr, "kernel_launch: unexpected problem (n_in %d, in0 %d, out %d, ws %zu < %zu)\n", n_in, n_in > 0 ? in_sizes[0] : -1, out_size, ws_size, (size_t)WS_END); grid = -1; return; }
        int dev = 0, cus = 0, per_cu = 0;
        (void)hipGetDevice(&dev);
        (void)hipDeviceGetAttribute(&cus, hipDeviceAttributeMultiprocessorCount, dev);
        if (hipFuncSetAttribute((const void*)mega, hipFuncAttributeMaxDynamicSharedMemorySize, LDS_BYTES) != hipSuccess) { fprintf(stderr, "kernel_launch: hipFuncSetAttribute failed\n"); grid = -1; return; }
        if (hipOccupancyMaxActiveBlocksPerMultiprocessor(&per_cu, (const void*)mega, 512, LDS_BYTES) != hipSuccess || per_cu < 1) { fprintf(stderr, "kernel_launch: occupancy query says %d blocks/CU\n", per_cu); grid = -1; return; }
        grid = cus;
    }
    if (grid < 0) return;
    (void)hipMemsetAsync((char*)d_ws + WS_BAR, 0, BAR_BYTES, stream);
    Args a{};
    for (int i = 0; i < 25; ++i) a.in[i] = (const float*)d_in[i];
    a.out = (float*)d_out; a.ws = (unsigned char*)d_ws;
    a.ph_lo = 0; a.ph_hi = NPH;
    void* args[] = {&a};
    hipError_t e = hipLaunchCooperativeKernel((const void*)mega, dim3(grid), dim3(512), args, LDS_BYTES, stream);
    if (e != hipSuccess) fprintf(stderr, "cooperative launch failed: %s (grid %d)\n", hipGetErrorString(e), grid);
}
```

```cpp
#include <hip/hip_runtime.h>
#include <cstdio>
#include <cstdint>

typedef unsigned short bf16_t;
typedef short bf16x8 __attribute__((ext_vector_type(8)));
typedef float f32x4 __attribute__((ext_vector_type(4)));
typedef unsigned u32x4 __attribute__((ext_vector_type(4)));
typedef unsigned u32x2 __attribute__((ext_vector_type(2)));


constexpr int T = 32768, DM = 1024, SEQ = 8192;
constexpr int NPROJ = 3584, DIN = 3592;
constexpr int TOPK = 8, TK = T * TOPK;
constexpr int SHARED_BASE = TK;
constexpr float EPS = 1e-6f;
constexpr float LOG2E = 1.4426950408889634f;
constexpr float C2 = 0.125f * LOG2E;
constexpr float LAM_INIT = 0.2f;
constexpr int NPH = 14;
constexpr int LDS_BYTES = 155648;

constexpr size_t MiB = 1ull << 20;
constexpr size_t WS_MOD = 0;
constexpr size_t WS_TILE = 128 * 1024;
constexpr size_t WS_HIST = 256 * 1024;
constexpr size_t WS_BAR = 512 * 1024;
constexpr size_t BAR_BYTES = 16384;
constexpr size_t WS_IPRE = 1 * MiB, WS_FPRE = 1 * MiB + 512 * 1024;
constexpr size_t WS_IDX = 2 * MiB, WS_GATEV = 3 * MiB, WS_PSLOT = 4 * MiB, WS_SLOTTOK = 5 * MiB, WS_SLOTGATE = 7 * MiB;
constexpr size_t WS_MST = 9 * MiB;
constexpr size_t WS_WIN = 12 * MiB, WS_WOUT = 19 * MiB, WS_WRS = 21 * MiB, WS_W2T = 23 * MiB;
constexpr size_t WS_H = 152 * MiB, WS_ACT = 216 * MiB, WS_MIX = 361 * MiB, WS_PROJ = 425 * MiB, WS_CLOC = 649 * MiB, WS_CIN = 713 * MiB, WS_W13T = 745 * MiB, WS_END = 1001 * MiB;
constexpr size_t WS_WS13F8 = WS_WRS + (size_t)768 * 1024 * 2;
constexpr size_t WS_WRB = 122 * MiB, WS_CB = 125 * MiB, WS_RSTD = 126 * MiB;
constexpr size_t WS_H8 = 89 * MiB;
constexpr size_t WS_YP = WS_MIX;
constexpr size_t WS_LOGITS = WS_CLOC;
constexpr size_t WS_X1B = 681 * MiB;
constexpr size_t WS_TMP = WS_ACT;

struct Args { const float* in[25]; float* out; unsigned char* ws; int ph_lo, ph_hi; };

__device__ __forceinline__ int mk_tid(int wave_s) { int l; asm volatile("v_mbcnt_lo_u32_b32 %0, -1, 0\n\tv_mbcnt_hi_u32_b32 %0, -1, %0" : "=v"(l)); return (wave_s << 6) | l; }

__device__ __forceinline__ float bflo(unsigned v) { return __uint_as_float(v << 16); }
__device__ __forceinline__ float bfhi(unsigned v) { return __uint_as_float(v & 0xffff0000u); }
__device__ __forceinline__ unsigned f2bf(float f) { unsigned u = __float_as_uint(f); return (u + 0x7fffu + ((u >> 16) & 1u)) >> 16; }
__device__ __forceinline__ unsigned pk2(float lo, float hi) { return f2bf(lo) | (f2bf(hi) << 16); }
__device__ __forceinline__ float wave_sum(float v) {
    v += __builtin_bit_cast(float, __builtin_amdgcn_update_dpp(0, __builtin_bit_cast(int, v), 0x111, 0xf, 0xf, false));
    v += __builtin_bit_cast(float, __builtin_amdgcn_update_dpp(0, __builtin_bit_cast(int, v), 0x112, 0xf, 0xf, false));
    v += __builtin_bit_cast(float, __builtin_amdgcn_update_dpp(0, __builtin_bit_cast(int, v), 0x114, 0xf, 0xf, false));
    v += __builtin_bit_cast(float, __builtin_amdgcn_update_dpp(0, __builtin_bit_cast(int, v), 0x118, 0xf, 0xf, false));
    v += __builtin_bit_cast(float, __builtin_amdgcn_update_dpp(0, __builtin_bit_cast(int, v), 0x142, 0xa, 0xf, false));
    v += __builtin_bit_cast(float, __builtin_amdgcn_update_dpp(0, __builtin_bit_cast(int, v), 0x143, 0xc, 0xf, false));
    return __builtin_bit_cast(float, __builtin_amdgcn_readlane(__builtin_bit_cast(int, v), 63));
}
__device__ __forceinline__ float siluf(float x) { return x / (1.f + __expf(-x)); }
__device__ __forceinline__ float sigm(float x) { return 1.f / (1.f + __expf(-x)); }
__device__ __forceinline__ void unpack8f8(const u32x2 v, float (&x)[8]) {
    const auto a = __builtin_amdgcn_cvt_pk_f32_fp8((int)v.x, false), b = __builtin_amdgcn_cvt_pk_f32_fp8((int)v.x, true), c = __builtin_amdgcn_cvt_pk_f32_fp8((int)v.y, false), d = __builtin_amdgcn_cvt_pk_f32_fp8((int)v.y, true);
    x[0] = a[0]; x[1] = a[1]; x[2] = b[0]; x[3] = b[1]; x[4] = c[0]; x[5] = c[1]; x[6] = d[0]; x[7] = d[1]; }
__device__ __forceinline__ void unpack8(const u32x4 v, float (&x)[8]) {
    x[0] = bflo(v.x); x[1] = bfhi(v.x); x[2] = bflo(v.y); x[3] = bfhi(v.y); x[4] = bflo(v.z); x[5] = bfhi(v.z); x[6] = bflo(v.w); x[7] = bfhi(v.w);
}
__device__ __forceinline__ unsigned pk4_fp8(float a, float b, float c, float d) { int p = __builtin_amdgcn_cvt_pk_fp8_f32(a, b, 0, false); p = __builtin_amdgcn_cvt_pk_fp8_f32(c, d, p, true); return (unsigned)p; }
__device__ __forceinline__ u32x4 pack8(const float (&x)[8]) { u32x4 o; o.x = pk2(x[0], x[1]); o.y = pk2(x[2], x[3]); o.z = pk2(x[4], x[5]); o.w = pk2(x[6], x[7]); return o; }

__device__ __forceinline__ void conv_item(const float* __restrict__ s0, const float* __restrict__ s1, int ldn, int k0, int n0, bool inter,
                                          bf16_t* dst, int ldk, int c0, float* scr, int lane) {
    const float* p = (inter && lane >= 32) ? (s1 + n0 + (lane - 32)) : (s0 + n0 + lane);
    p += (size_t)k0 * ldn;
#pragma unroll 8
    for (int i = 0; i < 64; ++i) scr[i * 65 + lane] = __builtin_nontemporal_load(p + (size_t)i * ldn);
    const int c = lane & 7;
#pragma unroll
    for (int j = 0; j < 8; ++j) {
        const int n = (lane >> 3) + 8 * j;
        const float* s = scr + (8 * c) * 65 + n;
        u32x4 o; o.x = pk2(s[0], s[65]); o.y = pk2(s[130], s[195]); o.z = pk2(s[260], s[325]); o.w = pk2(s[390], s[455]);
        const int drow = inter ? (c0 + ((n & 31) >> 2) * 8 + (n >> 5) * 4 + (n & 3)) : (c0 + n);
        __builtin_nontemporal_store(o, (u32x4*)(dst + (size_t)drow * ldk + k0 + 8 * c));
    }
}


__device__ __forceinline__ void conv_item8(const float* __restrict__ s0, const float* __restrict__ s1, int ldn, int k0, int n0, bool inter,
                                           unsigned char* dst, int ldk, int c0, float* scr, int lane, float scale) {
    const float* p = (inter && lane >= 32) ? (s1 + n0 + (lane - 32)) : (s0 + n0 + lane);
    p += (size_t)k0 * ldn;
#pragma unroll 8
    for (int i = 0; i < 64; ++i) scr[i * 65 + lane] = __builtin_nontemporal_load(p + (size_t)i * ldn) * scale;
    const int c = lane & 7;
#pragma unroll
    for (int j = 0; j < 8; ++j) {
        const int n = (lane >> 3) + 8 * j;
        const float* s = scr + (8 * c) * 65 + n;
        u32x2 o; o.x = pk4_fp8(s[0], s[65], s[130], s[195]); o.y = pk4_fp8(s[260], s[325], s[390], s[455]);
        const int drow = inter ? (c0 + ((n & 31) >> 2) * 8 + (n >> 5) * 4 + (n & 3)) : (c0 + n);
        __builtin_nontemporal_store(o, (u32x2*)(dst + (size_t)drow * ldk + k0 + 8 * c));
    }
}

__device__ __forceinline__ void ph0(const Args& a, unsigned char* lds, const int tid) {
    const int lane = tid & 63, wave = tid >> 6;
    const float* c_in = a.in[1]; const float* w_ada = a.in[2]; const float* b_ada = a.in[3];
    float* MOD = (float*)(a.ws + WS_MOD);
    {
        float* sc = (float*)lds; float* red = sc + 4096;
        { float t8[8];
#pragma unroll
          for (int j = 0; j < 8; ++j) t8[j] = c_in[tid + 512 * j];
#pragma unroll
          for (int j = 0; j < 8; ++j) sc[tid + 512 * j] = siluf(t8[j]); }
        __syncthreads();
        for (int it = blockIdx.x; it < 192; it += gridDim.x) {
            const int cc = tid & 31, ks = tid >> 5, col = it * 32 + cc;
            float a0 = 0.f, a1 = 0.f, a2 = 0.f, a3 = 0.f;
            const float* wp = w_ada + (size_t)(ks * 64) * 6144 + col;
            float wv[64];
#pragma unroll
            for (int k = 0; k < 64; ++k) wv[k] = __builtin_nontemporal_load(wp + (size_t)k * 6144);
#pragma unroll
            for (int k = 0; k < 64; ++k) { const float w = wv[k]; const int kk = ks * 64 + k;
                a0 += sc[kk] * w; a1 += sc[1024 + kk] * w; a2 += sc[2048 + kk] * w; a3 += sc[3072 + kk] * w; }
            float* rp = red + (ks * 32 + cc) * 4; rp[0] = a0; rp[1] = a1; rp[2] = a2; rp[3] = a3;
            __syncthreads();
            if (tid < 128) { const int c2 = tid & 31, b = tid >> 5; float s = 0.f;
                for (int k2 = 0; k2 < 16; ++k2) s += red[(k2 * 32 + c2) * 4 + b];
                MOD[b * 6144 + it * 32 + c2] = s + b_ada[it * 32 + c2]; }
            __syncthreads();
        }
    }
    __syncthreads();
    float* scr = (float*)lds + wave * (64 * 65);
    const int gw = blockIdx.x * 8 + wave, NGW = gridDim.x * 8;
    const float* w_in = a.in[4]; const float* w_out = a.in[16]; const float* w_router = a.in[17];
    const float* ws1 = a.in[22]; const float* ws3 = a.in[23]; const float* ws2 = a.in[24];
    bf16_t* WIN = (bf16_t*)(a.ws + WS_WIN); bf16_t* WOUT = (bf16_t*)(a.ws + WS_WOUT); bf16_t* WRS = (bf16_t*)(a.ws + WS_WRS);
    unsigned char* W2T8 = (unsigned char*)(a.ws + WS_W2T);
    constexpr int IT_WIN = 56 * 16, IT_WOUT = 16 * 16, IT_WR = 4 * 16, IT_WS13 = 8 * 16, IT_WS2 = 4 * 16;
    constexpr int NITEMS = IT_WIN + IT_WOUT + IT_WR + IT_WS13 + IT_WS2;
    for (int it = gw; it < NITEMS; it += NGW) {
        int r = it;
        if (r < IT_WIN) { const int kb = r / 56, cb = r % 56, c0 = 64 * cb, n0 = c0 + (c0 >= 2048 ? 8 : 0);
            conv_item8(w_in, w_in, DIN, 64 * kb, n0, false, (unsigned char*)WIN, 1024, c0, scr, lane, 64.f); continue; } r -= IT_WIN;
        if (r < IT_WOUT) { const int kb = r / 16, cb = r % 16; conv_item8(w_out, w_out, 1024, 64 * kb, 64 * cb, false, (unsigned char*)WOUT, 1024, 64 * cb, scr, lane, 64.f); continue; } r -= IT_WOUT;
        if (r < IT_WR) { const int kb = r / 4, cb = r % 4; conv_item(w_router, w_router, 256, 64 * kb, 64 * cb, false, WRS, 1024, 64 * cb, scr, lane); continue; } r -= IT_WR;
        if (r < IT_WS13) { const int kb = r / 8, cb = r % 8; conv_item8(ws1, ws3, 256, 64 * kb, 32 * cb, true, (unsigned char*)(a.ws + WS_WS13F8), 1024, 64 * cb, scr, lane, 64.f); continue; } r -= IT_WS13;
        { const int kb = r / 16, cb = r % 16; conv_item8(ws2, ws2, 1024, 64 * kb, 64 * cb, false, W2T8 + (size_t)256 * 1024 * 256, 256, 64 * cb, scr, lane, 64.f); }
    }
}

template <bool GATES>
__device__ __forceinline__ void ph_norm(const Args& a, unsigned char* lds, const float* X, int mod_shift, int mod_scale, const int tid) {
    const int lane = tid & 63, wave = tid >> 6;
    const float* MOD = (const float*)(a.ws + WS_MOD);
    float* wg = (float*)lds;
    if (GATES) {
        const float* w_in = a.in[4];
        float t16[16];
#pragma unroll
        for (int j = 0; j < 16; ++j) { const int i = tid + 512 * j; t16[j] = w_in[(size_t)(i >> 3) * DIN + 2048 + (i & 7)]; }
#pragma unroll
        for (int j = 0; j < 16; ++j) { const int i = tid + 512 * j; wg[(i & 7) * 1024 + (i >> 3)] = t16[j]; }
        __syncthreads();
    }
    const float* gate_b = a.in[7];
    float* IPRE = (float*)(a.ws + WS_IPRE); float* FPRE = (float*)(a.ws + WS_FPRE);
    const int gw = blockIdx.x * 8 + wave, NGW = gridDim.x * 8;
    f32x4 nx[4]; u32x2 nb[4];
#pragma unroll
    for (int j = 0; j < 4; ++j) { nx[j] = (f32x4){0.f, 0.f, 0.f, 0.f}; nb[j] = (u32x2){0u, 0u}; }
    if (gw < T) {
#pragma unroll
        for (int j = 0; j < 4; ++j) { if (GATES) nx[j] = __builtin_nontemporal_load((const f32x4*)(X + (size_t)gw * DM) + lane + 64 * j); else nb[j] = ((const u32x2*)((const bf16_t*)(a.ws + WS_X1B) + (size_t)gw * DM) + lane)[64 * j]; } }
    for (int row = gw; row < T; row += NGW) {
        const int b = row / SEQ;
        f32x4 cx[4]; u32x2 cb[4];
#pragma unroll
        for (int j = 0; j < 4; ++j) { cx[j] = nx[j]; cb[j] = nb[j]; }
        if (row + NGW < T) {
#pragma unroll
            for (int j = 0; j < 4; ++j) { if (GATES) nx[j] = __builtin_nontemporal_load((const f32x4*)(X + (size_t)(row + NGW) * DM) + lane + 64 * j); else nb[j] = ((const u32x2*)((const bf16_t*)(a.ws + WS_X1B) + (size_t)(row + NGW) * DM) + lane)[64 * j]; } }
        f32x4 v[4]; float ss = 0.f;
#pragma unroll
        for (int j = 0; j < 4; ++j) { if (GATES) v[j] = cx[j]; else { const u32x2 w = cb[j]; v[j] = (f32x4){bflo(w.x), bfhi(w.x), bflo(w.y), bfhi(w.y)}; } ss += (v[j].x * v[j].x + v[j].y * v[j].y) + (v[j].z * v[j].z + v[j].w * v[j].w); }
        const float rstd = rsqrtf(wave_sum(ss) * (1.f / DM) + EPS);
        const f32x4* sh = (const f32x4*)(MOD + b * 6144 + mod_shift * 1024) + lane;
        const f32x4* sc = (const f32x4*)(MOD + b * 6144 + mod_scale * 1024) + lane;
        if (!GATES && lane == 0) ((float*)(a.ws + WS_RSTD))[row] = rstd;
#pragma unroll
        for (int j = 0; j < 4; ++j) { const f32x4 s4 = sc[64 * j], h4 = sh[64 * j];
            v[j].x = v[j].x * rstd * (1.f + s4.x) + h4.x; v[j].y = v[j].y * rstd * (1.f + s4.y) + h4.y;
            v[j].z = v[j].z * rstd * (1.f + s4.z) + h4.z; v[j].w = v[j].w * rstd * (1.f + s4.w) + h4.w;
            *((unsigned*)(a.ws + WS_H8 + (size_t)row * DM) + lane + 64 * j) = pk4_fp8(v[j].x, v[j].y, v[j].z, v[j].w); }
        if (GATES) {
            float g[8];
#pragma unroll
            for (int q = 0; q < 8; ++q) { float s = 0.f;
#pragma unroll
                for (int j = 0; j < 4; ++j) { const f32x4 w4 = *((const f32x4*)(wg + q * 1024) + lane + 64 * j);
                    s += (v[j].x * w4.x + v[j].y * w4.y) + (v[j].z * w4.z + v[j].w * w4.w); }
                g[q] = wave_sum(s); }
            if (lane == 0) {
#pragma unroll
                for (int q = 0; q < 4; ++q) { IPRE[(size_t)row * 4 + q] = g[q] + gate_b[q]; FPRE[(size_t)row * 4 + q] = g[4 + q] + gate_b[4 + q]; }
            }
        }
    }
}


namespace pg8 {
#define PG8_LAS __attribute__((address_space(3)))
typedef int i32x4 __attribute__((ext_vector_type(4)));
typedef int i32x8 __attribute__((ext_vector_type(8)));
constexpr int BM = 256, BK = 64, HALF = 128, HTB = HALF * BK * 2;
__device__ __forceinline__ int lds_byte(int r, int c) { const int st = (r >> 4) * 2 + (c >> 5), rr = r & 15, cc = c & 31, ob = rr * 64 + cc * 2; return st * 1024 + (ob ^ (((ob >> 9) & 1) << 5)); }
__device__ __forceinline__ void stage_rc(int b, int& R, int& C) { const int st = b / 1024, sb = b % 1024, swz = sb ^ (((sb >> 9) & 1) << 5); R = (st >> 1) * 16 + swz / 64; C = (st & 1) * 32 + (swz % 64) / 2; }
__device__ __forceinline__ int perm32(int rho) { const int n = rho >> 4, i = rho & 15; return 8 * (i >> 2) + 4 * n + (i & 3); }
struct Unit { const char* A; const char* B; const int* gather; int row0, rend, col0; };

template <int PM, class RowEpi>
__device__ __forceinline__ void run_epi(const RowEpi& E, const f32x4 (&acc)[2][2][4][2], const Unit& u, int wr, int wc, int fr, int fq) {
#pragma unroll
    for (int ai = 0; ai < 2; ++ai)
#pragma unroll
        for (int m = 0; m < 4; ++m) { const int row = u.row0 + ai * HALF + wr * 64 + m * 16 + fr; const bool valid = row < u.rend;
            if constexpr (PM != 0) { const float v16[16] = {acc[ai][0][m][0][0], acc[ai][0][m][0][1], acc[ai][0][m][0][2], acc[ai][0][m][0][3], acc[ai][0][m][1][0], acc[ai][0][m][1][1], acc[ai][0][m][1][2], acc[ai][0][m][1][3],
                                                 acc[ai][1][m][0][0], acc[ai][1][m][0][1], acc[ai][1][m][0][2], acc[ai][1][m][0][3], acc[ai][1][m][1][0], acc[ai][1][m][1][1], acc[ai][1][m][1][2], acc[ai][1][m][1][3]};
                if constexpr (PM == 1) E.row16(row, valid, u.col0 + 64 * wc + 16 * fq, v16); else E.rowg(row, valid, u.col0 + 64 * wc + 8 * fq, v16); } else
#pragma unroll
            for (int bj = 0; bj < 2; ++bj) { const int col0 = u.col0 + bj * HALF + wc * 32 + 8 * fq;
                const float v[8] = {acc[ai][bj][m][0][0], acc[ai][bj][m][0][1], acc[ai][bj][m][0][2], acc[ai][bj][m][0][3], acc[ai][bj][m][1][0], acc[ai][bj][m][1][1], acc[ai][bj][m][1][2], acc[ai][bj][m][1][3]};
                E(row, valid, col0, v); } }
}

template <bool GATHER, bool FP8, int SCW, int SCX, int PM, class RowEpi, class Sched>
__device__ __forceinline__ void gemm_phase(PG8_LAS unsigned char* lds, const int KB, const Sched& S, const RowEpi& E) {
    const int tid = threadIdx.x, wid = __builtin_amdgcn_readfirstlane(tid >> 6), lane = tid & 63, wr = wid >> 2, wc = wid & 3, fr = lane & 15, fq = lane >> 4;
    const int nt = KB / 128;
    int scw_ = SCW, scx_ = SCX; asm volatile("" : "+v"(scw_), "+v"(scx_));
    int Rr[2], Cc[2]; unsigned voffB[2][2];
#pragma unroll
    for (int i = 0; i < 2; ++i) { stage_rc(tid * 16 + i * 8192, Rr[i], Cc[i]);
#pragma unroll
        for (int h = 0; h < 2; ++h) { const int R = Rr[i];
            const int cperm = PM == 1 ? 64 * (R >> 5) + 16 * ((R >> 2) & 3) + 8 * h + 4 * ((R >> 4) & 1) + (R & 3)
                            : PM == 2 ? 64 * (R >> 5) + 32 * h + 8 * ((R >> 2) & 3) + 4 * ((R >> 4) & 1) + (R & 3)
                            : h * HALF + (R & ~31) + perm32(R & 31);
            voffB[h][i] = (unsigned)(cperm * KB + Cc[i] * 2); } }
    const size_t kstep = (size_t)(BK * 2);
    const unsigned ldsw = (unsigned)wid * 1024u;
    const int aoff = lds_byte(wr * 64 + fr, fq * 8), boff = lds_byte(wc * 32 + fr, fq * 8);
#define PG8_SA(b, h) (((b) * 2 + (h)) * HTB)
#define PG8_SB(b, h) ((4 + (b) * 2 + (h)) * HTB)
#define PG8_STAGE(bufoff, gbase, voff) do { _Pragma("unroll") for (int _i = 0; _i < 2; ++_i) \
        __builtin_amdgcn_global_load_lds((const unsigned*)((const char*)(gbase) + (voff)[_i]), (PG8_LAS unsigned*)(lds + (bufoff) + ldsw + _i * 8192), 16, 0, 0); } while (0)
#define PG8_LD8(dst, addr) do { const i32x4 lo_ = *(const PG8_LAS i32x4*)(addr), hi_ = *(const PG8_LAS i32x4*)((addr) + 1024); dst = __builtin_shufflevector(lo_, hi_, 0, 1, 2, 3, 4, 5, 6, 7); } while (0)
#define PG8_LDA(dst, b, h) do { _Pragma("unroll") for (int m = 0; m < 4; ++m) PG8_LD8(dst[m], lds + PG8_SA(b, h) + aoff + m * 2048); } while (0)
#define PG8_LDB(dst, b, h) do { _Pragma("unroll") for (int n = 0; n < 2; ++n) PG8_LD8(dst[n], lds + PG8_SB(b, h) + boff + n * 2048); } while (0)
#define PG8_HALF(v, k) __builtin_bit_cast(bf16x8, (k) ? __builtin_shufflevector(v, v, 4, 5, 6, 7) : __builtin_shufflevector(v, v, 0, 1, 2, 3))
#define PG8_MMA(ai, bj, At, Bt) do { __builtin_amdgcn_s_setprio(1); _Pragma("unroll") for (int m = 0; m < 4; ++m) _Pragma("unroll") for (int n = 0; n < 2; ++n) { \
        if (FP8) asm volatile("v_mfma_scale_f32_16x16x128_f8f6f4 %0, %1, %2, %0, %3, %4 op_sel_hi:[0,0,0]" : "+v"(acc[ai][bj][m][n]) : "v"(Bt[n]), "v"(At[m]), "v"(scw_), "v"(scx_)); \
        else { _Pragma("unroll") for (int k = 0; k < 2; ++k) acc[ai][bj][m][n] = __builtin_amdgcn_mfma_f32_16x16x32_bf16(PG8_HALF(Bt[n], k), PG8_HALF(At[m], k), acc[ai][bj][m][n], 0, 0, 0); } } \
        __builtin_amdgcn_s_setprio(0); } while (0)
#define PG8_WAIT_V(n) asm volatile("s_waitcnt vmcnt(" #n ")" ::: "memory")
#define PG8_WAIT_L(n) asm volatile("s_waitcnt lgkmcnt(" #n ")" ::: "memory")
#define PG8_BAR __builtin_amdgcn_s_barrier()
#define PG8_SCHED __builtin_amdgcn_sched_barrier(0)
#define PG8_FILLA(u, v) do { _Pragma("unroll") for (int _h = 0; _h < 2; ++_h) _Pragma("unroll") for (int _i = 0; _i < 2; ++_i) { const int _row = _h * HALF + Rr[_i]; \
        if (GATHER) { const int _ri = (u).row0 + _row; const int _src = (u).gather[_ri < (u).rend ? _ri : (u).row0]; (v)[_h][_i] = (unsigned)(_src * KB + Cc[_i] * 2); } \
        else (v)[_h][_i] = (unsigned)(_row * KB + Cc[_i] * 2); } } while (0)
    Unit cur, nxt; int ui = 0;
    if (!S.next(0, cur)) return;
    f32x4 acc[2][2][4][2];
#pragma unroll
    for (int a = 0; a < 2; ++a)
#pragma unroll
        for (int b = 0; b < 2; ++b)
#pragma unroll
            for (int m = 0; m < 4; ++m)
#pragma unroll
                for (int n = 0; n < 2; ++n) acc[a][b][m][n] = (f32x4){0.f, 0.f, 0.f, 0.f};
    i32x8 At[4], B0[2], B1[2];
    unsigned voffA[2][2], nvoffA[2][2];
    PG8_FILLA(cur, voffA);
    const char* cA = cur.A; const char* cB = cur.B;
    PG8_STAGE(PG8_SB(0, 0), cB, voffB[0]); PG8_STAGE(PG8_SB(0, 1), cB, voffB[1]); PG8_STAGE(PG8_SA(0, 0), cA, voffA[0]); PG8_STAGE(PG8_SA(0, 1), cA, voffA[1]);
    if (wr == 1) PG8_BAR;
    PG8_WAIT_V(2); PG8_BAR;
    PG8_STAGE(PG8_SB(1, 0), cB + kstep, voffB[0]); PG8_STAGE(PG8_SA(1, 0), cA + kstep, voffA[0]); PG8_STAGE(PG8_SB(1, 1), cB + kstep, voffB[1]);
    PG8_WAIT_V(6); PG8_BAR;
    for (;;) {
        const bool has_next = S.next(ui + 1, nxt);
        const char* nA = has_next ? nxt.A : cA; const char* nB = has_next ? nxt.B : cB;
        if (GATHER && has_next) { PG8_FILLA(nxt, nvoffA); }
        else {
#pragma unroll
            for (int h = 0; h < 2; ++h)
#pragma unroll
                for (int i = 0; i < 2; ++i) nvoffA[h][i] = voffA[h][i]; }
        const bool half1 = cur.rend - cur.row0 > HALF;
        for (int t = 0; t < nt; t += 2) {
            const bool last = (t == nt - 2);
            const char* a1 = cA + (size_t)(t + 1) * kstep;
            const char* a2 = last ? nA : cA + (size_t)(t + 2) * kstep; const char* b2 = last ? nB : cB + (size_t)(t + 2) * kstep;
            const char* a3 = a2 + kstep; const char* b3 = b2 + kstep;
            unsigned v2[2][2];
#pragma unroll
            for (int h = 0; h < 2; ++h)
#pragma unroll
                for (int i = 0; i < 2; ++i) v2[h][i] = last ? nvoffA[h][i] : voffA[h][i];
            PG8_LDB(B0, 0, 0); PG8_LDB(B1, 0, 1); PG8_SCHED; PG8_LDA(At, 0, 0); PG8_STAGE(PG8_SA(1, 1), a1, voffA[1]);
            PG8_WAIT_V(8); PG8_WAIT_L(0); PG8_BAR; PG8_MMA(0, 0, At, B0); PG8_MMA(0, 1, At, B1); PG8_BAR; PG8_SCHED;
            if (half1) PG8_LDA(At, 0, 1); PG8_STAGE(PG8_SB(0, 0), b2, voffB[0]); PG8_STAGE(PG8_SB(0, 1), b2, voffB[1]); PG8_STAGE(PG8_SA(0, 0), a2, v2[0]);
            PG8_WAIT_V(8); PG8_WAIT_L(0); PG8_BAR; if (half1) { PG8_MMA(1, 0, At, B0); PG8_MMA(1, 1, At, B1); } PG8_BAR; PG8_SCHED;
            PG8_LDB(B0, 1, 0); PG8_LDB(B1, 1, 1); PG8_SCHED; PG8_LDA(At, 1, 0); PG8_STAGE(PG8_SA(0, 1), a2, v2[1]);
            PG8_WAIT_V(8); PG8_WAIT_L(0); PG8_BAR; PG8_MMA(0, 0, At, B0); PG8_MMA(0, 1, At, B1); PG8_BAR; PG8_SCHED;
            if (half1) PG8_LDA(At, 1, 1); PG8_STAGE(PG8_SB(1, 0), b3, voffB[0]); PG8_STAGE(PG8_SB(1, 1), b3, voffB[1]); PG8_STAGE(PG8_SA(1, 0), a3, v2[0]);
            PG8_WAIT_V(8); PG8_WAIT_L(0); PG8_BAR; if (half1) { PG8_MMA(1, 0, At, B0); PG8_MMA(1, 1, At, B1); } PG8_BAR; PG8_SCHED;
        }
        if (wr == 0) PG8_BAR;
        if (FP8) { PG8_SCHED; asm volatile("s_nop 15\n\ts_nop 7" ::: "memory"); PG8_SCHED; }
        run_epi<PM>(E, acc, cur, wr, wc, fr, fq);
        if (!has_next) break;
#pragma unroll
        for (int a = 0; a < 2; ++a)
#pragma unroll
            for (int b = 0; b < 2; ++b)
#pragma unroll
                for (int m = 0; m < 4; ++m)
#pragma unroll
                    for (int n = 0; n < 2; ++n) acc[a][b][m][n] = (f32x4){0.f, 0.f, 0.f, 0.f};
        cur = nxt; cA = nA; cB = nB; ++ui;
#pragma unroll
        for (int h = 0; h < 2; ++h)
#pragma unroll
            for (int i = 0; i < 2; ++i) voffA[h][i] = nvoffA[h][i];
        if (wr == 1) PG8_BAR;
    }
    PG8_WAIT_V(0);
    PG8_BAR;
#undef PG8_SA
#undef PG8_SB
#undef PG8_STAGE
#undef PG8_LDA
#undef PG8_LD8
#undef PG8_HALF
#undef PG8_LDB
#undef PG8_MMA
#undef PG8_WAIT_V
#undef PG8_WAIT_L
#undef PG8_BAR
#undef PG8_SCHED
#undef PG8_FILLA
}

struct DenseSched {
    const char* A; const char* Bt; int KB, M, nM, nN, nwg, G, c;
    __device__ __forceinline__ void init(const void* A_, const void* Bt_, int M_, int N_, int KB_, int G_, int c_) { A = (const char*)A_; Bt = (const char*)Bt_; KB = KB_; M = M_; nM = M_ / BM; nN = N_ / BM; nwg = nM * nN; G = G_; c = c_; }
    __device__ __forceinline__ bool next(int i, Unit& u) const {
        const long L = (long)i * G + c; if (L >= nwg) return false;
        int wgid = (int)L; { const int q = nwg / 8, r = nwg % 8, xcd = wgid % 8, off = wgid / 8; wgid = (xcd < r ? xcd * (q + 1) : r * (q + 1) + (xcd - r) * q) + off; }
        const int nig = 8 * nN, gid = wgid / nig, fm = gid * 8, gsz = (nM - fm) < 8 ? (nM - fm) : 8;
        const int pm = fm + ((wgid % nig) % gsz), pn = (wgid % nig) / gsz;
        u.A = A + (size_t)pm * BM * KB; u.B = Bt + (size_t)pn * BM * KB; u.gather = nullptr; u.row0 = pm * BM; u.rend = M; u.col0 = pn * BM; return true;
    }
};
struct ExpertSched {
    const int* TILE; int nunits, NPN; const char* A; const int* gather; const char* Bt; size_t bstride; int KB, G, vcu; const PG8_LAS int* uc;
    static constexpr int UC_OFF = 135680, UC_N = 64;
    __device__ __forceinline__ void fill(PG8_LAS unsigned char* lds, int tid) const {
        PG8_LAS int* w = (PG8_LAS int*)(lds + UC_OFF);
        if (tid < UC_N) { const int L = tid * G + vcu; if (L < nunits) { const int tl = L / NPN; w[3 * tid] = TILE[64 + tl]; w[3 * tid + 1] = TILE[64 + 2048 + tl]; w[3 * tid + 2] = TILE[64 + 4096 + tl]; } } }
    __device__ __forceinline__ bool next(int i, Unit& u) const {
        const int L = i * G + vcu; if (L >= nunits) return false;
        const int tl = L / NPN, pn = L % NPN;
        int e, r0, re;
        if (i < UC_N) { e = __builtin_amdgcn_readfirstlane(uc[3 * i]); r0 = __builtin_amdgcn_readfirstlane(uc[3 * i + 1]); re = __builtin_amdgcn_readfirstlane(uc[3 * i + 2]); }
        else { e = __builtin_amdgcn_readfirstlane(TILE[64 + tl]); r0 = __builtin_amdgcn_readfirstlane(TILE[64 + 2048 + tl]); re = __builtin_amdgcn_readfirstlane(TILE[64 + 4096 + tl]); }
        u.B = Bt + (size_t)e * bstride + (size_t)pn * BM * KB; u.row0 = r0; u.rend = re; u.col0 = pn * BM;
        if (gather) { u.A = A; u.gather = gather; } else { u.A = A + (size_t)r0 * KB; u.gather = nullptr; }
        return true;
    }
};
}

struct EpiProj { bf16_t* P; const float* gt;
    __device__ __forceinline__ void rowg(int row, bool valid, int colA, const float (&v)[16]) const {
        float y[16];
        if (colA >= 2048 && colA < 3072) {
            float ss = 0.f;
#pragma unroll
            for (int i = 0; i < 16; ++i) ss += v[i] * v[i];
            ss += __shfl_xor(ss, 16); ss += __shfl_xor(ss, 32);
            const float rstd = rsqrtf(ss * (1.f / 64.f) + EPS);
            const float* g = gt + (colA < 2560 ? 0 : 64) + (colA & 63);
            const f32x4 g0 = *(const f32x4*)g, g1 = *(const f32x4*)(g + 4), g2 = *(const f32x4*)(g + 32), g3 = *(const f32x4*)(g + 36);
            y[0] = v[0] * rstd * g0.x; y[1] = v[1] * rstd * g0.y; y[2] = v[2] * rstd * g0.z; y[3] = v[3] * rstd * g0.w; y[4] = v[4] * rstd * g1.x; y[5] = v[5] * rstd * g1.y; y[6] = v[6] * rstd * g1.z; y[7] = v[7] * rstd * g1.w;
            y[8] = v[8] * rstd * g2.x; y[9] = v[9] * rstd * g2.y; y[10] = v[10] * rstd * g2.z; y[11] = v[11] * rstd * g2.w; y[12] = v[12] * rstd * g3.x; y[13] = v[13] * rstd * g3.y; y[14] = v[14] * rstd * g3.z; y[15] = v[15] * rstd * g3.w;
        } else {
#pragma unroll
            for (int i = 0; i < 16; ++i) y[i] = v[i];
        }
        if (valid && colA < 2048) {
            unsigned char* pb = (unsigned char*)P + (size_t)row * (NPROJ * 2) + (colA >> 9) * 1024 + (colA & 511);
            u32x2 w0, w1; w0.x = pk4_fp8(y[0], y[1], y[2], y[3]); w0.y = pk4_fp8(y[4], y[5], y[6], y[7]); w1.x = pk4_fp8(y[8], y[9], y[10], y[11]); w1.y = pk4_fp8(y[12], y[13], y[14], y[15]);
            *(u32x2*)pb = w0; *(u32x2*)(pb + 32) = w1; }
        else if (valid) { const float y0[8] = {y[0], y[1], y[2], y[3], y[4], y[5], y[6], y[7]}, y1[8] = {y[8], y[9], y[10], y[11], y[12], y[13], y[14], y[15]};
            *(u32x4*)(P + (size_t)row * NPROJ + colA) = pack8(y0); *(u32x4*)(P + (size_t)row * NPROJ + colA + 32) = pack8(y1); } } };
struct EpiOut { const float* x; bf16_t* x1; const float* MOD;
    __device__ __forceinline__ void operator()(int row, bool valid, int col0, const float (&v)[8]) const {
        if (!valid) return; const int b = row / SEQ; const float* ga = MOD + b * 6144 + 2 * 1024 + col0;
        const f32x4 x0 = __builtin_nontemporal_load((const f32x4*)(x + (size_t)row * DM + col0)), x1v = __builtin_nontemporal_load((const f32x4*)(x + (size_t)row * DM + col0 + 4));
        const float o[8] = {x0.x + ga[0] * v[0], x0.y + ga[1] * v[1], x0.z + ga[2] * v[2], x0.w + ga[3] * v[3], x1v.x + ga[4] * v[4], x1v.y + ga[5] * v[5], x1v.z + ga[6] * v[6], x1v.w + ga[7] * v[7]};
        *(u32x4*)(x1 + (size_t)row * DM + col0) = pack8(o); } };
struct EpiRS { float* LOG; bf16_t* ACT;
    __device__ __forceinline__ void operator()(int row, bool valid, int col0, const float (&v)[8]) const {
        if (!valid) return;
        if (col0 < 256) { *(f32x4*)(LOG + (size_t)row * 256 + col0) = (f32x4){v[0], v[1], v[2], v[3]}; *(f32x4*)(LOG + (size_t)row * 256 + col0 + 4) = (f32x4){v[4], v[5], v[6], v[7]}; }
        else { const int j0 = (col0 - 256) >> 1;
            *(unsigned*)((unsigned char*)ACT + (size_t)(SHARED_BASE + row) * 256 + j0) = pk4_fp8(8.f * siluf(v[0]) * v[4], 8.f * siluf(v[1]) * v[5], 8.f * siluf(v[2]) * v[6], 8.f * siluf(v[3]) * v[7]); } } };
struct EpiSh { bf16_t* ACT;
    __device__ __forceinline__ void operator()(int row, bool valid, int col0, const float (&v)[8]) const {
        if (!valid) return; const int j0 = col0 >> 1;
        *(unsigned*)((unsigned char*)ACT + (size_t)(SHARED_BASE + row) * 256 + j0) = pk4_fp8(8.f * siluf(v[0]) * v[4], 8.f * siluf(v[1]) * v[5], 8.f * siluf(v[2]) * v[6], 8.f * siluf(v[3]) * v[7]); } };
struct EpiRouter { float* LOG; const float* RSTD; const float* CB;
    __device__ __forceinline__ void operator()(int row, bool valid, int col0, const float (&v)[8]) const {
        if (!valid) return; const float r = RSTD[row]; const float* cb = CB + (row / SEQ) * 256 + col0;
        *(f32x4*)(LOG + (size_t)row * 256 + col0) = (f32x4){r * v[0] + cb[0], r * v[1] + cb[1], r * v[2] + cb[2], r * v[3] + cb[3]}; *(f32x4*)(LOG + (size_t)row * 256 + col0 + 4) = (f32x4){r * v[4] + cb[4], r * v[5] + cb[5], r * v[6] + cb[6], r * v[7] + cb[7]}; } };
struct RouterSched { pg8::DenseSched d;
    __device__ __forceinline__ bool next(int i, pg8::Unit& u) const { if (!d.next(i, u)) return false; u.B += (size_t)(u.row0 / SEQ) * 256 * d.KB; return true; } };
struct EpiG1 { const float* SG; bf16_t* ACT;
    __device__ __forceinline__ void operator()(int row, bool valid, int col0, const float (&v)[8]) const {
        if (!valid) return; const float g = 8.f; const int j0 = col0 >> 1;
        *(unsigned*)((unsigned char*)ACT + (size_t)row * 256 + j0) = pk4_fp8(siluf(v[0]) * v[4] * g, siluf(v[1]) * v[5] * g, siluf(v[2]) * v[6] * g, siluf(v[3]) * v[7] * g); } };
struct EpiG2 { bf16_t* YP;
    __device__ __forceinline__ void operator()(int row, bool valid, int col0, const float (&v)[8]) const { if (valid) { u32x2 p; p.x = pk4_fp8(16.f * v[0], 16.f * v[1], 16.f * v[2], 16.f * v[3]); p.y = pk4_fp8(16.f * v[4], 16.f * v[5], 16.f * v[6], 16.f * v[7]);
            *(u32x2*)((unsigned char*)YP + (size_t)row * DM + col0) = p; } }
    __device__ __forceinline__ void row16(int row, bool valid, int col0, const float (&v)[16]) const { if (valid) { u32x4 p;
            p.x = pk4_fp8(16.f * v[0], 16.f * v[1], 16.f * v[2], 16.f * v[3]); p.y = pk4_fp8(16.f * v[4], 16.f * v[5], 16.f * v[6], 16.f * v[7]);
            p.z = pk4_fp8(16.f * v[8], 16.f * v[9], 16.f * v[10], 16.f * v[11]); p.w = pk4_fp8(16.f * v[12], 16.f * v[13], 16.f * v[14], 16.f * v[15]);
            __builtin_nontemporal_store(p, (u32x4*)((unsigned char*)YP + (size_t)row * DM + col0)); } } };

constexpr int LR = 136;
__device__ __forceinline__ f32x4 mfma16(bf16x8 a, bf16x8 b, f32x4 c) {
    asm volatile("s_nop 1\n\tv_mfma_f32_16x16x32_bf16 %0, %1, %2, %0" : "+v"(c) : "v"(a), "v"(b)); return c; }
#define MFMA_DRAIN8(x) asm volatile("s_nop 15\n\ts_nop 3" : "+v"(x[0]), "+v"(x[1]), "+v"(x[2]), "+v"(x[3]), "+v"(x[4]), "+v"(x[5]), "+v"(x[6]), "+v"(x[7]))
__device__ __forceinline__ bf16x8 ldfrag(const bf16_t* base, int row, int k0, int lane) { return *(const bf16x8*)(base + (row + (lane & 15)) * LR + k0 + 8 * (lane >> 4)); }


__device__ __forceinline__ void conv8_lds(const bf16_t* R, int pitch, int s, int col, const float* cw, int wpitch, const float* cb, int ch, float (&o)[8]) {
    float acc[8];
    { const f32x4 b0 = *(const f32x4*)(cb + ch), b1 = *(const f32x4*)(cb + ch + 4); acc[0] = b0.x; acc[1] = b0.y; acc[2] = b0.z; acc[3] = b0.w; acc[4] = b1.x; acc[5] = b1.y; acc[6] = b1.z; acc[7] = b1.w; }
#pragma unroll
    for (int j = 0; j < 4; ++j) { float x[8]; unpack8(*(const u32x4*)(R + (s + j) * pitch + col), x);
        const f32x4 w0 = *(const f32x4*)(cw + j * wpitch + ch), w1 = *(const f32x4*)(cw + j * wpitch + ch + 4);
        acc[0] += w0.x * x[0]; acc[1] += w0.y * x[1]; acc[2] += w0.z * x[2]; acc[3] += w0.w * x[3];
        acc[4] += w1.x * x[4]; acc[5] += w1.y * x[5]; acc[6] += w1.z * x[6]; acc[7] += w1.w * x[7]; }
#pragma unroll
    for (int q = 0; q < 8; ++q) o[q] = siluf(acc[q]);
}
__device__ __forceinline__ void conv8_lds8(const unsigned char* R, int pitch, int s, int col, const float* cw, int wpitch, const float* cb, int ch, float (&o)[8]) {
    float acc[8];
    { const f32x4 b0 = *(const f32x4*)(cb + ch), b1 = *(const f32x4*)(cb + ch + 4); acc[0] = b0.x; acc[1] = b0.y; acc[2] = b0.z; acc[3] = b0.w; acc[4] = b1.x; acc[5] = b1.y; acc[6] = b1.z; acc[7] = b1.w; }
#pragma unroll
    for (int j = 0; j < 4; ++j) { float x[8]; unpack8f8(*(const u32x2*)(R + (s + j) * pitch + col), x);
        const f32x4 w0 = *(const f32x4*)(cw + j * wpitch + ch), w1 = *(const f32x4*)(cw + j * wpitch + ch + 4);
        acc[0] += w0.x * x[0]; acc[1] += w0.y * x[1]; acc[2] += w0.z * x[2]; acc[3] += w0.w * x[3];
        acc[4] += w1.x * x[4]; acc[5] += w1.y * x[5]; acc[6] += w1.z * x[6]; acc[7] += w1.w * x[7]; }
#pragma unroll
    for (int q = 0; q < 8; ++q) o[q] = siluf(acc[q]);
}
__device__ __forceinline__ void chunk_gates(const Args& a, float* bb, float* ii, float* tmp, int t0, int h, int tid) {
    const float* IPRE = (const float*)(a.ws + WS_IPRE); const float* FPRE = (const float*)(a.ws + WS_FPRE);
    if (tid < 128) { const float f = FPRE[(size_t)(t0 + tid) * 4 + h]; ii[tid] = IPRE[(size_t)(t0 + tid) * 4 + h];
        tmp[tid] = fminf(f, 0.f) - log1pf(expf(-fabsf(f))); }
    __syncthreads();
    if (tid < 128) { float s = 0.f;
#pragma unroll 4
        for (int j4 = 0; j4 < 32; ++j4) { const f32x4 v = *(const f32x4*)(tmp + 4 * j4); const int j = 4 * j4;
            s += (j <= tid ? v.x : 0.f); s += (j + 1 <= tid ? v.y : 0.f); s += (j + 2 <= tid ? v.z : 0.f); s += (j + 3 <= tid ? v.w : 0.f); }
        bb[tid] = s; }
    __syncthreads();
}

__device__ __forceinline__ void mlstm_m1_unit(const Args& a, unsigned char* lds, int unit, const int wave_s) {
    const int tid = mk_tid(wave_s);
    const int lane = tid & 63, wave = tid >> 6;
    const int bh = unit >> 6, c = unit & 63, b = bh >> 2, h = bh & 3, t0 = b * SEQ + c * 128;
    bf16_t* kT = (bf16_t*)lds; bf16_t* vT = kT + 128 * LR;
    float* sf = (float*)(lds + 2 * 128 * LR * 2); float* bb = sf; float* ii = sf + 128; float* tmp = sf + 256; float* wk = sf + 384;
    const bf16_t* PROJ = (const bf16_t*)(a.ws + WS_PROJ);
    const float* cw = a.in[5]; const float* cbias = a.in[6];
    unsigned char* R = lds + 2 * 128 * LR * 2 + 2048;
    const int tl = tid;
    u32x2 rawk[5]; u32x2 vreg[4];
#pragma unroll
    for (int k = 0; k < 5; ++k) { const int idx = tl + 512 * k, row = idx >> 4, chunk = idx & 15; const int sp = c * 128 - 3 + row;
        rawk[k] = (u32x2){0u, 0u};
        if (idx < 131 * 16 && sp >= 0) rawk[k] = *(const u32x2*)((const unsigned char*)PROJ + (size_t)(b * SEQ + sp) * (NPROJ * 2) + 1024 + h * 128 + 8 * chunk); }
#pragma unroll
    for (int k = 0; k < 4; ++k) { const int it = tl + 512 * k, sidx = it & 127, ch = it >> 7; vreg[k] = *(const u32x2*)((const unsigned char*)PROJ + (size_t)(t0 + sidx) * (NPROJ * 2) + 2048 + h * 128 + 8 * ch); }
    float* WL = (float*)(lds + 147456);
    float wl0 = 0.f, wl1 = 0.f; if (tl < 512) wl0 = cw[(tl >> 7) * 1024 + 512 + h * 128 + (tl & 127)]; if (tl < 128) wl1 = cbias[512 + h * 128 + tl];
    float gcs = 0.f, giv = 0.f;
    if (wave < 2) { const float f = ((const float*)(a.ws + WS_FPRE))[(size_t)(t0 + tid) * 4 + h]; giv = ((const float*)(a.ws + WS_IPRE))[(size_t)(t0 + tid) * 4 + h];
        gcs = fminf(f, 0.f) - log1pf(expf(-fabsf(f)));
#pragma unroll
        for (int d = 1; d < 64; d <<= 1) { const float t = __shfl_up(gcs, d); if (lane >= d) gcs += t; }
        if (lane == 63) ii[wave] = gcs; }
    if (tl < 512) WL[tl] = wl0; if (tl < 128) WL[512 + tl] = wl1;
#pragma unroll
    for (int k = 0; k < 5; ++k) { const int idx = tl + 512 * k; if (idx < 131 * 16) *(u32x2*)(R + (idx >> 4) * 136 + 8 * (idx & 15)) = rawk[k]; }
    __syncthreads();
    const float blast = ii[0] + ii[1];
    float gv = -INFINITY;
    if (wave < 2) { if (wave == 1) gcs += ii[0];
        gv = blast - gcs + giv; float m = gv;
#pragma unroll
        for (int d = 1; d < 64; d <<= 1) m = fmaxf(m, __shfl_xor(m, d));
        if (lane == 0) ii[2 + wave] = m; }
    __syncthreads();
    const float mloc = fmaxf(ii[2], ii[3]);
    if (wave < 2) wk[tid] = expf(gv - mloc);
    __syncthreads();
#pragma unroll
    for (int k = 0; k < 4; ++k) { const int it = tl + 512 * k, sidx = it & 127, ch = it >> 7;
        float kv[8]; conv8_lds8(R, 136, sidx, 8 * ch, WL, 128, WL + 512, 8 * ch, kv);
        const float sc = 0.08838834764831845f * wk[sidx];
#pragma unroll
        for (int q = 0; q < 8; ++q) kT[(8 * ch + q) * LR + sidx] = (bf16_t)f2bf(kv[q] * sc);
        float vv[8]; unpack8f8(vreg[k], vv);
#pragma unroll
        for (int q = 0; q < 8; ++q) vT[(8 * ch + q) * LR + sidx] = (bf16_t)f2bf(vv[q]);
    }
    __syncthreads();
    unsigned* CLOC = (unsigned*)(a.ws + WS_CLOC) + (size_t)unit * 8192;
    float* MST = (float*)(a.ws + WS_MST);
    {
        f32x4 acc[8];
#pragma unroll
        for (int i = 0; i < 8; ++i) acc[i] = (f32x4){0.f, 0.f, 0.f, 0.f};
#pragma unroll
        for (int ks = 0; ks < 4; ++ks) { const bf16x8 af = ldfrag(vT, 16 * wave, 32 * ks, lane);
#pragma unroll
            for (int db = 0; db < 8; ++db) acc[db] = mfma16(af, ldfrag(kT, 16 * db, 32 * ks, lane), acc[db]); }
        MFMA_DRAIN8(acc);
#pragma unroll
        for (int db = 0; db < 8; ++db)
#pragma unroll
            for (int r0 = 0; r0 < 4; r0 += 2) {
                const bool odd = lane & 1; const float own = odd ? acc[db][r0 + 1] : acc[db][r0], give = odd ? acc[db][r0] : acc[db][r0 + 1];
                const float got = __shfl_xor(give, 1);
                const int row = 16 * wave + 4 * (lane >> 4) + r0 + (odd ? 1 : 0), cp = (16 * db + (lane & 15)) >> 1;
                CLOC[row * 64 + cp] = odd ? pk2(got, own) : pk2(own, got); }
    }
    if (tid < 128) { float s = 0.f;
#pragma unroll 4
        for (int j8 = 0; j8 < 16; ++j8) { float x[8]; unpack8(*(const u32x4*)(kT + tid * LR + 8 * j8), x); s += ((x[0] + x[1]) + (x[2] + x[3])) + ((x[4] + x[5]) + (x[6] + x[7])); }
        MST[16384 + (size_t)unit * 128 + tid] = s; }
    if (tid == 0) { MST[unit] = mloc; MST[1024 + unit] = blast; }
    __syncthreads();
}

__device__ __forceinline__ void mlstm_m2(const Args& a, const int tid2) {
    const unsigned* CLOC = (const unsigned*)(a.ws + WS_CLOC); unsigned* CIN = (unsigned*)(a.ws + WS_CIN);
    float* MST = (float*)(a.ws + WS_MST);
    const float* NLOC = MST + 16384; float* NIN = MST + 16384 + 131072;
    for (int gid = blockIdx.x * 512 + tid2; gid < 16 * 8192; gid += gridDim.x * 512) {
        const int bh = gid >> 13, e2 = gid & 8191; const bool hasn = e2 < 128;
        const unsigned* cl = CLOC + (size_t)(bh * 64) * 8192 + e2; const float* nl = NLOC + (size_t)(bh * 64) * 128 + e2;
        unsigned* ci = CIN + (size_t)(bh * 64) * 8192 + e2; float* ni = NIN + (size_t)(bh * 64) * 128 + e2;
        const float* mlp = MST + bh * 64; const float* blp = MST + 1024 + bh * 64;
        float s0 = 0.f, s1 = 0.f, sn = 0.f, m = 0.f;
        float p0[4], p1[4], pn[4], pm[4], pb[4];
#pragma unroll
        for (int k = 0; k < 4; ++k) { const unsigned w = __builtin_nontemporal_load(cl + (size_t)k * 8192); p0[k] = bflo(w); p1[k] = bfhi(w); pn[k] = hasn ? nl[k * 128] : 0.f; pm[k] = mlp[k]; pb[k] = blp[k]; }
        for (int c0 = 0; c0 < 64; c0 += 4) {
            float q0[4], q1[4], qn[4], qm[4], qb[4];
            const bool more = c0 + 4 < 64;
#pragma unroll
            for (int k = 0; k < 4; ++k) { const int c = more ? c0 + 4 + k : c0 + k;
                const unsigned w = __builtin_nontemporal_load(cl + (size_t)c * 8192); q0[k] = bflo(w); q1[k] = bfhi(w); qn[k] = hasn ? nl[c * 128] : 0.f; qm[k] = mlp[c]; qb[k] = blp[c]; }
#pragma unroll
            for (int k = 0; k < 4; ++k) { const int c = c0 + k;
                ci[(size_t)c * 8192] = pk2(s0, s1);
                if (hasn) ni[c * 128] = sn;
                if (e2 == 0) MST[2048 + bh * 64 + c] = m;
                const float ml = pm[k], bl = pb[k];
                const float mn = fmaxf(bl + m, ml), ca = expf(bl + m - mn), cb = expf(ml - mn);
                s0 = ca * s0 + cb * p0[k]; s1 = ca * s1 + cb * p1[k]; sn = ca * sn + cb * pn[k]; m = mn; }
#pragma unroll
            for (int k = 0; k < 4; ++k) { p0[k] = q0[k]; p1[k] = q1[k]; pn[k] = qn[k]; pm[k] = qm[k]; pb[k] = qb[k]; }
        }
    }
}

struct M3In { u32x4 creg[4]; u32x2 rawq[9], vreg[4]; float fpre, ipre, wl0, wl1, wl2, m_in, nnv, mlgv; };
__device__ __forceinline__ void m3_issue(const Args& a, int unit, const int tid, M3In& r) {
    const int bh = unit >> 6, c = unit & 63, b = bh >> 2, h = bh & 3, t0 = b * SEQ + c * 128; const int tl = tid;
    const bf16_t* PROJ = (const bf16_t*)(a.ws + WS_PROJ); const bf16_t* CIN = (const bf16_t*)(a.ws + WS_CIN) + (size_t)unit * 16384;
    const float* MST = (const float*)(a.ws + WS_MST); const float* IPRE = (const float*)(a.ws + WS_IPRE); const float* FPRE = (const float*)(a.ws + WS_FPRE);
    const float* cw = a.in[5]; const float* cbias = a.in[6];
    r.m_in = MST[2048 + unit];
#pragma unroll
    for (int k = 0; k < 9; ++k) { const int idx = tl + 512 * k, row = idx >> 5, chunk = idx & 31; const int sp = c * 128 - 3 + row;
        r.rawq[k] = (u32x2){0u, 0u};
        if (idx < 131 * 32 && sp >= 0) r.rawq[k] = *(const u32x2*)((const unsigned char*)PROJ + (size_t)(b * SEQ + sp) * (NPROJ * 2) + (chunk < 16 ? h * 128 + 8 * chunk : 1024 + h * 128 + 8 * (chunk - 16))); }
#pragma unroll
    for (int k = 0; k < 4; ++k) { const int it = tl + 512 * k, sidx = it & 127, ch = it >> 7, s2 = it >> 4, c2 = it & 15;
        r.vreg[k] = *(const u32x2*)((const unsigned char*)PROJ + (size_t)(t0 + sidx) * (NPROJ * 2) + 2048 + h * 128 + 8 * ch); r.creg[k] = *(const u32x4*)(CIN + s2 * 128 + 8 * c2); }
    r.wl0 = cw[(tl >> 7) * 1024 + h * 128 + (tl & 127)]; r.wl1 = cw[(tl >> 7) * 1024 + 512 + h * 128 + (tl & 127)]; r.wl2 = 0.f; if (tl < 256) r.wl2 = cbias[(tl >> 7) * 512 + h * 128 + (tl & 127)];
    r.fpre = 0.f; r.ipre = 0.f; r.nnv = 0.f; r.mlgv = 0.f; if (tid < 128) r.mlgv = a.in[8][tid];
    if (tid < 128) { r.fpre = FPRE[(size_t)(t0 + tid) * 4 + h]; r.ipre = IPRE[(size_t)(t0 + tid) * 4 + h]; r.nnv = MST[16384 + 131072 + (size_t)unit * 128 + tl]; }
}
__device__ __forceinline__ void mlstm_m3_unit(const Args& a, unsigned char* lds, int unit, const int wave_s, M3In& r, unsigned* qnext, volatile PG8_LAS unsigned* nextp) {
    const int tid = mk_tid(wave_s);
    const int lane = tid & 63, wave = tid >> 6;
    const int bh = unit >> 6, c = unit & 63, b = bh >> 2, h = bh & 3, t0 = b * SEQ + c * 128;
    bf16_t* qs = (bf16_t*)lds; bf16_t* ks = qs + 128 * LR; bf16_t* vT = ks + 128 * LR; bf16_t* CT = vT + 128 * LR; bf16_t* Ps = ks;
    float* sf = (float*)(lds + 4 * 128 * LR * 2);
    float* bb = sf; float* ii = sf + 128; float* tmp = sf + 256; float* gg = sf + 384; float* wint = sf + 512; float* nn = sf + 640; float* den = sf + 768; float* dint = sf + 896;
    const bf16_t* PROJ = (const bf16_t*)(a.ws + WS_PROJ);
    bf16_t* MIX = (bf16_t*)(a.ws + WS_MIX);
    unsigned char* R = (unsigned char*)vT;
    const float m_in = r.m_in;
    const int tl = tid;
    unsigned tk = 0u; if (tid == 0) tk = atomicAdd(qnext, 1u);
    float* WL = (float*)(lds + 147456);
    float gcs = 0.f, giv = 0.f, gu = 0.f, gpm = 0.f;
    if (wave < 2) { const float f = r.fpre; giv = r.ipre; gcs = fminf(f, 0.f) - log1pf(expf(-fabsf(f)));
#pragma unroll
        for (int d = 1; d < 64; d <<= 1) { const float t = __shfl_up(gcs, d); if (lane >= d) gcs += t; }
        if (lane == 63) dint[wave] = gcs; }
    WL[tl] = r.wl0; WL[512 + tl] = r.wl1; if (tl < 256) WL[1024 + tl] = r.wl2; if (tl < 128) WL[1280 + tl] = r.mlgv;
#pragma unroll
    for (int k = 0; k < 9; ++k) { const int idx = tl + 512 * k; if (idx < 131 * 32) *(u32x2*)(R + (idx >> 5) * 288 + 8 * (idx & 31)) = r.rawq[k]; }
    __syncthreads();
    if (wave < 2) { if (wave == 1) gcs += dint[0];
        gu = giv - gcs; gpm = gu;
#pragma unroll
        for (int d = 1; d < 64; d <<= 1) { const float t = __shfl_up(gpm, d); if (lane >= d) gpm = fmaxf(gpm, t); }
        if (lane == 63) dint[2 + wave] = gpm;
        bb[tid] = gcs; tmp[tid] = gu; nn[tid] = r.nnv; }
    if (tid == 0) *nextp = tk;
    __syncthreads();
    if (wave < 2) { if (wave == 1) gpm = fmaxf(gpm, dint[2]); const float g = fmaxf(m_in, gpm); gg[tid] = g; wint[tid] = expf(m_in - g); }
    {
        const int ch = tl & 15, s0 = 4 * (tl >> 4);
#pragma unroll 1
        for (int qk = 0; qk < 2; ++qk) {
            const float* cwp = WL + 512 * qk + 8 * ch; const float* cbp = WL + 1024 + 128 * qk + 8 * ch; const unsigned char* Rp = R + s0 * 288 + 128 * qk + 8 * ch;
            float w[4][8], bias[8];
#pragma unroll
            for (int j = 0; j < 4; ++j) { const f32x4 w0 = *(const f32x4*)(cwp + j * 128), w1 = *(const f32x4*)(cwp + j * 128 + 4);
                w[j][0] = w0.x; w[j][1] = w0.y; w[j][2] = w0.z; w[j][3] = w0.w; w[j][4] = w1.x; w[j][5] = w1.y; w[j][6] = w1.z; w[j][7] = w1.w; }
            { const f32x4 b0 = *(const f32x4*)cbp, b1 = *(const f32x4*)(cbp + 4); bias[0] = b0.x; bias[1] = b0.y; bias[2] = b0.z; bias[3] = b0.w; bias[4] = b1.x; bias[5] = b1.y; bias[6] = b1.z; bias[7] = b1.w; }
            float x[7][8];
#pragma unroll
            for (int rr = 0; rr < 7; ++rr) unpack8f8(*(const u32x2*)(Rp + rr * 288), x[rr]);
            const float osc = qk ? 0.08838834764831845f : 1.f;
            bf16_t* dstp = (qk ? ks : qs) + s0 * LR + 8 * ch;
#pragma unroll
            for (int pp = 0; pp < 4; ++pp) { float o8[8];
#pragma unroll
                for (int q = 0; q < 8; ++q) { float acc = bias[q];
#pragma unroll
                    for (int j = 0; j < 4; ++j) acc += w[j][q] * x[pp + j][q];
                    o8[q] = siluf(acc) * osc; }
                *(u32x4*)(dstp + pp * LR) = pack8(o8); }
        }
    }
    __syncthreads();
#pragma unroll
    for (int k = 0; k < 4; ++k) { const int it = tl + 512 * k, sidx = it & 127, ch = it >> 7, s2 = it >> 4, c2 = it & 15;
        float vv[8]; unpack8f8(r.vreg[k], vv);
#pragma unroll
        for (int q = 0; q < 8; ++q) vT[(8 * ch + q) * LR + sidx] = (bf16_t)f2bf(vv[q]);
        *(u32x4*)(CT + s2 * LR + 8 * c2) = r.creg[k]; }
    __syncthreads();
    { const int nxt = (int)*nextp; if (nxt < 1024) m3_issue(a, nxt, tid, r); }
    if (tid < 128) { float s = 0.f;
#pragma unroll 4
        for (int d8 = 0; d8 < 16; ++d8) { float x[8]; unpack8(*(const u32x4*)(qs + tl * LR + 8 * d8), x); const f32x4 n0 = *(const f32x4*)(nn + 8 * d8), n1 = *(const f32x4*)(nn + 8 * d8 + 4);
            s += (x[0] * n0.x + x[1] * n0.y) + (x[2] * n0.z + x[3] * n0.w) + (x[4] * n1.x + x[5] * n1.y) + (x[6] * n1.z + x[7] * n1.w); }
        dint[tl] = s * wint[tl]; }
    f32x4 sacc[8];
#pragma unroll
    for (int i = 0; i < 8; ++i) sacc[i] = (f32x4){0.f, 0.f, 0.f, 0.f};
#pragma unroll
    for (int kk = 0; kk < 4; ++kk) { const bf16x8 bq = ldfrag(qs, 16 * wave, 32 * kk, lane);
#pragma unroll
        for (int sb = 0; sb < 8; ++sb) sacc[sb] = mfma16(ldfrag(ks, 16 * sb, 32 * kk, lane), bq, sacc[sb]); }
    MFMA_DRAIN8(sacc);
    __syncthreads();
    {
        const int t = 16 * wave + (lane & 15); const float g = gg[t]; float rs = 0.f;
#pragma unroll
        for (int sb = 0; sb < 8; ++sb) { float p[4];
            const f32x4 u4 = *(const f32x4*)(tmp + 16 * sb + 4 * (lane >> 4));
#pragma unroll
            for (int r = 0; r < 4; ++r) { const int s = 16 * sb + 4 * (lane >> 4) + r;
                const float w = __builtin_amdgcn_exp2f(fminf(u4[r] - g, 0.f) * LOG2E);
                p[r] = (s <= t) ? sacc[sb][r] * w : 0.f; rs += p[r]; }
            u32x2 w; w.x = pk2(p[0], p[1]); w.y = pk2(p[2], p[3]);
            *(u32x2*)(Ps + t * LR + 16 * sb + 4 * (lane >> 4)) = w; }
        rs += __shfl_xor(rs, 16); rs += __shfl_xor(rs, 32);
        if (lane < 16) den[t] = rs + dint[t];
    }
    __syncthreads();
    u32x2 og[4];
    {
        f32x4 a1[8], a2[8];
#pragma unroll
        for (int i = 0; i < 8; ++i) { a1[i] = (f32x4){0.f, 0.f, 0.f, 0.f}; a2[i] = (f32x4){0.f, 0.f, 0.f, 0.f}; }
#pragma unroll
        for (int kk = 0; kk < 4; ++kk) { const bf16x8 ap = ldfrag(Ps, 16 * wave, 32 * kk, lane), aq = ldfrag(qs, 16 * wave, 32 * kk, lane);
#pragma unroll
            for (int eb = 0; eb < 8; ++eb) { a1[eb] = mfma16(ap, ldfrag(vT, 16 * eb, 32 * kk, lane), a1[eb]); a2[eb] = mfma16(aq, ldfrag(CT, 16 * eb, 32 * kk, lane), a2[eb]); } }
        MFMA_DRAIN8(a1); MFMA_DRAIN8(a2);
#pragma unroll
    for (int k = 0; k < 4; ++k) { const int idx = tl + 512 * k; og[k] = *(const u32x2*)((const unsigned char*)PROJ + (size_t)(t0 + (idx >> 4)) * (NPROJ * 2) + 3072 + h * 128 + 8 * (idx & 15)); }
        float hv[8][4]; float ssq[4];
#pragma unroll
        for (int r = 0; r < 4; ++r) { const int t = 16 * wave + 4 * (lane >> 4) + r;
            const float dd = fmaxf(fabsf(den[t]), expf(-(bb[t] + gg[t]))); const float inv = 1.f / dd, wi = wint[t]; float s2 = 0.f;
#pragma unroll
            for (int eb = 0; eb < 8; ++eb) { const float x = (a1[eb][r] + wi * a2[eb][r]) * inv; hv[eb][r] = x; s2 += x * x;
            }
            s2 += __shfl_xor(s2, 1); s2 += __shfl_xor(s2, 2); s2 += __shfl_xor(s2, 4); s2 += __shfl_xor(s2, 8);
            ssq[r] = rsqrtf(s2 * (1.f / 128.f) + EPS); }
        __syncthreads();
#pragma unroll
        for (int eb = 0; eb < 8; ++eb) { const int e = 16 * eb + (lane & 15); const float ge = WL[1280 + e];
#pragma unroll
            for (int r = 0; r < 4; ++r) { const int t = 16 * wave + 4 * (lane >> 4) + r; qs[t * LR + e] = (bf16_t)f2bf(hv[eb][r] * ssq[r] * ge); } }
    }
    __syncthreads();
#pragma unroll
    for (int k = 0; k < 4; ++k) { const int idx = tl + 512 * k, t = idx >> 4, c8 = idx & 15;
        float x[8], g[8], y[8]; unpack8(*(const u32x4*)(qs + t * LR + 8 * c8), x); unpack8f8(og[k], g);
#pragma unroll
        for (int q = 0; q < 8; ++q) y[q] = 8.f * x[q] * sigm(g[q]);
        u32x2 w8; w8.x = pk4_fp8(y[0], y[1], y[2], y[3]); w8.y = pk4_fp8(y[4], y[5], y[6], y[7]);
        *(u32x2*)((unsigned char*)MIX + (size_t)(t0 + t) * DM + h * 128 + 8 * c8) = w8; }
    __syncthreads();
}

__device__ __forceinline__ void qknorm_rows(const Args& a, const int tid) {
    const int lane = tid & 63, wave = tid >> 6;
    bf16_t* PROJ = (bf16_t*)(a.ws + WS_PROJ);
    const float* gq = a.in[9]; const float* gk = a.in[10];
    const float* g = (lane < 32) ? gq : gk; const float scl = (lane < 32) ? C2 : 1.f;
    float gv[16];
#pragma unroll
    for (int i = 0; i < 16; ++i) gv[i] = g[16 * (lane & 3) + i] * scl;
    const int gw = blockIdx.x * 8 + wave, NGW = gridDim.x * 8;
    for (int row = gw; row < T; row += NGW) {
        u32x4* p = (u32x4*)(PROJ + (size_t)row * NPROJ + 2048 + 16 * lane);
        float x[16]; { float t8[8]; unpack8(p[0], t8);
#pragma unroll
            for (int i = 0; i < 8; ++i) x[i] = t8[i]; unpack8(p[1], t8);
#pragma unroll
            for (int i = 0; i < 8; ++i) x[8 + i] = t8[i]; }
        float ss = 0.f;
#pragma unroll
        for (int i = 0; i < 16; ++i) ss += x[i] * x[i];
        ss += __shfl_xor(ss, 1); ss += __shfl_xor(ss, 2);
        const float rstd = rsqrtf(ss * (1.f / 64.f) + EPS);
        float y0[8], y1[8];
#pragma unroll
        for (int i = 0; i < 8; ++i) { y0[i] = x[i] * rstd * gv[i]; y1[i] = x[8 + i] * rstd * gv[8 + i]; }
        p[0] = pack8(y0); p[1] = pack8(y1);
    }
}

#include <hip/hip_bf16.h>
namespace attn_body {
using bf16=__hip_bfloat16;
using bf16x8=__attribute__((ext_vector_type(8)))short;
using s16x4=__attribute__((ext_vector_type(4)))short;
using f32x16=__attribute__((ext_vector_type(16)))float;
using u32x4=__attribute__((ext_vector_type(4)))unsigned;
constexpr int SEQ=8192,PQ=3584,KVBLK=64;
__device__ __forceinline__ int crow(int r,int hi){return (r&3)+8*(r>>2)+4*hi;}
#define SBAR() __builtin_amdgcn_sched_barrier(0)
__device__ __forceinline__ void cmask(f32x16&p0,f32x16&p1,int jb,int qrel,int hi){
  const float NEG=-INFINITY; int kb=64*jb+4*hi;
  #pragma unroll
  for(int r=0;r<16;++r){int kv=kb+(r&3)+8*(r>>2); if(kv>qrel)p0[r]=NEG; if(kv+32>qrel)p1[r]=NEG;}
}

__device__ __forceinline__ void glds16(const void*gsrc,unsigned lds_dst){unsigned keep;
  asm volatile("s_mov_b32 %0, m0\n\ts_mov_b32 m0, %2\n\ts_nop 0\n\tglobal_load_lds_dwordx4 %1, off\n\ts_mov_b32 m0, %0":"=&s"(keep):"v"(gsrc),"s"(lds_dst):"memory");}
typedef float f32x2_t __attribute__((ext_vector_type(2))); typedef __bf16 bf16x2_t __attribute__((ext_vector_type(2)));
__device__ __forceinline__ unsigned cvtpk_s(float lo,float hi){f32x2_t v={lo,hi};bf16x2_t b=__builtin_convertvector(v,bf16x2_t);return __builtin_bit_cast(unsigned,b);}

__device__ __forceinline__ unsigned bsplit(float b){ const unsigned u=__float_as_uint(b); const float lo=b-__uint_as_float(u&0xffff0000u); return (u>>16)|(__float_as_uint(lo)&0xffff0000u); }
__device__ __forceinline__ void qkt(f32x16&p0,f32x16&p1,unsigned kb,const bf16x8*qr,const bf16x8 aaug,const bf16x8 bq0,const bf16x8 bq1){
  bf16x8 k0,k1,k2,k3,k4,k5,k6,k7;
  #define QK_RD(K,OFF) asm volatile("ds_read_b128 %0,%1 offset:%c2":"=&v"(K):"v"(kb),"i"(OFF):"memory")
  QK_RD(k0,0);QK_RD(k1,512);QK_RD(k2,2048);QK_RD(k3,2560);QK_RD(k4,4096);QK_RD(k5,4608);QK_RD(k6,6144);QK_RD(k7,6656);
  #undef QK_RD
  p0=__builtin_amdgcn_mfma_f32_32x32x16_bf16(aaug,bq0,f32x16{},0,0,0);p1=__builtin_amdgcn_mfma_f32_32x32x16_bf16(aaug,bq1,f32x16{},0,0,0);SBAR();
  asm volatile("s_waitcnt lgkmcnt(6)":"+v"(k0),"+v"(k1)::"memory");SBAR();
  p0=__builtin_amdgcn_mfma_f32_32x32x16_bf16(k0,qr[0],p0,0,0,0);p1=__builtin_amdgcn_mfma_f32_32x32x16_bf16(k1,qr[0],p1,0,0,0);SBAR();
  asm volatile("s_waitcnt lgkmcnt(4)":::"memory");SBAR();
  p0=__builtin_amdgcn_mfma_f32_32x32x16_bf16(k2,qr[1],p0,0,0,0);p1=__builtin_amdgcn_mfma_f32_32x32x16_bf16(k3,qr[1],p1,0,0,0);SBAR();
  asm volatile("s_waitcnt lgkmcnt(2)":::"memory");SBAR();
  p0=__builtin_amdgcn_mfma_f32_32x32x16_bf16(k4,qr[2],p0,0,0,0);p1=__builtin_amdgcn_mfma_f32_32x32x16_bf16(k5,qr[2],p1,0,0,0);SBAR();
  asm volatile("s_waitcnt lgkmcnt(0)":::"memory");SBAR();
  p0=__builtin_amdgcn_mfma_f32_32x32x16_bf16(k6,qr[3],p0,0,0,0);p1=__builtin_amdgcn_mfma_f32_32x32x16_bf16(k7,qr[3],p1,0,0,0);SBAR();
}

__device__ __forceinline__ void pv4(f32x16*o,int vb,bf16x8 pa0,bf16x8 pa1,bf16x8 pa2,bf16x8 pa3){
  s16x4 la[4],ha[4],lb[4],hb[4];
  #define PV_READ(L,H,OFF) do{ _Pragma("unroll") for(int ks=0;ks<4;++ks){ \
      asm volatile("ds_read_b64_tr_b16 %0,%1 offset:%c2":"=&v"(L[ks]):"v"(vb),"i"((OFF)+ks*1024):"memory"); \
      asm volatile("ds_read_b64_tr_b16 %0,%1 offset:%c2":"=&v"(H[ks]):"v"(vb),"i"((OFF)+ks*1024+512):"memory"); } }while(0)
  #define PV_PK(L,H,k) (bf16x8){L[k][0],L[k][1],L[k][2],L[k][3],H[k][0],H[k][1],H[k][2],H[k][3]}
  #define PV_MMA(dst,L,H) do{ dst=__builtin_amdgcn_mfma_f32_32x32x16_bf16(pa0,PV_PK(L,H,0),dst,0,0,0); dst=__builtin_amdgcn_mfma_f32_32x32x16_bf16(pa1,PV_PK(L,H,1),dst,0,0,0); \
      dst=__builtin_amdgcn_mfma_f32_32x32x16_bf16(pa2,PV_PK(L,H,2),dst,0,0,0); dst=__builtin_amdgcn_mfma_f32_32x32x16_bf16(pa3,PV_PK(L,H,3),dst,0,0,0); }while(0)
  PV_READ(la,ha,0); PV_READ(lb,hb,4096);
  asm volatile("s_waitcnt lgkmcnt(8)":::"memory");SBAR(); PV_MMA(o[0],la,ha); SBAR();
  PV_READ(la,ha,8192);
  asm volatile("s_waitcnt lgkmcnt(8)":::"memory");SBAR(); PV_MMA(o[1],lb,hb); SBAR();
  PV_READ(lb,hb,12288);
  asm volatile("s_waitcnt lgkmcnt(8)":::"memory");SBAR(); PV_MMA(o[2],la,ha); SBAR();
  asm volatile("s_waitcnt lgkmcnt(0)":::"memory");SBAR(); PV_MMA(o[3],lb,hb); SBAR();
  #undef PV_READ
  #undef PV_PK
  #undef PV_MMA
}


constexpr int CV_GROUPS=24576;
struct CvCtx { const float*w1; const float*w3; const float*w2; unsigned char*d13; unsigned char*d2; };
__device__ __forceinline__ const u32x4* cv_src(const CvCtx cx,int g,int wid,int lane){
  const int r=lane&31,h=lane>>5; const int krow=16*((r>>2)&1)+(r&3)+4*(r>>3);
  const float*src; int ldn,kb,n0;
  if(g<16384){ const int e=g>>6,rr=g&63; src=((rr>>5)?cx.w3:cx.w1)+(size_t)e*1024*256; ldn=256; kb=rr&31; n0=32*wid; }
  else{ const int g2=g-16384,e=g2>>5,rr=g2&31; src=cx.w2+(size_t)e*256*1024; ldn=1024; kb=rr&7; n0=32*(8*(rr>>3)+wid); }
  return (const u32x4*)(src+(size_t)(32*kb+krow)*ldn+n0+8*h);
}
__device__ __forceinline__ void cv_issue(const CvCtx cx,int g,int wid,int lane,u32x4&c0,u32x4&c1,u32x4&c2,u32x4&c3){
  const u32x4*p=cv_src(cx,g,wid,lane);
  c0=__builtin_nontemporal_load(p); c1=__builtin_nontemporal_load(p+1); c2=__builtin_nontemporal_load(p+4); c3=__builtin_nontemporal_load(p+5);
}
struct CvPos { const char*s; unsigned char*d; };
__device__ __forceinline__ CvPos cv_pos_full(const CvCtx cx,int g,int wid){ CvPos p;
  if(g<16384){ const int e=g>>6,rr=g&63; p.s=(const char*)(((rr>>5)?cx.w3:cx.w1)+(size_t)e*1024*256+(size_t)(32*(rr&31))*256+32*wid); p.d=cx.d13+((size_t)e*512*1024+(size_t)(64*wid+4*(rr>>5))*1024+32*(rr&31)); }
  else{ const int g2=g-16384,e=g2>>5,rr=g2&31; p.s=(const char*)(cx.w2+(size_t)e*256*1024+(size_t)(32*(rr&7))*1024+32*(8*(rr>>3)+wid)); p.d=cx.d2+((size_t)e*1024*256+(size_t)(32*(8*(rr>>3)+wid))*256+32*(rr&7)); }
  return p; }
__device__ __forceinline__ CvPos cv_pos_next(const CvCtx cx,int g,int wid,CvPos p){
  if(g<16384){ if(g&31){ p.s+=32*1024; p.d+=32; return p; } }
  else{ if(g&7){ p.s+=32*4096; p.d+=32; return p; } }
  return cv_pos_full(cx,g,wid); }
__device__ __forceinline__ void cv_issue_pos(const char*base,bool e13,unsigned loff,unsigned wt){
  unsigned voff,pstep;
  if(e13){ voff=loff; pstep=8u*1024u; } else { voff=((loff&~1023u)<<2)+(loff&1023u); pstep=8u*4096u; }
  unsigned keep; const unsigned v1=voff+pstep,v2=v1+pstep,v3=v2+pstep;
  asm volatile("s_mov_b32 %0, m0\n\ts_mov_b32 m0, %6\n\ts_nop 0\n\tglobal_load_lds_dwordx4 %1, %5\n\ts_add_u32 m0, m0, 0x400\n\ts_nop 0\n\tglobal_load_lds_dwordx4 %2, %5\n\t"
               "s_add_u32 m0, m0, 0x400\n\ts_nop 0\n\tglobal_load_lds_dwordx4 %3, %5\n\ts_add_u32 m0, m0, 0x400\n\ts_nop 0\n\tglobal_load_lds_dwordx4 %4, %5\n\ts_mov_b32 m0, %0"
               :"=&s"(keep):"v"(voff),"v"(v1),"v"(v2),"v"(v3),"s"(base),"s"(wt):"memory","scc");
}
__device__ __forceinline__ void cv_issue_lds(const CvCtx cx,int g,int wid,unsigned loff,unsigned wt){
  const char*base; unsigned voff,pstep;
  if(g<16384){ const int e=g>>6,rr=g&63; base=(const char*)(((rr>>5)?cx.w3:cx.w1)+(size_t)e*1024*256+(size_t)(32*(rr&31))*256+32*wid); voff=loff; pstep=8u*1024u; }
  else{ const int g2=g-16384,e=g2>>5,rr=g2&31; base=(const char*)(cx.w2+(size_t)e*256*1024+(size_t)(32*(rr&7))*1024+32*(8*(rr>>3)+wid)); voff=((loff&~1023u)<<2)+(loff&1023u); pstep=8u*4096u; }
  unsigned keep; const unsigned v1=voff+pstep,v2=v1+pstep,v3=v2+pstep;
  asm volatile("s_mov_b32 %0, m0\n\ts_mov_b32 m0, %6\n\ts_nop 0\n\tglobal_load_lds_dwordx4 %1, %5\n\ts_add_u32 m0, m0, 0x400\n\ts_nop 0\n\tglobal_load_lds_dwordx4 %2, %5\n\t"
               "s_add_u32 m0, m0, 0x400\n\ts_nop 0\n\tglobal_load_lds_dwordx4 %3, %5\n\ts_add_u32 m0, m0, 0x400\n\ts_nop 0\n\tglobal_load_lds_dwordx4 %4, %5\n\ts_mov_b32 m0, %0"
               :"=&s"(keep):"v"(voff),"v"(v1),"v"(v2),"v"(v3),"s"(base),"s"(wt):"memory","scc");
}
__device__ __forceinline__ unsigned char* cv_dst(const CvCtx cx,int g,int wid,int lane){
  const int c=lane&31,h=lane>>5;
  if(g<16384){ const int e=g>>6,rr=g&63; return cx.d13+((size_t)e*512*1024+(size_t)(64*wid+4*(rr>>5))*1024+32*(rr&31))+(unsigned)(((c>>2)*8+(c&3))*1024+16*h); }
  const int g2=g-16384,e=g2>>5,rr=g2&31; return cx.d2+((size_t)e*1024*256+(size_t)(32*(8*(rr>>3)+wid))*256+32*(rr&7))+(unsigned)(c*256+16*h);
}
__device__ __forceinline__ void cv_consume_to(unsigned char*dbase,bool e13,int lane,const u32x4 c0,const u32x4 c1,const u32x4 c2,const u32x4 c3,const bf16x8 id0,const bf16x8 id1){
  const int c=lane&31,h=lane>>5;
  #define CVF(u) __uint_as_float(u)
  const u32x4 a0={cvtpk_s(CVF(c0.x),CVF(c0.y)),cvtpk_s(CVF(c0.z),CVF(c0.w)),cvtpk_s(CVF(c1.x),CVF(c1.y)),cvtpk_s(CVF(c1.z),CVF(c1.w))};
  const u32x4 a1={cvtpk_s(CVF(c2.x),CVF(c2.y)),cvtpk_s(CVF(c2.z),CVF(c2.w)),cvtpk_s(CVF(c3.x),CVF(c3.y)),cvtpk_s(CVF(c3.z),CVF(c3.w))};
  #undef CVF
  f32x16 d=f32x16{};
  d=__builtin_amdgcn_mfma_f32_32x32x16_bf16(__builtin_bit_cast(bf16x8,a0),id0,d,0,0,0);
  d=__builtin_amdgcn_mfma_f32_32x32x16_bf16(__builtin_bit_cast(bf16x8,a1),id1,d,0,0,0);
  u32x4 o; o.x=pk4_fp8(d[0],d[1],d[2],d[3]); o.y=pk4_fp8(d[4],d[5],d[6],d[7]); o.z=pk4_fp8(d[8],d[9],d[10],d[11]); o.w=pk4_fp8(d[12],d[13],d[14],d[15]);
  const unsigned lo=e13?(unsigned)(((c>>2)*8+(c&3))*1024+16*h):(unsigned)(c*256+16*h);
  *(u32x4*)(dbase+lo)=o;
}
__device__ __forceinline__ void cv_consume(const CvCtx cx,int g,int wid,int lane,const u32x4 c0,const u32x4 c1,const u32x4 c2,const u32x4 c3,const bf16x8 id0,const bf16x8 id1){
  const int c=lane&31,h=lane>>5;
  #define CVF(u) __uint_as_float(u)
  const u32x4 a0={cvtpk_s(CVF(c0.x),CVF(c0.y)),cvtpk_s(CVF(c0.z),CVF(c0.w)),cvtpk_s(CVF(c1.x),CVF(c1.y)),cvtpk_s(CVF(c1.z),CVF(c1.w))};
  const u32x4 a1={cvtpk_s(CVF(c2.x),CVF(c2.y)),cvtpk_s(CVF(c2.z),CVF(c2.w)),cvtpk_s(CVF(c3.x),CVF(c3.y)),cvtpk_s(CVF(c3.z),CVF(c3.w))};
  #undef CVF
  f32x16 d=f32x16{};
  d=__builtin_amdgcn_mfma_f32_32x32x16_bf16(__builtin_bit_cast(bf16x8,a0),id0,d,0,0,0);
  d=__builtin_amdgcn_mfma_f32_32x32x16_bf16(__builtin_bit_cast(bf16x8,a1),id1,d,0,0,0);
  u32x4 o; o.x=pk4_fp8(d[0],d[1],d[2],d[3]); o.y=pk4_fp8(d[4],d[5],d[6],d[7]); o.z=pk4_fp8(d[8],d[9],d[10],d[11]); o.w=pk4_fp8(d[12],d[13],d[14],d[15]);
  unsigned char*dst=cv_dst(cx,g,wid,lane);
  *(u32x4*)dst=o;
}
constexpr int A2_KS=16384, A2_K=0, A2_V=32768, A2_WT=65536, A2_WS=131072, A2_IDT=133120, A2_DG=135168, A2_STG=65536;
__device__ __forceinline__ int attn2_unit(const bf16*PROJ,const float*dg,bf16_t*MIX,char*shm,int bh,int qb,const float lam,const float m0,const CvCtx cx,int cnext,const int cend,unsigned*qnext,volatile PG8_LAS unsigned*tslot){
  const int tid=threadIdx.x,lane=tid&63,r32=lane&31,hi=lane>>5; const int wid=__builtin_amdgcn_readfirstlane(tid>>6);
  const int c=wid&1,qblk=wid>>1,b=bh>>2,h=bh&3; const long rowbase=(long)b*SEQ; const int q0=qb*128;
  const float sl2=exp2f(-2.f*(float)(h+1))*1.4426950408889634f;
  int tbeg=0; { const float kmin=(float)q0-(2.f*m0+40.f)/sl2; if(kmin>0.f)tbeg=((int)kmin)>>6; }
  const int NT=(q0+128)/KVBLK-tbeg;
  const bf16*Qw=PROJ+(rowbase+q0+qblk*32)*PQ+2048+h*128+c*64;
  const bf16*ksrc=PROJ+(rowbase+(long)tbeg*KVBLK+lane)*PQ+2560+h*128+wid*8;
  const bf16*vsrc=PROJ+(rowbase+(long)tbeg*KVBLK+16*(wid&3)+(lane>>2))*PQ+3072+h*128+(wid>>2)*32+(lane&3)*8;
  const unsigned lds0=(unsigned)(uintptr_t)shm;
  const unsigned kdst=lds0+A2_K+wid*1024, vdst=lds0+A2_V+wid*1024;
  #define A2_DMAK(t) do{ const bf16*kp_=ksrc+(long)(t)*KVBLK*PQ; const unsigned so_=(unsigned)((t)&1)*A2_KS; \
      glds16(kp_,(unsigned)__builtin_amdgcn_readfirstlane(kdst+so_)); glds16(kp_+64,(unsigned)__builtin_amdgcn_readfirstlane(kdst+so_+8192)); }while(0)
  #define A2_DMAV(t) do{ const bf16*vp_=vsrc+(long)(t)*KVBLK*PQ; const unsigned so_=(unsigned)((t)&1)*A2_KS; \
      glds16(vp_,(unsigned)__builtin_amdgcn_readfirstlane(vdst+so_)); glds16(vp_+64,(unsigned)__builtin_amdgcn_readfirstlane(vdst+so_+8192)); }while(0)
  A2_DMAK(0); A2_DMAV(0); A2_DMAK(1);
  bf16x8 qr[4];
  #pragma unroll
  for(int d0=0;d0<4;++d0)qr[d0]=*reinterpret_cast<const bf16x8*>(&Qw[(long)r32*PQ+d0*16+hi*8]);
  const int qrel=qblk*32+r32;
  const float sl64=sl2*64.f,c32=sl2*32.f;
  float l_reg=0.f; f32x16 o[4]; o[0]=f32x16{};o[1]=f32x16{};o[2]=f32x16{};o[3]=f32x16{};
  u32x4 aaugw; { const unsigned rb=__float_as_uint((float)r32)>>16; aaugw=(hi==0)?(u32x4){rb|(rb<<16),0x3F803F80u,0u,0u}:(u32x4){0u,0u,0u,0u}; }
  const bf16x8 aaug=__builtin_bit_cast(bf16x8,aaugw);
  const unsigned sd=bsplit(sl2);
  float beta=sl2*(float)(64*tbeg-q0-qrel)-m0;
  unsigned bd0=bsplit(beta),bd1=bsplit(beta+c32);
  const int vb0=(int)(lds0+A2_V)+((lane>>4)&1)*32+(lane&3)*8+(4*hi+((lane&15)>>2))*64;
  const unsigned kb0=lds0+A2_K+c*8192+hi*1024+r32*16;
  asm volatile(""::"v"(qr[0]),"v"(qr[1]),"v"(qr[2]),"v"(qr[3]));
  { asm volatile("s_waitcnt vmcnt(0)":::"memory"); asm volatile("s_barrier":::"memory"); }
  #define MF(A_,B_,C_) __builtin_amdgcn_mfma_f32_32x32x16_bf16(A_,B_,C_,0,0,0)
  #define PKW(P,B) cvtpk_s(P[B],P[B+1])
  #define A2_PACK(P0,P1) do{ float sacc=0.f; _Pragma("unroll") for(int r=0;r<16;++r)sacc+=P0[r]+P1[r]; l_reg+=sacc; \
      pw0=(u32x4){PKW(P0,0),PKW(P0,2),PKW(P0,4),PKW(P0,6)};pw1=(u32x4){PKW(P0,8),PKW(P0,10),PKW(P0,12),PKW(P0,14)}; \
      pw2=(u32x4){PKW(P1,0),PKW(P1,2),PKW(P1,4),PKW(P1,6)};pw3=(u32x4){PKW(P1,8),PKW(P1,10),PKW(P1,12),PKW(P1,14)}; }while(0)
  u32x4 pw0,pw1,pw2,pw3;
  { f32x16 p0,p1;
    qkt(p0,p1,kb0,qr,aaug,__builtin_bit_cast(bf16x8,(u32x4){sd,bd0,0u,0u}),__builtin_bit_cast(bf16x8,(u32x4){sd,bd1,0u,0u})); asm volatile("s_nop 15\n\ts_nop 7":"+v"(p0),"+v"(p1));
    beta+=sl64; bd0=bsplit(beta); bd1=bsplit(beta+c32);
    { const int jb=0-(NT-2); if(jb>=0)cmask(p0,p1,jb,qrel,hi); }
    #pragma unroll
    for(int r=0;r<16;++r){p0[r]=__builtin_amdgcn_exp2f(p0[r]);p1[r]=__builtin_amdgcn_exp2f(p1[r]);}
    A2_PACK(p0,p1); }
  const unsigned wtl=(unsigned)__builtin_amdgcn_readfirstlane(lds0+A2_WT+wid*8192);
  const unsigned loff=(unsigned)((lane>>3)*1024+16*((lane&7)^(lane>>3)));
  const int prow=16*((r32>>2)&1)+(r32&3)+4*(r32>>3);
  const unsigned rd0=(unsigned)((prow>>3)*1024+(prow&7)*128+16*((2*hi)^(prow&7)));
  int cgA=-1,cgB=-1;
  asm volatile("s_waitcnt lgkmcnt(0)\n\ts_barrier":::"memory");
  if(NT>2)A2_DMAK(2);
  A2_DMAV(1);
  CvPos pos; pos.s=nullptr; pos.d=nullptr; unsigned char*dA=nullptr,*dB=nullptr;
  if(0<=NT-3&&cnext<cend){ cgA=cnext++; pos=cv_pos_full(cx,cgA,wid); dA=pos.d; cv_issue_pos(pos.s,cgA<16384,loff,wtl); }
  for(int t=0;t+1<NT;++t){
    const unsigned kb=kb0+(unsigned)((t+1)&1)*A2_KS; const int vb=vb0+(t&1)*A2_KS;
    const bf16x8 pa0=__builtin_bit_cast(bf16x8,pw0),pa1=__builtin_bit_cast(bf16x8,pw1),pa2=__builtin_bit_cast(bf16x8,pw2),pa3=__builtin_bit_cast(bf16x8,pw3);
    bf16x8 k0,k1,k2,k3,k4,k5,k6,k7; s16x4 la[4],ha[4],lb[4],hb[4]; f32x16 n0,n1;
    #define QK_RD(K,OFF) asm volatile("ds_read_b128 %0,%1 offset:%c2":"=&v"(K):"v"(kb),"i"(OFF):"memory")
    #define PV_READ(L,H,OFF) do{ _Pragma("unroll") for(int ks=0;ks<4;++ks){ \
        asm volatile("ds_read_b64_tr_b16 %0,%1 offset:%c2":"=&v"(L[ks]):"v"(vb),"i"((OFF)+ks*1024):"memory"); \
        asm volatile("ds_read_b64_tr_b16 %0,%1 offset:%c2":"=&v"(H[ks]):"v"(vb),"i"((OFF)+ks*1024+512):"memory"); } }while(0)
    #define PV_PK(L,H,k) (bf16x8){L[k][0],L[k][1],L[k][2],L[k][3],H[k][0],H[k][1],H[k][2],H[k][3]}
    #define WK(N,A_,B_) asm volatile("s_waitcnt lgkmcnt(" #N ")":"+v"(A_),"+v"(B_)::"memory")
    #define WV(N,L,H) asm volatile("s_waitcnt lgkmcnt(" #N ")":"+v"(L[0]),"+v"(L[1]),"+v"(L[2]),"+v"(L[3]),"+v"(H[0]),"+v"(H[1]),"+v"(H[2]),"+v"(H[3])::"memory")
    #define PIN(X_) asm volatile("":"+v"(X_))
    #define EX(P,i) P[i]=__builtin_amdgcn_exp2f(P[i])
    QK_RD(k0,0);QK_RD(k1,512);QK_RD(k2,2048);QK_RD(k3,2560);QK_RD(k4,4096);QK_RD(k5,4608);QK_RD(k6,6144);QK_RD(k7,6656);
    PV_READ(la,ha,0);
    n0=MF(aaug,__builtin_bit_cast(bf16x8,(u32x4){sd,bd0,0u,0u}),f32x16{});n1=MF(aaug,__builtin_bit_cast(bf16x8,(u32x4){sd,bd1,0u,0u}),f32x16{});PIN(n0);PIN(n1);SBAR();
    WK(14,k0,k1);SBAR(); n0=MF(k0,qr[0],n0);n1=MF(k1,qr[0],n1);PIN(n0);PIN(n1);SBAR();
    WK(12,k2,k3);SBAR(); n0=MF(k2,qr[1],n0);n1=MF(k3,qr[1],n1);PIN(n0);PIN(n1);SBAR();
    WK(10,k4,k5);SBAR(); n0=MF(k4,qr[2],n0);n1=MF(k5,qr[2],n1);PIN(n0);PIN(n1);SBAR();
    WK(8,k6,k7);SBAR();  n0=MF(k6,qr[3],n0);n1=MF(k7,qr[3],n1);PIN(n0);PIN(n1);SBAR();
    PV_READ(lb,hb,4096);
    WV(8,la,ha);SBAR();
    o[0]=MF(pa0,PV_PK(la,ha,0),o[0]);PIN(o[0]); beta+=sl64; bd0=bsplit(beta); SBAR();
    o[0]=MF(pa1,PV_PK(la,ha,1),o[0]);PIN(o[0]); bd1=bsplit(beta+c32); SBAR();
    o[0]=MF(pa2,PV_PK(la,ha,2),o[0]);PIN(o[0]); SBAR();
    o[0]=MF(pa3,PV_PK(la,ha,3),o[0]);PIN(o[0]); SBAR();
    PV_READ(la,ha,8192);
    { const int jb=t+1-(NT-2); if(jb>=0){cmask(n0,n1,jb,qrel,hi);PIN(n0);PIN(n1);} }
    WV(8,lb,hb);SBAR();
    o[1]=MF(pa0,PV_PK(lb,hb,0),o[1]);PIN(o[1]); EX(n0,0);EX(n0,1);EX(n0,2);PIN(n0); SBAR();
    o[1]=MF(pa1,PV_PK(lb,hb,1),o[1]);PIN(o[1]); EX(n0,3);EX(n0,4);EX(n0,5);PIN(n0); SBAR();
    o[1]=MF(pa2,PV_PK(lb,hb,2),o[1]);PIN(o[1]); EX(n0,6);EX(n0,7);PIN(n0); SBAR();
    o[1]=MF(pa3,PV_PK(lb,hb,3),o[1]);PIN(o[1]); EX(n0,8);EX(n0,9);EX(n0,10);PIN(n0); SBAR();
    PV_READ(lb,hb,12288);
    WV(8,la,ha);SBAR();
    o[2]=MF(pa0,PV_PK(la,ha,0),o[2]);PIN(o[2]); EX(n0,11);EX(n0,12);EX(n0,13);PIN(n0); SBAR();
    o[2]=MF(pa1,PV_PK(la,ha,1),o[2]);PIN(o[2]); EX(n0,14);EX(n0,15);PIN(n0); SBAR();
    o[2]=MF(pa2,PV_PK(la,ha,2),o[2]);PIN(o[2]); EX(n1,0);EX(n1,1);EX(n1,2);PIN(n1); SBAR();
    o[2]=MF(pa3,PV_PK(la,ha,3),o[2]);PIN(o[2]); EX(n1,3);EX(n1,4);EX(n1,5);PIN(n1); SBAR();
    WV(0,lb,hb);SBAR();
    o[3]=MF(pa0,PV_PK(lb,hb,0),o[3]);PIN(o[3]); EX(n1,6);EX(n1,7);PIN(n1); SBAR();
    o[3]=MF(pa1,PV_PK(lb,hb,1),o[3]);PIN(o[3]); EX(n1,8);EX(n1,9);EX(n1,10);PIN(n1); SBAR();
    o[3]=MF(pa2,PV_PK(lb,hb,2),o[3]);PIN(o[3]); EX(n1,11);EX(n1,12);EX(n1,13);PIN(n1); SBAR();
    o[3]=MF(pa3,PV_PK(lb,hb,3),o[3]);PIN(o[3]); EX(n1,14);EX(n1,15);PIN(n1); SBAR();
    #undef WK
    #undef WV
    #undef PIN
    #undef QK_RD
    #undef PV_READ
    #undef PV_PK
    #undef EX
    A2_PACK(n0,n1);
    if(cgA>=0)asm volatile("s_waitcnt vmcnt(4)":::"memory"); else asm volatile("s_waitcnt vmcnt(0)":::"memory");
    if(cgB>=0){ const bf16x8*idt=(const bf16x8*)(shm+A2_IDT)+2*lane; const char*wt=shm+A2_WT+wid*8192+((t+1)&1)*4096;
      cv_consume_to(dB,cgB<16384,lane,*(const u32x4*)(wt+rd0),*(const u32x4*)(wt+(rd0^16)),*(const u32x4*)(wt+(rd0^64)),*(const u32x4*)(wt+(rd0^80)),idt[0],idt[1]); }
    asm volatile("s_waitcnt lgkmcnt(0)\n\ts_barrier":::"memory");
    if(t+3<NT)A2_DMAK(t+3);
    if(t+2<NT)A2_DMAV(t+2);
    cgB=cgA; dB=dA; cgA=-1;
    if(t+1<=NT-3&&cnext<cend){ cgA=cnext++; pos=(cgB>=0)?cv_pos_next(cx,cgA,wid,pos):cv_pos_full(cx,cgA,wid); dA=pos.d; cv_issue_pos(pos.s,cgA<16384,loff,wtl+(unsigned)((t+1)&1)*4096u); }
  }
  pv4(o,vb0+((NT-1)&1)*A2_KS,__builtin_bit_cast(bf16x8,pw0),__builtin_bit_cast(bf16x8,pw1),__builtin_bit_cast(bf16x8,pw2),__builtin_bit_cast(bf16x8,pw3));
  asm volatile("s_waitcnt lgkmcnt(0)\n\ts_barrier":::"memory");
  #undef MF
  #undef PKW
  #undef A2_PACK
  asm volatile("s_waitcnt vmcnt(0)":::"memory");
  #undef A2_DMAK
  #undef A2_DMAV
  unsigned tk=0u; if(tid==0)tk=atomicAdd(qnext,1u);
  {auto rr=__builtin_amdgcn_permlane32_swap(__float_as_uint(l_reg),__float_as_uint(l_reg),false,false);l_reg=__uint_as_float(rr[0])+__uint_as_float(rr[1]);}
  float*wsf=(float*)(shm+A2_WS)+wid*64;
  if(hi==0)wsf[r32]=l_reg; asm volatile("s_waitcnt lgkmcnt(0)":::"memory");
  float rli[16];
  #pragma unroll
  for(int r=0;r<16;++r)rli[r]=__builtin_amdgcn_rcpf(wsf[crow(r,hi)]);
  float*X=(float*)shm+qblk*4096;
  if(c==1){
    #pragma unroll
    for(int d0=0;d0<4;++d0)
      #pragma unroll
      for(int r=0;r<16;++r)X[(d0*16+r)*64+lane]=o[d0][r]*rli[r];
  }
  asm volatile("s_waitcnt lgkmcnt(0)\n\ts_barrier":::"memory");
  if(c==0){
    bf16_t*stg=(bf16_t*)(shm+A2_STG)+qblk*4096;
    #pragma unroll
    for(int d0=0;d0<4;++d0)
      #pragma unroll
      for(int r=0;r<16;++r){ const float v=o[d0][r]*rli[r]-lam*X[(d0*16+r)*64+lane]; stg[crow(r,hi)*128+d0*32+r32]=(bf16_t)(__builtin_bit_cast(unsigned short,__float2bfloat16(v))); }
    asm volatile("s_waitcnt lgkmcnt(0)":::"memory");
    const int row=lane>>1,half=lane&1; const bf16_t*sp=stg+row*128+half*64;
    float d[64]; float ss=0.f;
    #pragma unroll
    for(int i=0;i<8;++i){ const u32x4 w=*(const u32x4*)(sp+8*i);
      d[8*i+0]=__uint_as_float(w.x<<16);d[8*i+1]=__uint_as_float(w.x&0xffff0000u);d[8*i+2]=__uint_as_float(w.y<<16);d[8*i+3]=__uint_as_float(w.y&0xffff0000u);
      d[8*i+4]=__uint_as_float(w.z<<16);d[8*i+5]=__uint_as_float(w.z&0xffff0000u);d[8*i+6]=__uint_as_float(w.w<<16);d[8*i+7]=__uint_as_float(w.w&0xffff0000u); }
    #pragma unroll
    for(int i=0;i<64;++i)ss+=d[i]*d[i];
    ss+=__shfl_xor(ss,1);
    const float rs=rsqrtf(ss*(1.f/128.f)+1e-6f)*0.8f;
    unsigned char*mp=(unsigned char*)MIX+(size_t)(rowbase+q0+qblk*32+row)*1024+512+h*128+half*64; const float*gp=(const float*)(shm+A2_DG)+half*64;
    const float rs8=rs*8.f;
    #pragma unroll
    for(int i=0;i<4;++i){ u32x4 w;
      #define MV(j) (d[16*i+(j)]*rs8*gp[16*i+(j)])
      w.x=pk4_fp8(MV(0),MV(1),MV(2),MV(3)); w.y=pk4_fp8(MV(4),MV(5),MV(6),MV(7)); w.z=pk4_fp8(MV(8),MV(9),MV(10),MV(11)); w.w=pk4_fp8(MV(12),MV(13),MV(14),MV(15));
      #undef MV
      *(u32x4*)(mp+16*i)=w; }
  }
  asm volatile("s_waitcnt lgkmcnt(0)\n\ts_barrier":::"memory");
  if(tid==0)*tslot=tk;
  return cnext;
}
constexpr int ATTN_LDS_BYTES=LDS_BYTES;
#undef SBAR
#undef WAIT_BAR
}

__device__ __forceinline__ unsigned wave_umax(unsigned x) {
    x = max(x, (unsigned)__builtin_amdgcn_update_dpp(0, (int)x, 0x111, 0xf, 0xf, false));
    x = max(x, (unsigned)__builtin_amdgcn_update_dpp(0, (int)x, 0x112, 0xf, 0xf, false));
    x = max(x, (unsigned)__builtin_amdgcn_update_dpp(0, (int)x, 0x114, 0xf, 0xf, false));
    x = max(x, (unsigned)__builtin_amdgcn_update_dpp(0, (int)x, 0x118, 0xf, 0xf, false));
    x = max(x, (unsigned)__builtin_amdgcn_update_dpp(0, (int)x, 0x142, 0xa, 0xf, false));
    x = max(x, (unsigned)__builtin_amdgcn_update_dpp(0, (int)x, 0x143, 0xc, 0xf, false));
    return (unsigned)__builtin_amdgcn_readlane((int)x, 63);
}
__device__ __forceinline__ unsigned sel_key(float v, int idx) { unsigned u = __float_as_uint(v); u = (u & 0x80000000u) ? ~u : (u | 0x80000000u); return (u & 0xffffff00u) | (unsigned)(255 - idx); }

__device__ __forceinline__ void ph_route(const Args& a, unsigned char* lds, const int tid) {
    const int lane = tid & 63, wave = tid >> 6;
    int* hist = (int*)lds;
    const float* LOG = (const float*)(a.ws + WS_LOGITS); const float* rb = a.in[18];
    int* IDX = (int*)(a.ws + WS_IDX); float* GATEV = (float*)(a.ws + WS_GATEV); int* HIST = (int*)(a.ws + WS_HIST);
    unsigned* TOT = (unsigned*)(a.ws + WS_BAR) + 3456;
    const f32x4 rb4 = *((const f32x4*)rb + lane);
    for (int tb = blockIdx.x; tb < 256; tb += gridDim.x) {
        if (tid < 256) hist[tid] = 0;
        __syncthreads();
        f32x4 lgn = *((const f32x4*)(LOG + (size_t)(tb * 128 + wave * 16) * 256) + lane);
        for (int i = 0; i < 16; ++i) {
            const int t = tb * 128 + wave * 16 + i;
            const f32x4 lg = lgn;
            if (i < 15) lgn = *((const f32x4*)(LOG + (size_t)(t + 1) * 256) + lane);
            float s[4], sel[4];
            s[0] = sigm(lg.x); s[1] = sigm(lg.y); s[2] = sigm(lg.z); s[3] = sigm(lg.w);
            sel[0] = s[0] + rb4.x; sel[1] = s[1] + rb4.y; sel[2] = s[2] + rb4.z; sel[3] = s[3] + rb4.w;
            float m1 = fmaxf(sel[0], sel[1]), m2 = fminf(sel[0], sel[1]);
            { const float x = sel[2]; const float n1 = fmaxf(m1, x); m2 = fmaxf(m2, fminf(m1, x)); m1 = n1; }
            { const float x = sel[3]; const float n1 = fmaxf(m1, x); m2 = fmaxf(m2, fminf(m1, x)); m1 = n1; }
#pragma unroll
            for (int off = 1; off < 8; off <<= 1) { const float o1 = __shfl_xor(m1, off), o2 = __shfl_xor(m2, off);
                const float n1 = fmaxf(m1, o1), n2 = fmaxf(fminf(m1, o1), fmaxf(m2, o2)); m1 = n1; m2 = n2; }
            const float gs = m1 + m2; const int grp = lane >> 3; int rank = 0;
#pragma unroll
            for (int g2 = 0; g2 < 8; ++g2) { const float v = __builtin_bit_cast(float, __builtin_amdgcn_readlane(__builtin_bit_cast(int, gs), 8 * g2)); rank += ((v > gs) || (v == gs && g2 < grp)) ? 1 : 0; }
            const bool gsel = rank < 4;
            unsigned key[4];
#pragma unroll
            for (int j = 0; j < 4; ++j) key[j] = gsel ? sel_key(sel[j], 4 * lane + j) : 0u;
            float gsum = 0.f; float myg = 0.f; int myidx = 0;
#pragma unroll
            for (int k = 0; k < 8; ++k) {
                const unsigned best = wave_umax(max(max(key[0], key[1]), max(key[2], key[3])));
                const int bi = 255 - (int)(best & 255u);
                const int owner = bi >> 2, sub = bi & 3;
                float sv = (sub == 0) ? s[0] : (sub == 1) ? s[1] : (sub == 2) ? s[2] : s[3];
                sv = __builtin_bit_cast(float, __builtin_amdgcn_readlane(__builtin_bit_cast(int, sv), owner));
                if (lane == owner) {
#pragma unroll
                    for (int j = 0; j < 4; ++j) if (j == sub) key[j] = 0u;
                }
                gsum += sv;
                if (lane == k) { myg = sv; myidx = bi; }
            }
            if (lane < 8) { IDX[(size_t)t * 8 + lane] = myidx; GATEV[(size_t)t * 8 + lane] = myg / gsum * 2.5f; atomicAdd(&hist[myidx], 1); }
        }
        __syncthreads();
        if (tid < 256) { const int hv = hist[tid]; HIST[tb * 256 + tid] = hv; if (hv) atomicAdd(TOT + tid, (unsigned)hv); }
        __syncthreads();
    }
}

__device__ __forceinline__ void ph_scatter(const Args& a, unsigned char* lds, const int tid) {
    int* tot = (int*)lds; int* cur = tot + 256; int* base = cur + 256; int* tstart = base + 256;
    const int* HIST = (const int*)(a.ws + WS_HIST); const int* IDX = (const int*)(a.ws + WS_IDX); const float* GATEV = (const float*)(a.ws + WS_GATEV);
    int* PSLOT = (int*)(a.ws + WS_PSLOT); int* SLOTTOK = (int*)(a.ws + WS_SLOTTOK); float* SLOTGATE = (float*)(a.ws + WS_SLOTGATE);
    int* TILE = (int*)(a.ws + WS_TILE);
    unsigned* TOT = (unsigned*)(a.ws + WS_BAR) + 3456; unsigned* CUR = TOT + 256;
    for (int tb = blockIdx.x; tb < 256; tb += gridDim.x) {
        __syncthreads();
        int mine = 0;
        if (tid < 256) { tot[tid] = (int)__hip_atomic_load(TOT + tid, __ATOMIC_RELAXED, __HIP_MEMORY_SCOPE_AGENT); mine = HIST[tb * 256 + tid]; }
        __syncthreads();
        if (tid < 256) { int bs = 0, ts = 0; for (int j = 0; j < tid; ++j) { const int c = tot[j]; bs += c; ts += (c + 255) >> 8; } base[tid] = bs; tstart[tid] = ts;
            cur[tid] = bs + (mine ? (int)atomicAdd(CUR + tid, (unsigned)mine) : 0); }
        __syncthreads();
        for (int p = tid; p < 1024; p += 512) { const int t = tb * 128 + (p >> 3), k = p & 7; const int e = IDX[(size_t)t * 8 + k];
            const int slot = atomicAdd(&cur[e], 1); SLOTTOK[slot] = t; PSLOT[(size_t)t * 8 + k] = slot; }
        if (tb == 0) {
            if (tid < 256) { const int cnt = tot[tid], b0 = base[tid]; int n = tstart[tid];
                for (int r0 = 0; r0 < cnt; r0 += 256) { TILE[64 + n] = tid; TILE[64 + 2048 + n] = b0 + r0; TILE[64 + 4096 + n] = b0 + cnt; ++n; }
                if (tid == 255) TILE[0] = n; }
            __syncthreads();
            if (tid < 128) { const int n = tstart[255] + ((tot[255] + 255) >> 8);
                TILE[64 + n + tid] = 256; TILE[64 + 2048 + n + tid] = SHARED_BASE + 256 * tid; TILE[64 + 4096 + n + tid] = SHARED_BASE + T; }
        }
    }
}

template <int MODE>
__device__ __forceinline__ void ph_final(const Args& a, const int tid) {
    const int lane = tid & 63, wave = tid >> 6;
    const unsigned char* YP = (const unsigned char*)(a.ws + WS_YP); const int* PSLOT = (const int*)(a.ws + WS_PSLOT); const float* MOD = (const float*)(a.ws + WS_MOD);
    float* out = a.out;
    const int gw = blockIdx.x * 8 + wave, NGW = gridDim.x * 8;
    const int sub = lane & 15, rsel = lane >> 4;
    const float* GATEV = (const float*)(a.ws + WS_GATEV);
    int nslot = 0; float ngate = 1.f;
    { const int r0 = gw + (rsel == 1 ? NGW : 0); if (rsel < 2 && sub < 9 && r0 < T) { nslot = sub < 8 ? PSLOT[(size_t)r0 * 8 + sub] : SHARED_BASE + r0; if (sub < 8) ngate = GATEV[(size_t)r0 * 8 + sub]; } }
    for (int row = gw; row < T; row += 2 * NGW) {
        const int myslot = nslot; const float mygate = ngate; ngate = 1.f;
        { const int r1 = row + 2 * NGW + (rsel == 1 ? NGW : 0); if (rsel < 2 && sub < 9 && r1 < T) { nslot = sub < 8 ? PSLOT[(size_t)r1 * 8 + sub] : SHARED_BASE + r1; if (sub < 8) ngate = GATEV[(size_t)r1 * 8 + sub]; } }
#pragma unroll
        for (int half = 0; half < 2; ++half) {
            const int rw = row + half * NGW;
            if (rw < T) {
                const int b = rw / SEQ;
                float* o0 = out + (size_t)rw * DM + 8 * lane; float* o1 = o0 + 512;
                const bf16_t* xr = (const bf16_t*)(a.ws + WS_X1B) + (size_t)rw * DM + 8 * lane;
                const u32x4 xw0 = __builtin_nontemporal_load((const u32x4*)xr), xw1 = __builtin_nontemporal_load((const u32x4*)(xr + 512));
                const f32x4 xa = {bflo(xw0.x), bfhi(xw0.x), bflo(xw0.y), bfhi(xw0.y)}, xb = {bflo(xw0.z), bfhi(xw0.z), bflo(xw0.w), bfhi(xw0.w)}, xc = {bflo(xw1.x), bfhi(xw1.x), bflo(xw1.y), bfhi(xw1.y)}, xd = {bflo(xw1.z), bfhi(xw1.z), bflo(xw1.w), bfhi(xw1.w)};
                float acc[16];
#pragma unroll
                for (int i = 0; i < 16; ++i) acc[i] = 0.f;
                u32x2 w0[9], w1[9];
#pragma unroll
                for (int k = 0; k < 9; ++k) { const int slot = __shfl(myslot, 16 * half + k); const unsigned char* yp = YP + (size_t)slot * DM; w0[k] = __builtin_nontemporal_load((const u32x2*)(yp + 8 * lane)); w1[k] = __builtin_nontemporal_load((const u32x2*)(yp + 512 + 8 * lane)); }
#pragma unroll
                for (int k = 0; k < 9; ++k) { const float gk = __shfl(mygate, 16 * half + k);
                    { const auto a0 = __builtin_amdgcn_cvt_pk_f32_fp8((int)w0[k].x, false), a1 = __builtin_amdgcn_cvt_pk_f32_fp8((int)w0[k].x, true), a2 = __builtin_amdgcn_cvt_pk_f32_fp8((int)w0[k].y, false), a3 = __builtin_amdgcn_cvt_pk_f32_fp8((int)w0[k].y, true);
                      acc[0] += gk * a0[0]; acc[1] += gk * a0[1]; acc[2] += gk * a1[0]; acc[3] += gk * a1[1]; acc[4] += gk * a2[0]; acc[5] += gk * a2[1]; acc[6] += gk * a3[0]; acc[7] += gk * a3[1]; }
                    { const auto a0 = __builtin_amdgcn_cvt_pk_f32_fp8((int)w1[k].x, false), a1 = __builtin_amdgcn_cvt_pk_f32_fp8((int)w1[k].x, true), a2 = __builtin_amdgcn_cvt_pk_f32_fp8((int)w1[k].y, false), a3 = __builtin_amdgcn_cvt_pk_f32_fp8((int)w1[k].y, true);
                      acc[8] += gk * a0[0]; acc[9] += gk * a0[1]; acc[10] += gk * a1[0]; acc[11] += gk * a1[1]; acc[12] += gk * a2[0]; acc[13] += gk * a2[1]; acc[14] += gk * a3[0]; acc[15] += gk * a3[1]; } }
                const float* gf = MOD + b * 6144 + 5 * 1024 + 8 * lane;
                const f32x4 g0 = *(const f32x4*)gf * (1.f / 16.f), g1 = *(const f32x4*)(gf + 4) * (1.f / 16.f), g2 = *(const f32x4*)(gf + 512) * (1.f / 16.f), g3 = *(const f32x4*)(gf + 516) * (1.f / 16.f);
                f32x4 ya = xa, yb = xb, yc = xc, yd = xd;
                ya.x += g0.x * acc[0]; ya.y += g0.y * acc[1]; ya.z += g0.z * acc[2]; ya.w += g0.w * acc[3];
                yb.x += g1.x * acc[4]; yb.y += g1.y * acc[5]; yb.z += g1.z * acc[6]; yb.w += g1.w * acc[7];
                yc.x += g2.x * acc[8]; yc.y += g2.y * acc[9]; yc.z += g2.z * acc[10]; yc.w += g2.w * acc[11];
                yd.x += g3.x * acc[12]; yd.y += g3.y * acc[13]; yd.z += g3.z * acc[14]; yd.w += g3.w * acc[15];
                if (MODE == 0) { __builtin_nontemporal_store(ya, (f32x4*)o0); __builtin_nontemporal_store(yb, (f32x4*)(o0 + 4)); __builtin_nontemporal_store(yc, (f32x4*)o1); __builtin_nontemporal_store(yd, (f32x4*)(o1 + 4)); }
                else asm volatile("" :: "v"(ya), "v"(yb), "v"(yc), "v"(yd));
            }
        }
    }
}

#define LAS __attribute__((address_space(3)))
#define XB_TMO      128
#define XB_XCNT(j)  (256  + 64 * (j))
#define XB_XSUB(j)  (1280 + 64 * (j))
#define XB_XGEN(j)  (2304 + 64 * (j))
#define XB_TOP      3328
#define XB_TOPGEN   3392
#define XB_SPIN_CAP (1u << 27)
__device__ __forceinline__ unsigned xb_ld(unsigned* p)              { return __hip_atomic_load(p, __ATOMIC_RELAXED, __HIP_MEMORY_SCOPE_AGENT); }
__device__ __forceinline__ unsigned xb_add(unsigned* p, unsigned v) { return __hip_atomic_fetch_add(p, v, __ATOMIC_RELAXED, __HIP_MEMORY_SCOPE_AGENT); }
__device__ __forceinline__ unsigned xb_xcc_id() { return (unsigned)__builtin_amdgcn_s_getreg((3 << 11) | 20) & 0xFu; }
#define XB_SPIN(cond, bar) do { unsigned _sp = 0; while (cond) { __builtin_amdgcn_s_sleep(1); \
    if ((++_sp & 255u) == 0u) { if (xb_ld(&(bar)[XB_TMO])) break; if (_sp > XB_SPIN_CAP) { atomicAdd(&(bar)[XB_TMO], 1u); break; } } } } while (0)
struct XcdBarrier { unsigned* bar; unsigned x; volatile LAS unsigned* st; };
__device__ __forceinline__ XcdBarrier xcd_barrier_post(unsigned* bar, volatile LAS unsigned* st, const bool t0) {
    XcdBarrier b; b.bar = bar; b.x = xb_xcc_id(); b.st = st;
    if (t0) (void)xb_add(&bar[XB_XCNT(b.x)], 1u);
    return b;
}
__device__ __forceinline__ void xcd_barrier_complete(unsigned* bar, unsigned x, unsigned& nloc, unsigned& nx) {
    const unsigned G = gridDim.x * gridDim.y * gridDim.z;
    unsigned sum, cnt, mine, sp = 0u;
    for (;;) {
        sum = 0u; cnt = 0u; mine = 0u;
#pragma unroll
        for (unsigned j = 0; j < 16; ++j) { const unsigned c = xb_ld(&bar[XB_XCNT(j)]); sum += c; cnt += (c > 0u) ? 1u : 0u; mine = (j == x) ? c : mine; }
        if (sum == G) break;
        __builtin_amdgcn_s_sleep(1);
        if ((++sp & 255u) == 0u) { if (xb_ld(&bar[XB_TMO])) break; if (sp > XB_SPIN_CAP) { atomicAdd(&bar[XB_TMO], 1u); break; } }
    }
    nloc = mine > 0u ? mine : 1u; nx = cnt > 0u ? cnt : 1u;
}
__device__ __forceinline__ void xcd_barrier(const XcdBarrier& b, const bool t0) {
    asm volatile("s_waitcnt vmcnt(0)" ::: "memory");
    __syncthreads();
    if (t0) {
        unsigned* bar = b.bar;
        __builtin_amdgcn_s_waitcnt(0);
        unsigned nloc = b.st[0], nx = b.st[1];
        if (nloc == 0u) { xcd_barrier_complete(bar, b.x, nloc, nx); b.st[0] = nloc; b.st[1] = nx; }
        const unsigned old = xb_add(&bar[XB_XSUB(b.x)], 1u);
        const unsigned gen = old / nloc;
        if (old + 1u == (gen + 1u) * nloc) {
            __builtin_amdgcn_fence(__ATOMIC_RELEASE, "agent");
            asm volatile("s_waitcnt vmcnt(0)" ::: "memory");
            const unsigned og = xb_add(&bar[XB_TOP], 1u);
            const unsigned tg = og / nx;
            if (og + 1u == (tg + 1u) * nx) xb_add(&bar[XB_TOPGEN], 1u);
            else XB_SPIN(xb_ld(&bar[XB_TOPGEN]) == tg, bar);
            __builtin_amdgcn_fence(__ATOMIC_ACQUIRE, "agent");
            xb_add(&bar[XB_XGEN(b.x)], 1u);
            asm volatile("s_waitcnt vmcnt(0)" ::: "memory");
        } else {
            XB_SPIN(xb_ld(&bar[XB_XGEN(b.x)]) == gen, bar);
            __builtin_amdgcn_fence(__ATOMIC_ACQUIRE, "agent");
            asm volatile("s_waitcnt vmcnt(0)" ::: "memory");
        }
    }
    __syncthreads();
}


__global__ void __launch_bounds__(512) mega(Args a) {
    extern __shared__ __attribute__((aligned(16))) unsigned char lds[];
    const int lo = a.ph_lo, hi = a.ph_hi;
    const int wave_s = __builtin_amdgcn_readfirstlane((int)threadIdx.x >> 6);
#define tid mk_tid(wave_s)
    volatile LAS unsigned* bst = (volatile LAS unsigned*)((LAS unsigned char*)lds + (LDS_BYTES - 64));
    if (tid < 16) bst[tid] = 0u;
    __syncthreads();
    XcdBarrier bar = xcd_barrier_post((unsigned*)(a.ws + WS_BAR), bst, tid == 0);
#define IN(k) (lo <= (k) && (k) < hi)
#define SEAM(k) do { if (IN(k) && IN((k) + 1)) xcd_barrier(bar, tid == 0); } while (0)

    if (IN(0)) { ph0(a, lds, tid); } SEAM(0);
    if (IN(1)) {
        {
            const float* MOD = (const float*)(a.ws + WS_MOD); const bf16_t* WR = (const bf16_t*)(a.ws + WS_WRS); bf16_t* WRB = (bf16_t*)(a.ws + WS_WRB); float* CB = (float*)(a.ws + WS_CB);
            for (int it = (int)blockIdx.x * 512 + tid; it < 4 * 256 * 128; it += (int)gridDim.x * 512) { const int b = it >> 15, n = (it >> 7) & 255, k8 = (it & 127) * 8;
                float w[8]; unpack8(*(const u32x4*)(WR + (size_t)n * 1024 + k8), w); const float* sc = MOD + b * 6144 + 4 * 1024 + k8;
#pragma unroll
                for (int q = 0; q < 8; ++q) w[q] *= 1.f + sc[q];
                *(u32x4*)(WRB + ((size_t)b * 256 + n) * 1024 + k8) = pack8(w); }
            const int lane_ = tid & 63;
            for (int o = (int)blockIdx.x * 8 + (tid >> 6); o < 4 * 256; o += (int)gridDim.x * 8) { const int b = o >> 8, n = o & 255; const float* sh = MOD + b * 6144 + 3 * 1024; float acc = 0.f;
#pragma unroll
                for (int j = 0; j < 2; ++j) { float w[8]; unpack8(*(const u32x4*)(WR + (size_t)n * 1024 + 512 * j + 8 * lane_), w);
#pragma unroll
                    for (int q = 0; q < 8; ++q) acc += w[q] * sh[512 * j + 8 * lane_ + q]; }
                acc = wave_sum(acc); if (lane_ == 0) CB[o] = acc; }
        }
        ph_norm<true>(a, lds, a.in[0], 0, 1, tid); } SEAM(1);
    if (IN(2)) {
        float* gtab = (float*)(lds + 135168);
        { const int t_ = tid; if (t_ < 64) gtab[t_] = a.in[9][t_] * C2; else if (t_ < 128) gtab[t_] = a.in[10][t_ - 64]; }
        const EpiProj E{(bf16_t*)(a.ws + WS_PROJ), gtab};
        { pg8::DenseSched S; S.init(a.ws + WS_H8, a.ws + WS_WIN, T, NPROJ, DM, (int)gridDim.x, (int)blockIdx.x); __syncthreads();
          pg8::gemm_phase<false, true, 0x79797979, 0x7f7f7f7f, 2>((PG8_LAS unsigned char*)lds, DM, S, E); }
    } SEAM(2);
    if (IN(3)) { for (int u = blockIdx.x; u < 1024; u += gridDim.x) mlstm_m1_unit(a, lds, u, wave_s);
 } SEAM(3);
    if (IN(4)) { mlstm_m2(a, tid); } SEAM(4);
    if (IN(5)) {
        { float lam, m0;
          { const int l_ = tid & 63; const float p1 = a.in[11][l_] * a.in[12][l_], p2 = a.in[13][l_] * a.in[14][l_];
            const unsigned gqb = __float_as_uint(fabsf(a.in[9][l_])), gkb = __float_as_uint(fabsf(a.in[10][l_]));
            lam = expf(wave_sum(p1)) - expf(wave_sum(p2)) + LAM_INIT;
            m0 = 64.f * C2 * __uint_as_float(wave_umax(gqb)) * __uint_as_float(wave_umax(gkb)) * 1.01f + 0.01f; }
          unsigned* qhead = (unsigned*)(a.ws + WS_BAR) + 4001;
          const attn_body::CvCtx cx{a.in[19], a.in[20], a.in[21], (unsigned char*)(a.ws + WS_W13T), (unsigned char*)(a.ws + WS_W2T)};
          const int cper = (attn_body::CV_GROUPS + (int)gridDim.x - 1) / (int)gridDim.x;
          int cnext = min(attn_body::CV_GROUPS, (int)blockIdx.x * cper); const int cend = min(attn_body::CV_GROUPS, cnext + cper);
          if (tid < 64) {
              const int jj0 = (tid & 31) - 8 * (tid >> 5), jj1 = jj0 - 16; u32x4 w0, w1;
#define IDW(jj, q) (((jj) >= 0 && (jj) < 8 && ((jj) >> 1) == (q)) ? (((jj) & 1) ? 0x42800000u : 0x00004280u) : 0u)
              w0 = (u32x4){IDW(jj0, 0), IDW(jj0, 1), IDW(jj0, 2), IDW(jj0, 3)}; w1 = (u32x4){IDW(jj1, 0), IDW(jj1, 1), IDW(jj1, 2), IDW(jj1, 3)};
#undef IDW
              u32x4* idt = (u32x4*)((char*)lds + attn_body::A2_IDT) + 2 * tid; idt[0] = w0; idt[1] = w1; }
          if (tid < 128) ((float*)((char*)lds + attn_body::A2_DG))[tid] = a.in[15][tid];
          {   __syncthreads();
              if (tid == 0) bst[8] = atomicAdd(qhead, 1u);
              __syncthreads();
              int idx = (int)bst[8];
              while (idx < 1024) {
                  const int qb = 63 - (idx >> 4), j = idx & 15, bh = (j & 3) * 4 + (3 - (j >> 2));
                  cnext = attn_body::attn2_unit((const attn_body::bf16*)(a.ws + WS_PROJ), a.in[15], (bf16_t*)(a.ws + WS_MIX), (char*)lds, bh, qb, lam, m0, cx, cnext, cend, qhead, bst + 8);
                  __syncthreads();
                  idx = (int)bst[8];
              }
          }
          {
              const int lane = tid & 63, wid = __builtin_amdgcn_readfirstlane(tid >> 6); const int r32 = lane & 31, hi = lane >> 5;
              if (cnext < cend) {
                  const attn_body::bf16x8* idt = (const attn_body::bf16x8*)((char*)lds + attn_body::A2_IDT) + 2 * lane; const attn_body::bf16x8 id0 = idt[0], id1 = idt[1];
#pragma unroll 1
                  for (; cnext + 3 < cend; cnext += 4) {
                      u32x4 c0, c1, c2, c3, d0, d1, d2, d3, e0, e1, e2, e3, f0, f1, f2, f3;
                      attn_body::cv_issue(cx, cnext, wid, lane, c0, c1, c2, c3); attn_body::cv_issue(cx, cnext + 1, wid, lane, d0, d1, d2, d3);
                      attn_body::cv_issue(cx, cnext + 2, wid, lane, e0, e1, e2, e3); attn_body::cv_issue(cx, cnext + 3, wid, lane, f0, f1, f2, f3);
                      attn_body::cv_consume(cx, cnext, wid, lane, c0, c1, c2, c3, id0, id1); attn_body::cv_consume(cx, cnext + 1, wid, lane, d0, d1, d2, d3, id0, id1);
                      attn_body::cv_consume(cx, cnext + 2, wid, lane, e0, e1, e2, e3, id0, id1); attn_body::cv_consume(cx, cnext + 3, wid, lane, f0, f1, f2, f3, id0, id1); }
#pragma unroll 1
                  for (; cnext < cend; ++cnext) { u32x4 c0, c1, c2, c3; attn_body::cv_issue(cx, cnext, wid, lane, c0, c1, c2, c3); attn_body::cv_consume(cx, cnext, wid, lane, c0, c1, c2, c3, id0, id1); }
              }
          }
          __syncthreads();
          {
              __syncthreads();
              if (tid == 0) bst[8] = atomicAdd(qhead + 1, 1u);
              __syncthreads();
              int u = (int)bst[8];
              M3In r;
              if (u < 1024) m3_issue(a, u, tid, r);
              while (u < 1024) { mlstm_m3_unit(a, lds, u, wave_s, r, qhead + 1, bst + 9); u = (int)bst[9]; __syncthreads(); }
          }
          __syncthreads(); }
    } SEAM(5);
    if (IN(6)) {
        const EpiOut E{a.in[0], (bf16_t*)(a.ws + WS_X1B), (const float*)(a.ws + WS_MOD)};
        { pg8::DenseSched S; S.init(a.ws + WS_MIX, a.ws + WS_WOUT, T, DM, DM, (int)gridDim.x, (int)blockIdx.x); __syncthreads();
          pg8::gemm_phase<false, true, 0x79797979, 0x7c7c7c7c, 0>((PG8_LAS unsigned char*)lds, DM, S, E); }
    } SEAM(6);
    if (IN(7)) { ph_norm<false>(a, lds, a.out, 3, 4, tid); } SEAM(7);
    if (IN(8)) {
        const int G2 = (int)gridDim.x / 2, bx = (int)blockIdx.x;
        { const EpiRouter ER{(float*)(a.ws + WS_LOGITS), (const float*)(a.ws + WS_RSTD), (const float*)(a.ws + WS_CB)};
          RouterSched S; S.d.init(a.ws + WS_X1B, a.ws + WS_WRB, T, 256, 2 * DM, G2, bx < G2 ? bx : (1 << 28)); __syncthreads();
          pg8::gemm_phase<false, false, 0, 0, 0>((PG8_LAS unsigned char*)lds, 2 * DM, S, ER); }
        __syncthreads();
        { const EpiSh E2{(bf16_t*)(a.ws + WS_ACT)};
          pg8::DenseSched S; S.init(a.ws + WS_H8, a.ws + WS_WS13F8, T, 512, DM, (int)gridDim.x - G2, bx >= G2 ? bx - G2 : (1 << 28)); __syncthreads();
          pg8::gemm_phase<false, true, 0x79797979, 0x7f7f7f7f, 0>((PG8_LAS unsigned char*)lds, DM, S, E2); }
    } SEAM(8);
    if (IN(9)) { ph_route(a, lds, tid); } SEAM(9);
    if (IN(10)) { ph_scatter(a, lds, tid); } SEAM(10);
    if (IN(11)) {
        const int* TILE = (const int*)(a.ws + WS_TILE); const int ntile = TILE[0];
        const EpiG1 E{(const float*)(a.ws + WS_SLOTGATE), (bf16_t*)(a.ws + WS_ACT)};
        { const int G = (int)gridDim.x, bx = (int)blockIdx.x, vcu = (G % 8 == 0) ? (bx % 8) * (G / 8) + bx / 8 : bx;
          const pg8::ExpertSched S{TILE, ntile * 2, 2, (const char*)(a.ws + WS_H8), (const int*)(a.ws + WS_SLOTTOK), (const char*)(a.ws + WS_W13T), (size_t)512 * 1024, DM, G, vcu, (const PG8_LAS int*)((PG8_LAS unsigned char*)lds + pg8::ExpertSched::UC_OFF)};
          S.fill((PG8_LAS unsigned char*)lds, tid);
          __syncthreads(); pg8::gemm_phase<true, true, 0x79797979, 0x7f7f7f7f, 0>((PG8_LAS unsigned char*)lds, DM, S, E); }
    } SEAM(11);
    if (IN(12)) {
        const int* TILE = (const int*)(a.ws + WS_TILE); const int ntile = TILE[0] + 128;
        const EpiG2 E{(bf16_t*)(a.ws + WS_YP)};
        { const int G = (int)gridDim.x, bx = (int)blockIdx.x, vcu = (G % 8 == 0) ? (bx % 8) * (G / 8) + bx / 8 : bx;
          const pg8::ExpertSched S{TILE, ntile * 4, 4, (const char*)(a.ws + WS_ACT), nullptr, (const char*)(a.ws + WS_W2T), (size_t)1024 * 256, 256, G, vcu, (const PG8_LAS int*)((PG8_LAS unsigned char*)lds + pg8::ExpertSched::UC_OFF)};
          S.fill((PG8_LAS unsigned char*)lds, tid);
          __syncthreads(); pg8::gemm_phase<false, true, 0x79797979, 0x7c7c7c7c, 1>((PG8_LAS unsigned char*)lds, 256, S, E); }
    } SEAM(12);
    if (IN(13)) {
        ph_final<0>(a, tid); }
#undef IN
#undef SEAM
#undef tid
}

extern "C" void kernel_launch(void* const* d_in, const int* in_sizes, int n_in, void* d_out, int out_size, void* d_ws, size_t ws_size, hipStream_t stream) {
    static int grid = 0;
    if (grid == 0) {
        if (n_in != 25 || in_sizes[0] != T * DM || out_size != T * DM || ws_size < WS_END) {
            fprintf(stderr, "kernel_launch: unexpected problem (n_in %d, in0 %d, out %d, ws %zu < %zu)\n", n_in, n_in > 0 ? in_sizes[0] : -1, out_size, ws_size, (size_t)WS_END); grid = -1; return; }
        int dev = 0, cus = 0, per_cu = 0;
        (void)hipGetDevice(&dev);
        (void)hipDeviceGetAttribute(&cus, hipDeviceAttributeMultiprocessorCount, dev);
        if (hipFuncSetAttribute((const void*)mega, hipFuncAttributeMaxDynamicSharedMemorySize, LDS_BYTES) != hipSuccess) { fprintf(stderr, "kernel_launch: hipFuncSetAttribute failed\n"); grid = -1; return; }
        if (hipOccupancyMaxActiveBlocksPerMultiprocessor(&per_cu, (const void*)mega, 512, LDS_BYTES) != hipSuccess || per_cu < 1) { fprintf(stderr, "kernel_launch: occupancy query says %d blocks/CU\n", per_cu); grid = -1; return; }
        grid = cus;
    }
    if (grid < 0) return;
    (void)hipMemsetAsync((char*)d_ws + WS_BAR, 0, BAR_BYTES, stream);
    Args a{};
    for (int i = 0; i < 25; ++i) a.in[i] = (const float*)d_in[i];
    a.out = (float*)d_out; a.ws = (unsigned char*)d_ws;
    a.ph_lo = 0; a.ph_hi = NPH;
    void* args[] = {&a};
    hipError_t e = hipLaunchCooperativeKernel((const void*)mega, dim3(grid), dim3(512), args, LDS_BYTES, stream);
    if (e != hipSuccess) fprintf(stderr, "cooperative launch failed: %s (grid %d)\n", hipGetErrorString(e), grid);
}
```
